# Optimizing an MI355X kernel written in HIP

```python
import jax, jax.numpy as jnp
from jax import lax
import numpy as np

D_MODEL = 1024
BATCH = 2
SEQ = 8192
DEPTH = 2
DEC_BATCH = 8
DEC_SEQ = 32
PAST_LEN = 2048

CHUNK = 64
N_MIXERS = 2
N_HEADS = 16
HEAD_DIM = D_MODEL // N_HEADS
PAST_CHUNKS = 8
REACH = PAST_CHUNKS * CHUNK
BAND = (PAST_CHUNKS + 1) * CHUNK
MAX_REL = 128
N_REL = 2 * MAX_REL + 1
MLP_BLOCK = 128
GMLP_WIDTH = D_MODEL
N_GROUPS = 16
GROUP_DIM = GMLP_WIDTH // N_GROUPS
D_FF = 2816
CONV_W = 3
N_A = (DEPTH + 1) // 2
N_B = DEPTH // 2
EPS = 1e-6
NEG = -1e30

kernel_name = "hybrid_chunk_band_attn_gmlp_convffn_step"


def rms_norm(x, g):
    xf = x.astype(jnp.float32)
    y = xf * lax.rsqrt(jnp.mean(xf * xf, axis=-1, keepdims=True) + EPS)
    return (y * g.astype(jnp.float32)).astype(x.dtype)


def rel_bias(table, rel):
    idx = jnp.clip(rel, -MAX_REL, MAX_REL) + MAX_REL
    return table[:, idx].astype(jnp.float32)


def qkv_heads(h, w_qkv):
    B, T, _ = h.shape
    q, k, v = jnp.split(h @ w_qkv, 3, axis=-1)
    shp = (B, T, N_HEADS, HEAD_DIM)
    return q.reshape(shp), k.reshape(shp), v.reshape(shp)


def band_attn_prompt(h, w_qkv, table, w_o):
    B, S, _ = h.shape
    nc = S // CHUNK
    q, k, v = qkv_heads(h, w_qkv)
    pad = ((0, 0), (REACH, 0), (0, 0), (0, 0))
    kpad, vpad = jnp.pad(k, pad), jnp.pad(v, pad)
    rel = jnp.arange(CHUNK)[:, None] - jnp.arange(BAND)[None, :] + REACH
    bias = rel_bias(table, rel)
    scale = HEAD_DIM ** -0.5

    def one_chunk(c):
        start = c * CHUNK
        q_c = lax.dynamic_slice_in_dim(q, start, CHUNK, axis=1)
        k_c = lax.dynamic_slice_in_dim(kpad, start, BAND, axis=1)
        v_c = lax.dynamic_slice_in_dim(vpad, start, BAND, axis=1)
        s = jnp.einsum('bqhd,bkhd->bhqk', q_c, k_c).astype(jnp.float32) * scale + bias
        valid = (start - REACH + jnp.arange(BAND)) >= 0
        s = jnp.where(valid, s, NEG)
        p = jax.nn.softmax(s, axis=-1).astype(v.dtype)
        return jnp.einsum('bhqk,bkhd->bqhd', p, v_c)

    o = lax.map(one_chunk, jnp.arange(nc))
    o = jnp.moveaxis(o, 0, 1).reshape(B, S, D_MODEL)
    keep = min(REACH, S)
    return o @ w_o, k[:, S - keep:], v[:, S - keep:]


def band_attn_sample(h, cache_k, cache_v, w_qkv, table, w_o):
    B, T, _ = h.shape
    ca = cache_k.shape[1]
    q, k, v = qkv_heads(h, w_qkv)
    k_all = jnp.concatenate([cache_k.astype(k.dtype), k], axis=1)
    v_all = jnp.concatenate([cache_v.astype(v.dtype), v], axis=1)
    qpos = PAST_LEN + jnp.arange(T)
    kpos = jnp.concatenate([PAST_LEN - ca + jnp.arange(ca), PAST_LEN + jnp.arange(T)])
    bias = rel_bias(table, qpos[:, None] - kpos[None, :])
    s = jnp.einsum('bqhd,bkhd->bhqk', q, k_all).astype(jnp.float32) * (HEAD_DIM ** -0.5) + bias
    p = jax.nn.softmax(s, axis=-1).astype(v.dtype)
    o = jnp.einsum('bhqk,bkhd->bqhd', p, v_all).reshape(B, T, D_MODEL)
    return o @ w_o, k, v


def chunk_causal_mask(n):
    pos = jnp.arange(n)
    return (pos[None, :] // CHUNK) <= (pos[:, None] // CHUNK)


def gmlp_proj(h, w_in, v_gain):
    z = jax.nn.gelu(h @ w_in, approximate=False)
    u, v = jnp.split(z, 2, axis=-1)
    return u, rms_norm(v, v_gain)


def gmlp_prompt(h, w_in, v_gain, w_s, b_s, w_out):
    B, S, _ = h.shape
    nb = S // MLP_BLOCK
    u, v = gmlp_proj(h, w_in, v_gain)
    ws = jnp.where(chunk_causal_mask(MLP_BLOCK), w_s, 0.0)
    vb = v.reshape(B, nb, MLP_BLOCK, N_GROUPS, GROUP_DIM)
    mixed = jnp.einsum('gpq,bnqgd->bnpgd', ws.astype(v.dtype), vb) + b_s.T[None, None, :, :, None].astype(v.dtype)
    return (u * mixed.reshape(B, S, GMLP_WIDTH)) @ w_out


def gmlp_sample(h, w_in, v_gain, w_s, b_s, w_out):
    B, T, _ = h.shape
    u, v = gmlp_proj(h, w_in, v_gain)
    ws = jnp.where(chunk_causal_mask(MLP_BLOCK), w_s, 0.0)[:, :T, :T]
    vb = v.reshape(B, T, N_GROUPS, GROUP_DIM)
    mixed = jnp.einsum('gpq,bqgd->bpgd', ws.astype(v.dtype), vb) + b_s[:, :T].T[None, :, :, None].astype(v.dtype)
    return (u * mixed.reshape(B, T, GMLP_WIDTH)) @ w_out, v


def conv_ffn(h, hist, w_up, conv_w, conv_b, w_down):
    a = h @ w_up
    T = a.shape[1]
    full = jnp.concatenate([hist.astype(a.dtype), a], axis=1)
    c = conv_b.astype(a.dtype)
    for j in range(CONV_W):
        c = c + full[:, j:j + T] * conv_w[j].astype(a.dtype)
    gate, val = jnp.split(c, 2, axis=-1)
    return (jax.nn.silu(gate) * val) @ w_down, full[:, -(CONV_W - 1):]


def setup_inputs(seed: int = 0) -> dict:
    key = jax.random.key(seed)
    ks = jax.random.split(key, 24)
    nrm = lambda k, shp, s: jax.random.normal(k, shp, jnp.float32) * s
    ca = min(REACH, PAST_LEN)
    return {
        "x_prompt": nrm(ks[0], (BATCH, SEQ, D_MODEL), 1.0),
        "x_sample": nrm(ks[1], (DEC_BATCH, DEC_SEQ, D_MODEL), 1.0),
        "cache_a_k": nrm(ks[2], (N_A, DEC_BATCH, ca, N_HEADS, HEAD_DIM), 1.0),
        "cache_a_v": nrm(ks[3], (N_A, DEC_BATCH, ca, N_HEADS, HEAD_DIM), 1.0),
        "state_ffn_conv": nrm(ks[4], (DEPTH, DEC_BATCH, CONV_W - 1, 2 * D_FF), 1.0),
        "ln_mix": 1.0 + nrm(ks[5], (DEPTH, D_MODEL), 0.05),
        "ln_ffn": 1.0 + nrm(ks[6], (DEPTH, D_MODEL), 0.05),
        "ln_final": 1.0 + nrm(ks[7], (D_MODEL,), 0.05),
        "a_w_qkv": nrm(ks[8], (N_A, D_MODEL, 3 * D_MODEL), D_MODEL ** -0.5),
        "a_rel_bias": nrm(ks[9], (N_A, N_HEADS, N_REL), 0.5),
        "a_w_o": nrm(ks[10], (N_A, D_MODEL, D_MODEL), D_MODEL ** -0.5),
        "b_w_in": nrm(ks[11], (N_B, D_MODEL, 2 * GMLP_WIDTH), D_MODEL ** -0.5),
        "b_v_norm": 1.0 + nrm(ks[12], (N_B, GMLP_WIDTH), 0.05),
        "b_w_s": nrm(ks[13], (N_B, N_GROUPS, MLP_BLOCK, MLP_BLOCK), MLP_BLOCK ** -0.5),
        "b_bias_s": 1.0 + nrm(ks[14], (N_B, N_GROUPS, MLP_BLOCK), 0.1),
        "b_w_out": nrm(ks[15], (N_B, GMLP_WIDTH, D_MODEL), GMLP_WIDTH ** -0.5),
        "f_w_up": nrm(ks[16], (DEPTH, D_MODEL, 2 * D_FF), D_MODEL ** -0.5),
        "f_conv_w": nrm(ks[17], (DEPTH, CONV_W, 2 * D_FF), CONV_W ** -0.5),
        "f_conv_b": nrm(ks[18], (DEPTH, 2 * D_FF), 0.02),
        "f_w_down": nrm(ks[19], (DEPTH, D_FF, D_MODEL), D_FF ** -0.5),
    }


def reference(x_prompt, x_sample, cache_a_k, cache_a_v, state_ffn_conv,
              ln_mix, ln_ffn, ln_final,
              a_w_qkv, a_rel_bias, a_w_o,
              b_w_in, b_v_norm, b_w_s, b_bias_s, b_w_out,
              f_w_up, f_conv_w, f_conv_b, f_w_down):
    xp, xs = x_prompt, x_sample
    kp_l, vp_l, ks_l, vs_l, gv_l, cp_l, cs_l = [], [], [], [], [], [], []
    for i in range(DEPTH):
        j = i // N_MIXERS
        hp = rms_norm(xp, ln_mix[i])
        hs = rms_norm(xs, ln_mix[i])
        if i % N_MIXERS == 0:
            op, kp, vp = band_attn_prompt(hp, a_w_qkv[j], a_rel_bias[j], a_w_o[j])
            os_, kn, vn = band_attn_sample(hs, cache_a_k[j], cache_a_v[j], a_w_qkv[j], a_rel_bias[j], a_w_o[j])
            kp_l.append(kp); vp_l.append(vp); ks_l.append(kn); vs_l.append(vn)
        else:
            op = gmlp_prompt(hp, b_w_in[j], b_v_norm[j], b_w_s[j], b_bias_s[j], b_w_out[j])
            os_, gv = gmlp_sample(hs, b_w_in[j], b_v_norm[j], b_w_s[j], b_bias_s[j], b_w_out[j])
            gv_l.append(gv)
        xp = xp + op
        xs = xs + os_
        hp = rms_norm(xp, ln_ffn[i])
        hs = rms_norm(xs, ln_ffn[i])
        zero_hist = jnp.zeros((xp.shape[0], CONV_W - 1, 2 * D_FF), xp.dtype)
        fp, cp = conv_ffn(hp, zero_hist, f_w_up[i], f_conv_w[i], f_conv_b[i], f_w_down[i])
        fs, cs = conv_ffn(hs, state_ffn_conv[i], f_w_up[i], f_conv_w[i], f_conv_b[i], f_w_down[i])
        cp_l.append(cp); cs_l.append(cs)
        xp = xp + fp
        xs = xs + fs
    y_prompt = rms_norm(xp, ln_final)
    y_sample = rms_norm(xs, ln_final)
    return (y_prompt, y_sample, jnp.stack(kp_l), jnp.stack(vp_l), jnp.stack(ks_l), jnp.stack(vs_l),
            jnp.stack(gv_l), jnp.stack(cp_l), jnp.stack(cs_l))
```

```cpp
#include <hip/hip_runtime.h>
#include <hip/hip_cooperative_groups.h>
#include <cstdio>
#include <cstdint>
namespace cg = cooperative_groups;

#define LAS __attribute__((address_space(3)))
typedef unsigned short bf16_t;
typedef short bf16x8 __attribute__((ext_vector_type(8)));
typedef short s16x4 __attribute__((ext_vector_type(4)));
typedef float f32x2 __attribute__((ext_vector_type(2)));
typedef float f32x4 __attribute__((ext_vector_type(4)));
typedef float f32x16 __attribute__((ext_vector_type(16)));
typedef unsigned u32x2 __attribute__((ext_vector_type(2)));
typedef unsigned u32x4 __attribute__((ext_vector_type(4)));

constexpr int D = 1024, SEQ = 8192, NB = 2, MP = NB * SEQ, DB = 8, DT = 32, MS = DB * DT, MT = MP + MS;
constexpr int NH = 16, HD = 64, FF = 2816, FF2 = 5632, CA = 512, NREL = 257;
constexpr float EPS = 1e-6f, LOG2E = 1.4426950408889634f, C2 = 0.125f * LOG2E;
constexpr int NWAVES = 8, NTHR = 512;

constexpr size_t MiB = 1u << 20;
constexpr size_t WS_CTL = 0;
constexpr size_t WS_WQKV = 1 * MiB, WS_WO = 7 * MiB, WS_WIN = 9 * MiB, WS_WOUT = 13 * MiB, WS_WUP = 15 * MiB, WS_WDN = 37 * MiB;
constexpr size_t WUP_L = (size_t)FF2 * D * 2, WDN_L = (size_t)D * FF * 2;
constexpr size_t WS_XB = 48 * MiB + 65536;
constexpr size_t WS_Q = 82 * MiB, WS_K = 116 * MiB, WS_V = 150 * MiB;
constexpr size_t WS_G = 82 * MiB;
constexpr size_t WS_CK = 184 * MiB, WS_CV = 192 * MiB;
constexpr size_t WS_SSQ = 200 * MiB;
constexpr size_t WS_SSQV = 201 * MiB;
constexpr size_t WS_SSQS = 202 * MiB;
constexpr size_t WS_SSQVS = 202 * MiB + 65536;
constexpr size_t WS_END = 203 * MiB;

constexpr size_t O_YP = 0, O_YS = O_YP + (size_t)MP * D, O_KP = O_YS + (size_t)MS * D, O_VP = O_KP + (size_t)NB * CA * D, O_KS = O_VP + (size_t)NB * CA * D,
                 O_VS = O_KS + (size_t)MS * D, O_GV = O_VS + (size_t)MS * D, O_CP = O_GV + (size_t)MS * D, O_CS = O_CP + (size_t)2 * NB * 2 * FF2, O_END = O_CS + (size_t)2 * DB * 2 * FF2;

constexpr int RING_BYTES = 131072;
constexpr int L_XBUF = 131072, L_RSTAB = 139264, L_PTAB = 140288;
constexpr int LDS_BYTES = 155648;

__device__ __forceinline__ unsigned cvt_pk_bf16(float lo, float hi) { unsigned r; asm volatile("v_cvt_pk_bf16_f32 %0, %1, %2" : "=v"(r) : "v"(lo), "v"(hi)); return r; }
__device__ __forceinline__ float bf2f(unsigned h) { return __uint_as_float(h << 16); }
__device__ __forceinline__ int crow(int r, int hi) { return (r & 3) + 8 * (r >> 2) + 4 * hi; }
#define LDS_WAIT() asm volatile("s_waitcnt lgkmcnt(0)" ::: "memory")
#define VM_WAIT() asm volatile("s_waitcnt vmcnt(0)" ::: "memory")
#define RAW_BAR() do { asm volatile("s_waitcnt lgkmcnt(0)" ::: "memory"); __builtin_amdgcn_s_barrier(); asm volatile("" ::: "memory"); } while (0)
__device__ __forceinline__ float wave_sum(float v) {
#pragma unroll
    for (int o = 1; o < 64; o <<= 1) v += __shfl_xor(v, o);
    return v;
}
__device__ __forceinline__ f32x2 gelu_pk(f32x2 v) {
    const f32x2 av = __builtin_elementwise_abs(v), d = av * 0.2316418882f + 1.0f;
    f32x2 t; t.x = __builtin_amdgcn_rcpf(d.x); t.y = __builtin_amdgcn_rcpf(d.y);
    f32x2 q = t * 0.5307027145f + (-0.7265760135f); q = q * t + 0.7107068705f; q = q * t + (-0.142248368f); q = q * t + 0.127414796f; q = q * t;
    const f32x2 s = (v * v) * (-0.72134752044f);
    f32x2 e; e.x = __builtin_amdgcn_exp2f(s.x); e.y = __builtin_amdgcn_exp2f(s.y);
    const f32x2 m = v * (q * e), r = v - m;
    f32x2 o; o.x = v.x < 0.f ? m.x : r.x; o.y = v.y < 0.f ? m.y : r.y; return o;
}
__device__ __forceinline__ float gelu1(float x) { f32x2 r = gelu_pk((f32x2){x, x}); return r.x; }
__device__ __forceinline__ float silu1(float x) { return x * __builtin_amdgcn_rcpf(1.0f + __builtin_amdgcn_exp2f(-x * LOG2E)); }

namespace pg8 {
constexpr int BM = 256, BK = 64, HALF = 128, HTB = HALF * BK * 2, NXCD = 8, WGM = 8;
__host__ __device__ __forceinline__ int lds_byte(int r, int c) { const int st = (r >> 4) * 2 + (c >> 5), rr = r & 15, cc = c & 31, ob = rr * 64 + cc * 2; return st * 1024 + (ob ^ (((ob >> 9) & 1) << 5)); }
__host__ __device__ __forceinline__ void stage_rc(int b, int& R, int& C) { const int st = b / 1024, sb = b % 1024, swz = sb ^ (((sb >> 9) & 1) << 5); R = (st >> 1) * 16 + swz / 64; C = (st & 1) * 32 + (swz % 64) / 2; }
__host__ __device__ __forceinline__ int perm32(int rho) { const int n = rho >> 4, i = rho & 15; return 8 * (i >> 2) + 4 * n + (i & 3); }

struct Unit { int pm, pn, arow; };
struct Gemm { const bf16_t* A; const bf16_t* Bt; int K; };

struct StaticOrder {
    int nM, nN, nwg, G, c, up;
    __device__ void init(int nM_, int nN_, int G_, int c_, int up_) { nM = nM_; nN = nN_; nwg = nM * nN; G = G_; c = c_; up = up_; }
    __device__ bool next(int i, Unit& u) const {
        const long L = (long)i * G + c; if (L >= nwg) return false;
        int wgid = (int)L; { const int q = nwg / NXCD, r = nwg % NXCD, xcd = wgid % NXCD, off = wgid / NXCD; wgid = (xcd < r ? xcd * (q + 1) : r * (q + 1) + (xcd - r) * q) + off; }
        const int nig = WGM * nN, gid = wgid / nig, fm = gid * WGM, gsz = (nM - fm) < WGM ? (nM - fm) : WGM;
        u.pm = fm + ((wgid % nig) % gsz); u.pn = (wgid % nig) / gsz;
        u.arow = up ? ((u.pm / 33) * SEQ + 254 * (u.pm % 33) - 2) : u.pm * BM;
        return true;
    }
};

template <class Epi, class Sched>
__device__ __forceinline__ void gemm_phase(LAS unsigned char* lds, const Gemm g, const Sched& S, const Epi& E, const int tid) {
    const int wid = __builtin_amdgcn_readfirstlane(tid >> 6), lane = tid & 63, wr = wid >> 2, wc = wid & 3, fr = lane & 15, fq = lane >> 4;
    const int K = g.K, nt = K / BK;
    unsigned voffA[2], voffB[2];
#pragma unroll
    for (int i = 0; i < 2; ++i) { int R, C; stage_rc(tid * 16 + i * 8192, R, C); const int Rb = Epi::PERM ? ((R & ~31) + perm32(R & 31)) : R;
        voffA[i] = (unsigned)(R * K + C) * 2u; voffB[i] = (unsigned)(Rb * K + C) * 2u; }
    const size_t kstep = (size_t)(BK * 2);
    const size_t hstep = (size_t)HALF * K * 2;
    const size_t tstep = 2 * hstep;
    const size_t rstep = (size_t)K * 2;
    const unsigned ldsw = (unsigned)wid * 1024u;
    const int aoff = lds_byte(wr * 64 + fr, fq * 8), boff = lds_byte(wc * 32 + fr, fq * 8);
#define PG8_SA(b, h) (((b) * 2 + (h)) * HTB)
#define PG8_SB(b, h) ((4 + (b) * 2 + (h)) * HTB)
#define PG8_STAGE(bufoff, gbase, voff) do { _Pragma("unroll") for (int _i = 0; _i < 2; ++_i) \
        __builtin_amdgcn_global_load_lds((const unsigned*)((const char*)(gbase) + (voff)[_i]), (LAS unsigned*)(lds + (bufoff) + ldsw + _i * 8192), 16, 0, 0); } while (0)
#define PG8_LDA(dst, b, h) do { _Pragma("unroll") for (int m = 0; m < 4; ++m) _Pragma("unroll") for (int k = 0; k < 2; ++k) dst[m][k] = *(const LAS bf16x8*)(lds + PG8_SA(b, h) + aoff + m * 2048 + k * 1024); } while (0)
#define PG8_LDB(dst, b, h) do { _Pragma("unroll") for (int n = 0; n < 2; ++n) _Pragma("unroll") for (int k = 0; k < 2; ++k) dst[n][k] = *(const LAS bf16x8*)(lds + PG8_SB(b, h) + boff + n * 2048 + k * 1024); } while (0)
#define PG8_MMA(ai, bj, At, Bt) do { __builtin_amdgcn_s_setprio(1); _Pragma("unroll") for (int m = 0; m < 4; ++m) _Pragma("unroll") for (int n = 0; n < 2; ++n) _Pragma("unroll") for (int k = 0; k < 2; ++k) \
        acc[ai][bj][m][n] = __builtin_amdgcn_mfma_f32_16x16x32_bf16(Bt[n][k], At[m][k], acc[ai][bj][m][n], 0, 0, 0); __builtin_amdgcn_s_setprio(0); } while (0)
#define PG8_WAIT_V(n) asm volatile("s_waitcnt vmcnt(" #n ")" ::: "memory")
#define PG8_WAIT_L(n) asm volatile("s_waitcnt lgkmcnt(" #n ")" ::: "memory")
#define PG8_BAR __builtin_amdgcn_s_barrier()
#define PG8_SCHED __builtin_amdgcn_sched_barrier(0)
    Unit cur, nxt; int ui = 0;
    if (!S.next(0, cur)) return;
    f32x4 acc[2][2][4][2];
#pragma unroll
    for (int a = 0; a < 2; ++a)
#pragma unroll
        for (int b = 0; b < 2; ++b)
#pragma unroll
            for (int m = 0; m < 4; ++m)
#pragma unroll
                for (int n = 0; n < 2; ++n) acc[a][b][m][n] = (f32x4){0.f, 0.f, 0.f, 0.f};
    bf16x8 At[4][2], B0[2][2], B1[2][2];
    const char* cA = (const char*)g.A + (ptrdiff_t)cur.arow * (ptrdiff_t)rstep; const char* cB = (const char*)g.Bt + (size_t)cur.pn * tstep;
    PG8_STAGE(PG8_SB(0, 0), cB, voffB); PG8_STAGE(PG8_SB(0, 1), cB + hstep, voffB); PG8_STAGE(PG8_SA(0, 0), cA, voffA); PG8_STAGE(PG8_SA(0, 1), cA + hstep, voffA);
    if (wr == 1) PG8_BAR;
    PG8_WAIT_V(2); PG8_BAR;
    PG8_STAGE(PG8_SB(1, 0), cB + kstep, voffB); PG8_STAGE(PG8_SA(1, 0), cA + kstep, voffA); PG8_STAGE(PG8_SB(1, 1), cB + hstep + kstep, voffB);
    PG8_WAIT_V(6); PG8_BAR;
    for (;;) {
        const bool has_next = S.next(ui + 1, nxt);
        const char* nA = has_next ? (const char*)g.A + (ptrdiff_t)nxt.arow * (ptrdiff_t)rstep : cA; const char* nB = has_next ? (const char*)g.Bt + (size_t)nxt.pn * tstep : cB;
        for (int t = 0; t < nt; t += 2) {
            const bool last = (t == nt - 2);
            const char* a1 = cA + (size_t)(t + 1) * kstep;
            const char* a2 = last ? nA : cA + (size_t)(t + 2) * kstep; const char* b2 = last ? nB : cB + (size_t)(t + 2) * kstep;
            const char* a3 = a2 + kstep; const char* b3 = b2 + kstep;
            PG8_LDB(B0, 0, 0); PG8_LDB(B1, 0, 1); PG8_SCHED; PG8_LDA(At, 0, 0); PG8_STAGE(PG8_SA(1, 1), a1 + hstep, voffA);
            PG8_WAIT_V(8); PG8_WAIT_L(0); PG8_BAR; PG8_MMA(0, 0, At, B0); PG8_MMA(0, 1, At, B1); PG8_BAR; PG8_SCHED;
            PG8_LDA(At, 0, 1); PG8_STAGE(PG8_SB(0, 0), b2, voffB); PG8_STAGE(PG8_SB(0, 1), b2 + hstep, voffB); PG8_STAGE(PG8_SA(0, 0), a2, voffA);
            PG8_WAIT_V(8); PG8_WAIT_L(0); PG8_BAR; PG8_MMA(1, 0, At, B0); PG8_MMA(1, 1, At, B1); PG8_BAR; PG8_SCHED;
            PG8_LDB(B0, 1, 0); PG8_LDB(B1, 1, 1); PG8_SCHED; PG8_LDA(At, 1, 0); PG8_STAGE(PG8_SA(0, 1), a2 + hstep, voffA);
            PG8_WAIT_V(8); PG8_WAIT_L(0); PG8_BAR; PG8_MMA(0, 0, At, B0); PG8_MMA(0, 1, At, B1); PG8_BAR; PG8_SCHED;
            PG8_LDA(At, 1, 1); PG8_STAGE(PG8_SB(1, 0), b3, voffB); PG8_STAGE(PG8_SB(1, 1), b3 + hstep, voffB); PG8_STAGE(PG8_SA(1, 0), a3, voffA);
            PG8_WAIT_V(8); PG8_WAIT_L(0); PG8_BAR; PG8_MMA(1, 0, At, B0); PG8_MMA(1, 1, At, B1); PG8_BAR; PG8_SCHED;
        }
        if (wr == 0) PG8_BAR;
        E(acc, cur, wr, wc, fr, fq, lds, tid);
        if (!has_next) break;
#pragma unroll
        for (int a = 0; a < 2; ++a)
#pragma unroll
            for (int b = 0; b < 2; ++b)
#pragma unroll
                for (int m = 0; m < 4; ++m)
#pragma unroll
                    for (int n = 0; n < 2; ++n) acc[a][b][m][n] = (f32x4){0.f, 0.f, 0.f, 0.f};
        cur = nxt; cA = nA; cB = nB; ++ui;
        if (wr == 1) PG8_BAR;
    }
    PG8_WAIT_V(0);
    PG8_BAR;
#undef PG8_SA
#undef PG8_SB
#undef PG8_STAGE
#undef PG8_LDA
#undef PG8_LDB
#undef PG8_MMA
#undef PG8_WAIT_V
#undef PG8_WAIT_L
#undef PG8_BAR
#undef PG8_SCHED
}
}

typedef f32x4 AccT[2][2][4][2];

__device__ __forceinline__ void rs_table(LAS unsigned char* lds, const float* ssq, int tok0, int tid) {
    LAS float* rst = (LAS float*)(lds + L_RSTAB);
    if (tid < 256) { int tok = tok0 + tid; tok = tok < 0 ? 0 : (tok >= MT ? MT - 1 : tok);
        const float s = (ssq[tok] + ssq[MT + tok]) + (ssq[2 * MT + tok] + ssq[3 * MT + tok]); rst[tid] = 1.0f / sqrtf(s * (1.0f / D) + EPS); }
    RAW_BAR();
}

struct EpiQKV {
    static constexpr bool PERM = true;
    bf16_t* O; size_t split_stride; const float* ssq; float* okp; float* ovp;
    __device__ __forceinline__ void operator()(const AccT& acc, const pg8::Unit& u, int wr, int wc, int fr, int fq, LAS unsigned char* lds, int tid) const {
        rs_table(lds, ssq, u.pm * 256, tid);
        const LAS float* rst = (const LAS float*)(lds + L_RSTAB);
        const int t = u.pn >> 2, colt = (u.pn & 3) * 256; bf16_t* base = O + (size_t)t * split_stride; const float sc = (t == 0) ? C2 : 1.0f;
        const bool side = (t >= 1) && ((u.pm & 31) >= 30);
        float* sp = (t == 1 ? okp : ovp) + ((size_t)((u.pm >> 5) * CA + (u.pm & 1) * 256)) * D;
        const int col0 = colt + wc * 32 + 8 * fq;
#pragma unroll
        for (int ai = 0; ai < 2; ++ai)
#pragma unroll
            for (int m = 0; m < 4; ++m) { const int r = ai * 128 + wr * 64 + m * 16 + fr; const float rs = rst[r] * sc; bf16_t* rowp = base + (size_t)(u.pm * 256 + r) * D + col0;
#pragma unroll
                for (int bj = 0; bj < 2; ++bj) { const f32x4 v0 = acc[ai][bj][m][0] * rs, v1 = acc[ai][bj][m][1] * rs;
                    u32x4 w; w.x = cvt_pk_bf16(v0[0], v0[1]); w.y = cvt_pk_bf16(v0[2], v0[3]); w.z = cvt_pk_bf16(v1[0], v1[1]); w.w = cvt_pk_bf16(v1[2], v1[3]);
                    *(u32x4*)(rowp + bj * 128) = w;
                    if (side) { float* s = sp + (size_t)r * D + col0 + bj * 128; *(f32x4*)s = v0; *(f32x4*)(s + 4) = v1; } } }
    }
};

struct EpiRes {
    static constexpr bool PERM = false;
    const float* base; float* out; bf16_t* xb; float* ssq;
    __device__ __forceinline__ void operator()(const AccT& acc, const pg8::Unit& u, int wr, int wc, int fr, int fq, LAS unsigned char* lds, int tid) const {
        LAS float* P = (LAS float*)(lds + L_PTAB);
        const int col0 = u.pn * 256 + wc * 32 + 4 * fq;
#pragma unroll
        for (int ai = 0; ai < 2; ++ai)
#pragma unroll
            for (int m = 0; m < 4; ++m) { const int r = ai * 128 + wr * 64 + m * 16 + fr; const size_t off = (size_t)(u.pm * 256 + r) * D + col0; float s = 0.f;
#pragma unroll
                for (int bj = 0; bj < 2; ++bj)
#pragma unroll
                    for (int n = 0; n < 2; ++n) { const f32x4 b = *(const f32x4*)(base + off + bj * 128 + n * 16); const f32x4 v = b + acc[ai][bj][m][n];
                        *(f32x4*)(out + off + bj * 128 + n * 16) = v; s += (v[0] * v[0] + v[1] * v[1]) + (v[2] * v[2] + v[3] * v[3]);
                        u32x2 w; w.x = cvt_pk_bf16(v[0], v[1]); w.y = cvt_pk_bf16(v[2], v[3]); *(u32x2*)(xb + off + bj * 128 + n * 16) = w; }
                s += __shfl_xor(s, 16); s += __shfl_xor(s, 32);
                if (fq == 0) P[r * 4 + wc] = s; }
        RAW_BAR();
        if (tid < 256) { const f32x4 p = *(const LAS f32x4*)(P + tid * 4); ssq[(size_t)u.pn * MT + u.pm * 256 + tid] = (p[0] + p[1]) + (p[2] + p[3]); }
    }
};

struct EpiIn {
    static constexpr bool PERM = true;
    bf16_t* O; size_t split_stride; const float* ssq; float* ssqv;
    __device__ __forceinline__ void operator()(const AccT& acc, const pg8::Unit& u, int wr, int wc, int fr, int fq, LAS unsigned char* lds, int tid) const {
        rs_table(lds, ssq, u.pm * 256, tid);
        const LAS float* rst = (const LAS float*)(lds + L_RSTAB); LAS float* P = (LAS float*)(lds + L_PTAB);
        const int t = u.pn >> 2, colt = (u.pn & 3) * 256; bf16_t* base = O + (size_t)t * split_stride;
        const int col0 = colt + wc * 32 + 8 * fq;
#pragma unroll
        for (int ai = 0; ai < 2; ++ai)
#pragma unroll
            for (int m = 0; m < 4; ++m) { const int r = ai * 128 + wr * 64 + m * 16 + fr; const float rs = rst[r]; bf16_t* rowp = base + (size_t)(u.pm * 256 + r) * D + col0; float s = 0.f;
#pragma unroll
                for (int bj = 0; bj < 2; ++bj) { const f32x4 x0 = acc[ai][bj][m][0] * rs, x1 = acc[ai][bj][m][1] * rs;
                    const f32x2 a = gelu_pk((f32x2){x0[0], x0[1]}), b = gelu_pk((f32x2){x0[2], x0[3]}), c = gelu_pk((f32x2){x1[0], x1[1]}), d = gelu_pk((f32x2){x1[2], x1[3]});
                    s += (a.x * a.x + a.y * a.y) + (b.x * b.x + b.y * b.y) + (c.x * c.x + c.y * c.y) + (d.x * d.x + d.y * d.y);
                    u32x4 w; w.x = cvt_pk_bf16(a.x, a.y); w.y = cvt_pk_bf16(b.x, b.y); w.z = cvt_pk_bf16(c.x, c.y); w.w = cvt_pk_bf16(d.x, d.y);
                    *(u32x4*)(rowp + bj * 128) = w; }
                if (t == 1) { s += __shfl_xor(s, 16); s += __shfl_xor(s, 32); if (fq == 0) P[r * 4 + wc] = s; } }
        if (t == 1) { RAW_BAR();
            if (tid < 256) { const f32x4 p = *(const LAS f32x4*)(P + tid * 4); ssqv[(size_t)(u.pn & 3) * MT + u.pm * 256 + tid] = (p[0] + p[1]) + (p[2] + p[3]); } }
    }
};

__device__ __forceinline__ float dpp_shr1(float v) { return __builtin_bit_cast(float, __builtin_amdgcn_update_dpp(0, __builtin_bit_cast(int, v), 0x111, 0xf, 0xf, true)); }
__device__ __forceinline__ float dpp_shr2(float v) { return __builtin_bit_cast(float, __builtin_amdgcn_update_dpp(0, __builtin_bit_cast(int, v), 0x112, 0xf, 0xf, true)); }
__device__ __forceinline__ float dpp_shl15(float v) { return __builtin_bit_cast(float, __builtin_amdgcn_update_dpp(0, __builtin_bit_cast(int, v), 0x10f, 0xf, 0xf, true)); }
__device__ __forceinline__ float dpp_shl14(float v) { return __builtin_bit_cast(float, __builtin_amdgcn_update_dpp(0, __builtin_bit_cast(int, v), 0x10e, 0xf, 0xf, true)); }

struct EpiUp {
    static constexpr bool PERM = true;
    bf16_t* G; const float* ssq; const float* cw; const float* cb; float* ocp;
    __device__ __forceinline__ void operator()(AccT& acc, const pg8::Unit& u, int wr, int wc, int fr, int fq, LAS unsigned char* lds, int tid) const {
        const int b = u.pm / 33, j = u.pm % 33, tok0 = u.arow;
        rs_table(lds, ssq, tok0, tid);
        const LAS float* rst = (const LAS float*)(lds + L_RSTAB); LAS float* xbuf = (LAS float*)(lds + L_XBUF);
#pragma unroll
        for (int ai = 0; ai < 2; ++ai)
#pragma unroll
            for (int m = 0; m < 4; ++m) { const float rs = rst[ai * 128 + wr * 64 + m * 16 + fr];
#pragma unroll
                for (int bj = 0; bj < 2; ++bj)
#pragma unroll
                    for (int n = 0; n < 2; ++n) acc[ai][bj][m][n] *= rs; }
        if (j == 0 && wr == 0 && fr < 2) {
#pragma unroll
            for (int bj = 0; bj < 2; ++bj)
#pragma unroll
                for (int n = 0; n < 2; ++n) acc[0][bj][0][n] = (f32x4){0.f, 0.f, 0.f, 0.f}; }
        const int cl = wc * 32 + 8 * fq;
        if (j == 32 && wr == 1 && fr < 2) {
#pragma unroll
            for (int bj = 0; bj < 2; ++bj)
#pragma unroll
                for (int n = 0; n < 2; ++n) *(f32x4*)(ocp + (size_t)(b * 2 + fr) * FF2 + bj * FF + u.pn * 128 + cl + 4 * n) = acc[0][bj][0][n]; }
        if (fr >= 14) {
#pragma unroll
            for (int ai = 0; ai < 2; ++ai)
#pragma unroll
                for (int bj = 0; bj < 2; ++bj)
#pragma unroll
                    for (int n = 0; n < 2; ++n) *(LAS f32x4*)(xbuf + ((2 * ai + wr) * 2 + (fr - 14)) * 256 + bj * 128 + cl + 4 * n) = acc[ai][bj][3][n]; }
        RAW_BAR();
        const int bend = (b + 1) * SEQ;
#pragma unroll
        for (int n = 0; n < 2; ++n) {
            f32x4 w0[2], w1[2], w2[2], cbv[2];
#pragma unroll
            for (int bj = 0; bj < 2; ++bj) { const int oc = bj * FF + u.pn * 128 + cl + 4 * n;
                w0[bj] = *(const f32x4*)(cw + oc); w1[bj] = *(const f32x4*)(cw + FF2 + oc); w2[bj] = *(const f32x4*)(cw + 2 * FF2 + oc); cbv[bj] = *(const f32x4*)(cb + oc); }
#pragma unroll
            for (int ai = 0; ai < 2; ++ai) {
                const int ps = (2 * ai + wr + 3) & 3;
#pragma unroll
                for (int m = 3; m >= 0; --m) {
                    f32x4 c[2];
#pragma unroll
                    for (int bj = 0; bj < 2; ++bj) {
                        const f32x4 cur = acc[ai][bj][m][n];
                        f32x4 prv; if (m > 0) prv = acc[ai][bj][m - 1][n]; else prv = *(const LAS f32x4*)(xbuf + (ps * 2 + (fr & 1)) * 256 + bj * 128 + cl + 4 * n);
                        f32x4 o;
#pragma unroll
                        for (int e = 0; e < 4; ++e) { float v = cbv[bj][e] + w2[bj][e] * cur[e];
                            v += w1[bj][e] * (dpp_shr1(cur[e]) + dpp_shl15(prv[e]));
                            v += w0[bj][e] * (dpp_shr2(cur[e]) + dpp_shl14(prv[e])); o[e] = v; }
                        c[bj] = o; }
                    const int tr = ai * 128 + wr * 64 + m * 16 + fr, tok = tok0 + tr;
                    if (tr >= 2 && tok < bend) {
                        u32x2 w;
                        w.x = cvt_pk_bf16(silu1(c[0][0]) * c[1][0], silu1(c[0][1]) * c[1][1]); w.y = cvt_pk_bf16(silu1(c[0][2]) * c[1][2], silu1(c[0][3]) * c[1][3]);
                        *(u32x2*)(G + (size_t)tok * FF + u.pn * 128 + cl + 4 * n) = w; }
                }
            }
        }
    }
};

constexpr int L_SPART = 0, L_SC = 32768, L_SRS = 40960;
template <int K, class BRow>
__device__ __forceinline__ void stask_mm(LAS unsigned char* lds, const bf16_t* A, int arow0, const bf16_t* Bt, BRow brow, const int tid) {
    const int lane = tid & 63, r32 = lane & 31, hi = lane >> 5, w = tid >> 6;
    constexpr int KW = K / 8, NK = KW / 16;
    const bf16_t* ap = A + (size_t)(arow0 + r32) * K + w * KW + hi * 8;
    const bf16_t* bp = Bt + (size_t)brow(r32) * K + w * KW + hi * 8;
    f32x16 acc;
#pragma unroll
    for (int r = 0; r < 16; ++r) acc[r] = 0.f;
#pragma unroll 11
    for (int ks = 0; ks < NK; ++ks) { const bf16x8 a = *(const bf16x8*)(ap + ks * 16), b = *(const bf16x8*)(bp + ks * 16); acc = __builtin_amdgcn_mfma_f32_32x32x16_bf16(a, b, acc, 0, 0, 0); }
    LAS float* part = (LAS float*)(lds + L_SPART) + w * 1024;
#pragma unroll
    for (int r = 0; r < 16; ++r) part[crow(r, hi) * 32 + r32] = acc[r];
    __syncthreads();
    LAS float* C = (LAS float*)(lds + L_SC); const LAS float* P0 = (const LAS float*)(lds + L_SPART);
#pragma unroll
    for (int i = 0; i < 2; ++i) { const int e = tid + i * 512; float s = 0.f;
#pragma unroll
        for (int ww = 0; ww < 8; ++ww) s += P0[ww * 1024 + e];
        C[(e >> 5) * 33 + (e & 31)] = s; }
    __syncthreads();
}
__device__ __forceinline__ void srs_table(LAS unsigned char* lds, const float* ssqs, int mt, int tid) {
    const int row = tid >> 4, jj = tid & 15; float s = ssqs[(size_t)jj * MS + mt * 32 + row] + ssqs[(size_t)(jj + 16) * MS + mt * 32 + row];
    s += __shfl_xor(s, 1); s += __shfl_xor(s, 2); s += __shfl_xor(s, 4); s += __shfl_xor(s, 8);
    if (jj == 0) ((LAS float*)(lds + L_SRS))[row] = 1.0f / sqrtf(s * (1.0f / D) + EPS);
}

namespace att {
constexpr int NS = 6, SLOTB = 8192;
constexpr int L_K = 0, L_V = NS * SLOTB, L_OST = 2 * NS * SLOTB, L_BIAS = 131072, L_WSF = 132352;
#define SBAR() __builtin_amdgcn_sched_barrier(0)
__device__ __forceinline__ void glds16(const void* gsrc, unsigned lds_dst) { unsigned keep;
    asm volatile("s_mov_b32 %0, m0\n\ts_mov_b32 m0, %2\n\ts_nop 0\n\tglobal_load_lds_dwordx4 %1, off\n\ts_mov_b32 m0, %0" : "=&s"(keep) : "v"(gsrc), "s"(lds_dst) : "memory"); }
#define WAIT_BAR(N) asm volatile("s_waitcnt vmcnt(" #N ") lgkmcnt(0)\n\ts_barrier" ::: "memory")

struct State { float m, l; f32x16 o[2]; };

__device__ __forceinline__ void tile(State& st, const bf16x8 (&qr)[4], unsigned kslot, unsigned vslot, float cinit, bool near, int base, bool mask1, const LAS float* tab, LAS float* wsf, int r32, int hi, int lane) {
    f32x16 p0, p1;
    { const LAS char* kb = (const LAS char*)(uintptr_t)kslot + hi * 1024 + r32 * 16;
        f32x16 ci;
#pragma unroll
        for (int r = 0; r < 16; ++r) ci[r] = cinit;
#pragma unroll
        for (int d0 = 0; d0 < 4; ++d0) { const bf16x8 b0 = *(const LAS bf16x8*)(kb + d0 * 2048), b1 = *(const LAS bf16x8*)(kb + d0 * 2048 + 512);
            if (d0 == 0) { p0 = __builtin_amdgcn_mfma_f32_32x32x16_bf16(b0, qr[0], ci, 0, 0, 0); p1 = __builtin_amdgcn_mfma_f32_32x32x16_bf16(b1, qr[0], ci, 0, 0, 0); }
            else { p0 = __builtin_amdgcn_mfma_f32_32x32x16_bf16(b0, qr[d0], p0, 0, 0, 0); p1 = __builtin_amdgcn_mfma_f32_32x32x16_bf16(b1, qr[d0], p1, 0, 0, 0); } } }
    if (near) {
#pragma unroll
        for (int r = 0; r < 16; ++r) { int i0 = base - crow(r, hi), i1 = i0 - 32; i0 = i0 < 0 ? 0 : (i0 > 256 ? 256 : i0); i1 = i1 < 0 ? 0 : (i1 > 256 ? 256 : i1); p0[r] += tab[i0]; p1[r] += tab[i1]; } }
    if (mask1) {
#pragma unroll
        for (int r = 0; r < 16; ++r) p1[r] = -1e30f; }
    float rm = fmaxf(p0[0], p1[0]);
#pragma unroll
    for (int r = 1; r < 16; ++r) rm = fmaxf(rm, fmaxf(p0[r], p1[r]));
    rm = fmaxf(rm, __shfl_xor(rm, 32));
    const float mn = fmaxf(st.m, rm);
    if (__any(mn > st.m)) {
        const float f = __builtin_amdgcn_exp2f(st.m - mn); st.l *= f; st.m = mn;
        if (hi == 0) wsf[r32] = f;
        LDS_WAIT();
#pragma unroll
        for (int g = 0; g < 4; ++g) { const f32x4 fv = *(const LAS f32x4*)(wsf + 8 * g + 4 * hi);
#pragma unroll
            for (int e = 0; e < 4; ++e) { st.o[0][4 * g + e] *= fv[e]; st.o[1][4 * g + e] *= fv[e]; } }
    }
    float sacc = 0.f;
#pragma unroll
    for (int r = 0; r < 16; ++r) { p0[r] = __builtin_amdgcn_exp2f(p0[r] - st.m); p1[r] = __builtin_amdgcn_exp2f(p1[r] - st.m); sacc += p0[r] + p1[r]; }
    st.l += sacc;
    u32x4 pw[4];
#pragma unroll
    for (int k = 0; k < 2; ++k) { pw[k] = (u32x4){cvt_pk_bf16(p0[8 * k], p0[8 * k + 1]), cvt_pk_bf16(p0[8 * k + 2], p0[8 * k + 3]), cvt_pk_bf16(p0[8 * k + 4], p0[8 * k + 5]), cvt_pk_bf16(p0[8 * k + 6], p0[8 * k + 7])};
        pw[2 + k] = (u32x4){cvt_pk_bf16(p1[8 * k], p1[8 * k + 1]), cvt_pk_bf16(p1[8 * k + 2], p1[8 * k + 3]), cvt_pk_bf16(p1[8 * k + 4], p1[8 * k + 5]), cvt_pk_bf16(p1[8 * k + 6], p1[8 * k + 7])}; }
    const int vb = (int)vslot + ((lane >> 4) & 1) * 32 + (lane & 3) * 8 + (4 * hi + ((lane & 15) >> 2)) * 64;
#pragma unroll
    for (int d0 = 0; d0 < 2; ++d0) { s16x4 lo[4], hh[4];
#pragma unroll
        for (int ks = 0; ks < 4; ++ks) {
            asm volatile("ds_read_b64_tr_b16 %0,%1 offset:%c2" : "=&v"(lo[ks]) : "v"(vb), "i"(d0 * 4096 + ks * 1024) : "memory");
            asm volatile("ds_read_b64_tr_b16 %0,%1 offset:%c2" : "=&v"(hh[ks]) : "v"(vb), "i"(d0 * 4096 + ks * 1024 + 512) : "memory"); }
        asm volatile("s_waitcnt lgkmcnt(0)" ::: "memory"); SBAR();
#pragma unroll
        for (int ks = 0; ks < 4; ++ks) { const bf16x8 vf = (bf16x8){lo[ks][0], lo[ks][1], lo[ks][2], lo[ks][3], hh[ks][0], hh[ks][1], hh[ks][2], hh[ks][3]};
            st.o[d0] = __builtin_amdgcn_mfma_f32_32x32x16_bf16(__builtin_bit_cast(bf16x8, pw[ks]), vf, st.o[d0], 0, 0, 0); }
    }
}

__device__ __forceinline__ void prompt_unit(int b, int h, int qg, const bf16_t* Q, const bf16_t* Kg, const bf16_t* Vg, bf16_t* O, LAS unsigned char* lds, const int tid) {
    const int lane = tid & 63, r32 = lane & 31, hi = lane >> 5; const int wid = __builtin_amdgcn_readfirstlane(tid >> 6);
    const int c0 = 4 * qg, pj = wid >> 1, half = wid & 1; const long rowbase = (long)b * SEQ;
    const unsigned lds0 = (unsigned)(uintptr_t)lds;
    const LAS float* tab = (const LAS float*)(lds + L_BIAS); LAS float* wsf = (LAS float*)(lds + L_WSF) + wid * 64;
    const bf16_t* Qw = Q + (rowbase + 64 * (c0 + pj) + 32 * half) * D + h * HD;
    const bf16_t* Kh = Kg + rowbase * D + h * HD; const bf16_t* Vh = Vg + rowbase * D + h * HD;
#define DMA_T(i) do { int ck_ = c0 - 8 + (i); ck_ = ck_ < 0 ? 0 : ck_; const unsigned so_ = (unsigned)(((i) % NS) * SLOTB + wid * 1024); \
        glds16(Kh + (long)(64 * ck_ + lane) * D + wid * 8, (unsigned)__builtin_amdgcn_readfirstlane(lds0 + L_K + so_)); \
        glds16(Vh + (long)(64 * ck_ + 16 * (wid & 3) + (lane >> 2)) * D + (wid >> 2) * 32 + (lane & 3) * 8, (unsigned)__builtin_amdgcn_readfirstlane(lds0 + L_V + so_)); } while (0)
    DMA_T(0); DMA_T(1); DMA_T(2); DMA_T(3); DMA_T(4);
    bf16x8 qr[4];
#pragma unroll
    for (int d0 = 0; d0 < 4; ++d0) qr[d0] = *(const bf16x8*)(Qw + (long)r32 * D + d0 * 16 + hi * 8);
    State st; st.m = -1e30f; st.l = 0.f;
#pragma unroll
    for (int r = 0; r < 16; ++r) { st.o[0][r] = 0.f; st.o[1][r] = 0.f; }
    const float cfar = tab[256];
    const int ql = 32 * half + r32;
    for (int s = 0; s < 9; ++s) {
        if (s == 0) { WAIT_BAR(0); asm volatile("" : "+v"(qr[0]), "+v"(qr[1]), "+v"(qr[2]), "+v"(qr[3])); }
        else if (s < 8) WAIT_BAR(2); else WAIT_BAR(0);
        if (s + 5 < 12) DMA_T(s + 5);
        const int ck = c0 - 8 + s + pj;
        if (ck >= 0) { const int sl = (s + pj) % NS; const bool near = s >= 6;
            tile(st, qr, lds0 + L_K + sl * SLOTB, lds0 + L_V + sl * SLOTB, near ? 0.f : cfar, near, 64 * (8 - s) + ql + 128, false, tab, wsf, r32, hi, lane); }
    }
#undef DMA_T
    float l = st.l + __shfl_xor(st.l, 32);
    if (hi == 0) wsf[32 + r32] = l;
    LDS_WAIT();
    float rli[16];
#pragma unroll
    for (int r = 0; r < 16; ++r) rli[r] = __builtin_amdgcn_rcpf(wsf[32 + crow(r, hi)]);
    bf16_t* Ow = O + (rowbase + 64 * (c0 + pj) + 32 * half) * D + h * HD;
    { LAS bf16_t* stg = (LAS bf16_t*)(lds + L_OST) + wid * 2048;
#pragma unroll
        for (int r = 0; r < 16; ++r) { const int orow = crow(r, hi);
#pragma unroll
            for (int d0 = 0; d0 < 2; ++d0) stg[orow * 64 + d0 * 32 + r32] = (bf16_t)(cvt_pk_bf16(st.o[d0][r] * rli[r], 0.f) & 0xffffu); }
        LDS_WAIT();
#pragma unroll
        for (int i = 0; i < 4; ++i) { const int row = i * 8 + (lane >> 3), ch = lane & 7; const u32x4 v = *(const LAS u32x4*)(stg + row * 64 + ch * 8); *(u32x4*)(Ow + (long)row * D + ch * 8) = v; } }
    asm volatile("s_waitcnt lgkmcnt(0)\n\ts_barrier" ::: "memory");
}

__device__ __forceinline__ void sample_unit(int b, int h, const bf16_t* Q, const bf16_t* Kg, const bf16_t* Vg, const bf16_t* CK, const bf16_t* CV, bf16_t* O, LAS unsigned char* lds, const int tid) {
    const int lane = tid & 63, r32 = lane & 31, hi = lane >> 5; const int wid = __builtin_amdgcn_readfirstlane(tid >> 6);
    const unsigned lds0 = (unsigned)(uintptr_t)lds;
    const LAS float* tab = (const LAS float*)(lds + L_BIAS); LAS float* wsf = (LAS float*)(lds + L_WSF) + wid * 64;
    const long srow = (long)MP + 32 * b;
    const bf16_t* Qw = Q + srow * D + h * HD;
    const unsigned ks = lds0 + wid * 16384, vs = ks + 8192;
    { const bf16_t* Kc = CK + ((long)b * CA + 64 * wid) * D + h * HD; const bf16_t* Vc = CV + ((long)b * CA + 64 * wid) * D + h * HD;
#pragma unroll
        for (int p = 0; p < 8; ++p) { glds16(Kc + (long)lane * D + p * 8, (unsigned)__builtin_amdgcn_readfirstlane(ks + p * 1024));
            glds16(Vc + (long)(16 * (p & 3) + (lane >> 2)) * D + (p >> 2) * 32 + (lane & 3) * 8, (unsigned)__builtin_amdgcn_readfirstlane(vs + p * 1024)); } }
    bf16x8 qr[4];
#pragma unroll
    for (int d0 = 0; d0 < 4; ++d0) qr[d0] = *(const bf16x8*)(Qw + (long)r32 * D + d0 * 16 + hi * 8);
    State st; st.m = -1e30f; st.l = 0.f;
#pragma unroll
    for (int r = 0; r < 16; ++r) { st.o[0][r] = 0.f; st.o[1][r] = 0.f; }
    asm volatile("s_waitcnt vmcnt(0)" ::: "memory"); asm volatile("" : "+v"(qr[0]), "+v"(qr[1]), "+v"(qr[2]), "+v"(qr[3]));
    { const bool near = wid >= 6; tile(st, qr, ks, vs, near ? 0.f : tab[256], near, r32 + 512 - 64 * wid + 128, false, tab, wsf, r32, hi, lane); }
    if (wid == 0) {
        const bf16_t* Kn = Kg + srow * D + h * HD; const bf16_t* Vn = Vg + srow * D + h * HD;
#pragma unroll
        for (int p = 0; p < 8; ++p) { const int kr = lane < 32 ? lane : 31; const int vr0 = 16 * (p & 3) + (lane >> 2), vr = vr0 < 32 ? vr0 : 31;
            glds16(Kn + (long)kr * D + p * 8, (unsigned)__builtin_amdgcn_readfirstlane(ks + p * 1024));
            glds16(Vn + (long)vr * D + (p >> 2) * 32 + (lane & 3) * 8, (unsigned)__builtin_amdgcn_readfirstlane(vs + p * 1024)); }
        asm volatile("s_waitcnt vmcnt(0)" ::: "memory");
        tile(st, qr, ks, vs, 0.f, true, r32 + 128, true, tab, wsf, r32, hi, lane);
    }
    const float l = st.l + __shfl_xor(st.l, 32);
    asm volatile("s_waitcnt lgkmcnt(0)\n\ts_barrier" ::: "memory");
    LAS float* OP = (LAS float*)lds;
    LAS float* MLp = (LAS float*)(lds + 65536);
#pragma unroll
    for (int r = 0; r < 16; ++r) { const int q = crow(r, hi); OP[(wid * 32 + q) * 64 + r32] = st.o[0][r]; OP[(wid * 32 + q) * 64 + 32 + r32] = st.o[1][r]; }
    if (hi == 0) { MLp[wid * 32 + r32] = st.m; MLp[256 + wid * 32 + r32] = l; }
    __syncthreads();
    { const int q = tid >> 4, d4 = (tid & 15) * 4; float mg = -1e30f;
#pragma unroll
        for (int w = 0; w < 8; ++w) mg = fmaxf(mg, MLp[w * 32 + q]);
        f32x4 num = (f32x4){0.f, 0.f, 0.f, 0.f}; float den = 0.f;
#pragma unroll
        for (int w = 0; w < 8; ++w) { const float f = __builtin_amdgcn_exp2f(MLp[w * 32 + q] - mg); den += f * MLp[256 + w * 32 + q]; num += *(const LAS f32x4*)(OP + (w * 32 + q) * 64 + d4) * f; }
        const float rd = 1.0f / den; u32x2 w2; w2.x = cvt_pk_bf16(num[0] * rd, num[1] * rd); w2.y = cvt_pk_bf16(num[2] * rd, num[3] * rd);
        *(u32x2*)(O + (srow + q) * D + h * HD + d4) = w2; }
    __syncthreads();
}
#undef WAIT_BAR
}

namespace gate {
constexpr int L_VS = 0, L_STG = 32768, L_RV = 98304;
__device__ __forceinline__ void unit(bool sample, int nb, int gp, bf16_t* U, const bf16_t* Vv, const float* ssqv, const float* ssqvs, const float* vgain, const float* wsp, const float* bsp, float* ogv, LAS unsigned char* lds, const int tid) {
    const int lane = tid & 63, r32 = lane & 31, hi = lane >> 5; const int wid = __builtin_amdgcn_readfirstlane(tid >> 6);
    const long tok0 = sample ? (long)MP + 32 * nb : (long)128 * nb; const int nrows = sample ? 32 : 128;
    LAS float* rv = (LAS float*)(lds + L_RV);
    if (!sample) { if (tid < 128) { const long t = tok0 + tid; const float s = (ssqv[t] + ssqv[MT + t]) + (ssqv[2 * MT + t] + ssqv[3 * MT + t]); rv[tid] = 1.0f / sqrtf(s * (1.0f / D) + EPS); } }
    else { const int row = tid >> 4, jj = tid & 15; float s = ssqvs[(size_t)jj * MS + nb * 32 + row] + ssqvs[(size_t)(jj + 16) * MS + nb * 32 + row];
        s += __shfl_xor(s, 1); s += __shfl_xor(s, 2); s += __shfl_xor(s, 4); s += __shfl_xor(s, 8); if (jj == 0) rv[row] = 1.0f / sqrtf(s * (1.0f / D) + EPS); }
    __syncthreads();
    for (int pi = wid; pi < 32; pi += 8) { const int gi = pi >> 4, qt = (pi >> 3) & 1, dh = (pi >> 2) & 1, rg = pi & 3;
        const int row = 64 * qt + 16 * rg + (lane >> 2), col = 64 * (2 * gp + gi) + 32 * dh + 8 * (lane & 3);
        if (row < nrows) { const u32x4 raw = *(const u32x4*)(Vv + (tok0 + row) * D + col); const float rs = rv[row];
            const f32x4 g0 = *(const f32x4*)(vgain + col), g1 = *(const f32x4*)(vgain + col + 4);
            float f[8]; f[0] = bf2f(raw.x & 0xffffu) * rs * g0[0]; f[1] = bf2f(raw.x >> 16) * rs * g0[1]; f[2] = bf2f(raw.y & 0xffffu) * rs * g0[2]; f[3] = bf2f(raw.y >> 16) * rs * g0[3];
            f[4] = bf2f(raw.z & 0xffffu) * rs * g1[0]; f[5] = bf2f(raw.z >> 16) * rs * g1[1]; f[6] = bf2f(raw.w & 0xffffu) * rs * g1[2]; f[7] = bf2f(raw.w >> 16) * rs * g1[3];
            u32x4 w; w.x = cvt_pk_bf16(f[0], f[1]); w.y = cvt_pk_bf16(f[2], f[3]); w.z = cvt_pk_bf16(f[4], f[5]); w.w = cvt_pk_bf16(f[6], f[7]);
            *(LAS u32x4*)(lds + L_VS + (gi * 2 + qt) * 8192 + (dh * 4 + rg) * 1024 + lane * 16) = w;
            if (sample) { float* o = ogv + (size_t)(nb * 32 + row) * D + col; *(f32x4*)o = (f32x4){f[0], f[1], f[2], f[3]}; *(f32x4*)(o + 4) = (f32x4){f[4], f[5], f[6], f[7]}; } } }
    __syncthreads();
    const int gi = wid >> 2, pb = wid & 3, g = 2 * gp + gi;
    if (pb * 32 < nrows) {
        const int nks = sample ? 2 : (pb < 2 ? 4 : 8);
        f32x16 o[2];
#pragma unroll
        for (int r = 0; r < 16; ++r) { o[0][r] = 0.f; o[1][r] = 0.f; }
        const float* wrow = wsp + ((size_t)g * 128 + 32 * pb + r32) * 128 + 4 * hi;
        const unsigned lds0 = (unsigned)(uintptr_t)lds;
        for (int ks = 0; ks < nks; ++ks) {
            const f32x4 a0 = *(const f32x4*)(wrow + 16 * ks), a1 = *(const f32x4*)(wrow + 16 * ks + 8);
            u32x4 pa; pa.x = cvt_pk_bf16(a0[0], a0[1]); pa.y = cvt_pk_bf16(a0[2], a0[3]); pa.z = cvt_pk_bf16(a1[0], a1[1]); pa.w = cvt_pk_bf16(a1[2], a1[3]);
            const int vb = (int)(lds0 + L_VS + (gi * 2 + (ks >> 2)) * 8192 + (ks & 3) * 1024) + ((lane >> 4) & 1) * 32 + (lane & 3) * 8 + (4 * hi + ((lane & 15) >> 2)) * 64;
            s16x4 lo[2], hh[2];
#pragma unroll
            for (int d0 = 0; d0 < 2; ++d0) {
                asm volatile("ds_read_b64_tr_b16 %0,%1 offset:%c2" : "=&v"(lo[d0]) : "v"(vb), "i"(d0 * 4096) : "memory");
                asm volatile("ds_read_b64_tr_b16 %0,%1 offset:%c2" : "=&v"(hh[d0]) : "v"(vb), "i"(d0 * 4096 + 512) : "memory"); }
            asm volatile("s_waitcnt lgkmcnt(0)" ::: "memory"); __builtin_amdgcn_sched_barrier(0);
#pragma unroll
            for (int d0 = 0; d0 < 2; ++d0) { const bf16x8 vf = (bf16x8){lo[d0][0], lo[d0][1], lo[d0][2], lo[d0][3], hh[d0][0], hh[d0][1], hh[d0][2], hh[d0][3]};
                o[d0] = __builtin_amdgcn_mfma_f32_32x32x16_bf16(__builtin_bit_cast(bf16x8, pa), vf, o[d0], 0, 0, 0); }
        }
        LAS float* stg = (LAS float*)(lds + L_STG) + wid * 2048;
        const float* bs = bsp + g * 128 + 32 * pb;
#pragma unroll
        for (int r = 0; r < 16; ++r) { const int q = crow(r, hi); const float bq = bs[q]; stg[q * 64 + r32] = o[0][r] + bq; stg[q * 64 + 32 + r32] = o[1][r] + bq; }
        LDS_WAIT();
#pragma unroll
        for (int i = 0; i < 4; ++i) { const int row = i * 8 + (lane >> 3), ch = lane & 7;
            const f32x4 m0 = *(const LAS f32x4*)(stg + row * 64 + ch * 8), m1 = *(const LAS f32x4*)(stg + row * 64 + ch * 8 + 4);
            bf16_t* up = U + (tok0 + 32 * pb + row) * D + 64 * g + ch * 8; const u32x4 uu = *(const u32x4*)up;
            u32x4 w; w.x = cvt_pk_bf16(bf2f(uu.x & 0xffffu) * m0[0], bf2f(uu.x >> 16) * m0[1]); w.y = cvt_pk_bf16(bf2f(uu.y & 0xffffu) * m0[2], bf2f(uu.y >> 16) * m0[3]);
            w.z = cvt_pk_bf16(bf2f(uu.z & 0xffffu) * m1[0], bf2f(uu.z >> 16) * m1[1]); w.w = cvt_pk_bf16(bf2f(uu.w & 0xffffu) * m1[2], bf2f(uu.w >> 16) * m1[3]);
            *(u32x4*)up = w; }
    }
    __syncthreads();
}
}

template <bool UP>
__device__ __forceinline__ void transpose_item(const float* W, int K, int N, const float* gain, bf16_t* WT, LAS float* scr, int item, int lane) {
    const int nblk = N / 32, kb = item / nblk, nb = item % nblk, k0 = 64 * kb, n0 = 32 * nb;
#pragma unroll 8
    for (int i = 0; i < 32; ++i) { const int kk = 2 * i + (lane >> 5); const float gk = gain ? gain[k0 + kk] : 1.0f; scr[kk * 33 + (lane & 31)] = W[(size_t)(k0 + kk) * N + n0 + (lane & 31)] * gk; }
    LDS_WAIT(); asm volatile("" ::: "memory");
    const int c = lane & 7;
#pragma unroll
    for (int jj = 0; jj < 4; ++jj) { const int n = (lane >> 3) + 8 * jj; const LAS float* s = scr + (8 * c) * 33 + n;
        u32x4 o; o.x = cvt_pk_bf16(s[0 * 33], s[1 * 33]); o.y = cvt_pk_bf16(s[2 * 33], s[3 * 33]); o.z = cvt_pk_bf16(s[4 * 33], s[5 * 33]); o.w = cvt_pk_bf16(s[6 * 33], s[7 * 33]);
        int dn = n0 + n; if (UP) { const int v = dn >= FF ? 1 : 0, gc = dn - v * FF; dn = 256 * (gc >> 7) + 128 * v + (gc & 127); }
        *(u32x4*)(WT + (size_t)dn * K + k0 + 8 * c) = o; }
    LDS_WAIT(); asm volatile("" ::: "memory");
}

#ifndef PHM
#define PHM 0xfff
#endif
#define PH(k) ((PHM >> (k)) & 1)
struct Args { const float* in[20]; float* out; unsigned char* ws; };

__global__ void __launch_bounds__(NTHR, 2) fwd_kernel(Args a) {
    extern __shared__ __attribute__((aligned(16))) unsigned char lds_raw[];
    LAS unsigned char* lds = (LAS unsigned char*)lds_raw;
    cg::grid_group grid = cg::this_grid();
    const int wave0 = __builtin_amdgcn_readfirstlane((int)threadIdx.x >> 6);
#define PHASE_VARS int tid; asm volatile("v_mbcnt_lo_u32_b32 %0, -1, 0\n\tv_mbcnt_hi_u32_b32 %0, -1, %0" : "=v"(tid)); tid |= wave0 << 6; const int lane = tid & 63, wave = wave0; (void)lane; (void)wave;
    const int G = gridDim.x, bx = blockIdx.x; const int vcu = (G % 8 == 0) ? (bx % 8) * (G / 8) + bx / 8 : bx;
    unsigned char* ws = a.ws; float* out = a.out;
    const float *x_prompt = a.in[0], *x_sample = a.in[1], *cache_k = a.in[2], *cache_v = a.in[3], *state_conv = a.in[4], *ln_mix = a.in[5], *ln_ffn = a.in[6], *ln_final = a.in[7],
                *w_qkv = a.in[8], *rel_bias = a.in[9], *w_o = a.in[10], *w_in = a.in[11], *v_norm = a.in[12], *w_s = a.in[13], *bias_s = a.in[14], *w_out = a.in[15],
                *w_up = a.in[16], *conv_w = a.in[17], *conv_b = a.in[18], *w_down = a.in[19];
    bf16_t *Wqkv_t = (bf16_t*)(ws + WS_WQKV), *Wo_t = (bf16_t*)(ws + WS_WO), *Win_t = (bf16_t*)(ws + WS_WIN), *Wout_t = (bf16_t*)(ws + WS_WOUT);
    bf16_t *XB = (bf16_t*)(ws + WS_XB), *QB = (bf16_t*)(ws + WS_Q), *KB = (bf16_t*)(ws + WS_K), *VB = (bf16_t*)(ws + WS_V), *GB = (bf16_t*)(ws + WS_G), *CKB = (bf16_t*)(ws + WS_CK), *CVB = (bf16_t*)(ws + WS_CV);
    float *SSQ = (float*)(ws + WS_SSQ), *SSQV = (float*)(ws + WS_SSQV), *SSQS = (float*)(ws + WS_SSQS), *SSQVS = (float*)(ws + WS_SSQVS);
    float* XS = out + O_YS;

    if (PH(0)) { PHASE_VARS
        LAS float* scr = (LAS float*)(lds + wave * 16384);
        const int gw = vcu * NWAVES + wave, NGW = G * NWAVES;
        constexpr int I_QKV = (D / 64) * (3 * D / 32), I_O = (D / 64) * (D / 32), I_IN = (D / 64) * (2 * D / 32), I_UP = (D / 64) * (FF2 / 32), I_DN = (FF / 64) * (D / 32);
        constexpr int NITEMS = I_QKV + 2 * I_O + I_IN + 2 * I_UP + 2 * I_DN;
        for (int it = gw; it < NITEMS; it += NGW) {
            int r = it;
            if (r < I_QKV) { transpose_item<false>(w_qkv, D, 3 * D, ln_mix, Wqkv_t, scr, r, lane); continue; } r -= I_QKV;
            if (r < I_O) { transpose_item<false>(w_o, D, D, nullptr, Wo_t, scr, r, lane); continue; } r -= I_O;
            if (r < I_IN) { transpose_item<false>(w_in, D, 2 * D, ln_mix + D, Win_t, scr, r, lane); continue; } r -= I_IN;
            if (r < I_O) { transpose_item<false>(w_out, D, D, nullptr, Wout_t, scr, r, lane); continue; } r -= I_O;
            if (r < 2 * I_UP) { const int l = r / I_UP; transpose_item<true>(w_up + (size_t)l * D * FF2, D, FF2, ln_ffn + l * D, (bf16_t*)(ws + WS_WUP + l * WUP_L), scr, r % I_UP, lane); continue; } r -= 2 * I_UP;
            { const int l = r / I_DN; transpose_item<false>(w_down + (size_t)l * FF * D, FF, D, nullptr, (bf16_t*)(ws + WS_WDN + l * WDN_L), scr, r % I_DN, lane); }
        }
        for (int m = gw; m < MT; m += NGW) {
            const float* xr = m < MP ? x_prompt + (size_t)m * D : x_sample + (size_t)(m - MP) * D;
            f32x4 v[4]; float s = 0.f;
#pragma unroll
            for (int jj = 0; jj < 4; ++jj) { v[jj] = ((const f32x4*)xr)[lane + 64 * jj]; s += (v[jj][0] * v[jj][0] + v[jj][1] * v[jj][1]) + (v[jj][2] * v[jj][2] + v[jj][3] * v[jj][3]); }
            s = wave_sum(s);
#pragma unroll
            for (int jj = 0; jj < 4; ++jj) { u32x2 w; w.x = cvt_pk_bf16(v[jj][0], v[jj][1]); w.y = cvt_pk_bf16(v[jj][2], v[jj][3]); ((u32x2*)(XB + (size_t)m * D))[lane + 64 * jj] = w; }
            if (m < MP) { if (lane < 4) SSQ[(size_t)lane * MT + m] = lane == 0 ? s : 0.f; }
            else { if (lane < 32) SSQS[(size_t)lane * MS + (m - MP)] = lane == 0 ? s : 0.f; }
        }
        for (int m = gw; m < 2 * DB * CA; m += NGW) { const int which = m >= DB * CA, rr = m - which * DB * CA; const float* src = (which ? cache_v : cache_k) + (size_t)rr * D; bf16_t* dst = (which ? CVB : CKB) + (size_t)rr * D;
#pragma unroll
            for (int jj = 0; jj < 4; ++jj) { const f32x4 v = ((const f32x4*)src)[lane + 64 * jj]; u32x2 w; w.x = cvt_pk_bf16(v[0], v[1]); w.y = cvt_pk_bf16(v[2], v[3]); ((u32x2*)dst)[lane + 64 * jj] = w; } }
    }
    grid.sync();

    if (PH(1)) { PHASE_VARS
        for (int task = vcu; task < DB * 96; task += G) { const int mt = task / 96, nt = task % 96;
            srs_table(lds, SSQS, mt, tid);
            stask_mm<D>(lds, XB, MP + 32 * mt, Wqkv_t, [&](int jn) { return 32 * nt + jn; }, tid);
            const LAS float* C = (const LAS float*)(lds + L_SC); const LAS float* rs = (const LAS float*)(lds + L_SRS);
            const int row = tid >> 4, c0 = (tid & 15) * 2, n = 32 * nt + c0, t = n >> 10, nn = n & 1023; const float r_ = rs[row];
            const float v0 = C[row * 33 + c0] * r_, v1 = C[row * 33 + c0 + 1] * r_; const float sc = t == 0 ? C2 : 1.0f;
            bf16_t* dst = (t == 0 ? QB : (t == 1 ? KB : VB)) + (size_t)(MP + 32 * mt + row) * D + nn; *(unsigned*)dst = cvt_pk_bf16(v0 * sc, v1 * sc);
            if (t >= 1) { float* o = out + (t == 1 ? O_KS : O_VS) + (size_t)(32 * mt + row) * D + nn; *(f32x2*)o = (f32x2){v0, v1}; }
            __syncthreads();
        }
        pg8::Gemm g{XB, Wqkv_t, D}; pg8::StaticOrder S; S.init(MP / 256, 3 * D / 256, G, bx, 0);
        EpiQKV E{QB, (size_t)(WS_K - WS_Q) / 2, SSQ, out + O_KP, out + O_VP};
        pg8::gemm_phase<EpiQKV, pg8::StaticOrder>(lds, g, S, E, tid);
    }
    grid.sync();

    if (PH(2)) { PHASE_VARS
        LAS float* tab = (LAS float*)(lds + att::L_BIAS);
        const int per = (NB * NH * 32 + G - 1) / G;
        int lasth = -1;
        for (int id = vcu * per; id < (vcu + 1) * per && id < NB * NH * 32; ++id) { const int bh = id >> 5, qg = id & 31, b = bh / NH, h = bh % NH;
            if (h != lasth) { __syncthreads(); for (int i = tid; i < NREL; i += NTHR) tab[i] = rel_bias[h * NREL + i] * LOG2E; __syncthreads(); lasth = h; }
            att::prompt_unit(b, h, qg, QB, KB, VB, QB, lds, tid); }
        for (int id = vcu; id < DB * NH; id += G) { const int b = id / NH, h = id % NH;
            if (h != lasth) { __syncthreads(); for (int i = tid; i < NREL; i += NTHR) tab[i] = rel_bias[h * NREL + i] * LOG2E; __syncthreads(); lasth = h; }
            att::sample_unit(b, h, QB, KB, VB, CKB, CVB, QB, lds, tid); }
    }
    grid.sync();

#define RES_PHASE(A_, Wt_, KK, BASE_P, BASE_S) do { \
        for (int task = vcu; task < DB * 32; task += G) { const int mt = task / 32, nt = task % 32; \
            stask_mm<KK>(lds, A_, MP + 32 * mt, Wt_, [&](int jn) { return 32 * nt + jn; }, tid); \
            const LAS float* C = (const LAS float*)(lds + L_SC); \
            const int row = tid >> 4, c0 = (tid & 15) * 2, n = 32 * nt + c0; const size_t o_ = (size_t)(32 * mt + row) * D + n; \
            const f32x2 bb = *(const f32x2*)((BASE_S) + o_); const float v0 = bb.x + C[row * 33 + c0], v1 = bb.y + C[row * 33 + c0 + 1]; \
            *(f32x2*)(XS + o_) = (f32x2){v0, v1}; *(unsigned*)(XB + (size_t)MP * D + o_) = cvt_pk_bf16(v0, v1); \
            float s_ = v0 * v0 + v1 * v1; s_ += __shfl_xor(s_, 1); s_ += __shfl_xor(s_, 2); s_ += __shfl_xor(s_, 4); s_ += __shfl_xor(s_, 8); \
            if ((tid & 15) == 0) SSQS[(size_t)nt * MS + 32 * mt + row] = s_; \
            __syncthreads(); } \
        pg8::Gemm g{A_, Wt_, KK}; pg8::StaticOrder S; S.init(MP / 256, D / 256, G, bx, 0); \
        EpiRes E{BASE_P, out + O_YP, XB, SSQ}; \
        pg8::gemm_phase<EpiRes, pg8::StaticOrder>(lds, g, S, E, tid); } while (0)
    if (PH(3)) { PHASE_VARS RES_PHASE(QB, Wo_t, D, x_prompt, x_sample); }
    grid.sync();

#define UP_PHASE(L_) do { \
        const bf16_t* Wup_ = (const bf16_t*)(ws + WS_WUP + (L_) * WUP_L); const float* cw_ = conv_w + (size_t)(L_) * 3 * FF2; const float* cb_ = conv_b + (size_t)(L_) * FF2; \
        for (int task = vcu; task < DB * 176; task += G) { const int mt = task / 176, nt = task % 176; \
            srs_table(lds, SSQS, mt, tid); \
            stask_mm<D>(lds, XB, MP + 32 * mt, Wup_, [&](int jn) { const int gc = 16 * nt + (jn & 15); return 256 * (gc >> 7) + (gc & 127) + 128 * (jn >> 4); }, tid); \
            LAS float* C = (LAS float*)(lds + L_SC); const LAS float* rs = (const LAS float*)(lds + L_SRS); \
            { const int row = tid >> 4, c0 = (tid & 15) * 2; const float r_ = rs[row]; C[row * 33 + c0] *= r_; C[row * 33 + c0 + 1] *= r_; } \
            __syncthreads(); \
            { const int row = tid >> 4, jn = tid & 15, gc = 16 * nt + jn; const float* hs = state_conv + ((size_t)((L_) * DB + mt) * 2) * FF2; float cc[2]; \
                _Pragma("unroll") for (int v = 0; v < 2; ++v) { const int oc = v * FF + gc, tc = jn + 16 * v; \
                    const float a0 = C[row * 33 + tc], a1 = row >= 1 ? C[(row - 1) * 33 + tc] : hs[FF2 + oc], a2 = row >= 2 ? C[(row - 2) * 33 + tc] : hs[(size_t)row * FF2 + oc]; \
                    cc[v] = cb_[oc] + cw_[oc] * a2 + cw_[FF2 + oc] * a1 + cw_[2 * FF2 + oc] * a0; \
                    if (row >= 30) out[O_CS + ((size_t)((L_) * DB + mt) * 2 + (row - 30)) * FF2 + oc] = a0; } \
                GB[(size_t)(MP + 32 * mt + row) * FF + gc] = (bf16_t)(cvt_pk_bf16(silu1(cc[0]) * cc[1], 0.f) & 0xffffu); } \
            __syncthreads(); } \
        pg8::Gemm g{XB, Wup_, D}; pg8::StaticOrder S; S.init(66, FF2 / 256, G, bx, 1); \
        EpiUp E{GB, SSQ, cw_, cb_, out + O_CP + (size_t)(L_) * NB * 2 * FF2}; \
        pg8::gemm_phase<EpiUp, pg8::StaticOrder>(lds, g, S, E, tid); } while (0)
    if (PH(4)) { PHASE_VARS UP_PHASE(0); }
    grid.sync();
    if (PH(5)) { PHASE_VARS RES_PHASE(GB, (const bf16_t*)(ws + WS_WDN), FF, out + O_YP, XS); }
    grid.sync();

    if (PH(6)) { PHASE_VARS
        for (int task = vcu; task < DB * 64; task += G) { const int mt = task / 64, nt = task % 64;
            srs_table(lds, SSQS, mt, tid);
            stask_mm<D>(lds, XB, MP + 32 * mt, Win_t, [&](int jn) { return 32 * nt + jn; }, tid);
            const LAS float* C = (const LAS float*)(lds + L_SC); const LAS float* rs = (const LAS float*)(lds + L_SRS);
            const int row = tid >> 4, c0 = (tid & 15) * 2, n = 32 * nt + c0, t = n >> 10, nn = n & 1023; const float r_ = rs[row];
            const f32x2 z = gelu_pk((f32x2){C[row * 33 + c0] * r_, C[row * 33 + c0 + 1] * r_});
            *(unsigned*)((t == 0 ? QB : KB) + (size_t)(MP + 32 * mt + row) * D + nn) = cvt_pk_bf16(z.x, z.y);
            if (t == 1) { float s_ = z.x * z.x + z.y * z.y; s_ += __shfl_xor(s_, 1); s_ += __shfl_xor(s_, 2); s_ += __shfl_xor(s_, 4); s_ += __shfl_xor(s_, 8);
                if ((tid & 15) == 0) SSQVS[(size_t)(nt - 32) * MS + 32 * mt + row] = s_; }
            __syncthreads();
        }
        pg8::Gemm g{XB, Win_t, D}; pg8::StaticOrder S; S.init(MP / 256, 2 * D / 256, G, bx, 0);
        EpiIn E{QB, (size_t)(WS_K - WS_Q) / 2, SSQ, SSQV};
        pg8::gemm_phase<EpiIn, pg8::StaticOrder>(lds, g, S, E, tid);
    }
    grid.sync();

    if (PH(7)) { PHASE_VARS
        const int per = (128 * 8 + G - 1) / G;
        for (int id = vcu * per; id < (vcu + 1) * per && id < 128 * 8; ++id) gate::unit(false, id >> 3, id & 7, QB, KB, SSQV, SSQVS, v_norm, w_s, bias_s, out + O_GV, lds, tid);
        for (int id = vcu; id < DB * 8; id += G) gate::unit(true, id >> 3, id & 7, QB, KB, SSQV, SSQVS, v_norm, w_s, bias_s, out + O_GV, lds, tid);
    }
    grid.sync();

    if (PH(8)) { PHASE_VARS RES_PHASE(QB, Wout_t, D, out + O_YP, XS); }
    grid.sync();
    if (PH(9)) { PHASE_VARS UP_PHASE(1); }
    grid.sync();
    if (PH(10)) { PHASE_VARS RES_PHASE(GB, (const bf16_t*)(ws + WS_WDN + WDN_L), FF, out + O_YP, XS); }
    grid.sync();

    if (PH(11)) { PHASE_VARS
        const int gw = vcu * NWAVES + wave, NGW = G * NWAVES;
        f32x4 gn[4];
#pragma unroll
        for (int jj = 0; jj < 4; ++jj) gn[jj] = ((const f32x4*)ln_final)[lane + 64 * jj];
        for (int m = gw; m < MT; m += NGW) {
            float s;
            if (m < MP) s = (SSQ[m] + SSQ[MT + m]) + (SSQ[2 * MT + m] + SSQ[3 * MT + m]);
            else { s = lane < 32 ? SSQS[(size_t)lane * MS + (m - MP)] : 0.f; s = wave_sum(s); }
            const float rs = 1.0f / sqrtf(s * (1.0f / D) + EPS);
            f32x4* xr = (f32x4*)(out + (size_t)m * D);
#pragma unroll
            for (int jj = 0; jj < 4; ++jj) { f32x4 v = xr[lane + 64 * jj]; v = v * rs * gn[jj]; xr[lane + 64 * jj] = v; }
        }
    }
}

extern "C" void kernel_launch(void* const* d_in, const int* in_sizes, int n_in, void* d_out, int out_size, void* d_ws, size_t ws_size, hipStream_t stream) {
    static int grid = 0;
    if (grid == 0) {
        if (n_in != 20 || (size_t)out_size != O_END || ws_size < WS_END) { fprintf(stderr, "kernel_launch: unexpected sizes n_in %d out %d ws %zu\n", n_in, out_size, ws_size); grid = -1; return; }
        int dev = 0, cus = 0, per_cu = 0;
        if (hipGetDevice(&dev) != hipSuccess || hipDeviceGetAttribute(&cus, hipDeviceAttributeMultiprocessorCount, dev) != hipSuccess) { grid = -1; return; }
        if (hipFuncSetAttribute((const void*)fwd_kernel, hipFuncAttributeMaxDynamicSharedMemorySize, LDS_BYTES) != hipSuccess) { fprintf(stderr, "kernel_launch: hipFuncSetAttribute failed\n"); grid = -1; return; }
        if (hipOccupancyMaxActiveBlocksPerMultiprocessor(&per_cu, (const void*)fwd_kernel, NTHR, LDS_BYTES) != hipSuccess || per_cu < 1) { fprintf(stderr, "kernel_launch: occupancy query says %d\n", per_cu); per_cu = 1; }
        (void)hipGetLastError();
        grid = cus;
    }
    if (grid < 0) return;
    Args a{};
    for (int i = 0; i < 20; ++i) a.in[i] = (const float*)d_in[i];
    a.out = (float*)d_out; a.ws = (unsigned char*)d_ws;
    void* args[] = {&a};
    hipError_t e = hipLaunchCooperativeKernel((const void*)fwd_kernel, dim3(grid), dim3(NTHR), args, LDS_BYTES, stream);
    if (e != hipSuccess) fprintf(stderr, "kernel_launch: cooperative launch failed: %s (grid %d)\n", hipGetErrorString(e), grid);
}
```

```cpp
#include <hip/hip_runtime.h>
#include <cstdio>
#include <cstdint>

#define LAS __attribute__((address_space(3)))
typedef unsigned short bf16_t;
typedef short bf16x8 __attribute__((ext_vector_type(8)));
typedef short s16x4 __attribute__((ext_vector_type(4)));
typedef float f32x2 __attribute__((ext_vector_type(2)));
typedef float f32x4 __attribute__((ext_vector_type(4)));
typedef float f32x16 __attribute__((ext_vector_type(16)));
typedef unsigned u32x2 __attribute__((ext_vector_type(2)));
typedef unsigned u32x4 __attribute__((ext_vector_type(4)));

constexpr int D = 1024, SEQ = 8192, NB = 2, MP = NB * SEQ, DB = 8, DT = 32, MS = DB * DT, MT = MP + MS;
constexpr int NH = 16, HD = 64, FF = 2816, FF2 = 5632, CA = 512, NREL = 257;
constexpr float EPS = 1e-6f, LOG2E = 1.4426950408889634f, C2 = 0.125f * LOG2E;
constexpr int NWAVES = 8, NTHR = 512;

constexpr size_t MiB = 1u << 20;
constexpr size_t WS_CTL = 0;
constexpr size_t WS_WQKV = 1 * MiB, WS_WO = 7 * MiB, WS_WIN = 9 * MiB, WS_WOUT = 13 * MiB, WS_WUP = 15 * MiB, WS_WDN = 37 * MiB;
constexpr size_t WUP_L = (size_t)FF2 * D * 2, WDN_L = (size_t)D * FF * 2;
constexpr size_t WS_XB = 48 * MiB + 65536;
constexpr size_t WS_Q = 82 * MiB, WS_K = 116 * MiB, WS_V = 150 * MiB;
constexpr size_t WS_G = 82 * MiB;
constexpr size_t WS_CK = 184 * MiB, WS_CV = 192 * MiB;
constexpr size_t WS_SSQ = 200 * MiB;
constexpr size_t WS_SSQV = 201 * MiB;
constexpr size_t WS_SSQS = 202 * MiB;
constexpr size_t WS_SSQVS = 202 * MiB + 65536;
constexpr size_t WS_END = 203 * MiB;

constexpr size_t O_YP = 0, O_YS = O_YP + (size_t)MP * D, O_KP = O_YS + (size_t)MS * D, O_VP = O_KP + (size_t)NB * CA * D, O_KS = O_VP + (size_t)NB * CA * D,
                 O_VS = O_KS + (size_t)MS * D, O_GV = O_VS + (size_t)MS * D, O_CP = O_GV + (size_t)MS * D, O_CS = O_CP + (size_t)2 * NB * 2 * FF2, O_END = O_CS + (size_t)2 * DB * 2 * FF2;

constexpr int RING_BYTES = 131072;
constexpr int L_XBUF = 131072, L_RSTAB = 139264, L_PTAB = 140288;
constexpr int L_MISC = 144384;
constexpr int LDS_BYTES = 155648;

__device__ __forceinline__ unsigned cvt_pk_bf16(float lo, float hi) { unsigned r; asm volatile("v_cvt_pk_bf16_f32 %0, %1, %2" : "=v"(r) : "v"(lo), "v"(hi)); return r; }
__device__ __forceinline__ float bf2f(unsigned h) { return __uint_as_float(h << 16); }
__device__ __forceinline__ int crow(int r, int hi) { return (r & 3) + 8 * (r >> 2) + 4 * hi; }
#define LDS_WAIT() asm volatile("s_waitcnt lgkmcnt(0)" ::: "memory")
#define VM_WAIT() asm volatile("s_waitcnt vmcnt(0)" ::: "memory")
#define RAW_BAR() do { asm volatile("s_waitcnt lgkmcnt(0)" ::: "memory"); __builtin_amdgcn_s_barrier(); asm volatile("" ::: "memory"); } while (0)
__device__ __forceinline__ float wave_sum(float v) {
#pragma unroll
    for (int o = 1; o < 64; o <<= 1) v += __shfl_xor(v, o);
    return v;
}
__device__ __forceinline__ f32x2 gelu_pk(f32x2 v) {
    const f32x2 av = __builtin_elementwise_abs(v), d = av * 0.2316418882f + 1.0f;
    f32x2 t; t.x = __builtin_amdgcn_rcpf(d.x); t.y = __builtin_amdgcn_rcpf(d.y);
    f32x2 q = t * 0.5307027145f + (-0.7265760135f); q = q * t + 0.7107068705f; q = q * t + (-0.142248368f); q = q * t + 0.127414796f; q = q * t;
    const f32x2 s = (v * v) * (-0.72134752044f);
    f32x2 e; e.x = __builtin_amdgcn_exp2f(s.x); e.y = __builtin_amdgcn_exp2f(s.y);
    const f32x2 m = v * (q * e), r = v - m;
    f32x2 o; o.x = v.x < 0.f ? m.x : r.x; o.y = v.y < 0.f ? m.y : r.y; return o;
}
__device__ __forceinline__ float gelu1(float x) { f32x2 r = gelu_pk((f32x2){x, x}); return r.x; }
__device__ __forceinline__ float silu1(float x) { return x * __builtin_amdgcn_rcpf(1.0f + __builtin_amdgcn_exp2f(-x * LOG2E)); }

namespace pg8 {
constexpr int BM = 256, BK = 64, HALF = 128, HTB = HALF * BK * 2, NXCD = 8, WGM = 8;
__host__ __device__ __forceinline__ int lds_byte(int r, int c) { const int st = (r >> 4) * 2 + (c >> 5), rr = r & 15, cc = c & 31, ob = rr * 64 + cc * 2; return st * 1024 + (ob ^ (((ob >> 9) & 1) << 5)); }
__host__ __device__ __forceinline__ void stage_rc(int b, int& R, int& C) { const int st = b / 1024, sb = b % 1024, swz = sb ^ (((sb >> 9) & 1) << 5); R = (st >> 1) * 16 + swz / 64; C = (st & 1) * 32 + (swz % 64) / 2; }
__host__ __device__ __forceinline__ int perm32(int rho) { const int n = rho >> 4, i = rho & 15; return 8 * (i >> 2) + 4 * n + (i & 3); }

struct Unit { int pm, pn, arow; };
struct Gemm { const bf16_t* A; const bf16_t* Bt; int K; };

struct StaticOrder {
    int nM, nN, nwg, G, c, up;
    __device__ void init(int nM_, int nN_, int G_, int c_, int up_) { nM = nM_; nN = nN_; nwg = nM * nN; G = G_; c = c_; up = up_; }
    __device__ bool next(int i, Unit& u) const {
        const long L = (long)i * G + c; if (L >= nwg) return false;
        int wgid = (int)L; { const int q = nwg / NXCD, r = nwg % NXCD, xcd = wgid % NXCD, off = wgid / NXCD; wgid = (xcd < r ? xcd * (q + 1) : r * (q + 1) + (xcd - r) * q) + off; }
        const int nig = WGM * nN, gid = wgid / nig, fm = gid * WGM, gsz = (nM - fm) < WGM ? (nM - fm) : WGM;
        u.pm = fm + ((wgid % nig) % gsz); u.pn = (wgid % nig) / gsz;
        u.arow = up ? ((u.pm / 33) * SEQ + 254 * (u.pm % 33) - 2) : u.pm * BM;
        return true;
    }
};

template <class Epi, class Sched>
__device__ __forceinline__ void gemm_phase(LAS unsigned char* lds, const Gemm g, const Sched& S, const Epi& E, const int tid) {
    const int wid = __builtin_amdgcn_readfirstlane(tid >> 6), lane = tid & 63, wr = wid >> 2, wc = wid & 3, fr = lane & 15, fq = lane >> 4;
    const int K = g.K, nt = K / BK;
    unsigned voffA[2], voffB[2];
#pragma unroll
    for (int i = 0; i < 2; ++i) { int R, C; stage_rc(tid * 16 + i * 8192, R, C); const int Rb = Epi::PERM ? ((R & ~31) + perm32(R & 31)) : R;
        voffA[i] = (unsigned)(R * K + C) * 2u; voffB[i] = (unsigned)(Rb * K + C) * 2u; }
    const size_t kstep = (size_t)(BK * 2);
    const size_t hstep = (size_t)HALF * K * 2;
    const size_t tstep = 2 * hstep;
    const size_t rstep = (size_t)K * 2;
    const unsigned ldsw = (unsigned)wid * 1024u;
    const int aoff = lds_byte(wr * 64 + fr, fq * 8), boff = lds_byte(wc * 32 + fr, fq * 8);
#define PG8_SA(b, h) (((b) * 2 + (h)) * HTB)
#define PG8_SB(b, h) ((4 + (b) * 2 + (h)) * HTB)
#define PG8_STAGE(bufoff, gbase, voff) do { _Pragma("unroll") for (int _i = 0; _i < 2; ++_i) \
        __builtin_amdgcn_global_load_lds((const unsigned*)((const char*)(gbase) + (voff)[_i]), (LAS unsigned*)(lds + (bufoff) + ldsw + _i * 8192), 16, 0, 0); } while (0)
#define PG8_LDA(dst, b, h) do { _Pragma("unroll") for (int m = 0; m < 4; ++m) _Pragma("unroll") for (int k = 0; k < 2; ++k) dst[m][k] = *(const LAS bf16x8*)(lds + PG8_SA(b, h) + aoff + m * 2048 + k * 1024); } while (0)
#define PG8_LDB(dst, b, h) do { _Pragma("unroll") for (int n = 0; n < 2; ++n) _Pragma("unroll") for (int k = 0; k < 2; ++k) dst[n][k] = *(const LAS bf16x8*)(lds + PG8_SB(b, h) + boff + n * 2048 + k * 1024); } while (0)
#define PG8_MMA(ai, bj, At, Bt) do { __builtin_amdgcn_s_setprio(1); _Pragma("unroll") for (int m = 0; m < 4; ++m) _Pragma("unroll") for (int n = 0; n < 2; ++n) _Pragma("unroll") for (int k = 0; k < 2; ++k) \
        acc[ai][bj][m][n] = __builtin_amdgcn_mfma_f32_16x16x32_bf16(Bt[n][k], At[m][k], acc[ai][bj][m][n], 0, 0, 0); __builtin_amdgcn_s_setprio(0); } while (0)
#define PG8_WAIT_V(n) asm volatile("s_waitcnt vmcnt(" #n ")" ::: "memory")
#define PG8_WAIT_L(n) asm volatile("s_waitcnt lgkmcnt(" #n ")" ::: "memory")
#define PG8_BAR __builtin_amdgcn_s_barrier()
#define PG8_SCHED __builtin_amdgcn_sched_barrier(0)
    Unit cur, nxt; int ui = 0;
    if (!S.next(0, cur)) return;
    f32x4 acc[2][2][4][2];
#pragma unroll
    for (int a = 0; a < 2; ++a)
#pragma unroll
        for (int b = 0; b < 2; ++b)
#pragma unroll
            for (int m = 0; m < 4; ++m)
#pragma unroll
                for (int n = 0; n < 2; ++n) acc[a][b][m][n] = (f32x4){0.f, 0.f, 0.f, 0.f};
    bf16x8 At[4][2], B0[2][2], B1[2][2];
    const char* cA = (const char*)g.A + (ptrdiff_t)cur.arow * (ptrdiff_t)rstep; const char* cB = (const char*)g.Bt + (size_t)cur.pn * tstep;
    PG8_STAGE(PG8_SB(0, 0), cB, voffB); PG8_STAGE(PG8_SB(0, 1), cB + hstep, voffB); PG8_STAGE(PG8_SA(0, 0), cA, voffA); PG8_STAGE(PG8_SA(0, 1), cA + hstep, voffA);
    if (wr == 1) PG8_BAR;
    PG8_WAIT_V(2); PG8_BAR;
    PG8_STAGE(PG8_SB(1, 0), cB + kstep, voffB); PG8_STAGE(PG8_SA(1, 0), cA + kstep, voffA); PG8_STAGE(PG8_SB(1, 1), cB + hstep + kstep, voffB);
    PG8_WAIT_V(6); PG8_BAR;
    for (;;) {
        const bool has_next = S.next(ui + 1, nxt);
        const char* nA = has_next ? (const char*)g.A + (ptrdiff_t)nxt.arow * (ptrdiff_t)rstep : cA; const char* nB = has_next ? (const char*)g.Bt + (size_t)nxt.pn * tstep : cB;
        for (int t = 0; t < nt; t += 2) {
            const bool last = (t == nt - 2);
            const char* a1 = cA + (size_t)(t + 1) * kstep;
            const char* a2 = last ? nA : cA + (size_t)(t + 2) * kstep; const char* b2 = last ? nB : cB + (size_t)(t + 2) * kstep;
            const char* a3 = a2 + kstep; const char* b3 = b2 + kstep;
            PG8_LDB(B0, 0, 0); PG8_LDB(B1, 0, 1); PG8_SCHED; PG8_LDA(At, 0, 0); PG8_STAGE(PG8_SA(1, 1), a1 + hstep, voffA);
            PG8_WAIT_V(8); PG8_WAIT_L(0); PG8_BAR; PG8_MMA(0, 0, At, B0); PG8_MMA(0, 1, At, B1); PG8_BAR; PG8_SCHED;
            PG8_LDA(At, 0, 1); PG8_STAGE(PG8_SB(0, 0), b2, voffB); PG8_STAGE(PG8_SB(0, 1), b2 + hstep, voffB); PG8_STAGE(PG8_SA(0, 0), a2, voffA);
            PG8_WAIT_V(8); PG8_WAIT_L(0); PG8_BAR; PG8_MMA(1, 0, At, B0); PG8_MMA(1, 1, At, B1); PG8_BAR; PG8_SCHED;
            PG8_LDB(B0, 1, 0); PG8_LDB(B1, 1, 1); PG8_SCHED; PG8_LDA(At, 1, 0); PG8_STAGE(PG8_SA(0, 1), a2 + hstep, voffA);
            PG8_WAIT_V(8); PG8_WAIT_L(0); PG8_BAR; PG8_MMA(0, 0, At, B0); PG8_MMA(0, 1, At, B1); PG8_BAR; PG8_SCHED;
            PG8_LDA(At, 1, 1); PG8_STAGE(PG8_SB(1, 0), b3, voffB); PG8_STAGE(PG8_SB(1, 1), b3 + hstep, voffB); PG8_STAGE(PG8_SA(1, 0), a3, voffA);
            PG8_WAIT_V(8); PG8_WAIT_L(0); PG8_BAR; PG8_MMA(1, 0, At, B0); PG8_MMA(1, 1, At, B1); PG8_BAR; PG8_SCHED;
        }
        if (wr == 0) PG8_BAR;
        E(acc, cur, wr, wc, fr, fq, lds, tid);
        if (!has_next) break;
#pragma unroll
        for (int a = 0; a < 2; ++a)
#pragma unroll
            for (int b = 0; b < 2; ++b)
#pragma unroll
                for (int m = 0; m < 4; ++m)
#pragma unroll
                    for (int n = 0; n < 2; ++n) acc[a][b][m][n] = (f32x4){0.f, 0.f, 0.f, 0.f};
        cur = nxt; cA = nA; cB = nB; ++ui;
        if (wr == 1) PG8_BAR;
    }
    PG8_WAIT_V(0);
    PG8_BAR;
#undef PG8_SA
#undef PG8_SB
#undef PG8_STAGE
#undef PG8_LDA
#undef PG8_LDB
#undef PG8_MMA
#undef PG8_WAIT_V
#undef PG8_WAIT_L
#undef PG8_BAR
#undef PG8_SCHED
}
}

typedef f32x4 AccT[2][2][4][2];

__device__ __forceinline__ void rs_table(LAS unsigned char* lds, const float* ssq, int tok0, int tid) {
    LAS float* rst = (LAS float*)(lds + L_RSTAB);
    if (tid < 256) { int tok = tok0 + tid; tok = tok < 0 ? 0 : (tok >= MT ? MT - 1 : tok);
        const float s = (ssq[tok] + ssq[MT + tok]) + (ssq[2 * MT + tok] + ssq[3 * MT + tok]); rst[tid] = 1.0f / sqrtf(s * (1.0f / D) + EPS); }
    RAW_BAR();
}

struct EpiQKV {
    static constexpr bool PERM = true;
    bf16_t* O; size_t split_stride; const float* ssq; float* okp; float* ovp;
    __device__ __forceinline__ void operator()(const AccT& acc, const pg8::Unit& u, int wr, int wc, int fr, int fq, LAS unsigned char* lds, int tid) const {
        rs_table(lds, ssq, u.pm * 256, tid);
        const LAS float* rst = (const LAS float*)(lds + L_RSTAB);
        const int t = u.pn >> 2, colt = (u.pn & 3) * 256; bf16_t* base = O + (size_t)t * split_stride; const float sc = (t == 0) ? C2 : 1.0f;
        const bool side = (t >= 1) && ((u.pm & 31) >= 30);
        float* sp = (t == 1 ? okp : ovp) + ((size_t)((u.pm >> 5) * CA + (u.pm & 1) * 256)) * D;
        const int col0 = colt + wc * 32 + 8 * fq;
#pragma unroll
        for (int ai = 0; ai < 2; ++ai)
#pragma unroll
            for (int m = 0; m < 4; ++m) { const int r = ai * 128 + wr * 64 + m * 16 + fr; const float rs = rst[r] * sc; bf16_t* rowp = base + (size_t)(u.pm * 256 + r) * D + col0;
#pragma unroll
                for (int bj = 0; bj < 2; ++bj) { const f32x4 v0 = acc[ai][bj][m][0] * rs, v1 = acc[ai][bj][m][1] * rs;
                    u32x4 w; w.x = cvt_pk_bf16(v0[0], v0[1]); w.y = cvt_pk_bf16(v0[2], v0[3]); w.z = cvt_pk_bf16(v1[0], v1[1]); w.w = cvt_pk_bf16(v1[2], v1[3]);
                    *(u32x4*)(rowp + bj * 128) = w;
                    if (side) { float* s = sp + (size_t)r * D + col0 + bj * 128; *(f32x4*)s = v0; *(f32x4*)(s + 4) = v1; } } }
    }
};

struct EpiRes {
    static constexpr bool PERM = false;
    const float* base; float* out; bf16_t* xb; float* ssq;
    __device__ __forceinline__ void operator()(const AccT& acc, const pg8::Unit& u, int wr, int wc, int fr, int fq, LAS unsigned char* lds, int tid) const {
        LAS float* P = (LAS float*)(lds + L_PTAB);
        const int col0 = u.pn * 256 + wc * 32 + 4 * fq;
#pragma unroll
        for (int ai = 0; ai < 2; ++ai)
#pragma unroll
            for (int m = 0; m < 4; ++m) { const int r = ai * 128 + wr * 64 + m * 16 + fr; const size_t off = (size_t)(u.pm * 256 + r) * D + col0; float s = 0.f;
#pragma unroll
                for (int bj = 0; bj < 2; ++bj)
#pragma unroll
                    for (int n = 0; n < 2; ++n) { const f32x4 b = *(const f32x4*)(base + off + bj * 128 + n * 16); const f32x4 v = b + acc[ai][bj][m][n];
                        *(f32x4*)(out + off + bj * 128 + n * 16) = v; s += (v[0] * v[0] + v[1] * v[1]) + (v[2] * v[2] + v[3] * v[3]);
                        u32x2 w; w.x = cvt_pk_bf16(v[0], v[1]); w.y = cvt_pk_bf16(v[2], v[3]); *(u32x2*)(xb + off + bj * 128 + n * 16) = w; }
                s += __shfl_xor(s, 16); s += __shfl_xor(s, 32);
                if (fq == 0) P[r * 4 + wc] = s; }
        RAW_BAR();
        if (tid < 256) { const f32x4 p = *(const LAS f32x4*)(P + tid * 4); ssq[(size_t)u.pn * MT + u.pm * 256 + tid] = (p[0] + p[1]) + (p[2] + p[3]); }
    }
};

struct EpiIn {
    static constexpr bool PERM = true;
    bf16_t* O; size_t split_stride; const float* ssq; float* ssqv;
    __device__ __forceinline__ void operator()(const AccT& acc, const pg8::Unit& u, int wr, int wc, int fr, int fq, LAS unsigned char* lds, int tid) const {
        rs_table(lds, ssq, u.pm * 256, tid);
        const LAS float* rst = (const LAS float*)(lds + L_RSTAB); LAS float* P = (LAS float*)(lds + L_PTAB);
        const int t = u.pn >> 2, colt = (u.pn & 3) * 256; bf16_t* base = O + (size_t)t * split_stride;
        const int col0 = colt + wc * 32 + 8 * fq;
#pragma unroll
        for (int ai = 0; ai < 2; ++ai)
#pragma unroll
            for (int m = 0; m < 4; ++m) { const int r = ai * 128 + wr * 64 + m * 16 + fr; const float rs = rst[r]; bf16_t* rowp = base + (size_t)(u.pm * 256 + r) * D + col0; float s = 0.f;
#pragma unroll
                for (int bj = 0; bj < 2; ++bj) { const f32x4 x0 = acc[ai][bj][m][0] * rs, x1 = acc[ai][bj][m][1] * rs;
                    const f32x2 a = gelu_pk((f32x2){x0[0], x0[1]}), b = gelu_pk((f32x2){x0[2], x0[3]}), c = gelu_pk((f32x2){x1[0], x1[1]}), d = gelu_pk((f32x2){x1[2], x1[3]});
                    s += (a.x * a.x + a.y * a.y) + (b.x * b.x + b.y * b.y) + (c.x * c.x + c.y * c.y) + (d.x * d.x + d.y * d.y);
                    u32x4 w; w.x = cvt_pk_bf16(a.x, a.y); w.y = cvt_pk_bf16(b.x, b.y); w.z = cvt_pk_bf16(c.x, c.y); w.w = cvt_pk_bf16(d.x, d.y);
                    *(u32x4*)(rowp + bj * 128) = w; }
                if (t == 1) { s += __shfl_xor(s, 16); s += __shfl_xor(s, 32); if (fq == 0) P[r * 4 + wc] = s; } }
        if (t == 1) { RAW_BAR();
            if (tid < 256) { const f32x4 p = *(const LAS f32x4*)(P + tid * 4); ssqv[(size_t)(u.pn & 3) * MT + u.pm * 256 + tid] = (p[0] + p[1]) + (p[2] + p[3]); } }
    }
};

__device__ __forceinline__ float dpp_shr1(float v) { return __builtin_bit_cast(float, __builtin_amdgcn_update_dpp(0, __builtin_bit_cast(int, v), 0x111, 0xf, 0xf, true)); }
__device__ __forceinline__ float dpp_shr2(float v) { return __builtin_bit_cast(float, __builtin_amdgcn_update_dpp(0, __builtin_bit_cast(int, v), 0x112, 0xf, 0xf, true)); }
__device__ __forceinline__ float dpp_shl15(float v) { return __builtin_bit_cast(float, __builtin_amdgcn_update_dpp(0, __builtin_bit_cast(int, v), 0x10f, 0xf, 0xf, true)); }
__device__ __forceinline__ float dpp_shl14(float v) { return __builtin_bit_cast(float, __builtin_amdgcn_update_dpp(0, __builtin_bit_cast(int, v), 0x10e, 0xf, 0xf, true)); }

struct EpiUp {
    static constexpr bool PERM = true;
    bf16_t* G; const float* ssq; const float* cw; const float* cb; float* ocp;
    __device__ __forceinline__ void operator()(AccT& acc, const pg8::Unit& u, int wr, int wc, int fr, int fq, LAS unsigned char* lds, int tid) const {
        const int b = u.pm / 33, j = u.pm % 33, tok0 = u.arow;
        rs_table(lds, ssq, tok0, tid);
        const LAS float* rst = (const LAS float*)(lds + L_RSTAB); LAS float* xbuf = (LAS float*)(lds + L_XBUF);
#pragma unroll
        for (int ai = 0; ai < 2; ++ai)
#pragma unroll
            for (int m = 0; m < 4; ++m) { const float rs = rst[ai * 128 + wr * 64 + m * 16 + fr];
#pragma unroll
                for (int bj = 0; bj < 2; ++bj)
#pragma unroll
                    for (int n = 0; n < 2; ++n) acc[ai][bj][m][n] *= rs; }
        if (j == 0 && wr == 0 && fr < 2) {
#pragma unroll
            for (int bj = 0; bj < 2; ++bj)
#pragma unroll
                for (int n = 0; n < 2; ++n) acc[0][bj][0][n] = (f32x4){0.f, 0.f, 0.f, 0.f}; }
        const int cl = wc * 32 + 8 * fq;
        if (j == 32 && wr == 1 && fr < 2) {
#pragma unroll
            for (int bj = 0; bj < 2; ++bj)
#pragma unroll
                for (int n = 0; n < 2; ++n) *(f32x4*)(ocp + (size_t)(b * 2 + fr) * FF2 + bj * FF + u.pn * 128 + cl + 4 * n) = acc[0][bj][0][n]; }
        if (fr >= 14) {
#pragma unroll
            for (int ai = 0; ai < 2; ++ai)
#pragma unroll
                for (int bj = 0; bj < 2; ++bj)
#pragma unroll
                    for (int n = 0; n < 2; ++n) *(LAS f32x4*)(xbuf + ((2 * ai + wr) * 2 + (fr - 14)) * 256 + bj * 128 + cl + 4 * n) = acc[ai][bj][3][n]; }
        RAW_BAR();
        const int bend = (b + 1) * SEQ;
#pragma unroll
        for (int n = 0; n < 2; ++n) {
            f32x4 w0[2], w1[2], w2[2], cbv[2];
#pragma unroll
            for (int bj = 0; bj < 2; ++bj) { const int oc = bj * FF + u.pn * 128 + cl + 4 * n;
                w0[bj] = *(const f32x4*)(cw + oc); w1[bj] = *(const f32x4*)(cw + FF2 + oc); w2[bj] = *(const f32x4*)(cw + 2 * FF2 + oc); cbv[bj] = *(const f32x4*)(cb + oc); }
#pragma unroll
            for (int ai = 0; ai < 2; ++ai) {
                const int ps = (2 * ai + wr + 3) & 3;
#pragma unroll
                for (int m = 3; m >= 0; --m) {
                    f32x4 c[2];
#pragma unroll
                    for (int bj = 0; bj < 2; ++bj) {
                        const f32x4 cur = acc[ai][bj][m][n];
                        f32x4 prv; if (m > 0) prv = acc[ai][bj][m - 1][n]; else prv = *(const LAS f32x4*)(xbuf + (ps * 2 + (fr & 1)) * 256 + bj * 128 + cl + 4 * n);
                        f32x4 o;
#pragma unroll
                        for (int e = 0; e < 4; ++e) { float v = cbv[bj][e] + w2[bj][e] * cur[e];
                            v += w1[bj][e] * (dpp_shr1(cur[e]) + dpp_shl15(prv[e]));
                            v += w0[bj][e] * (dpp_shr2(cur[e]) + dpp_shl14(prv[e])); o[e] = v; }
                        c[bj] = o; }
                    const int tr = ai * 128 + wr * 64 + m * 16 + fr, tok = tok0 + tr;
                    if (tr >= 2 && tok < bend) {
                        u32x2 w;
                        w.x = cvt_pk_bf16(silu1(c[0][0]) * c[1][0], silu1(c[0][1]) * c[1][1]); w.y = cvt_pk_bf16(silu1(c[0][2]) * c[1][2], silu1(c[0][3]) * c[1][3]);
                        *(u32x2*)(G + (size_t)tok * FF + u.pn * 128 + cl + 4 * n) = w; }
                }
            }
        }
    }
};

constexpr int L_SPART = 0, L_SC = 32768, L_SRS = 40960;
template <int K, class BRow>
__device__ __forceinline__ void stask_mm(LAS unsigned char* lds, const bf16_t* A, int arow0, const bf16_t* Bt, BRow brow, const int tid) {
    const int lane = tid & 63, r32 = lane & 31, hi = lane >> 5, w = tid >> 6;
    constexpr int KW = K / 8, NK = KW / 16;
    const bf16_t* ap = A + (size_t)(arow0 + r32) * K + w * KW + hi * 8;
    const bf16_t* bp = Bt + (size_t)brow(r32) * K + w * KW + hi * 8;
    f32x16 acc;
#pragma unroll
    for (int r = 0; r < 16; ++r) acc[r] = 0.f;
#pragma unroll 11
    for (int ks = 0; ks < NK; ++ks) { const bf16x8 a = *(const bf16x8*)(ap + ks * 16), b = *(const bf16x8*)(bp + ks * 16); acc = __builtin_amdgcn_mfma_f32_32x32x16_bf16(a, b, acc, 0, 0, 0); }
    LAS float* part = (LAS float*)(lds + L_SPART) + w * 1024;
#pragma unroll
    for (int r = 0; r < 16; ++r) part[crow(r, hi) * 32 + r32] = acc[r];
    __syncthreads();
    LAS float* C = (LAS float*)(lds + L_SC); const LAS float* P0 = (const LAS float*)(lds + L_SPART);
#pragma unroll
    for (int i = 0; i < 2; ++i) { const int e = tid + i * 512; float s = 0.f;
#pragma unroll
        for (int ww = 0; ww < 8; ++ww) s += P0[ww * 1024 + e];
        C[(e >> 5) * 33 + (e & 31)] = s; }
    __syncthreads();
}
__device__ __forceinline__ void srs_table(LAS unsigned char* lds, const float* ssqs, int mt, int tid) {
    const int row = tid >> 4, jj = tid & 15; float s = ssqs[(size_t)jj * MS + mt * 32 + row] + ssqs[(size_t)(jj + 16) * MS + mt * 32 + row];
    s += __shfl_xor(s, 1); s += __shfl_xor(s, 2); s += __shfl_xor(s, 4); s += __shfl_xor(s, 8);
    if (jj == 0) ((LAS float*)(lds + L_SRS))[row] = 1.0f / sqrtf(s * (1.0f / D) + EPS);
}

namespace att {
constexpr int NS = 6, SLOTB = 8192;
constexpr int L_K = 0, L_V = NS * SLOTB, L_OST = 2 * NS * SLOTB, L_BIAS = 131072, L_WSF = 132352;
#define SBAR() __builtin_amdgcn_sched_barrier(0)
__device__ __forceinline__ void glds16(const void* gsrc, unsigned lds_dst) { unsigned keep;
    asm volatile("s_mov_b32 %0, m0\n\ts_mov_b32 m0, %2\n\ts_nop 0\n\tglobal_load_lds_dwordx4 %1, off\n\ts_mov_b32 m0, %0" : "=&s"(keep) : "v"(gsrc), "s"(lds_dst) : "memory"); }
#define WAIT_BAR(N) asm volatile("s_waitcnt vmcnt(" #N ") lgkmcnt(0)\n\ts_barrier" ::: "memory")

struct State { float m, l; f32x16 o[2]; };

__device__ __forceinline__ void tile(State& st, const bf16x8 (&qr)[4], unsigned kslot, unsigned vslot, float cinit, bool near, int base, bool mask1, const LAS float* tab, LAS float* wsf, int r32, int hi, int lane) {
    f32x16 p0, p1;
    { const LAS char* kb = (const LAS char*)(uintptr_t)kslot + hi * 1024 + r32 * 16;
        f32x16 ci;
#pragma unroll
        for (int r = 0; r < 16; ++r) ci[r] = cinit;
#pragma unroll
        for (int d0 = 0; d0 < 4; ++d0) { const bf16x8 b0 = *(const LAS bf16x8*)(kb + d0 * 2048), b1 = *(const LAS bf16x8*)(kb + d0 * 2048 + 512);
            if (d0 == 0) { p0 = __builtin_amdgcn_mfma_f32_32x32x16_bf16(b0, qr[0], ci, 0, 0, 0); p1 = __builtin_amdgcn_mfma_f32_32x32x16_bf16(b1, qr[0], ci, 0, 0, 0); }
            else { p0 = __builtin_amdgcn_mfma_f32_32x32x16_bf16(b0, qr[d0], p0, 0, 0, 0); p1 = __builtin_amdgcn_mfma_f32_32x32x16_bf16(b1, qr[d0], p1, 0, 0, 0); } } }
    if (near) {
#pragma unroll
        for (int r = 0; r < 16; ++r) { int i0 = base - crow(r, hi), i1 = i0 - 32; i0 = i0 < 0 ? 0 : (i0 > 256 ? 256 : i0); i1 = i1 < 0 ? 0 : (i1 > 256 ? 256 : i1); p0[r] += tab[i0]; p1[r] += tab[i1]; } }
    if (mask1) {
#pragma unroll
        for (int r = 0; r < 16; ++r) p1[r] = -1e30f; }
    float rm = fmaxf(p0[0], p1[0]);
#pragma unroll
    for (int r = 1; r < 16; ++r) rm = fmaxf(rm, fmaxf(p0[r], p1[r]));
    rm = fmaxf(rm, __shfl_xor(rm, 32));
    const float mn = fmaxf(st.m, rm);
    if (__any(mn > st.m)) {
        const float f = __builtin_amdgcn_exp2f(st.m - mn); st.l *= f; st.m = mn;
        if (hi == 0) wsf[r32] = f;
        LDS_WAIT();
#pragma unroll
        for (int g = 0; g < 4; ++g) { const f32x4 fv = *(const LAS f32x4*)(wsf + 8 * g + 4 * hi);
#pragma unroll
            for (int e = 0; e < 4; ++e) { st.o[0][4 * g + e] *= fv[e]; st.o[1][4 * g + e] *= fv[e]; } }
    }
    float sacc = 0.f;
#pragma unroll
    for (int r = 0; r < 16; ++r) { p0[r] = __builtin_amdgcn_exp2f(p0[r] - st.m); p1[r] = __builtin_amdgcn_exp2f(p1[r] - st.m); sacc += p0[r] + p1[r]; }
    st.l += sacc;
    u32x4 pw[4];
#pragma unroll
    for (int k = 0; k < 2; ++k) { pw[k] = (u32x4){cvt_pk_bf16(p0[8 * k], p0[8 * k + 1]), cvt_pk_bf16(p0[8 * k + 2], p0[8 * k + 3]), cvt_pk_bf16(p0[8 * k + 4], p0[8 * k + 5]), cvt_pk_bf16(p0[8 * k + 6], p0[8 * k + 7])};
        pw[2 + k] = (u32x4){cvt_pk_bf16(p1[8 * k], p1[8 * k + 1]), cvt_pk_bf16(p1[8 * k + 2], p1[8 * k + 3]), cvt_pk_bf16(p1[8 * k + 4], p1[8 * k + 5]), cvt_pk_bf16(p1[8 * k + 6], p1[8 * k + 7])}; }
    const int vb = (int)vslot + ((lane >> 4) & 1) * 32 + (lane & 3) * 8 + (4 * hi + ((lane & 15) >> 2)) * 64;
#pragma unroll
    for (int d0 = 0; d0 < 2; ++d0) { s16x4 lo[4], hh[4];
#pragma unroll
        for (int ks = 0; ks < 4; ++ks) {
            asm volatile("ds_read_b64_tr_b16 %0,%1 offset:%c2" : "=&v"(lo[ks]) : "v"(vb), "i"(d0 * 4096 + ks * 1024) : "memory");
            asm volatile("ds_read_b64_tr_b16 %0,%1 offset:%c2" : "=&v"(hh[ks]) : "v"(vb), "i"(d0 * 4096 + ks * 1024 + 512) : "memory"); }
        asm volatile("s_waitcnt lgkmcnt(0)" ::: "memory"); SBAR();
#pragma unroll
        for (int ks = 0; ks < 4; ++ks) { const bf16x8 vf = (bf16x8){lo[ks][0], lo[ks][1], lo[ks][2], lo[ks][3], hh[ks][0], hh[ks][1], hh[ks][2], hh[ks][3]};
            st.o[d0] = __builtin_amdgcn_mfma_f32_32x32x16_bf16(__builtin_bit_cast(bf16x8, pw[ks]), vf, st.o[d0], 0, 0, 0); }
    }
}

__device__ __forceinline__ void prompt_unit(int b, int h, int qg, const bf16_t* Q, const bf16_t* Kg, const bf16_t* Vg, bf16_t* O, LAS unsigned char* lds, const int tid) {
    const int lane = tid & 63, r32 = lane & 31, hi = lane >> 5; const int wid = __builtin_amdgcn_readfirstlane(tid >> 6);
    const int c0 = 4 * qg, pj = wid >> 1, half = wid & 1; const long rowbase = (long)b * SEQ;
    const unsigned lds0 = (unsigned)(uintptr_t)lds;
    const LAS float* tab = (const LAS float*)(lds + L_BIAS); LAS float* wsf = (LAS float*)(lds + L_WSF) + wid * 64;
    const bf16_t* Qw = Q + (rowbase + 64 * (c0 + pj) + 32 * half) * D + h * HD;
    const bf16_t* Kh = Kg + rowbase * D + h * HD; const bf16_t* Vh = Vg + rowbase * D + h * HD;
#define DMA_T(i) do { int ck_ = c0 - 8 + (i); ck_ = ck_ < 0 ? 0 : ck_; const unsigned so_ = (unsigned)(((i) % NS) * SLOTB + wid * 1024); \
        glds16(Kh + (long)(64 * ck_ + lane) * D + wid * 8, (unsigned)__builtin_amdgcn_readfirstlane(lds0 + L_K + so_)); \
        glds16(Vh + (long)(64 * ck_ + 16 * (wid & 3) + (lane >> 2)) * D + (wid >> 2) * 32 + (lane & 3) * 8, (unsigned)__builtin_amdgcn_readfirstlane(lds0 + L_V + so_)); } while (0)
    DMA_T(0); DMA_T(1); DMA_T(2); DMA_T(3); DMA_T(4);
    bf16x8 qr[4];
#pragma unroll
    for (int d0 = 0; d0 < 4; ++d0) qr[d0] = *(const bf16x8*)(Qw + (long)r32 * D + d0 * 16 + hi * 8);
    State st; st.m = -1e30f; st.l = 0.f;
#pragma unroll
    for (int r = 0; r < 16; ++r) { st.o[0][r] = 0.f; st.o[1][r] = 0.f; }
    const float cfar = tab[256];
    const int ql = 32 * half + r32;
    for (int s = 0; s < 9; ++s) {
        if (s == 0) { WAIT_BAR(0); asm volatile("" : "+v"(qr[0]), "+v"(qr[1]), "+v"(qr[2]), "+v"(qr[3])); }
        else if (s < 8) WAIT_BAR(2); else WAIT_BAR(0);
        if (s + 5 < 12) DMA_T(s + 5);
        const int ck = c0 - 8 + s + pj;
        if (ck >= 0) { const int sl = (s + pj) % NS; const bool near = s >= 6;
            tile(st, qr, lds0 + L_K + sl * SLOTB, lds0 + L_V + sl * SLOTB, near ? 0.f : cfar, near, 64 * (8 - s) + ql + 128, false, tab, wsf, r32, hi, lane); }
    }
#undef DMA_T
    float l = st.l + __shfl_xor(st.l, 32);
    if (hi == 0) wsf[32 + r32] = l;
    LDS_WAIT();
    float rli[16];
#pragma unroll
    for (int r = 0; r < 16; ++r) rli[r] = __builtin_amdgcn_rcpf(wsf[32 + crow(r, hi)]);
    bf16_t* Ow = O + (rowbase + 64 * (c0 + pj) + 32 * half) * D + h * HD;
    { LAS bf16_t* stg = (LAS bf16_t*)(lds + L_OST) + wid * 2048;
#pragma unroll
        for (int r = 0; r < 16; ++r) { const int orow = crow(r, hi);
#pragma unroll
            for (int d0 = 0; d0 < 2; ++d0) stg[orow * 64 + d0 * 32 + r32] = (bf16_t)(cvt_pk_bf16(st.o[d0][r] * rli[r], 0.f) & 0xffffu); }
        LDS_WAIT();
#pragma unroll
        for (int i = 0; i < 4; ++i) { const int row = i * 8 + (lane >> 3), ch = lane & 7; const u32x4 v = *(const LAS u32x4*)(stg + row * 64 + ch * 8); *(u32x4*)(Ow + (long)row * D + ch * 8) = v; } }
    asm volatile("s_waitcnt lgkmcnt(0)\n\ts_barrier" ::: "memory");
}

__device__ __forceinline__ void sample_unit(int b, int h, const bf16_t* Q, const bf16_t* Kg, const bf16_t* Vg, const bf16_t* CK, const bf16_t* CV, bf16_t* O, LAS unsigned char* lds, const int tid) {
    const int lane = tid & 63, r32 = lane & 31, hi = lane >> 5; const int wid = __builtin_amdgcn_readfirstlane(tid >> 6);
    const unsigned lds0 = (unsigned)(uintptr_t)lds;
    const LAS float* tab = (const LAS float*)(lds + L_BIAS); LAS float* wsf = (LAS float*)(lds + L_WSF) + wid * 64;
    const long srow = (long)MP + 32 * b;
    const bf16_t* Qw = Q + srow * D + h * HD;
    const unsigned ks = lds0 + wid * 16384, vs = ks + 8192;
    { const bf16_t* Kc = CK + ((long)b * CA + 64 * wid) * D + h * HD; const bf16_t* Vc = CV + ((long)b * CA + 64 * wid) * D + h * HD;
#pragma unroll
        for (int p = 0; p < 8; ++p) { glds16(Kc + (long)lane * D + p * 8, (unsigned)__builtin_amdgcn_readfirstlane(ks + p * 1024));
            glds16(Vc + (long)(16 * (p & 3) + (lane >> 2)) * D + (p >> 2) * 32 + (lane & 3) * 8, (unsigned)__builtin_amdgcn_readfirstlane(vs + p * 1024)); } }
    bf16x8 qr[4];
#pragma unroll
    for (int d0 = 0; d0 < 4; ++d0) qr[d0] = *(const bf16x8*)(Qw + (long)r32 * D + d0 * 16 + hi * 8);
    State st; st.m = -1e30f; st.l = 0.f;
#pragma unroll
    for (int r = 0; r < 16; ++r) { st.o[0][r] = 0.f; st.o[1][r] = 0.f; }
    asm volatile("s_waitcnt vmcnt(0)" ::: "memory"); asm volatile("" : "+v"(qr[0]), "+v"(qr[1]), "+v"(qr[2]), "+v"(qr[3]));
    { const bool near = wid >= 6; tile(st, qr, ks, vs, near ? 0.f : tab[256], near, r32 + 512 - 64 * wid + 128, false, tab, wsf, r32, hi, lane); }
    if (wid == 0) {
        const bf16_t* Kn = Kg + srow * D + h * HD; const bf16_t* Vn = Vg + srow * D + h * HD;
#pragma unroll
        for (int p = 0; p < 8; ++p) { const int kr = lane < 32 ? lane : 31; const int vr0 = 16 * (p & 3) + (lane >> 2), vr = vr0 < 32 ? vr0 : 31;
            glds16(Kn + (long)kr * D + p * 8, (unsigned)__builtin_amdgcn_readfirstlane(ks + p * 1024));
            glds16(Vn + (long)vr * D + (p >> 2) * 32 + (lane & 3) * 8, (unsigned)__builtin_amdgcn_readfirstlane(vs + p * 1024)); }
        asm volatile("s_waitcnt vmcnt(0)" ::: "memory");
        tile(st, qr, ks, vs, 0.f, true, r32 + 128, true, tab, wsf, r32, hi, lane);
    }
    const float l = st.l + __shfl_xor(st.l, 32);
    asm volatile("s_waitcnt lgkmcnt(0)\n\ts_barrier" ::: "memory");
    LAS float* OP = (LAS float*)lds;
    LAS float* MLp = (LAS float*)(lds + 65536);
#pragma unroll
    for (int r = 0; r < 16; ++r) { const int q = crow(r, hi); OP[(wid * 32 + q) * 64 + r32] = st.o[0][r]; OP[(wid * 32 + q) * 64 + 32 + r32] = st.o[1][r]; }
    if (hi == 0) { MLp[wid * 32 + r32] = st.m; MLp[256 + wid * 32 + r32] = l; }
    __syncthreads();
    { const int q = tid >> 4, d4 = (tid & 15) * 4; float mg = -1e30f;
#pragma unroll
        for (int w = 0; w < 8; ++w) mg = fmaxf(mg, MLp[w * 32 + q]);
        f32x4 num = (f32x4){0.f, 0.f, 0.f, 0.f}; float den = 0.f;
#pragma unroll
        for (int w = 0; w < 8; ++w) { const float f = __builtin_amdgcn_exp2f(MLp[w * 32 + q] - mg); den += f * MLp[256 + w * 32 + q]; num += *(const LAS f32x4*)(OP + (w * 32 + q) * 64 + d4) * f; }
        const float rd = 1.0f / den; u32x2 w2; w2.x = cvt_pk_bf16(num[0] * rd, num[1] * rd); w2.y = cvt_pk_bf16(num[2] * rd, num[3] * rd);
        *(u32x2*)(O + (srow + q) * D + h * HD + d4) = w2; }
    __syncthreads();
}
#undef WAIT_BAR
}

namespace gate {
constexpr int L_VS = 0, L_STG = 32768, L_RV = 98304;
__device__ __forceinline__ void unit(bool sample, int nb, int gp, bf16_t* U, const bf16_t* Vv, const float* ssqv, const float* ssqvs, const float* vgain, const float* wsp, const float* bsp, float* ogv, LAS unsigned char* lds, const int tid) {
    const int lane = tid & 63, r32 = lane & 31, hi = lane >> 5; const int wid = __builtin_amdgcn_readfirstlane(tid >> 6);
    const long tok0 = sample ? (long)MP + 32 * nb : (long)128 * nb; const int nrows = sample ? 32 : 128;
    LAS float* rv = (LAS float*)(lds + L_RV);
    if (!sample) { if (tid < 128) { const long t = tok0 + tid; const float s = (ssqv[t] + ssqv[MT + t]) + (ssqv[2 * MT + t] + ssqv[3 * MT + t]); rv[tid] = 1.0f / sqrtf(s * (1.0f / D) + EPS); } }
    else { const int row = tid >> 4, jj = tid & 15; float s = ssqvs[(size_t)jj * MS + nb * 32 + row] + ssqvs[(size_t)(jj + 16) * MS + nb * 32 + row];
        s += __shfl_xor(s, 1); s += __shfl_xor(s, 2); s += __shfl_xor(s, 4); s += __shfl_xor(s, 8); if (jj == 0) rv[row] = 1.0f / sqrtf(s * (1.0f / D) + EPS); }
    __syncthreads();
    for (int pi = wid; pi < 32; pi += 8) { const int gi = pi >> 4, qt = (pi >> 3) & 1, dh = (pi >> 2) & 1, rg = pi & 3;
        const int row = 64 * qt + 16 * rg + (lane >> 2), col = 64 * (2 * gp + gi) + 32 * dh + 8 * (lane & 3);
        if (row < nrows) { const u32x4 raw = *(const u32x4*)(Vv + (tok0 + row) * D + col); const float rs = rv[row];
            const f32x4 g0 = *(const f32x4*)(vgain + col), g1 = *(const f32x4*)(vgain + col + 4);
            float f[8]; f[0] = bf2f(raw.x & 0xffffu) * rs * g0[0]; f[1] = bf2f(raw.x >> 16) * rs * g0[1]; f[2] = bf2f(raw.y & 0xffffu) * rs * g0[2]; f[3] = bf2f(raw.y >> 16) * rs * g0[3];
            f[4] = bf2f(raw.z & 0xffffu) * rs * g1[0]; f[5] = bf2f(raw.z >> 16) * rs * g1[1]; f[6] = bf2f(raw.w & 0xffffu) * rs * g1[2]; f[7] = bf2f(raw.w >> 16) * rs * g1[3];
            u32x4 w; w.x = cvt_pk_bf16(f[0], f[1]); w.y = cvt_pk_bf16(f[2], f[3]); w.z = cvt_pk_bf16(f[4], f[5]); w.w = cvt_pk_bf16(f[6], f[7]);
            *(LAS u32x4*)(lds + L_VS + (gi * 2 + qt) * 8192 + (dh * 4 + rg) * 1024 + lane * 16) = w;
            if (sample) { float* o = ogv + (size_t)(nb * 32 + row) * D + col; *(f32x4*)o = (f32x4){f[0], f[1], f[2], f[3]}; *(f32x4*)(o + 4) = (f32x4){f[4], f[5], f[6], f[7]}; } } }
    __syncthreads();
    const int gi = wid >> 2, pb = wid & 3, g = 2 * gp + gi;
    if (pb * 32 < nrows) {
        const int nks = sample ? 2 : (pb < 2 ? 4 : 8);
        f32x16 o[2];
#pragma unroll
        for (int r = 0; r < 16; ++r) { o[0][r] = 0.f; o[1][r] = 0.f; }
        const float* wrow = wsp + ((size_t)g * 128 + 32 * pb + r32) * 128 + 4 * hi;
        const unsigned lds0 = (unsigned)(uintptr_t)lds;
        for (int ks = 0; ks < nks; ++ks) {
            const f32x4 a0 = *(const f32x4*)(wrow + 16 * ks), a1 = *(const f32x4*)(wrow + 16 * ks + 8);
            u32x4 pa; pa.x = cvt_pk_bf16(a0[0], a0[1]); pa.y = cvt_pk_bf16(a0[2], a0[3]); pa.z = cvt_pk_bf16(a1[0], a1[1]); pa.w = cvt_pk_bf16(a1[2], a1[3]);
            const int vb = (int)(lds0 + L_VS + (gi * 2 + (ks >> 2)) * 8192 + (ks & 3) * 1024) + ((lane >> 4) & 1) * 32 + (lane & 3) * 8 + (4 * hi + ((lane & 15) >> 2)) * 64;
            s16x4 lo[2], hh[2];
#pragma unroll
            for (int d0 = 0; d0 < 2; ++d0) {
                asm volatile("ds_read_b64_tr_b16 %0,%1 offset:%c2" : "=&v"(lo[d0]) : "v"(vb), "i"(d0 * 4096) : "memory");
                asm volatile("ds_read_b64_tr_b16 %0,%1 offset:%c2" : "=&v"(hh[d0]) : "v"(vb), "i"(d0 * 4096 + 512) : "memory"); }
            asm volatile("s_waitcnt lgkmcnt(0)" ::: "memory"); __builtin_amdgcn_sched_barrier(0);
#pragma unroll
            for (int d0 = 0; d0 < 2; ++d0) { const bf16x8 vf = (bf16x8){lo[d0][0], lo[d0][1], lo[d0][2], lo[d0][3], hh[d0][0], hh[d0][1], hh[d0][2], hh[d0][3]};
                o[d0] = __builtin_amdgcn_mfma_f32_32x32x16_bf16(__builtin_bit_cast(bf16x8, pa), vf, o[d0], 0, 0, 0); }
        }
        LAS float* stg = (LAS float*)(lds + L_STG) + wid * 2048;
        const float* bs = bsp + g * 128 + 32 * pb;
#pragma unroll
        for (int r = 0; r < 16; ++r) { const int q = crow(r, hi); const float bq = bs[q]; stg[q * 64 + r32] = o[0][r] + bq; stg[q * 64 + 32 + r32] = o[1][r] + bq; }
        LDS_WAIT();
#pragma unroll
        for (int i = 0; i < 4; ++i) { const int row = i * 8 + (lane >> 3), ch = lane & 7;
            const f32x4 m0 = *(const LAS f32x4*)(stg + row * 64 + ch * 8), m1 = *(const LAS f32x4*)(stg + row * 64 + ch * 8 + 4);
            bf16_t* up = U + (tok0 + 32 * pb + row) * D + 64 * g + ch * 8; const u32x4 uu = *(const u32x4*)up;
            u32x4 w; w.x = cvt_pk_bf16(bf2f(uu.x & 0xffffu) * m0[0], bf2f(uu.x >> 16) * m0[1]); w.y = cvt_pk_bf16(bf2f(uu.y & 0xffffu) * m0[2], bf2f(uu.y >> 16) * m0[3]);
            w.z = cvt_pk_bf16(bf2f(uu.z & 0xffffu) * m1[0], bf2f(uu.z >> 16) * m1[1]); w.w = cvt_pk_bf16(bf2f(uu.w & 0xffffu) * m1[2], bf2f(uu.w >> 16) * m1[3]);
            *(u32x4*)up = w; }
    }
    __syncthreads();
}
}

template <bool UP>
__device__ __forceinline__ void transpose_item(const float* W, int K, int N, const float* gain, bf16_t* WT, LAS float* scr, int item, int lane) {
    const int nblk = N / 32, kb = item / nblk, nb = item % nblk, k0 = 64 * kb, n0 = 32 * nb;
#pragma unroll 8
    for (int i = 0; i < 32; ++i) { const int kk = 2 * i + (lane >> 5); const float gk = gain ? gain[k0 + kk] : 1.0f; scr[kk * 33 + (lane & 31)] = W[(size_t)(k0 + kk) * N + n0 + (lane & 31)] * gk; }
    LDS_WAIT(); asm volatile("" ::: "memory");
    const int c = lane & 7;
#pragma unroll
    for (int jj = 0; jj < 4; ++jj) { const int n = (lane >> 3) + 8 * jj; const LAS float* s = scr + (8 * c) * 33 + n;
        u32x4 o; o.x = cvt_pk_bf16(s[0 * 33], s[1 * 33]); o.y = cvt_pk_bf16(s[2 * 33], s[3 * 33]); o.z = cvt_pk_bf16(s[4 * 33], s[5 * 33]); o.w = cvt_pk_bf16(s[6 * 33], s[7 * 33]);
        int dn = n0 + n; if (UP) { const int v = dn >= FF ? 1 : 0, gc = dn - v * FF; dn = 256 * (gc >> 7) + 128 * v + (gc & 127); }
        *(u32x4*)(WT + (size_t)dn * K + k0 + 8 * c) = o; }
    LDS_WAIT(); asm volatile("" ::: "memory");
}

#define XB_TMO      128
#define XB_XCNT(j)  (256  + 64 * (j))
#define XB_XSUB(j)  (1280 + 64 * (j))
#define XB_XGEN(j)  (2304 + 64 * (j))
#define XB_TOP      3328
#define XB_TOPGEN   3392
#define XCD_BAR_WORDS 3456
#define XB_SPIN_CAP (1u << 18)
__device__ __forceinline__ unsigned xb_ld(unsigned* p)              { return __hip_atomic_load(p, __ATOMIC_RELAXED, __HIP_MEMORY_SCOPE_AGENT); }
__device__ __forceinline__ unsigned xb_add(unsigned* p, unsigned v) { return __hip_atomic_fetch_add(p, v, __ATOMIC_RELAXED, __HIP_MEMORY_SCOPE_AGENT); }
__device__ __forceinline__ unsigned xb_xcc_id() { return (unsigned)__builtin_amdgcn_s_getreg((3 << 11) | 20) & 0xFu; }
#define XB_SPIN(cond, bar) do { unsigned _sp = 0; while (cond) { __builtin_amdgcn_s_sleep(1); \
    if ((++_sp & 255u) == 0u) { if (xb_ld(&(bar)[XB_TMO])) break; if (_sp > XB_SPIN_CAP) { atomicAdd(&(bar)[XB_TMO], 1u); break; } } } } while (0)
struct XcdBarrier { unsigned* bar; unsigned x; volatile LAS unsigned* st; };
__device__ __forceinline__ void xcd_barrier_complete(unsigned* bar, unsigned x, unsigned& nloc, unsigned& nx) {
    const unsigned G = gridDim.x * gridDim.y * gridDim.z;
    unsigned sum, cnt, mine, sp = 0u;
    for (;;) {
        sum = 0u; cnt = 0u; mine = 0u;
#pragma unroll
        for (unsigned j = 0; j < 16; ++j) { const unsigned c = xb_ld(&bar[XB_XCNT(j)]); sum += c; cnt += (c > 0u) ? 1u : 0u; mine = (j == x) ? c : mine; }
        if (sum == G) break;
        __builtin_amdgcn_s_sleep(1);
        if ((++sp & 255u) == 0u) { if (xb_ld(&bar[XB_TMO])) break; if (sp > XB_SPIN_CAP) { atomicAdd(&bar[XB_TMO], 1u); break; } }
    }
    nloc = mine > 0u ? mine : 1u; nx = cnt > 0u ? cnt : 1u;
}
__device__ __forceinline__ void xcd_barrier(const XcdBarrier& b, const int tid) {
    asm volatile("s_waitcnt vmcnt(0)" ::: "memory");
    __syncthreads();
    if (tid == 0) {
        unsigned* bar = b.bar;
        __builtin_amdgcn_s_waitcnt(0);
        unsigned nloc = b.st[0], nx = b.st[1];
        if (nloc == 0u) { xcd_barrier_complete(bar, b.x, nloc, nx); b.st[0] = nloc; b.st[1] = nx; }
        const unsigned old = xb_add(&bar[XB_XSUB(b.x)], 1u);
        const unsigned gen = old / nloc;
        if (old + 1u == (gen + 1u) * nloc) {
            __builtin_amdgcn_fence(__ATOMIC_RELEASE, "agent");
            asm volatile("s_waitcnt vmcnt(0)" ::: "memory");
            const unsigned og = xb_add(&bar[XB_TOP], 1u);
            const unsigned tg = og / nx;
            if (og + 1u == (tg + 1u) * nx) xb_add(&bar[XB_TOPGEN], 1u);
            else XB_SPIN(xb_ld(&bar[XB_TOPGEN]) == tg, bar);
            __builtin_amdgcn_fence(__ATOMIC_ACQUIRE, "agent");
            xb_add(&bar[XB_XGEN(b.x)], 1u);
            asm volatile("s_waitcnt vmcnt(0)" ::: "memory");
        } else {
            XB_SPIN(xb_ld(&bar[XB_XGEN(b.x)]) == gen, bar);
            __builtin_amdgcn_fence(__ATOMIC_ACQUIRE, "agent");
            asm volatile("s_waitcnt vmcnt(0)" ::: "memory");
        }
    }
    __syncthreads();
}

#ifndef PHM
#define PHM 0xfff
#endif
#define PH(k) ((PHM >> (k)) & 1)
struct Args { const float* in[20]; float* out; unsigned char* ws; };

__global__ void __launch_bounds__(NTHR, 2) fwd_kernel(Args a) {
    extern __shared__ __attribute__((aligned(16))) unsigned char lds_raw[];
    LAS unsigned char* lds = (LAS unsigned char*)lds_raw;
    const int wave0 = __builtin_amdgcn_readfirstlane((int)threadIdx.x >> 6);
    XcdBarrier bar;
    { volatile LAS unsigned* MISC = (volatile LAS unsigned*)(lds + L_MISC);
        if (threadIdx.x < 4) MISC[threadIdx.x] = 0u;
        __syncthreads();
        bar.bar = (unsigned*)(a.ws + WS_CTL); bar.x = xb_xcc_id(); bar.st = MISC;
        if (threadIdx.x == 0) (void)xb_add(&bar.bar[XB_XCNT(bar.x)], 1u); }
#define GRID_BAR() do { PHASE_VARS xcd_barrier(bar, tid); } while (0)
#define PHASE_VARS int tid; asm volatile("v_mbcnt_lo_u32_b32 %0, -1, 0\n\tv_mbcnt_hi_u32_b32 %0, -1, %0" : "=v"(tid)); tid |= wave0 << 6; const int lane = tid & 63, wave = wave0; (void)lane; (void)wave;
    const int G = gridDim.x, bx = blockIdx.x; const int vcu = (G % 8 == 0) ? (bx % 8) * (G / 8) + bx / 8 : bx;
    unsigned char* ws = a.ws; float* out = a.out;
    const float *x_prompt = a.in[0], *x_sample = a.in[1], *cache_k = a.in[2], *cache_v = a.in[3], *state_conv = a.in[4], *ln_mix = a.in[5], *ln_ffn = a.in[6], *ln_final = a.in[7],
                *w_qkv = a.in[8], *rel_bias = a.in[9], *w_o = a.in[10], *w_in = a.in[11], *v_norm = a.in[12], *w_s = a.in[13], *bias_s = a.in[14], *w_out = a.in[15],
                *w_up = a.in[16], *conv_w = a.in[17], *conv_b = a.in[18], *w_down = a.in[19];
    bf16_t *Wqkv_t = (bf16_t*)(ws + WS_WQKV), *Wo_t = (bf16_t*)(ws + WS_WO), *Win_t = (bf16_t*)(ws + WS_WIN), *Wout_t = (bf16_t*)(ws + WS_WOUT);
    bf16_t *XB = (bf16_t*)(ws + WS_XB), *QB = (bf16_t*)(ws + WS_Q), *KB = (bf16_t*)(ws + WS_K), *VB = (bf16_t*)(ws + WS_V), *GB = (bf16_t*)(ws + WS_G), *CKB = (bf16_t*)(ws + WS_CK), *CVB = (bf16_t*)(ws + WS_CV);
    float *SSQ = (float*)(ws + WS_SSQ), *SSQV = (float*)(ws + WS_SSQV), *SSQS = (float*)(ws + WS_SSQS), *SSQVS = (float*)(ws + WS_SSQVS);
    float* XS = out + O_YS;

    if (PH(0)) { PHASE_VARS
        LAS float* scr = (LAS float*)(lds + wave * 16384);
        const int gw = vcu * NWAVES + wave, NGW = G * NWAVES;
        constexpr int I_QKV = (D / 64) * (3 * D / 32), I_O = (D / 64) * (D / 32), I_IN = (D / 64) * (2 * D / 32), I_UP = (D / 64) * (FF2 / 32), I_DN = (FF / 64) * (D / 32);
        constexpr int NITEMS = I_QKV + 2 * I_O + I_IN + 2 * I_UP + 2 * I_DN;
        for (int it = gw; it < NITEMS; it += NGW) {
            int r = it;
            if (r < I_QKV) { transpose_item<false>(w_qkv, D, 3 * D, ln_mix, Wqkv_t, scr, r, lane); continue; } r -= I_QKV;
            if (r < I_O) { transpose_item<false>(w_o, D, D, nullptr, Wo_t, scr, r, lane); continue; } r -= I_O;
            if (r < I_IN) { transpose_item<false>(w_in, D, 2 * D, ln_mix + D, Win_t, scr, r, lane); continue; } r -= I_IN;
            if (r < I_O) { transpose_item<false>(w_out, D, D, nullptr, Wout_t, scr, r, lane); continue; } r -= I_O;
            if (r < 2 * I_UP) { const int l = r / I_UP; transpose_item<true>(w_up + (size_t)l * D * FF2, D, FF2, ln_ffn + l * D, (bf16_t*)(ws + WS_WUP + l * WUP_L), scr, r % I_UP, lane); continue; } r -= 2 * I_UP;
            { const int l = r / I_DN; transpose_item<false>(w_down + (size_t)l * FF * D, FF, D, nullptr, (bf16_t*)(ws + WS_WDN + l * WDN_L), scr, r % I_DN, lane); }
        }
        for (int m = gw; m < MT; m += NGW) {
            const float* xr = m < MP ? x_prompt + (size_t)m * D : x_sample + (size_t)(m - MP) * D;
            f32x4 v[4]; float s = 0.f;
#pragma unroll
            for (int jj = 0; jj < 4; ++jj) { v[jj] = ((const f32x4*)xr)[lane + 64 * jj]; s += (v[jj][0] * v[jj][0] + v[jj][1] * v[jj][1]) + (v[jj][2] * v[jj][2] + v[jj][3] * v[jj][3]); }
            s = wave_sum(s);
#pragma unroll
            for (int jj = 0; jj < 4; ++jj) { u32x2 w; w.x = cvt_pk_bf16(v[jj][0], v[jj][1]); w.y = cvt_pk_bf16(v[jj][2], v[jj][3]); ((u32x2*)(XB + (size_t)m * D))[lane + 64 * jj] = w; }
            if (m < MP) { if (lane < 4) SSQ[(size_t)lane * MT + m] = lane == 0 ? s : 0.f; }
            else { if (lane < 32) SSQS[(size_t)lane * MS + (m - MP)] = lane == 0 ? s : 0.f; }
        }
        for (int m = gw; m < 2 * DB * CA; m += NGW) { const int which = m >= DB * CA, rr = m - which * DB * CA; const float* src = (which ? cache_v : cache_k) + (size_t)rr * D; bf16_t* dst = (which ? CVB : CKB) + (size_t)rr * D;
#pragma unroll
            for (int jj = 0; jj < 4; ++jj) { const f32x4 v = ((const f32x4*)src)[lane + 64 * jj]; u32x2 w; w.x = cvt_pk_bf16(v[0], v[1]); w.y = cvt_pk_bf16(v[2], v[3]); ((u32x2*)dst)[lane + 64 * jj] = w; } }
    }
    GRID_BAR();

    if (PH(1)) { PHASE_VARS
        for (int task = vcu; task < DB * 96; task += G) { const int mt = task / 96, nt = task % 96;
            srs_table(lds, SSQS, mt, tid);
            stask_mm<D>(lds, XB, MP + 32 * mt, Wqkv_t, [&](int jn) { return 32 * nt + jn; }, tid);
            const LAS float* C = (const LAS float*)(lds + L_SC); const LAS float* rs = (const LAS float*)(lds + L_SRS);
            const int row = tid >> 4, c0 = (tid & 15) * 2, n = 32 * nt + c0, t = n >> 10, nn = n & 1023; const float r_ = rs[row];
            const float v0 = C[row * 33 + c0] * r_, v1 = C[row * 33 + c0 + 1] * r_; const float sc = t == 0 ? C2 : 1.0f;
            bf16_t* dst = (t == 0 ? QB : (t == 1 ? KB : VB)) + (size_t)(MP + 32 * mt + row) * D + nn; *(unsigned*)dst = cvt_pk_bf16(v0 * sc, v1 * sc);
            if (t >= 1) { float* o = out + (t == 1 ? O_KS : O_VS) + (size_t)(32 * mt + row) * D + nn; *(f32x2*)o = (f32x2){v0, v1}; }
            __syncthreads();
        }
        pg8::Gemm g{XB, Wqkv_t, D}; pg8::StaticOrder S; S.init(MP / 256, 3 * D / 256, G, bx, 0);
        EpiQKV E{QB, (size_t)(WS_K - WS_Q) / 2, SSQ, out + O_KP, out + O_VP};
        pg8::gemm_phase<EpiQKV, pg8::StaticOrder>(lds, g, S, E, tid);
    }
    GRID_BAR();

    if (PH(2)) { PHASE_VARS
        LAS float* tab = (LAS float*)(lds + att::L_BIAS);
        const int per = (NB * NH * 32 + G - 1) / G;
        int lasth = -1;
        for (int id = vcu * per; id < (vcu + 1) * per && id < NB * NH * 32; ++id) { const int bh = id >> 5, qg = id & 31, b = bh / NH, h = bh % NH;
            if (h != lasth) { __syncthreads(); for (int i = tid; i < NREL; i += NTHR) tab[i] = rel_bias[h * NREL + i] * LOG2E; __syncthreads(); lasth = h; }
            att::prompt_unit(b, h, qg, QB, KB, VB, QB, lds, tid); }
        for (int id = vcu; id < DB * NH; id += G) { const int b = id / NH, h = id % NH;
            if (h != lasth) { __syncthreads(); for (int i = tid; i < NREL; i += NTHR) tab[i] = rel_bias[h * NREL + i] * LOG2E; __syncthreads(); lasth = h; }
            att::sample_unit(b, h, QB, KB, VB, CKB, CVB, QB, lds, tid); }
    }
    GRID_BAR();

#define RES_PHASE(A_, Wt_, KK, BASE_P, BASE_S) do { \
        for (int task = vcu; task < DB * 32; task += G) { const int mt = task / 32, nt = task % 32; \
            stask_mm<KK>(lds, A_, MP + 32 * mt, Wt_, [&](int jn) { return 32 * nt + jn; }, tid); \
            const LAS float* C = (const LAS float*)(lds + L_SC); \
            const int row = tid >> 4, c0 = (tid & 15) * 2, n = 32 * nt + c0; const size_t o_ = (size_t)(32 * mt + row) * D + n; \
            const f32x2 bb = *(const f32x2*)((BASE_S) + o_); const float v0 = bb.x + C[row * 33 + c0], v1 = bb.y + C[row * 33 + c0 + 1]; \
            *(f32x2*)(XS + o_) = (f32x2){v0, v1}; *(unsigned*)(XB + (size_t)MP * D + o_) = cvt_pk_bf16(v0, v1); \
            float s_ = v0 * v0 + v1 * v1; s_ += __shfl_xor(s_, 1); s_ += __shfl_xor(s_, 2); s_ += __shfl_xor(s_, 4); s_ += __shfl_xor(s_, 8); \
            if ((tid & 15) == 0) SSQS[(size_t)nt * MS + 32 * mt + row] = s_; \
            __syncthreads(); } \
        pg8::Gemm g{A_, Wt_, KK}; pg8::StaticOrder S; S.init(MP / 256, D / 256, G, bx, 0); \
        EpiRes E{BASE_P, out + O_YP, XB, SSQ}; \
        pg8::gemm_phase<EpiRes, pg8::StaticOrder>(lds, g, S, E, tid); } while (0)
    if (PH(3)) { PHASE_VARS RES_PHASE(QB, Wo_t, D, x_prompt, x_sample); }
    GRID_BAR();

#define UP_PHASE(L_) do { \
        const bf16_t* Wup_ = (const bf16_t*)(ws + WS_WUP + (L_) * WUP_L); const float* cw_ = conv_w + (size_t)(L_) * 3 * FF2; const float* cb_ = conv_b + (size_t)(L_) * FF2; \
        for (int task = vcu; task < DB * 176; task += G) { const int mt = task / 176, nt = task % 176; \
            srs_table(lds, SSQS, mt, tid); \
            stask_mm<D>(lds, XB, MP + 32 * mt, Wup_, [&](int jn) { const int gc = 16 * nt + (jn & 15); return 256 * (gc >> 7) + (gc & 127) + 128 * (jn >> 4); }, tid); \
            LAS float* C = (LAS float*)(lds + L_SC); const LAS float* rs = (const LAS float*)(lds + L_SRS); \
            { const int row = tid >> 4, c0 = (tid & 15) * 2; const float r_ = rs[row]; C[row * 33 + c0] *= r_; C[row * 33 + c0 + 1] *= r_; } \
            __syncthreads(); \
            { const int row = tid >> 4, jn = tid & 15, gc = 16 * nt + jn; const float* hs = state_conv + ((size_t)((L_) * DB + mt) * 2) * FF2; float cc[2]; \
                _Pragma("unroll") for (int v = 0; v < 2; ++v) { const int oc = v * FF + gc, tc = jn + 16 * v; \
                    const float a0 = C[row * 33 + tc], a1 = row >= 1 ? C[(row - 1) * 33 + tc] : hs[FF2 + oc], a2 = row >= 2 ? C[(row - 2) * 33 + tc] : hs[(size_t)row * FF2 + oc]; \
                    cc[v] = cb_[oc] + cw_[oc] * a2 + cw_[FF2 + oc] * a1 + cw_[2 * FF2 + oc] * a0; \
                    if (row >= 30) out[O_CS + ((size_t)((L_) * DB + mt) * 2 + (row - 30)) * FF2 + oc] = a0; } \
                GB[(size_t)(MP + 32 * mt + row) * FF + gc] = (bf16_t)(cvt_pk_bf16(silu1(cc[0]) * cc[1], 0.f) & 0xffffu); } \
            __syncthreads(); } \
        pg8::Gemm g{XB, Wup_, D}; pg8::StaticOrder S; S.init(66, FF2 / 256, G, bx, 1); \
        EpiUp E{GB, SSQ, cw_, cb_, out + O_CP + (size_t)(L_) * NB * 2 * FF2}; \
        pg8::gemm_phase<EpiUp, pg8::StaticOrder>(lds, g, S, E, tid); } while (0)
    if (PH(4)) { PHASE_VARS UP_PHASE(0); }
    GRID_BAR();
    if (PH(5)) { PHASE_VARS RES_PHASE(GB, (const bf16_t*)(ws + WS_WDN), FF, out + O_YP, XS); }
    GRID_BAR();

    if (PH(6)) { PHASE_VARS
        for (int task = vcu; task < DB * 64; task += G) { const int mt = task / 64, nt = task % 64;
            srs_table(lds, SSQS, mt, tid);
            stask_mm<D>(lds, XB, MP + 32 * mt, Win_t, [&](int jn) { return 32 * nt + jn; }, tid);
            const LAS float* C = (const LAS float*)(lds + L_SC); const LAS float* rs = (const LAS float*)(lds + L_SRS);
            const int row = tid >> 4, c0 = (tid & 15) * 2, n = 32 * nt + c0, t = n >> 10, nn = n & 1023; const float r_ = rs[row];
            const f32x2 z = gelu_pk((f32x2){C[row * 33 + c0] * r_, C[row * 33 + c0 + 1] * r_});
            *(unsigned*)((t == 0 ? QB : KB) + (size_t)(MP + 32 * mt + row) * D + nn) = cvt_pk_bf16(z.x, z.y);
            if (t == 1) { float s_ = z.x * z.x + z.y * z.y; s_ += __shfl_xor(s_, 1); s_ += __shfl_xor(s_, 2); s_ += __shfl_xor(s_, 4); s_ += __shfl_xor(s_, 8);
                if ((tid & 15) == 0) SSQVS[(size_t)(nt - 32) * MS + 32 * mt + row] = s_; }
            __syncthreads();
        }
        pg8::Gemm g{XB, Win_t, D}; pg8::StaticOrder S; S.init(MP / 256, 2 * D / 256, G, bx, 0);
        EpiIn E{QB, (size_t)(WS_K - WS_Q) / 2, SSQ, SSQV};
        pg8::gemm_phase<EpiIn, pg8::StaticOrder>(lds, g, S, E, tid);
    }
    GRID_BAR();

    if (PH(7)) { PHASE_VARS
        const int per = (128 * 8 + G - 1) / G;
        for (int id = vcu * per; id < (vcu + 1) * per && id < 128 * 8; ++id) gate::unit(false, id >> 3, id & 7, QB, KB, SSQV, SSQVS, v_norm, w_s, bias_s, out + O_GV, lds, tid);
        for (int id = vcu; id < DB * 8; id += G) gate::unit(true, id >> 3, id & 7, QB, KB, SSQV, SSQVS, v_norm, w_s, bias_s, out + O_GV, lds, tid);
    }
    GRID_BAR();

    if (PH(8)) { PHASE_VARS RES_PHASE(QB, Wout_t, D, out + O_YP, XS); }
    GRID_BAR();
    if (PH(9)) { PHASE_VARS UP_PHASE(1); }
    GRID_BAR();
    if (PH(10)) { PHASE_VARS RES_PHASE(GB, (const bf16_t*)(ws + WS_WDN + WDN_L), FF, out + O_YP, XS); }
    GRID_BAR();

    if (PH(11)) { PHASE_VARS
        const int gw = vcu * NWAVES + wave, NGW = G * NWAVES;
        f32x4 gn[4];
#pragma unroll
        for (int jj = 0; jj < 4; ++jj) gn[jj] = ((const f32x4*)ln_final)[lane + 64 * jj];
        for (int m = gw; m < MT; m += NGW) {
            float s;
            if (m < MP) s = (SSQ[m] + SSQ[MT + m]) + (SSQ[2 * MT + m] + SSQ[3 * MT + m]);
            else { s = lane < 32 ? SSQS[(size_t)lane * MS + (m - MP)] : 0.f; s = wave_sum(s); }
            const float rs = 1.0f / sqrtf(s * (1.0f / D) + EPS);
            f32x4* xr = (f32x4*)(out + (size_t)m * D);
#pragma unroll
            for (int jj = 0; jj < 4; ++jj) { f32x4 v = xr[lane + 64 * jj]; v = v * rs * gn[jj]; xr[lane + 64 * jj] = v; }
        }
    }
}

extern "C" void kernel_launch(void* const* d_in, const int* in_sizes, int n_in, void* d_out, int out_size, void* d_ws, size_t ws_size, hipStream_t stream) {
    static int grid = 0;
    if (grid == 0) {
        if (n_in != 20 || (size_t)out_size != O_END || ws_size < WS_END) { fprintf(stderr, "kernel_launch: unexpected sizes n_in %d out %d ws %zu\n", n_in, out_size, ws_size); grid = -1; return; }
        int dev = 0, cus = 0, per_cu = 0;
        if (hipGetDevice(&dev) != hipSuccess || hipDeviceGetAttribute(&cus, hipDeviceAttributeMultiprocessorCount, dev) != hipSuccess) { grid = -1; return; }
        if (hipFuncSetAttribute((const void*)fwd_kernel, hipFuncAttributeMaxDynamicSharedMemorySize, LDS_BYTES) != hipSuccess) { fprintf(stderr, "kernel_launch: hipFuncSetAttribute failed\n"); grid = -1; return; }
        if (hipOccupancyMaxActiveBlocksPerMultiprocessor(&per_cu, (const void*)fwd_kernel, NTHR, LDS_BYTES) != hipSuccess || per_cu < 1) { fprintf(stderr, "kernel_launch: occupancy query says %d\n", per_cu); per_cu = 1; }
        (void)hipGetLastError();
        grid = cus;
    }
    if (grid < 0) return;
    Args a{};
    for (int i = 0; i < 20; ++i) a.in[i] = (const float*)d_in[i];
    a.out = (float*)d_out; a.ws = (unsigned char*)d_ws;
    if (hipMemsetAsync((char*)d_ws + WS_CTL, 0, 16384, stream) != hipSuccess) { fprintf(stderr, "kernel_launch: memset of the barrier words failed\n"); return; }
    hipLaunchKernelGGL(fwd_kernel, dim3(grid), dim3(NTHR), LDS_BYTES, stream, a);
    const hipError_t e = hipPeekAtLastError();
    if (e != hipSuccess) fprintf(stderr, "kernel_launch: launch failed: %s (grid %d)\n", hipGetErrorName(e), grid);
}
```

```cpp
#include <hip/hip_runtime.h>
#include <cstdio>
#include <cstdint>

#define LAS __attribute__((address_space(3)))
typedef unsigned short bf16_t;
typedef short bf16x8 __attribute__((ext_vector_type(8)));
typedef short s16x4 __attribute__((ext_vector_type(4)));
typedef float f32x2 __attribute__((ext_vector_type(2)));
typedef float f32x4 __attribute__((ext_vector_type(4)));
typedef float f32x16 __attribute__((ext_vector_type(16)));
typedef unsigned u32x2 __attribute__((ext_vector_type(2)));
typedef unsigned u32x4 __attribute__((ext_vector_type(4)));

constexpr int D = 1024, SEQ = 8192, NB = 2, MP = NB * SEQ, DB = 8, DT = 32, MS = DB * DT, MT = MP + MS;
constexpr int NH = 16, HD = 64, FF = 2816, FF2 = 5632, CA = 512, NREL = 257;
constexpr float EPS = 1e-6f, LOG2E = 1.4426950408889634f, C2 = 0.125f * LOG2E;
constexpr int NWAVES = 8, NTHR = 512;

constexpr size_t MiB = 1u << 20;
constexpr size_t WS_CTL = 0;
constexpr size_t WS_WQKV = 1 * MiB, WS_WO = 7 * MiB, WS_WIN = 9 * MiB, WS_WOUT = 13 * MiB, WS_WUP = 15 * MiB, WS_WDN = 37 * MiB;
constexpr size_t WUP_L = (size_t)FF2 * D * 2, WDN_L = (size_t)D * FF * 2;
constexpr size_t WS_XB = 48 * MiB + 65536;
constexpr size_t WS_Q = 82 * MiB, WS_K = 116 * MiB, WS_V = 150 * MiB;
constexpr size_t WS_G = 82 * MiB;
constexpr size_t WS_CK = 184 * MiB, WS_CV = 192 * MiB;
constexpr size_t WS_SSQ = 200 * MiB;
constexpr size_t WS_SSQV = 201 * MiB;
constexpr size_t WS_SSQS = 202 * MiB;
constexpr size_t WS_SSQVS = 202 * MiB + 65536;
constexpr size_t WS_OB = 204 * MiB;
constexpr size_t WS_END = 238 * MiB;

constexpr size_t O_YP = 0, O_YS = O_YP + (size_t)MP * D, O_KP = O_YS + (size_t)MS * D, O_VP = O_KP + (size_t)NB * CA * D, O_KS = O_VP + (size_t)NB * CA * D,
                 O_VS = O_KS + (size_t)MS * D, O_GV = O_VS + (size_t)MS * D, O_CP = O_GV + (size_t)MS * D, O_CS = O_CP + (size_t)2 * NB * 2 * FF2, O_END = O_CS + (size_t)2 * DB * 2 * FF2;

constexpr int RING_BYTES = 131072;
constexpr int L_XBUF = 131072, L_RSTAB = 139264, L_PTAB = 140288;
constexpr int L_MISC = 144384;
constexpr int LDS_BYTES = 155648;

__device__ __forceinline__ unsigned cvt_pk_bf16(float lo, float hi) { unsigned r; asm volatile("v_cvt_pk_bf16_f32 %0, %1, %2" : "=v"(r) : "v"(lo), "v"(hi)); return r; }
__device__ __forceinline__ float bf2f(unsigned h) { return __uint_as_float(h << 16); }
__device__ __forceinline__ int crow(int r, int hi) { return (r & 3) + 8 * (r >> 2) + 4 * hi; }
#define LDS_WAIT() asm volatile("s_waitcnt lgkmcnt(0)" ::: "memory")
#define VM_WAIT() asm volatile("s_waitcnt vmcnt(0)" ::: "memory")
#define RAW_BAR() do { asm volatile("s_waitcnt lgkmcnt(0)" ::: "memory"); __builtin_amdgcn_s_barrier(); asm volatile("" ::: "memory"); } while (0)
__device__ __forceinline__ float wave_sum(float v) {
#pragma unroll
    for (int o = 1; o < 64; o <<= 1) v += __shfl_xor(v, o);
    return v;
}
__device__ __forceinline__ f32x2 gelu_pk(f32x2 v) {
    const f32x2 av = __builtin_elementwise_abs(v), d = av * 0.2316418882f + 1.0f;
    f32x2 t; t.x = __builtin_amdgcn_rcpf(d.x); t.y = __builtin_amdgcn_rcpf(d.y);
    f32x2 q = t * 0.5307027145f + (-0.7265760135f); q = q * t + 0.7107068705f; q = q * t + (-0.142248368f); q = q * t + 0.127414796f; q = q * t;
    const f32x2 s = (v * v) * (-0.72134752044f);
    f32x2 e; e.x = __builtin_amdgcn_exp2f(s.x); e.y = __builtin_amdgcn_exp2f(s.y);
    const f32x2 m = v * (q * e), r = v - m;
    f32x2 o; o.x = v.x < 0.f ? m.x : r.x; o.y = v.y < 0.f ? m.y : r.y; return o;
}
__device__ __forceinline__ float gelu1(float x) { f32x2 r = gelu_pk((f32x2){x, x}); return r.x; }
__device__ __forceinline__ float silu1(float x) { return x * __builtin_amdgcn_rcpf(1.0f + __builtin_amdgcn_exp2f(-x * LOG2E)); }

namespace pg8 {
constexpr int BM = 256, BK = 64, HALF = 128, HTB = HALF * BK * 2, NXCD = 8, WGM = 8;
__host__ __device__ __forceinline__ int lds_byte(int r, int c) { const int st = (r >> 4) * 2 + (c >> 5), rr = r & 15, cc = c & 31, ob = rr * 64 + cc * 2; return st * 1024 + (ob ^ (((ob >> 9) & 1) << 5)); }
__host__ __device__ __forceinline__ void stage_rc(int b, int& R, int& C) { const int st = b / 1024, sb = b % 1024, swz = sb ^ (((sb >> 9) & 1) << 5); R = (st >> 1) * 16 + swz / 64; C = (st & 1) * 32 + (swz % 64) / 2; }
__host__ __device__ __forceinline__ int perm32(int rho) { const int n = rho >> 4, i = rho & 15; return 8 * (i >> 2) + 4 * n + (i & 3); }

struct Unit { int pm, pn, arow; };
struct Gemm { const bf16_t* A; const bf16_t* Bt; int K; };

struct StaticOrder {
    int nM, nN, nwg, G, c, up;
    __device__ void init(int nM_, int nN_, int G_, int c_, int up_) { nM = nM_; nN = nN_; nwg = nM * nN; G = G_; c = c_; up = up_; }
    __device__ bool next(int i, Unit& u) const {
        const long L = (long)i * G + c; if (L >= nwg) return false;
        int wgid = (int)L; { const int q = nwg / NXCD, r = nwg % NXCD, xcd = wgid % NXCD, off = wgid / NXCD; wgid = (xcd < r ? xcd * (q + 1) : r * (q + 1) + (xcd - r) * q) + off; }
        const int nig = WGM * nN, gid = wgid / nig, fm = gid * WGM, gsz = (nM - fm) < WGM ? (nM - fm) : WGM;
        u.pm = fm + ((wgid % nig) % gsz); u.pn = (wgid % nig) / gsz;
        u.arow = up ? ((u.pm / 33) * SEQ + 254 * (u.pm % 33) - 2) : u.pm * BM;
        return true;
    }
};

template <class Epi, class Sched>
__device__ __forceinline__ void gemm_phase(LAS unsigned char* lds, const Gemm g, const Sched& S, const Epi& E, const int tid) {
    const int wid = __builtin_amdgcn_readfirstlane(tid >> 6), lane = tid & 63, wr = wid >> 2, wc = wid & 3, fr = lane & 15, fq = lane >> 4;
    const int K = g.K, nt = K / BK;
    unsigned voffA[2], voffB[2];
#pragma unroll
    for (int i = 0; i < 2; ++i) { int R, C; stage_rc(tid * 16 + i * 8192, R, C); const int Rb = Epi::PERM ? ((R & ~31) + perm32(R & 31)) : R;
        voffA[i] = (unsigned)(R * K + C) * 2u; voffB[i] = (unsigned)(Rb * K + C) * 2u; }
    const size_t kstep = (size_t)(BK * 2);
    const size_t hstep = (size_t)HALF * K * 2;
    const size_t tstep = 2 * hstep;
    const size_t rstep = (size_t)K * 2;
    const unsigned ldsw = (unsigned)wid * 1024u;
    const int aoff = lds_byte(wr * 64 + fr, fq * 8), boff = lds_byte(wc * 32 + fr, fq * 8);
#define PG8_SA(b, h) (((b) * 2 + (h)) * HTB)
#define PG8_SB(b, h) ((4 + (b) * 2 + (h)) * HTB)
#define PG8_STAGE(bufoff, gbase, voff) do { _Pragma("unroll") for (int _i = 0; _i < 2; ++_i) \
        __builtin_amdgcn_global_load_lds((const unsigned*)((const char*)(gbase) + (voff)[_i]), (LAS unsigned*)(lds + (bufoff) + ldsw + _i * 8192), 16, 0, 0); } while (0)
#define PG8_LDA(dst, b, h) do { _Pragma("unroll") for (int m = 0; m < 4; ++m) _Pragma("unroll") for (int k = 0; k < 2; ++k) dst[m][k] = *(const LAS bf16x8*)(lds + PG8_SA(b, h) + aoff + m * 2048 + k * 1024); } while (0)
#define PG8_LDB(dst, b, h) do { _Pragma("unroll") for (int n = 0; n < 2; ++n) _Pragma("unroll") for (int k = 0; k < 2; ++k) dst[n][k] = *(const LAS bf16x8*)(lds + PG8_SB(b, h) + boff + n * 2048 + k * 1024); } while (0)
#define PG8_MMA(ai, bj, At, Bt) do { __builtin_amdgcn_s_setprio(1); _Pragma("unroll") for (int m = 0; m < 4; ++m) _Pragma("unroll") for (int n = 0; n < 2; ++n) _Pragma("unroll") for (int k = 0; k < 2; ++k) \
        acc[ai][bj][m][n] = __builtin_amdgcn_mfma_f32_16x16x32_bf16(Bt[n][k], At[m][k], acc[ai][bj][m][n], 0, 0, 0); __builtin_amdgcn_s_setprio(0); } while (0)
#define PG8_WAIT_V(n) asm volatile("s_waitcnt vmcnt(" #n ")" ::: "memory")
#define PG8_WAIT_L(n) asm volatile("s_waitcnt lgkmcnt(" #n ")" ::: "memory")
#define PG8_BAR __builtin_amdgcn_s_barrier()
#define PG8_SCHED __builtin_amdgcn_sched_barrier(0)
    Unit cur, nxt; int ui = 0;
    if (!S.next(0, cur)) return;
    f32x4 acc[2][2][4][2];
#pragma unroll
    for (int a = 0; a < 2; ++a)
#pragma unroll
        for (int b = 0; b < 2; ++b)
#pragma unroll
            for (int m = 0; m < 4; ++m)
#pragma unroll
                for (int n = 0; n < 2; ++n) acc[a][b][m][n] = (f32x4){0.f, 0.f, 0.f, 0.f};
    bf16x8 At[4][2], B0[2][2], B1[2][2];
    const char* cA = (const char*)g.A + (ptrdiff_t)cur.arow * (ptrdiff_t)rstep; const char* cB = (const char*)g.Bt + (size_t)cur.pn * tstep;
    PG8_STAGE(PG8_SB(0, 0), cB, voffB); PG8_STAGE(PG8_SB(0, 1), cB + hstep, voffB); PG8_STAGE(PG8_SA(0, 0), cA, voffA); PG8_STAGE(PG8_SA(0, 1), cA + hstep, voffA);
    if (wr == 1) PG8_BAR;
    PG8_WAIT_V(2); PG8_BAR;
    PG8_STAGE(PG8_SB(1, 0), cB + kstep, voffB); PG8_STAGE(PG8_SA(1, 0), cA + kstep, voffA); PG8_STAGE(PG8_SB(1, 1), cB + hstep + kstep, voffB);
    PG8_WAIT_V(6); PG8_BAR;
    for (;;) {
        const bool has_next = S.next(ui + 1, nxt);
        const char* nA = has_next ? (const char*)g.A + (ptrdiff_t)nxt.arow * (ptrdiff_t)rstep : cA; const char* nB = has_next ? (const char*)g.Bt + (size_t)nxt.pn * tstep : cB;
        for (int t = 0; t < nt; t += 2) {
            const bool last = (t == nt - 2);
            const char* a1 = cA + (size_t)(t + 1) * kstep;
            const char* a2 = last ? nA : cA + (size_t)(t + 2) * kstep; const char* b2 = last ? nB : cB + (size_t)(t + 2) * kstep;
            const char* a3 = a2 + kstep; const char* b3 = b2 + kstep;
            PG8_LDB(B0, 0, 0); PG8_LDB(B1, 0, 1); PG8_SCHED; PG8_LDA(At, 0, 0); PG8_STAGE(PG8_SA(1, 1), a1 + hstep, voffA);
            PG8_WAIT_V(8); PG8_WAIT_L(0); PG8_BAR; PG8_MMA(0, 0, At, B0); PG8_MMA(0, 1, At, B1); PG8_BAR; PG8_SCHED;
            PG8_LDA(At, 0, 1); PG8_STAGE(PG8_SB(0, 0), b2, voffB); PG8_STAGE(PG8_SB(0, 1), b2 + hstep, voffB); PG8_STAGE(PG8_SA(0, 0), a2, voffA);
            PG8_WAIT_V(8); PG8_WAIT_L(0); PG8_BAR; PG8_MMA(1, 0, At, B0); PG8_MMA(1, 1, At, B1); PG8_BAR; PG8_SCHED;
            PG8_LDB(B0, 1, 0); PG8_LDB(B1, 1, 1); PG8_SCHED; PG8_LDA(At, 1, 0); PG8_STAGE(PG8_SA(0, 1), a2 + hstep, voffA);
            PG8_WAIT_V(8); PG8_WAIT_L(0); PG8_BAR; PG8_MMA(0, 0, At, B0); PG8_MMA(0, 1, At, B1); PG8_BAR; PG8_SCHED;
            PG8_LDA(At, 1, 1); PG8_STAGE(PG8_SB(1, 0), b3, voffB); PG8_STAGE(PG8_SB(1, 1), b3 + hstep, voffB); PG8_STAGE(PG8_SA(1, 0), a3, voffA);
            PG8_WAIT_V(8); PG8_WAIT_L(0); PG8_BAR; PG8_MMA(1, 0, At, B0); PG8_MMA(1, 1, At, B1); PG8_BAR; PG8_SCHED;
        }
        if (wr == 0) PG8_BAR;
        E(acc, cur, wr, wc, fr, fq, lds, tid);
        if (!has_next) break;
#pragma unroll
        for (int a = 0; a < 2; ++a)
#pragma unroll
            for (int b = 0; b < 2; ++b)
#pragma unroll
                for (int m = 0; m < 4; ++m)
#pragma unroll
                    for (int n = 0; n < 2; ++n) acc[a][b][m][n] = (f32x4){0.f, 0.f, 0.f, 0.f};
        cur = nxt; cA = nA; cB = nB; ++ui;
        if (wr == 1) PG8_BAR;
    }
    PG8_WAIT_V(0);
    PG8_BAR;
#undef PG8_SA
#undef PG8_SB
#undef PG8_STAGE
#undef PG8_LDA
#undef PG8_LDB
#undef PG8_MMA
#undef PG8_WAIT_V
#undef PG8_WAIT_L
#undef PG8_BAR
#undef PG8_SCHED
}
}

typedef f32x4 AccT[2][2][4][2];

__device__ __forceinline__ void rs_table(LAS unsigned char* lds, const float* ssq, int tok0, int tid) {
    LAS float* rst = (LAS float*)(lds + L_RSTAB);
    if (tid < 256) { int tok = tok0 + tid; tok = tok < 0 ? 0 : (tok >= MT ? MT - 1 : tok);
        const float s = (ssq[tok] + ssq[MT + tok]) + (ssq[2 * MT + tok] + ssq[3 * MT + tok]); rst[tid] = 1.0f / sqrtf(s * (1.0f / D) + EPS); }
    RAW_BAR();
}

struct EpiQKV {
    static constexpr bool PERM = true;
    bf16_t* O; size_t split_stride; const float* ssq; float* okp; float* ovp;
    __device__ __forceinline__ void operator()(const AccT& acc, const pg8::Unit& u, int wr, int wc, int fr, int fq, LAS unsigned char* lds, int tid) const {
        rs_table(lds, ssq, u.pm * 256, tid);
        const LAS float* rst = (const LAS float*)(lds + L_RSTAB);
        const int t = u.pn >> 2, colt = (u.pn & 3) * 256; bf16_t* base = O + (size_t)t * split_stride; const float sc = (t == 0) ? C2 : 1.0f;
        const bool side = (t >= 1) && ((u.pm & 31) >= 30);
        float* sp = (t == 1 ? okp : ovp) + ((size_t)((u.pm >> 5) * CA + (u.pm & 1) * 256)) * D;
        const int col0 = colt + wc * 32 + 8 * fq;
#pragma unroll
        for (int ai = 0; ai < 2; ++ai)
#pragma unroll
            for (int m = 0; m < 4; ++m) { const int r = ai * 128 + wr * 64 + m * 16 + fr; const float rs = rst[r] * sc; bf16_t* rowp = base + (size_t)(u.pm * 256 + r) * D + col0;
#pragma unroll
                for (int bj = 0; bj < 2; ++bj) { const f32x4 v0 = acc[ai][bj][m][0] * rs, v1 = acc[ai][bj][m][1] * rs;
                    u32x4 w; w.x = cvt_pk_bf16(v0[0], v0[1]); w.y = cvt_pk_bf16(v0[2], v0[3]); w.z = cvt_pk_bf16(v1[0], v1[1]); w.w = cvt_pk_bf16(v1[2], v1[3]);
                    *(u32x4*)(rowp + bj * 128) = w;
                    if (side) { float* s = sp + (size_t)r * D + col0 + bj * 128; *(f32x4*)s = v0; *(f32x4*)(s + 4) = v1; } } }
    }
};

struct EpiRes {
    static constexpr bool PERM = false;
    const float* base; float* out; bf16_t* xb; float* ssq;
    __device__ __forceinline__ void operator()(const AccT& acc, const pg8::Unit& u, int wr, int wc, int fr, int fq, LAS unsigned char* lds, int tid) const {
        LAS float* P = (LAS float*)(lds + L_PTAB);
        const int col0 = u.pn * 256 + wc * 32 + 4 * fq;
#pragma unroll
        for (int ai = 0; ai < 2; ++ai)
#pragma unroll
            for (int m = 0; m < 4; ++m) { const int r = ai * 128 + wr * 64 + m * 16 + fr; const size_t off = (size_t)(u.pm * 256 + r) * D + col0; float s = 0.f;
#pragma unroll
                for (int bj = 0; bj < 2; ++bj)
#pragma unroll
                    for (int n = 0; n < 2; ++n) { const f32x4 b = *(const f32x4*)(base + off + bj * 128 + n * 16); const f32x4 v = b + acc[ai][bj][m][n];
                        *(f32x4*)(out + off + bj * 128 + n * 16) = v; s += (v[0] * v[0] + v[1] * v[1]) + (v[2] * v[2] + v[3] * v[3]);
                        u32x2 w; w.x = cvt_pk_bf16(v[0], v[1]); w.y = cvt_pk_bf16(v[2], v[3]); *(u32x2*)(xb + off + bj * 128 + n * 16) = w; }
                s += __shfl_xor(s, 16); s += __shfl_xor(s, 32);
                if (fq == 0) P[r * 4 + wc] = s; }
        RAW_BAR();
        if (tid < 256) { const f32x4 p = *(const LAS f32x4*)(P + tid * 4); ssq[(size_t)u.pn * MT + u.pm * 256 + tid] = (p[0] + p[1]) + (p[2] + p[3]); }
    }
};

struct EpiIn {
    static constexpr bool PERM = true;
    bf16_t* O; size_t split_stride; const float* ssq; float* ssqv;
    __device__ __forceinline__ void operator()(const AccT& acc, const pg8::Unit& u, int wr, int wc, int fr, int fq, LAS unsigned char* lds, int tid) const {
        rs_table(lds, ssq, u.pm * 256, tid);
        const LAS float* rst = (const LAS float*)(lds + L_RSTAB); LAS float* P = (LAS float*)(lds + L_PTAB);
        const int t = u.pn >> 2, colt = (u.pn & 3) * 256; bf16_t* base = O + (size_t)t * split_stride;
        const int col0 = colt + wc * 32 + 8 * fq;
#pragma unroll
        for (int ai = 0; ai < 2; ++ai)
#pragma unroll
            for (int m = 0; m < 4; ++m) { const int r = ai * 128 + wr * 64 + m * 16 + fr; const float rs = rst[r]; bf16_t* rowp = base + (size_t)(u.pm * 256 + r) * D + col0; float s = 0.f;
#pragma unroll
                for (int bj = 0; bj < 2; ++bj) { const f32x4 x0 = acc[ai][bj][m][0] * rs, x1 = acc[ai][bj][m][1] * rs;
                    const f32x2 a = gelu_pk((f32x2){x0[0], x0[1]}), b = gelu_pk((f32x2){x0[2], x0[3]}), c = gelu_pk((f32x2){x1[0], x1[1]}), d = gelu_pk((f32x2){x1[2], x1[3]});
                    s += (a.x * a.x + a.y * a.y) + (b.x * b.x + b.y * b.y) + (c.x * c.x + c.y * c.y) + (d.x * d.x + d.y * d.y);
                    u32x4 w; w.x = cvt_pk_bf16(a.x, a.y); w.y = cvt_pk_bf16(b.x, b.y); w.z = cvt_pk_bf16(c.x, c.y); w.w = cvt_pk_bf16(d.x, d.y);
                    *(u32x4*)(rowp + bj * 128) = w; }
                if (t == 1) { s += __shfl_xor(s, 16); s += __shfl_xor(s, 32); if (fq == 0) P[r * 4 + wc] = s; } }
        if (t == 1) { RAW_BAR();
            if (tid < 256) { const f32x4 p = *(const LAS f32x4*)(P + tid * 4); ssqv[(size_t)(u.pn & 3) * MT + u.pm * 256 + tid] = (p[0] + p[1]) + (p[2] + p[3]); } }
    }
};

__device__ __forceinline__ float dpp_shr1(float v) { return __builtin_bit_cast(float, __builtin_amdgcn_update_dpp(0, __builtin_bit_cast(int, v), 0x111, 0xf, 0xf, true)); }
__device__ __forceinline__ float dpp_shr2(float v) { return __builtin_bit_cast(float, __builtin_amdgcn_update_dpp(0, __builtin_bit_cast(int, v), 0x112, 0xf, 0xf, true)); }
__device__ __forceinline__ float dpp_shl15(float v) { return __builtin_bit_cast(float, __builtin_amdgcn_update_dpp(0, __builtin_bit_cast(int, v), 0x10f, 0xf, 0xf, true)); }
__device__ __forceinline__ float dpp_shl14(float v) { return __builtin_bit_cast(float, __builtin_amdgcn_update_dpp(0, __builtin_bit_cast(int, v), 0x10e, 0xf, 0xf, true)); }

struct EpiUp {
    static constexpr bool PERM = true;
    bf16_t* G; const float* ssq; const float* cw; const float* cb; float* ocp;
    __device__ __forceinline__ void operator()(AccT& acc, const pg8::Unit& u, int wr, int wc, int fr, int fq, LAS unsigned char* lds, int tid) const {
        const int b = u.pm / 33, j = u.pm % 33, tok0 = u.arow;
        rs_table(lds, ssq, tok0, tid);
        const LAS float* rst = (const LAS float*)(lds + L_RSTAB); LAS float* xbuf = (LAS float*)(lds + L_XBUF);
#pragma unroll
        for (int ai = 0; ai < 2; ++ai)
#pragma unroll
            for (int m = 0; m < 4; ++m) { const float rs = rst[ai * 128 + wr * 64 + m * 16 + fr];
#pragma unroll
                for (int bj = 0; bj < 2; ++bj)
#pragma unroll
                    for (int n = 0; n < 2; ++n) acc[ai][bj][m][n] *= rs; }
        if (j == 0 && wr == 0 && fr < 2) {
#pragma unroll
            for (int bj = 0; bj < 2; ++bj)
#pragma unroll
                for (int n = 0; n < 2; ++n) acc[0][bj][0][n] = (f32x4){0.f, 0.f, 0.f, 0.f}; }
        const int cl = wc * 32 + 8 * fq;
        if (j == 32 && wr == 1 && fr < 2) {
#pragma unroll
            for (int bj = 0; bj < 2; ++bj)
#pragma unroll
                for (int n = 0; n < 2; ++n) *(f32x4*)(ocp + (size_t)(b * 2 + fr) * FF2 + bj * FF + u.pn * 128 + cl + 4 * n) = acc[0][bj][0][n]; }
        if (fr >= 14) {
#pragma unroll
            for (int ai = 0; ai < 2; ++ai)
#pragma unroll
                for (int bj = 0; bj < 2; ++bj)
#pragma unroll
                    for (int n = 0; n < 2; ++n) *(LAS f32x4*)(xbuf + ((2 * ai + wr) * 2 + (fr - 14)) * 256 + bj * 128 + cl + 4 * n) = acc[ai][bj][3][n]; }
        RAW_BAR();
        const int bend = (b + 1) * SEQ;
#pragma unroll
        for (int n = 0; n < 2; ++n) {
            f32x4 w0[2], w1[2], w2[2], cbv[2];
#pragma unroll
            for (int bj = 0; bj < 2; ++bj) { const int oc = bj * FF + u.pn * 128 + cl + 4 * n;
                w0[bj] = *(const f32x4*)(cw + oc); w1[bj] = *(const f32x4*)(cw + FF2 + oc); w2[bj] = *(const f32x4*)(cw + 2 * FF2 + oc); cbv[bj] = *(const f32x4*)(cb + oc); }
#pragma unroll
            for (int ai = 0; ai < 2; ++ai) {
                const int ps = (2 * ai + wr + 3) & 3;
#pragma unroll
                for (int m = 3; m >= 0; --m) {
                    f32x4 c[2];
#pragma unroll
                    for (int bj = 0; bj < 2; ++bj) {
                        const f32x4 cur = acc[ai][bj][m][n];
                        f32x4 prv; if (m > 0) prv = acc[ai][bj][m - 1][n]; else prv = *(const LAS f32x4*)(xbuf + (ps * 2 + (fr & 1)) * 256 + bj * 128 + cl + 4 * n);
                        f32x4 o;
#pragma unroll
                        for (int e = 0; e < 4; ++e) { float v = cbv[bj][e] + w2[bj][e] * cur[e];
                            v += w1[bj][e] * (dpp_shr1(cur[e]) + dpp_shl15(prv[e]));
                            v += w0[bj][e] * (dpp_shr2(cur[e]) + dpp_shl14(prv[e])); o[e] = v; }
                        c[bj] = o; }
                    const int tr = ai * 128 + wr * 64 + m * 16 + fr, tok = tok0 + tr;
                    if (tr >= 2 && tok < bend) {
                        u32x2 w;
                        w.x = cvt_pk_bf16(silu1(c[0][0]) * c[1][0], silu1(c[0][1]) * c[1][1]); w.y = cvt_pk_bf16(silu1(c[0][2]) * c[1][2], silu1(c[0][3]) * c[1][3]);
                        *(u32x2*)(G + (size_t)tok * FF + u.pn * 128 + cl + 4 * n) = w; }
                }
            }
        }
    }
};

constexpr int L_SPART = 0, L_SC = 32768, L_SRS = 40960;
template <int K, class BRow>
__device__ __forceinline__ void stask_mm(LAS unsigned char* lds, const bf16_t* A, int arow0, const bf16_t* Bt, BRow brow, const int tid) {
    const int lane = tid & 63, r32 = lane & 31, hi = lane >> 5, w = tid >> 6;
    constexpr int KW = K / 8, NK = KW / 16;
    const bf16_t* ap = A + (size_t)(arow0 + r32) * K + w * KW + hi * 8;
    const bf16_t* bp = Bt + (size_t)brow(r32) * K + w * KW + hi * 8;
    f32x16 acc;
#pragma unroll
    for (int r = 0; r < 16; ++r) acc[r] = 0.f;
#pragma unroll 11
    for (int ks = 0; ks < NK; ++ks) { const bf16x8 a = *(const bf16x8*)(ap + ks * 16), b = *(const bf16x8*)(bp + ks * 16); acc = __builtin_amdgcn_mfma_f32_32x32x16_bf16(a, b, acc, 0, 0, 0); }
    LAS float* part = (LAS float*)(lds + L_SPART) + w * 1024;
#pragma unroll
    for (int r = 0; r < 16; ++r) part[crow(r, hi) * 32 + r32] = acc[r];
    __syncthreads();
    LAS float* C = (LAS float*)(lds + L_SC); const LAS float* P0 = (const LAS float*)(lds + L_SPART);
#pragma unroll
    for (int i = 0; i < 2; ++i) { const int e = tid + i * 512; float s = 0.f;
#pragma unroll
        for (int ww = 0; ww < 8; ++ww) s += P0[ww * 1024 + e];
        C[(e >> 5) * 33 + (e & 31)] = s; }
    __syncthreads();
}
__device__ __forceinline__ void srs_table(LAS unsigned char* lds, const float* ssqs, int mt, int tid) {
    const int row = tid >> 4, jj = tid & 15; float s = ssqs[(size_t)jj * MS + mt * 32 + row] + ssqs[(size_t)(jj + 16) * MS + mt * 32 + row];
    s += __shfl_xor(s, 1); s += __shfl_xor(s, 2); s += __shfl_xor(s, 4); s += __shfl_xor(s, 8);
    if (jj == 0) ((LAS float*)(lds + L_SRS))[row] = 1.0f / sqrtf(s * (1.0f / D) + EPS);
}

namespace att {
constexpr int NS = 6, SLOTB = 8192;
constexpr int L_K = 0, L_V = NS * SLOTB, L_OST = 2 * NS * SLOTB, L_BIAS = 131072, L_WSF = 132352;
#define SBAR() __builtin_amdgcn_sched_barrier(0)
__device__ __forceinline__ void glds16(const void* gsrc, unsigned lds_dst) { unsigned keep;
    asm volatile("s_mov_b32 %0, m0\n\ts_mov_b32 m0, %2\n\ts_nop 0\n\tglobal_load_lds_dwordx4 %1, off\n\ts_mov_b32 m0, %0" : "=&s"(keep) : "v"(gsrc), "s"(lds_dst) : "memory"); }
#define WAIT_BAR(N) asm volatile("s_waitcnt vmcnt(" #N ") lgkmcnt(0)\n\ts_barrier" ::: "memory")

struct State { float m, l; f32x16 o[2]; };

__device__ __forceinline__ void tile(State& st, const bf16x8 (&qr)[4], unsigned kslot, unsigned vslot, float cinit, bool near, int base, bool mask1, const LAS float* tab, LAS float* wsf, int r32, int hi, int lane) {
    f32x16 p0, p1;
    { const LAS char* kb = (const LAS char*)(uintptr_t)kslot + hi * 1024 + r32 * 16;
        f32x16 ci;
#pragma unroll
        for (int r = 0; r < 16; ++r) ci[r] = cinit;
#pragma unroll
        for (int d0 = 0; d0 < 4; ++d0) { const bf16x8 b0 = *(const LAS bf16x8*)(kb + d0 * 2048), b1 = *(const LAS bf16x8*)(kb + d0 * 2048 + 512);
            if (d0 == 0) { p0 = __builtin_amdgcn_mfma_f32_32x32x16_bf16(b0, qr[0], ci, 0, 0, 0); p1 = __builtin_amdgcn_mfma_f32_32x32x16_bf16(b1, qr[0], ci, 0, 0, 0); }
            else { p0 = __builtin_amdgcn_mfma_f32_32x32x16_bf16(b0, qr[d0], p0, 0, 0, 0); p1 = __builtin_amdgcn_mfma_f32_32x32x16_bf16(b1, qr[d0], p1, 0, 0, 0); } } }
    if (near) {
#pragma unroll
        for (int r = 0; r < 16; ++r) { int i0 = base - crow(r, hi), i1 = i0 - 32; i0 = i0 < 0 ? 0 : (i0 > 256 ? 256 : i0); i1 = i1 < 0 ? 0 : (i1 > 256 ? 256 : i1); p0[r] += tab[i0]; p1[r] += tab[i1]; } }
    if (mask1) {
#pragma unroll
        for (int r = 0; r < 16; ++r) p1[r] = -1e30f; }
    float rm = fmaxf(p0[0], p1[0]);
#pragma unroll
    for (int r = 1; r < 16; ++r) rm = fmaxf(rm, fmaxf(p0[r], p1[r]));
    rm = fmaxf(rm, __shfl_xor(rm, 32));
    const float mn = fmaxf(st.m, rm);
    if (__any(mn > st.m)) {
        const float f = __builtin_amdgcn_exp2f(st.m - mn); st.l *= f; st.m = mn;
        if (hi == 0) wsf[r32] = f;
        LDS_WAIT();
#pragma unroll
        for (int g = 0; g < 4; ++g) { const f32x4 fv = *(const LAS f32x4*)(wsf + 8 * g + 4 * hi);
#pragma unroll
            for (int e = 0; e < 4; ++e) { st.o[0][4 * g + e] *= fv[e]; st.o[1][4 * g + e] *= fv[e]; } }
    }
    float sacc = 0.f;
#pragma unroll
    for (int r = 0; r < 16; ++r) { p0[r] = __builtin_amdgcn_exp2f(p0[r] - st.m); p1[r] = __builtin_amdgcn_exp2f(p1[r] - st.m); sacc += p0[r] + p1[r]; }
    st.l += sacc;
    u32x4 pw[4];
#pragma unroll
    for (int k = 0; k < 2; ++k) { pw[k] = (u32x4){cvt_pk_bf16(p0[8 * k], p0[8 * k + 1]), cvt_pk_bf16(p0[8 * k + 2], p0[8 * k + 3]), cvt_pk_bf16(p0[8 * k + 4], p0[8 * k + 5]), cvt_pk_bf16(p0[8 * k + 6], p0[8 * k + 7])};
        pw[2 + k] = (u32x4){cvt_pk_bf16(p1[8 * k], p1[8 * k + 1]), cvt_pk_bf16(p1[8 * k + 2], p1[8 * k + 3]), cvt_pk_bf16(p1[8 * k + 4], p1[8 * k + 5]), cvt_pk_bf16(p1[8 * k + 6], p1[8 * k + 7])}; }
    const int vb = (int)vslot + ((lane >> 4) & 1) * 32 + (lane & 3) * 8 + (4 * hi + ((lane & 15) >> 2)) * 64;
#pragma unroll
    for (int d0 = 0; d0 < 2; ++d0) { s16x4 lo[4], hh[4];
#pragma unroll
        for (int ks = 0; ks < 4; ++ks) {
            asm volatile("ds_read_b64_tr_b16 %0,%1 offset:%c2" : "=&v"(lo[ks]) : "v"(vb), "i"(d0 * 4096 + ks * 1024) : "memory");
            asm volatile("ds_read_b64_tr_b16 %0,%1 offset:%c2" : "=&v"(hh[ks]) : "v"(vb), "i"(d0 * 4096 + ks * 1024 + 512) : "memory"); }
        asm volatile("s_waitcnt lgkmcnt(0)" ::: "memory"); SBAR();
#pragma unroll
        for (int ks = 0; ks < 4; ++ks) { const bf16x8 vf = (bf16x8){lo[ks][0], lo[ks][1], lo[ks][2], lo[ks][3], hh[ks][0], hh[ks][1], hh[ks][2], hh[ks][3]};
            st.o[d0] = __builtin_amdgcn_mfma_f32_32x32x16_bf16(__builtin_bit_cast(bf16x8, pw[ks]), vf, st.o[d0], 0, 0, 0); }
    }
}

__device__ __forceinline__ void prompt_unit(int b, int h, int qg, const bf16_t* Q, const bf16_t* Kg, const bf16_t* Vg, bf16_t* O, LAS unsigned char* lds, const int tid) {
    const int lane = tid & 63, r32 = lane & 31, hi = lane >> 5; const int wid = __builtin_amdgcn_readfirstlane(tid >> 6);
    const int c0 = 4 * qg, pj = wid >> 1, half = wid & 1; const long rowbase = (long)b * SEQ;
    const unsigned lds0 = (unsigned)(uintptr_t)lds;
    const LAS float* tab = (const LAS float*)(lds + L_BIAS); LAS float* wsf = (LAS float*)(lds + L_WSF) + wid * 64;
    const bf16_t* Qw = Q + (rowbase + 64 * (c0 + pj) + 32 * half) * D + h * HD;
    const bf16_t* Kh = Kg + rowbase * D + h * HD; const bf16_t* Vh = Vg + rowbase * D + h * HD;
#define DMA_T(i) do { int ck_ = c0 - 8 + (i); ck_ = ck_ < 0 ? 0 : ck_; const unsigned so_ = (unsigned)(((i) % NS) * SLOTB + wid * 1024); \
        glds16(Kh + (long)(64 * ck_ + lane) * D + wid * 8, (unsigned)__builtin_amdgcn_readfirstlane(lds0 + L_K + so_)); \
        glds16(Vh + (long)(64 * ck_ + 16 * (wid & 3) + (lane >> 2)) * D + (wid >> 2) * 32 + (lane & 3) * 8, (unsigned)__builtin_amdgcn_readfirstlane(lds0 + L_V + so_)); } while (0)
    DMA_T(0); DMA_T(1); DMA_T(2); DMA_T(3); DMA_T(4);
    bf16x8 qr[4];
#pragma unroll
    for (int d0 = 0; d0 < 4; ++d0) qr[d0] = *(const bf16x8*)(Qw + (long)r32 * D + d0 * 16 + hi * 8);
    State st; st.m = -1e30f; st.l = 0.f;
#pragma unroll
    for (int r = 0; r < 16; ++r) { st.o[0][r] = 0.f; st.o[1][r] = 0.f; }
    const float cfar = tab[256];
    const int ql = 32 * half + r32;
    for (int s = 0; s < 9; ++s) {
        if (s == 0) { WAIT_BAR(0); asm volatile("" : "+v"(qr[0]), "+v"(qr[1]), "+v"(qr[2]), "+v"(qr[3])); }
        else if (s < 8) WAIT_BAR(2); else WAIT_BAR(0);
        if (s + 5 < 12) DMA_T(s + 5);
        const int ck = c0 - 8 + s + pj;
        if (ck >= 0) { const int sl = (s + pj) % NS; const bool near = s >= 6;
            tile(st, qr, lds0 + L_K + sl * SLOTB, lds0 + L_V + sl * SLOTB, near ? 0.f : cfar, near, 64 * (8 - s) + ql + 128, false, tab, wsf, r32, hi, lane); }
    }
#undef DMA_T
    float l = st.l + __shfl_xor(st.l, 32);
    if (hi == 0) wsf[32 + r32] = l;
    LDS_WAIT();
    float rli[16];
#pragma unroll
    for (int r = 0; r < 16; ++r) rli[r] = __builtin_amdgcn_rcpf(wsf[32 + crow(r, hi)]);
    bf16_t* Ow = O + (rowbase + 64 * (c0 + pj) + 32 * half) * D + h * HD;
    { LAS bf16_t* stg = (LAS bf16_t*)(lds + L_OST) + wid * 2048;
#pragma unroll
        for (int r = 0; r < 16; ++r) { const int orow = crow(r, hi);
#pragma unroll
            for (int d0 = 0; d0 < 2; ++d0) stg[orow * 64 + d0 * 32 + r32] = (bf16_t)(cvt_pk_bf16(st.o[d0][r] * rli[r], 0.f) & 0xffffu); }
        LDS_WAIT();
#pragma unroll
        for (int i = 0; i < 4; ++i) { const int row = i * 8 + (lane >> 3), ch = lane & 7; const u32x4 v = *(const LAS u32x4*)(stg + row * 64 + ch * 8); *(u32x4*)(Ow + (long)row * D + ch * 8) = v; } }
    asm volatile("s_waitcnt lgkmcnt(0)\n\ts_barrier" ::: "memory");
}

__device__ __forceinline__ void sample_unit(int b, int h, const bf16_t* Q, const bf16_t* Kg, const bf16_t* Vg, const bf16_t* CK, const bf16_t* CV, bf16_t* O, LAS unsigned char* lds, const int tid) {
    const int lane = tid & 63, r32 = lane & 31, hi = lane >> 5; const int wid = __builtin_amdgcn_readfirstlane(tid >> 6);
    const unsigned lds0 = (unsigned)(uintptr_t)lds;
    const LAS float* tab = (const LAS float*)(lds + L_BIAS); LAS float* wsf = (LAS float*)(lds + L_WSF) + wid * 64;
    const long srow = (long)MP + 32 * b;
    const bf16_t* Qw = Q + srow * D + h * HD;
    const unsigned ks = lds0 + wid * 16384, vs = ks + 8192;
    { const bf16_t* Kc = CK + ((long)b * CA + 64 * wid) * D + h * HD; const bf16_t* Vc = CV + ((long)b * CA + 64 * wid) * D + h * HD;
#pragma unroll
        for (int p = 0; p < 8; ++p) { glds16(Kc + (long)lane * D + p * 8, (unsigned)__builtin_amdgcn_readfirstlane(ks + p * 1024));
            glds16(Vc + (long)(16 * (p & 3) + (lane >> 2)) * D + (p >> 2) * 32 + (lane & 3) * 8, (unsigned)__builtin_amdgcn_readfirstlane(vs + p * 1024)); } }
    bf16x8 qr[4];
#pragma unroll
    for (int d0 = 0; d0 < 4; ++d0) qr[d0] = *(const bf16x8*)(Qw + (long)r32 * D + d0 * 16 + hi * 8);
    State st; st.m = -1e30f; st.l = 0.f;
#pragma unroll
    for (int r = 0; r < 16; ++r) { st.o[0][r] = 0.f; st.o[1][r] = 0.f; }
    asm volatile("s_waitcnt vmcnt(0)" ::: "memory"); asm volatile("" : "+v"(qr[0]), "+v"(qr[1]), "+v"(qr[2]), "+v"(qr[3]));
    { const bool near = wid >= 6; tile(st, qr, ks, vs, near ? 0.f : tab[256], near, r32 + 512 - 64 * wid + 128, false, tab, wsf, r32, hi, lane); }
    if (wid == 0) {
        const bf16_t* Kn = Kg + srow * D + h * HD; const bf16_t* Vn = Vg + srow * D + h * HD;
#pragma unroll
        for (int p = 0; p < 8; ++p) { const int kr = lane < 32 ? lane : 31; const int vr0 = 16 * (p & 3) + (lane >> 2), vr = vr0 < 32 ? vr0 : 31;
            glds16(Kn + (long)kr * D + p * 8, (unsigned)__builtin_amdgcn_readfirstlane(ks + p * 1024));
            glds16(Vn + (long)vr * D + (p >> 2) * 32 + (lane & 3) * 8, (unsigned)__builtin_amdgcn_readfirstlane(vs + p * 1024)); }
        asm volatile("s_waitcnt vmcnt(0)" ::: "memory");
        tile(st, qr, ks, vs, 0.f, true, r32 + 128, true, tab, wsf, r32, hi, lane);
    }
    const float l = st.l + __shfl_xor(st.l, 32);
    asm volatile("s_waitcnt lgkmcnt(0)\n\ts_barrier" ::: "memory");
    LAS float* OP = (LAS float*)lds;
    LAS float* MLp = (LAS float*)(lds + 65536);
#pragma unroll
    for (int r = 0; r < 16; ++r) { const int q = crow(r, hi); OP[(wid * 32 + q) * 64 + r32] = st.o[0][r]; OP[(wid * 32 + q) * 64 + 32 + r32] = st.o[1][r]; }
    if (hi == 0) { MLp[wid * 32 + r32] = st.m; MLp[256 + wid * 32 + r32] = l; }
    __syncthreads();
    { const int q = tid >> 4, d4 = (tid & 15) * 4; float mg = -1e30f;
#pragma unroll
        for (int w = 0; w < 8; ++w) mg = fmaxf(mg, MLp[w * 32 + q]);
        f32x4 num = (f32x4){0.f, 0.f, 0.f, 0.f}; float den = 0.f;
#pragma unroll
        for (int w = 0; w < 8; ++w) { const float f = __builtin_amdgcn_exp2f(MLp[w * 32 + q] - mg); den += f * MLp[256 + w * 32 + q]; num += *(const LAS f32x4*)(OP + (w * 32 + q) * 64 + d4) * f; }
        const float rd = 1.0f / den; u32x2 w2; w2.x = cvt_pk_bf16(num[0] * rd, num[1] * rd); w2.y = cvt_pk_bf16(num[2] * rd, num[3] * rd);
        *(u32x2*)(O + (srow + q) * D + h * HD + d4) = w2; }
    __syncthreads();
}
#undef WAIT_BAR
}

namespace gate {
constexpr int L_VS = 0, L_STG = 32768, L_RV = 98304;
__device__ __forceinline__ void unit(bool sample, int nb, int gp, bf16_t* U, const bf16_t* Vv, const float* ssqv, const float* ssqvs, const float* vgain, const float* wsp, const float* bsp, float* ogv, LAS unsigned char* lds, const int tid) {
    const int lane = tid & 63, r32 = lane & 31, hi = lane >> 5; const int wid = __builtin_amdgcn_readfirstlane(tid >> 6);
    const long tok0 = sample ? (long)MP + 32 * nb : (long)128 * nb; const int nrows = sample ? 32 : 128;
    LAS float* rv = (LAS float*)(lds + L_RV);
    if (!sample) { if (tid < 128) { const long t = tok0 + tid; const float s = (ssqv[t] + ssqv[MT + t]) + (ssqv[2 * MT + t] + ssqv[3 * MT + t]); rv[tid] = 1.0f / sqrtf(s * (1.0f / D) + EPS); } }
    else { const int row = tid >> 4, jj = tid & 15; float s = ssqvs[(size_t)jj * MS + nb * 32 + row] + ssqvs[(size_t)(jj + 16) * MS + nb * 32 + row];
        s += __shfl_xor(s, 1); s += __shfl_xor(s, 2); s += __shfl_xor(s, 4); s += __shfl_xor(s, 8); if (jj == 0) rv[row] = 1.0f / sqrtf(s * (1.0f / D) + EPS); }
    __syncthreads();
    for (int pi = wid; pi < 32; pi += 8) { const int gi = pi >> 4, qt = (pi >> 3) & 1, dh = (pi >> 2) & 1, rg = pi & 3;
        const int row = 64 * qt + 16 * rg + (lane >> 2), col = 64 * (2 * gp + gi) + 32 * dh + 8 * (lane & 3);
        if (row < nrows) { const u32x4 raw = *(const u32x4*)(Vv + (tok0 + row) * D + col); const float rs = rv[row];
            const f32x4 g0 = *(const f32x4*)(vgain + col), g1 = *(const f32x4*)(vgain + col + 4);
            float f[8]; f[0] = bf2f(raw.x & 0xffffu) * rs * g0[0]; f[1] = bf2f(raw.x >> 16) * rs * g0[1]; f[2] = bf2f(raw.y & 0xffffu) * rs * g0[2]; f[3] = bf2f(raw.y >> 16) * rs * g0[3];
            f[4] = bf2f(raw.z & 0xffffu) * rs * g1[0]; f[5] = bf2f(raw.z >> 16) * rs * g1[1]; f[6] = bf2f(raw.w & 0xffffu) * rs * g1[2]; f[7] = bf2f(raw.w >> 16) * rs * g1[3];
            u32x4 w; w.x = cvt_pk_bf16(f[0], f[1]); w.y = cvt_pk_bf16(f[2], f[3]); w.z = cvt_pk_bf16(f[4], f[5]); w.w = cvt_pk_bf16(f[6], f[7]);
            *(LAS u32x4*)(lds + L_VS + (gi * 2 + qt) * 8192 + (dh * 4 + rg) * 1024 + lane * 16) = w;
            if (sample) { float* o = ogv + (size_t)(nb * 32 + row) * D + col; *(f32x4*)o = (f32x4){f[0], f[1], f[2], f[3]}; *(f32x4*)(o + 4) = (f32x4){f[4], f[5], f[6], f[7]}; } } }
    __syncthreads();
    const int gi = wid >> 2, pb = wid & 3, g = 2 * gp + gi;
    if (pb * 32 < nrows) {
        const int nks = sample ? 2 : (pb < 2 ? 4 : 8);
        f32x16 o[2];
#pragma unroll
        for (int r = 0; r < 16; ++r) { o[0][r] = 0.f; o[1][r] = 0.f; }
        const float* wrow = wsp + ((size_t)g * 128 + 32 * pb + r32) * 128 + 4 * hi;
        const unsigned lds0 = (unsigned)(uintptr_t)lds;
        for (int ks = 0; ks < nks; ++ks) {
            const f32x4 a0 = *(const f32x4*)(wrow + 16 * ks), a1 = *(const f32x4*)(wrow + 16 * ks + 8);
            u32x4 pa; pa.x = cvt_pk_bf16(a0[0], a0[1]); pa.y = cvt_pk_bf16(a0[2], a0[3]); pa.z = cvt_pk_bf16(a1[0], a1[1]); pa.w = cvt_pk_bf16(a1[2], a1[3]);
            const int vb = (int)(lds0 + L_VS + (gi * 2 + (ks >> 2)) * 8192 + (ks & 3) * 1024) + ((lane >> 4) & 1) * 32 + (lane & 3) * 8 + (4 * hi + ((lane & 15) >> 2)) * 64;
            s16x4 lo[2], hh[2];
#pragma unroll
            for (int d0 = 0; d0 < 2; ++d0) {
                asm volatile("ds_read_b64_tr_b16 %0,%1 offset:%c2" : "=&v"(lo[d0]) : "v"(vb), "i"(d0 * 4096) : "memory");
                asm volatile("ds_read_b64_tr_b16 %0,%1 offset:%c2" : "=&v"(hh[d0]) : "v"(vb), "i"(d0 * 4096 + 512) : "memory"); }
            asm volatile("s_waitcnt lgkmcnt(0)" ::: "memory"); __builtin_amdgcn_sched_barrier(0);
#pragma unroll
            for (int d0 = 0; d0 < 2; ++d0) { const bf16x8 vf = (bf16x8){lo[d0][0], lo[d0][1], lo[d0][2], lo[d0][3], hh[d0][0], hh[d0][1], hh[d0][2], hh[d0][3]};
                o[d0] = __builtin_amdgcn_mfma_f32_32x32x16_bf16(__builtin_bit_cast(bf16x8, pa), vf, o[d0], 0, 0, 0); }
        }
        LAS float* stg = (LAS float*)(lds + L_STG) + wid * 2048;
        const float* bs = bsp + g * 128 + 32 * pb;
#pragma unroll
        for (int r = 0; r < 16; ++r) { const int q = crow(r, hi); const float bq = bs[q]; stg[q * 64 + r32] = o[0][r] + bq; stg[q * 64 + 32 + r32] = o[1][r] + bq; }
        LDS_WAIT();
#pragma unroll
        for (int i = 0; i < 4; ++i) { const int row = i * 8 + (lane >> 3), ch = lane & 7;
            const f32x4 m0 = *(const LAS f32x4*)(stg + row * 64 + ch * 8), m1 = *(const LAS f32x4*)(stg + row * 64 + ch * 8 + 4);
            bf16_t* up = U + (tok0 + 32 * pb + row) * D + 64 * g + ch * 8; const u32x4 uu = *(const u32x4*)up;
            u32x4 w; w.x = cvt_pk_bf16(bf2f(uu.x & 0xffffu) * m0[0], bf2f(uu.x >> 16) * m0[1]); w.y = cvt_pk_bf16(bf2f(uu.y & 0xffffu) * m0[2], bf2f(uu.y >> 16) * m0[3]);
            w.z = cvt_pk_bf16(bf2f(uu.z & 0xffffu) * m1[0], bf2f(uu.z >> 16) * m1[1]); w.w = cvt_pk_bf16(bf2f(uu.w & 0xffffu) * m1[2], bf2f(uu.w >> 16) * m1[3]);
            *(u32x4*)up = w; }
    }
    __syncthreads();
}
}

template <bool UP>
__device__ __forceinline__ void transpose_item(const float* W, int K, int N, const float* gain, bf16_t* WT, LAS float* scr, int item, int lane) {
    const int nblk = N / 32, kb = item / nblk, nb = item % nblk, k0 = 64 * kb, n0 = 32 * nb;
#pragma unroll 8
    for (int i = 0; i < 32; ++i) { const int kk = 2 * i + (lane >> 5); const float gk = gain ? gain[k0 + kk] : 1.0f; scr[kk * 33 + (lane & 31)] = W[(size_t)(k0 + kk) * N + n0 + (lane & 31)] * gk; }
    LDS_WAIT(); asm volatile("" ::: "memory");
    const int c = lane & 7;
#pragma unroll
    for (int jj = 0; jj < 4; ++jj) { const int n = (lane >> 3) + 8 * jj; const LAS float* s = scr + (8 * c) * 33 + n;
        u32x4 o; o.x = cvt_pk_bf16(s[0 * 33], s[1 * 33]); o.y = cvt_pk_bf16(s[2 * 33], s[3 * 33]); o.z = cvt_pk_bf16(s[4 * 33], s[5 * 33]); o.w = cvt_pk_bf16(s[6 * 33], s[7 * 33]);
        int dn = n0 + n; if (UP) { const int v = dn >= FF ? 1 : 0, gc = dn - v * FF; dn = 256 * (gc >> 7) + 128 * v + (gc & 127); }
        *(u32x4*)(WT + (size_t)dn * K + k0 + 8 * c) = o; }
    LDS_WAIT(); asm volatile("" ::: "memory");
}

#define XB_TMO      128
#define XB_XCNT(j)  (256  + 64 * (j))
#define XB_XSUB(j)  (1280 + 64 * (j))
#define XB_XGEN(j)  (2304 + 64 * (j))
#define XB_TOP      3328
#define XB_TOPGEN   3392
#define XCD_BAR_WORDS 3456
#define XB_SPIN_CAP (1u << 18)
__device__ __forceinline__ unsigned xb_ld(unsigned* p)              { return __hip_atomic_load(p, __ATOMIC_RELAXED, __HIP_MEMORY_SCOPE_AGENT); }
__device__ __forceinline__ unsigned xb_add(unsigned* p, unsigned v) { return __hip_atomic_fetch_add(p, v, __ATOMIC_RELAXED, __HIP_MEMORY_SCOPE_AGENT); }
__device__ __forceinline__ unsigned xb_xcc_id() { return (unsigned)__builtin_amdgcn_s_getreg((3 << 11) | 20) & 0xFu; }
#define XB_SPIN(cond, bar) do { unsigned _sp = 0; while (cond) { __builtin_amdgcn_s_sleep(1); \
    if ((++_sp & 255u) == 0u) { if (xb_ld(&(bar)[XB_TMO])) break; if (_sp > XB_SPIN_CAP) { atomicAdd(&(bar)[XB_TMO], 1u); break; } } } } while (0)
struct XcdBarrier { unsigned* bar; unsigned x; volatile LAS unsigned* st; };
__device__ __forceinline__ void xcd_barrier_complete(unsigned* bar, unsigned x, unsigned& nloc, unsigned& nx) {
    const unsigned G = gridDim.x * gridDim.y * gridDim.z;
    unsigned sum, cnt, mine, sp = 0u;
    for (;;) {
        sum = 0u; cnt = 0u; mine = 0u;
#pragma unroll
        for (unsigned j = 0; j < 16; ++j) { const unsigned c = xb_ld(&bar[XB_XCNT(j)]); sum += c; cnt += (c > 0u) ? 1u : 0u; mine = (j == x) ? c : mine; }
        if (sum == G) break;
        __builtin_amdgcn_s_sleep(1);
        if ((++sp & 255u) == 0u) { if (xb_ld(&bar[XB_TMO])) break; if (sp > XB_SPIN_CAP) { atomicAdd(&bar[XB_TMO], 1u); break; } }
    }
    nloc = mine > 0u ? mine : 1u; nx = cnt > 0u ? cnt : 1u;
}
__device__ __forceinline__ void xcd_barrier(const XcdBarrier& b, const int tid) {
    asm volatile("s_waitcnt vmcnt(0)" ::: "memory");
    __syncthreads();
    if (tid == 0) {
        unsigned* bar = b.bar;
        __builtin_amdgcn_s_waitcnt(0);
        unsigned nloc = b.st[0], nx = b.st[1];
        if (nloc == 0u) { xcd_barrier_complete(bar, b.x, nloc, nx); b.st[0] = nloc; b.st[1] = nx; }
        const unsigned old = xb_add(&bar[XB_XSUB(b.x)], 1u);
        const unsigned gen = old / nloc;
        if (old + 1u == (gen + 1u) * nloc) {
            __builtin_amdgcn_fence(__ATOMIC_RELEASE, "agent");
            asm volatile("s_waitcnt vmcnt(0)" ::: "memory");
            const unsigned og = xb_add(&bar[XB_TOP], 1u);
            const unsigned tg = og / nx;
            if (og + 1u == (tg + 1u) * nx) xb_add(&bar[XB_TOPGEN], 1u);
            else XB_SPIN(xb_ld(&bar[XB_TOPGEN]) == tg, bar);
            __builtin_amdgcn_fence(__ATOMIC_ACQUIRE, "agent");
            xb_add(&bar[XB_XGEN(b.x)], 1u);
            asm volatile("s_waitcnt vmcnt(0)" ::: "memory");
        } else {
            XB_SPIN(xb_ld(&bar[XB_XGEN(b.x)]) == gen, bar);
            __builtin_amdgcn_fence(__ATOMIC_ACQUIRE, "agent");
            asm volatile("s_waitcnt vmcnt(0)" ::: "memory");
        }
    }
    __syncthreads();
}

#define PH(k)
struct Args { const float* in[20]; float* out; unsigned char* ws; };

__global__ void __launch_bounds__(NTHR, 2) fwd_kernel(Args a) {
    extern __shared__ __attribute__((aligned(16))) unsigned char lds_raw[];
    LAS unsigned char* lds = (LAS unsigned char*)lds_raw;
    const int wave0 = __builtin_amdgcn_readfirstlane((int)threadIdx.x >> 6);
    XcdBarrier bar;
    { volatile LAS unsigned* MISC = (volatile LAS unsigned*)(lds + L_MISC);
        if (threadIdx.x < 4) MISC[threadIdx.x] = 0u;
        __syncthreads();
        bar.bar = (unsigned*)(a.ws + WS_CTL); bar.x = xb_xcc_id(); bar.st = MISC;
        if (threadIdx.x == 0) (void)xb_add(&bar.bar[XB_XCNT(bar.x)], 1u); }
#define GRID_BAR() do { PHASE_VARS xcd_barrier(bar, tid); } while (0)
#define PHASE_VARS int tid; asm volatile("v_mbcnt_lo_u32_b32 %0, -1, 0\n\tv_mbcnt_hi_u32_b32 %0, -1, %0" : "=v"(tid)); tid |= wave0 << 6; const int lane = tid & 63, wave = wave0; (void)lane; (void)wave;
    const int G = gridDim.x, bx = blockIdx.x; const int vcu = (G % 8 == 0) ? (bx % 8) * (G / 8) + bx / 8 : bx;
    unsigned char* ws = a.ws; float* out = a.out;
    const float *x_prompt = a.in[0], *x_sample = a.in[1], *cache_k = a.in[2], *cache_v = a.in[3], *state_conv = a.in[4], *ln_mix = a.in[5], *ln_ffn = a.in[6], *ln_final = a.in[7],
                *w_qkv = a.in[8], *rel_bias = a.in[9], *w_o = a.in[10], *w_in = a.in[11], *v_norm = a.in[12], *w_s = a.in[13], *bias_s = a.in[14], *w_out = a.in[15],
                *w_up = a.in[16], *conv_w = a.in[17], *conv_b = a.in[18], *w_down = a.in[19];
    bf16_t *Wqkv_t = (bf16_t*)(ws + WS_WQKV), *Wo_t = (bf16_t*)(ws + WS_WO), *Win_t = (bf16_t*)(ws + WS_WIN), *Wout_t = (bf16_t*)(ws + WS_WOUT);
    bf16_t *XB = (bf16_t*)(ws + WS_XB), *QB = (bf16_t*)(ws + WS_Q), *KB = (bf16_t*)(ws + WS_K), *VB = (bf16_t*)(ws + WS_V), *GB = (bf16_t*)(ws + WS_G), *CKB = (bf16_t*)(ws + WS_CK), *CVB = (bf16_t*)(ws + WS_CV), *OB = (bf16_t*)(ws + WS_OB);
    float *SSQ = (float*)(ws + WS_SSQ), *SSQV = (float*)(ws + WS_SSQV), *SSQS = (float*)(ws + WS_SSQS), *SSQVS = (float*)(ws + WS_SSQVS);
    float* XS = out + O_YS;

    PH(0) { PHASE_VARS
        LAS float* scr = (LAS float*)(lds + wave * 16384);
        const int gw = vcu * NWAVES + wave, NGW = G * NWAVES;
        constexpr int I_QKV = (D / 64) * (3 * D / 32), I_O = (D / 64) * (D / 32), I_IN = (D / 64) * (2 * D / 32), I_UP = (D / 64) * (FF2 / 32), I_DN = (FF / 64) * (D / 32);
        constexpr int NITEMS = I_QKV + 2 * I_O + I_IN + 2 * I_UP + 2 * I_DN;
        for (int it = gw; it < NITEMS; it += NGW) {
            int r = it;
            if (r < I_QKV) { transpose_item<false>(w_qkv, D, 3 * D, ln_mix, Wqkv_t, scr, r, lane); continue; } r -= I_QKV;
            if (r < I_O) { transpose_item<false>(w_o, D, D, nullptr, Wo_t, scr, r, lane); continue; } r -= I_O;
            if (r < I_IN) { transpose_item<false>(w_in, D, 2 * D, ln_mix + D, Win_t, scr, r, lane); continue; } r -= I_IN;
            if (r < I_O) { transpose_item<false>(w_out, D, D, nullptr, Wout_t, scr, r, lane); continue; } r -= I_O;
            if (r < 2 * I_UP) { const int l = r / I_UP; transpose_item<true>(w_up + (size_t)l * D * FF2, D, FF2, ln_ffn + l * D, (bf16_t*)(ws + WS_WUP + l * WUP_L), scr, r % I_UP, lane); continue; } r -= 2 * I_UP;
            { const int l = r / I_DN; transpose_item<false>(w_down + (size_t)l * FF * D, FF, D, nullptr, (bf16_t*)(ws + WS_WDN + l * WDN_L), scr, r % I_DN, lane); }
        }
        for (int m = gw; m < MT; m += NGW) {
            const float* xr = m < MP ? x_prompt + (size_t)m * D : x_sample + (size_t)(m - MP) * D;
            f32x4 v[4]; float s = 0.f;
#pragma unroll
            for (int jj = 0; jj < 4; ++jj) { v[jj] = ((const f32x4*)xr)[lane + 64 * jj]; s += (v[jj][0] * v[jj][0] + v[jj][1] * v[jj][1]) + (v[jj][2] * v[jj][2] + v[jj][3] * v[jj][3]); }
            s = wave_sum(s);
#pragma unroll
            for (int jj = 0; jj < 4; ++jj) { u32x2 w; w.x = cvt_pk_bf16(v[jj][0], v[jj][1]); w.y = cvt_pk_bf16(v[jj][2], v[jj][3]); ((u32x2*)(XB + (size_t)m * D))[lane + 64 * jj] = w; }
            if (m < MP) { if (lane < 4) SSQ[(size_t)lane * MT + m] = lane == 0 ? s : 0.f; }
            else { if (lane < 32) SSQS[(size_t)lane * MS + (m - MP)] = lane == 0 ? s : 0.f; }
        }
        for (int m = gw; m < 2 * DB * CA; m += NGW) { const int which = m >= DB * CA, rr = m - which * DB * CA; const float* src = (which ? cache_v : cache_k) + (size_t)rr * D; bf16_t* dst = (which ? CVB : CKB) + (size_t)rr * D;
#pragma unroll
            for (int jj = 0; jj < 4; ++jj) { const f32x4 v = ((const f32x4*)src)[lane + 64 * jj]; u32x2 w; w.x = cvt_pk_bf16(v[0], v[1]); w.y = cvt_pk_bf16(v[2], v[3]); ((u32x2*)dst)[lane + 64 * jj] = w; } }
    }
    GRID_BAR();

    PH(1) { PHASE_VARS
        for (int task = vcu; task < DB * 96; task += G) { const int mt = task / 96, nt = task % 96;
            srs_table(lds, SSQS, mt, tid);
            stask_mm<D>(lds, XB, MP + 32 * mt, Wqkv_t, [&](int jn) { return 32 * nt + jn; }, tid);
            const LAS float* C = (const LAS float*)(lds + L_SC); const LAS float* rs = (const LAS float*)(lds + L_SRS);
            const int row = tid >> 4, c0 = (tid & 15) * 2, n = 32 * nt + c0, t = n >> 10, nn = n & 1023; const float r_ = rs[row];
            const float v0 = C[row * 33 + c0] * r_, v1 = C[row * 33 + c0 + 1] * r_; const float sc = t == 0 ? C2 : 1.0f;
            bf16_t* dst = (t == 0 ? QB : (t == 1 ? KB : VB)) + (size_t)(MP + 32 * mt + row) * D + nn; *(unsigned*)dst = cvt_pk_bf16(v0 * sc, v1 * sc);
            if (t >= 1) { float* o = out + (t == 1 ? O_KS : O_VS) + (size_t)(32 * mt + row) * D + nn; *(f32x2*)o = (f32x2){v0, v1}; }
            __syncthreads();
        }
        pg8::Gemm g{XB, Wqkv_t, D}; pg8::StaticOrder S; S.init(MP / 256, 3 * D / 256, G, bx, 0);
        EpiQKV E{QB, (size_t)(WS_K - WS_Q) / 2, SSQ, out + O_KP, out + O_VP};
        pg8::gemm_phase<EpiQKV, pg8::StaticOrder>(lds, g, S, E, tid);
    }
    GRID_BAR();

    PH(2) { PHASE_VARS
        LAS float* tab = (LAS float*)(lds + att::L_BIAS);
        const int per = (NB * NH * 32 + G - 1) / G;
        int lasth = -1;
        for (int id = vcu * per; id < (vcu + 1) * per && id < NB * NH * 32; ++id) { const int bh = id >> 5, qg = id & 31, b = bh / NH, h = bh % NH;
            if (h != lasth) { __syncthreads(); for (int i = tid; i < NREL; i += NTHR) tab[i] = rel_bias[h * NREL + i] * LOG2E; __syncthreads(); lasth = h; }
            att::prompt_unit(b, h, qg, QB, KB, VB, OB, lds, tid); }
        for (int id = vcu; id < DB * NH; id += G) { const int b = id / NH, h = id % NH;
            if (h != lasth) { __syncthreads(); for (int i = tid; i < NREL; i += NTHR) tab[i] = rel_bias[h * NREL + i] * LOG2E; __syncthreads(); lasth = h; }
            att::sample_unit(b, h, QB, KB, VB, CKB, CVB, OB, lds, tid); }
    }
    GRID_BAR();

#define RES_PHASE(A_, Wt_, KK, BASE_P, BASE_S) do { \
        for (int task = vcu; task < DB * 32; task += G) { const int mt = task / 32, nt = task % 32; \
            stask_mm<KK>(lds, A_, MP + 32 * mt, Wt_, [&](int jn) { return 32 * nt + jn; }, tid); \
            const LAS float* C = (const LAS float*)(lds + L_SC); \
            const int row = tid >> 4, c0 = (tid & 15) * 2, n = 32 * nt + c0; const size_t o_ = (size_t)(32 * mt + row) * D + n; \
            const f32x2 bb = *(const f32x2*)((BASE_S) + o_); const float v0 = bb.x + C[row * 33 + c0], v1 = bb.y + C[row * 33 + c0 + 1]; \
            *(f32x2*)(XS + o_) = (f32x2){v0, v1}; *(unsigned*)(XB + (size_t)MP * D + o_) = cvt_pk_bf16(v0, v1); \
            float s_ = v0 * v0 + v1 * v1; s_ += __shfl_xor(s_, 1); s_ += __shfl_xor(s_, 2); s_ += __shfl_xor(s_, 4); s_ += __shfl_xor(s_, 8); \
            if ((tid & 15) == 0) SSQS[(size_t)nt * MS + 32 * mt + row] = s_; \
            __syncthreads(); } \
        pg8::Gemm g{A_, Wt_, KK}; pg8::StaticOrder S; S.init(MP / 256, D / 256, G, bx, 0); \
        EpiRes E{BASE_P, out + O_YP, XB, SSQ}; \
        pg8::gemm_phase<EpiRes, pg8::StaticOrder>(lds, g, S, E, tid); } while (0)
    PH(3) { PHASE_VARS RES_PHASE(OB, Wo_t, D, x_prompt, x_sample); }
    GRID_BAR();

#define UP_PHASE(L_) do { \
        const bf16_t* Wup_ = (const bf16_t*)(ws + WS_WUP + (L_) * WUP_L); const float* cw_ = conv_w + (size_t)(L_) * 3 * FF2; const float* cb_ = conv_b + (size_t)(L_) * FF2; \
        for (int task = vcu; task < DB * 176; task += G) { const int mt = task / 176, nt = task % 176; \
            srs_table(lds, SSQS, mt, tid); \
            stask_mm<D>(lds, XB, MP + 32 * mt, Wup_, [&](int jn) { const int gc = 16 * nt + (jn & 15); return 256 * (gc >> 7) + (gc & 127) + 128 * (jn >> 4); }, tid); \
            LAS float* C = (LAS float*)(lds + L_SC); const LAS float* rs = (const LAS float*)(lds + L_SRS); \
            { const int row = tid >> 4, c0 = (tid & 15) * 2; const float r_ = rs[row]; C[row * 33 + c0] *= r_; C[row * 33 + c0 + 1] *= r_; } \
            __syncthreads(); \
            { const int row = tid >> 4, jn = tid & 15, gc = 16 * nt + jn; const float* hs = state_conv + ((size_t)((L_) * DB + mt) * 2) * FF2; float cc[2]; \
                _Pragma("unroll") for (int v = 0; v < 2; ++v) { const int oc = v * FF + gc, tc = jn + 16 * v; \
                    const float a0 = C[row * 33 + tc], a1 = row >= 1 ? C[(row - 1) * 33 + tc] : hs[FF2 + oc], a2 = row >= 2 ? C[(row - 2) * 33 + tc] : hs[(size_t)row * FF2 + oc]; \
                    cc[v] = cb_[oc] + cw_[oc] * a2 + cw_[FF2 + oc] * a1 + cw_[2 * FF2 + oc] * a0; \
                    if (row >= 30) out[O_CS + ((size_t)((L_) * DB + mt) * 2 + (row - 30)) * FF2 + oc] = a0; } \
                GB[(size_t)(MP + 32 * mt + row) * FF + gc] = (bf16_t)(cvt_pk_bf16(silu1(cc[0]) * cc[1], 0.f) & 0xffffu); } \
            __syncthreads(); } \
        pg8::Gemm g{XB, Wup_, D}; pg8::StaticOrder S; S.init(66, FF2 / 256, G, bx, 1); \
        EpiUp E{GB, SSQ, cw_, cb_, out + O_CP + (size_t)(L_) * NB * 2 * FF2}; \
        pg8::gemm_phase<EpiUp, pg8::StaticOrder>(lds, g, S, E, tid); } while (0)
    PH(4) { PHASE_VARS UP_PHASE(0); }
    GRID_BAR();
    PH(5) { PHASE_VARS RES_PHASE(GB, (const bf16_t*)(ws + WS_WDN), FF, out + O_YP, XS); }
    GRID_BAR();

    PH(6) { PHASE_VARS
        for (int task = vcu; task < DB * 64; task += G) { const int mt = task / 64, nt = task % 64;
            srs_table(lds, SSQS, mt, tid);
            stask_mm<D>(lds, XB, MP + 32 * mt, Win_t, [&](int jn) { return 32 * nt + jn; }, tid);
            const LAS float* C = (const LAS float*)(lds + L_SC); const LAS float* rs = (const LAS float*)(lds + L_SRS);
            const int row = tid >> 4, c0 = (tid & 15) * 2, n = 32 * nt + c0, t = n >> 10, nn = n & 1023; const float r_ = rs[row];
            const f32x2 z = gelu_pk((f32x2){C[row * 33 + c0] * r_, C[row * 33 + c0 + 1] * r_});
            *(unsigned*)((t == 0 ? QB : KB) + (size_t)(MP + 32 * mt + row) * D + nn) = cvt_pk_bf16(z.x, z.y);
            if (t == 1) { float s_ = z.x * z.x + z.y * z.y; s_ += __shfl_xor(s_, 1); s_ += __shfl_xor(s_, 2); s_ += __shfl_xor(s_, 4); s_ += __shfl_xor(s_, 8);
                if ((tid & 15) == 0) SSQVS[(size_t)(nt - 32) * MS + 32 * mt + row] = s_; }
            __syncthreads();
        }
        pg8::Gemm g{XB, Win_t, D}; pg8::StaticOrder S; S.init(MP / 256, 2 * D / 256, G, bx, 0);
        EpiIn E{QB, (size_t)(WS_K - WS_Q) / 2, SSQ, SSQV};
        pg8::gemm_phase<EpiIn, pg8::StaticOrder>(lds, g, S, E, tid);
    }
    GRID_BAR();

    PH(7) { PHASE_VARS
        const int per = (128 * 8 + G - 1) / G;
        for (int id = vcu * per; id < (vcu + 1) * per && id < 128 * 8; ++id) gate::unit(false, id >> 3, id & 7, QB, KB, SSQV, SSQVS, v_norm, w_s, bias_s, out + O_GV, lds, tid);
        for (int id = vcu; id < DB * 8; id += G) gate::unit(true, id >> 3, id & 7, QB, KB, SSQV, SSQVS, v_norm, w_s, bias_s, out + O_GV, lds, tid);
    }
    GRID_BAR();

    PH(8) { PHASE_VARS RES_PHASE(QB, Wout_t, D, out + O_YP, XS); }
    GRID_BAR();
    PH(9) { PHASE_VARS UP_PHASE(1); }
    GRID_BAR();
    PH(10) { PHASE_VARS RES_PHASE(GB, (const bf16_t*)(ws + WS_WDN + WDN_L), FF, out + O_YP, XS); }
    GRID_BAR();

    PH(11) { PHASE_VARS
        const int gw = vcu * NWAVES + wave, NGW = G * NWAVES;
        f32x4 gn[4];
#pragma unroll
        for (int jj = 0; jj < 4; ++jj) gn[jj] = ((const f32x4*)ln_final)[lane + 64 * jj];
        for (int m = gw; m < MT; m += NGW) {
            float s;
            if (m < MP) s = (SSQ[m] + SSQ[MT + m]) + (SSQ[2 * MT + m] + SSQ[3 * MT + m]);
            else { s = lane < 32 ? SSQS[(size_t)lane * MS + (m - MP)] : 0.f; s = wave_sum(s); }
            const float rs = 1.0f / sqrtf(s * (1.0f / D) + EPS);
            f32x4* xr = (f32x4*)(out + (size_t)m * D);
#pragma unroll
            for (int jj = 0; jj < 4; ++jj) { f32x4 v = xr[lane + 64 * jj]; v = v * rs * gn[jj]; xr[lane + 64 * jj] = v; }
        }
    }
}

extern "C" void kernel_launch(void* const* d_in, const int* in_sizes, int n_in, void* d_out, int out_size, void* d_ws, size_t ws_size, hipStream_t stream) {
    static int grid = 0;
    if (grid == 0) {
        if (n_in != 20 || (size_t)out_size != O_END || ws_size < WS_END) { fprintf(stderr, "kernel_launch: unexpected sizes n_in %d out %d ws %zu\n", n_in, out_size, ws_size); grid = -1; return; }
        int dev = 0, cus = 0, per_cu = 0;
        if (hipGetDevice(&dev) != hipSuccess || hipDeviceGetAttribute(&cus, hipDeviceAttributeMultiprocessorCount, dev) != hipSuccess) { grid = -1; return; }
        if (hipFuncSetAttribute((const void*)fwd_kernel, hipFuncAttributeMaxDynamicSharedMemorySize, LDS_BYTES) != hipSuccess) { fprintf(stderr, "kernel_launch: hipFuncSetAttribute failed\n"); grid = -1; return; }
        if (hipOccupancyMaxActiveBlocksPerMultiprocessor(&per_cu, (const void*)fwd_kernel, NTHR, LDS_BYTES) != hipSuccess || per_cu < 1) { fprintf(stderr, "kernel_launch: occupancy query says %d\n", per_cu); per_cu = 1; }
        (void)hipGetLastError();
        grid = cus;
    }
    if (grid < 0) return;
    Args a{};
    for (int i = 0; i < 20; ++i) a.in[i] = (const float*)d_in[i];
    a.out = (float*)d_out; a.ws = (unsigned char*)d_ws;
    if (hipMemsetAsync((char*)d_ws + WS_CTL, 0, 16384, stream) != hipSuccess) { fprintf(stderr, "kernel_launch: memset of the barrier words failed\n"); return; }
    hipLaunchKernelGGL(fwd_kernel, dim3(grid), dim3(NTHR), LDS_BYTES, stream, a);
    const hipError_t e = hipPeekAtLastError();
    if (e != hipSuccess) fprintf(stderr, "kernel_launch: launch failed: %s (grid %d)\n", hipGetErrorName(e), grid);
}
```

```cpp
#include <hip/hip_runtime.h>
#include <cstdio>
#include <cstdint>

#define LAS __attribute__((address_space(3)))
typedef unsigned short bf16_t;
typedef short bf16x8 __attribute__((ext_vector_type(8)));
typedef short s16x4 __attribute__((ext_vector_type(4)));
typedef float f32x2 __attribute__((ext_vector_type(2)));
typedef float f32x4 __attribute__((ext_vector_type(4)));
typedef float f32x16 __attribute__((ext_vector_type(16)));
typedef unsigned u32x2 __attribute__((ext_vector_type(2)));
typedef unsigned u32x4 __attribute__((ext_vector_type(4)));

constexpr int D = 1024, SEQ = 8192, NB = 2, MP = NB * SEQ, DB = 8, DT = 32, MS = DB * DT, MT = MP + MS;
constexpr int NH = 16, HD = 64, FF = 2816, FF2 = 5632, CA = 512, NREL = 257;
constexpr float EPS = 1e-6f, LOG2E = 1.4426950408889634f, C2 = 0.125f * LOG2E;
constexpr int NWAVES = 8, NTHR = 512;

constexpr size_t MiB = 1u << 20;
constexpr size_t WS_CTL = 0;
constexpr size_t WS_WQKV = 1 * MiB, WS_WO = 7 * MiB, WS_WIN = 9 * MiB, WS_WOUT = 13 * MiB, WS_WUP = 15 * MiB, WS_WDN = 37 * MiB;
constexpr size_t WUP_L = (size_t)FF2 * D * 2, WDN_L = (size_t)D * FF * 2;
constexpr size_t WS_XB = 48 * MiB + 65536;
constexpr size_t WS_Q = 82 * MiB, WS_K = 116 * MiB, WS_V = 150 * MiB;
constexpr size_t WS_G = 82 * MiB;
constexpr size_t WS_CK = 184 * MiB, WS_CV = 192 * MiB;
constexpr size_t WS_SSQ = 200 * MiB;
constexpr size_t WS_SSQV = 201 * MiB;
constexpr size_t WS_SSQS = 202 * MiB;
constexpr size_t WS_SSQVS = 202 * MiB + 65536;
constexpr size_t WS_OB = 204 * MiB;
constexpr size_t WS_END = 238 * MiB;

constexpr size_t O_YP = 0, O_YS = O_YP + (size_t)MP * D, O_KP = O_YS + (size_t)MS * D, O_VP = O_KP + (size_t)NB * CA * D, O_KS = O_VP + (size_t)NB * CA * D,
                 O_VS = O_KS + (size_t)MS * D, O_GV = O_VS + (size_t)MS * D, O_CP = O_GV + (size_t)MS * D, O_CS = O_CP + (size_t)2 * NB * 2 * FF2, O_END = O_CS + (size_t)2 * DB * 2 * FF2;

constexpr int RING_BYTES = 131072;
constexpr int L_XBUF = 131072, L_RSTAB = 139264, L_PTAB = 140288;
constexpr int L_MISC = 144384;
constexpr int LDS_BYTES = 155648;

__device__ __forceinline__ unsigned cvt_pk_bf16(float lo, float hi) { unsigned r; asm volatile("v_cvt_pk_bf16_f32 %0, %1, %2" : "=v"(r) : "v"(lo), "v"(hi)); return r; }
__device__ __forceinline__ float bf2f(unsigned h) { return __uint_as_float(h << 16); }
__device__ __forceinline__ int crow(int r, int hi) { return (r & 3) + 8 * (r >> 2) + 4 * hi; }
#define LDS_WAIT() asm volatile("s_waitcnt lgkmcnt(0)" ::: "memory")
#define VM_WAIT() asm volatile("s_waitcnt vmcnt(0)" ::: "memory")
#define RAW_BAR() do { asm volatile("s_waitcnt lgkmcnt(0)" ::: "memory"); __builtin_amdgcn_s_barrier(); asm volatile("" ::: "memory"); } while (0)
__device__ __forceinline__ float wave_sum(float v) {
#pragma unroll
    for (int o = 1; o < 64; o <<= 1) v += __shfl_xor(v, o);
    return v;
}
__device__ __forceinline__ f32x2 gelu_pk(f32x2 v) {
    const f32x2 av = __builtin_elementwise_abs(v), d = av * 0.2316418882f + 1.0f;
    f32x2 t; t.x = __builtin_amdgcn_rcpf(d.x); t.y = __builtin_amdgcn_rcpf(d.y);
    f32x2 q = t * 0.5307027145f + (-0.7265760135f); q = q * t + 0.7107068705f; q = q * t + (-0.142248368f); q = q * t + 0.127414796f; q = q * t;
    const f32x2 s = (v * v) * (-0.72134752044f);
    f32x2 e; e.x = __builtin_amdgcn_exp2f(s.x); e.y = __builtin_amdgcn_exp2f(s.y);
    const f32x2 m = v * (q * e), r = v - m;
    f32x2 o; o.x = v.x < 0.f ? m.x : r.x; o.y = v.y < 0.f ? m.y : r.y; return o;
}
__device__ __forceinline__ float gelu1(float x) { f32x2 r = gelu_pk((f32x2){x, x}); return r.x; }
__device__ __forceinline__ float silu1(float x) { return x * __builtin_amdgcn_rcpf(1.0f + __builtin_amdgcn_exp2f(-x * LOG2E)); }

namespace pg8 {
constexpr int BM = 256, BK = 64, HALF = 128, HTB = HALF * BK * 2, NXCD = 8, WGM = 8;
__host__ __device__ __forceinline__ int lds_byte(int r, int c) { const int st = (r >> 4) * 2 + (c >> 5), rr = r & 15, cc = c & 31, ob = rr * 64 + cc * 2; return st * 1024 + (ob ^ (((ob >> 9) & 1) << 5)); }
__host__ __device__ __forceinline__ void stage_rc(int b, int& R, int& C) { const int st = b / 1024, sb = b % 1024, swz = sb ^ (((sb >> 9) & 1) << 5); R = (st >> 1) * 16 + swz / 64; C = (st & 1) * 32 + (swz % 64) / 2; }
__host__ __device__ __forceinline__ int perm32(int rho) { const int n = rho >> 4, i = rho & 15; return 8 * (i >> 2) + 4 * n + (i & 3); }

struct Unit { int pm, pn, arow; };
struct Gemm { const bf16_t* A; const bf16_t* Bt; int K; };

struct StaticOrder {
    int nM, nN, nwg, G, c, up;
    __device__ void init(int nM_, int nN_, int G_, int c_, int up_) { nM = nM_; nN = nN_; nwg = nM * nN; G = G_; c = c_; up = up_; }
    __device__ bool next(int i, Unit& u) const {
        const long L = (long)i * G + c; if (L >= nwg) return false;
        int wgid = (int)L; { const int q = nwg / NXCD, r = nwg % NXCD, xcd = wgid % NXCD, off = wgid / NXCD; wgid = (xcd < r ? xcd * (q + 1) : r * (q + 1) + (xcd - r) * q) + off; }
        const int nig = WGM * nN, gid = wgid / nig, fm = gid * WGM, gsz = (nM - fm) < WGM ? (nM - fm) : WGM;
        u.pm = fm + ((wgid % nig) % gsz); u.pn = (wgid % nig) / gsz;
        u.arow = up ? ((u.pm / 33) * SEQ + 254 * (u.pm % 33) - 2) : u.pm * BM;
        return true;
    }
};

template <class Epi, class Sched>
__device__ __forceinline__ void gemm_phase(LAS unsigned char* lds, const Gemm g, const Sched& S, const Epi& E, const int tid) {
    const int wid = __builtin_amdgcn_readfirstlane(tid >> 6), lane = tid & 63, wr = wid >> 2, wc = wid & 3, fr = lane & 15, fq = lane >> 4;
    const int K = g.K, nt = K / BK;
    unsigned voffA[2], voffB[2];
#pragma unroll
    for (int i = 0; i < 2; ++i) { int R, C; stage_rc(tid * 16 + i * 8192, R, C); const int Rb = Epi::PERM ? ((R & ~31) + perm32(R & 31)) : R;
        voffA[i] = (unsigned)(R * K + C) * 2u; voffB[i] = (unsigned)(Rb * K + C) * 2u; }
    const size_t kstep = (size_t)(BK * 2);
    const size_t hstep = (size_t)HALF * K * 2;
    const size_t tstep = 2 * hstep;
    const size_t rstep = (size_t)K * 2;
    const unsigned ldsw = (unsigned)wid * 1024u;
    const int aoff = lds_byte(wr * 64 + fr, fq * 8), boff = lds_byte(wc * 32 + fr, fq * 8);
#define PG8_SA(b, h) (((b) * 2 + (h)) * HTB)
#define PG8_SB(b, h) ((4 + (b) * 2 + (h)) * HTB)
#define PG8_STAGE(bufoff, gbase, voff) do { _Pragma("unroll") for (int _i = 0; _i < 2; ++_i) \
        __builtin_amdgcn_global_load_lds((const unsigned*)((const char*)(gbase) + (voff)[_i]), (LAS unsigned*)(lds + (bufoff) + ldsw + _i * 8192), 16, 0, 0); } while (0)
#define PG8_LDA(dst, b, h) do { _Pragma("unroll") for (int m = 0; m < 4; ++m) _Pragma("unroll") for (int k = 0; k < 2; ++k) dst[m][k] = *(const LAS bf16x8*)(lds + PG8_SA(b, h) + aoff + m * 2048 + k * 1024); } while (0)
#define PG8_LDB(dst, b, h) do { _Pragma("unroll") for (int n = 0; n < 2; ++n) _Pragma("unroll") for (int k = 0; k < 2; ++k) dst[n][k] = *(const LAS bf16x8*)(lds + PG8_SB(b, h) + boff + n * 2048 + k * 1024); } while (0)
#define PG8_MMA(ai, bj, At, Bt) do { __builtin_amdgcn_s_setprio(1); _Pragma("unroll") for (int m = 0; m < 4; ++m) _Pragma("unroll") for (int n = 0; n < 2; ++n) _Pragma("unroll") for (int k = 0; k < 2; ++k) \
        acc[ai][bj][m][n] = __builtin_amdgcn_mfma_f32_16x16x32_bf16(Bt[n][k], At[m][k], acc[ai][bj][m][n], 0, 0, 0); __builtin_amdgcn_s_setprio(0); } while (0)
#define PG8_WAIT_V(n) asm volatile("s_waitcnt vmcnt(" #n ")" ::: "memory")
#define PG8_WAIT_L(n) asm volatile("s_waitcnt lgkmcnt(" #n ")" ::: "memory")
#define PG8_BAR __builtin_amdgcn_s_barrier()
#define PG8_SCHED __builtin_amdgcn_sched_barrier(0)
    Unit cur, nxt; int ui = 0;
    if (!S.next(0, cur)) return;
    f32x4 acc[2][2][4][2];
#pragma unroll
    for (int a = 0; a < 2; ++a)
#pragma unroll
        for (int b = 0; b < 2; ++b)
#pragma unroll
            for (int m = 0; m < 4; ++m)
#pragma unroll
                for (int n = 0; n < 2; ++n) acc[a][b][m][n] = (f32x4){0.f, 0.f, 0.f, 0.f};
    bf16x8 At[4][2], B0[2][2], B1[2][2];
    const char* cA = (const char*)g.A + (ptrdiff_t)cur.arow * (ptrdiff_t)rstep; const char* cB = (const char*)g.Bt + (size_t)cur.pn * tstep;
    PG8_STAGE(PG8_SB(0, 0), cB, voffB); PG8_STAGE(PG8_SB(0, 1), cB + hstep, voffB); PG8_STAGE(PG8_SA(0, 0), cA, voffA); PG8_STAGE(PG8_SA(0, 1), cA + hstep, voffA);
    if (wr == 1) PG8_BAR;
    PG8_WAIT_V(2); PG8_BAR;
    PG8_STAGE(PG8_SB(1, 0), cB + kstep, voffB); PG8_STAGE(PG8_SA(1, 0), cA + kstep, voffA); PG8_STAGE(PG8_SB(1, 1), cB + hstep + kstep, voffB);
    PG8_WAIT_V(6); PG8_BAR;
    for (;;) {
        const bool has_next = S.next(ui + 1, nxt);
        const char* nA = has_next ? (const char*)g.A + (ptrdiff_t)nxt.arow * (ptrdiff_t)rstep : cA; const char* nB = has_next ? (const char*)g.Bt + (size_t)nxt.pn * tstep : cB;
        for (int t = 0; t < nt; t += 2) {
            const bool last = (t == nt - 2);
            const char* a1 = cA + (size_t)(t + 1) * kstep;
            const char* a2 = last ? nA : cA + (size_t)(t + 2) * kstep; const char* b2 = last ? nB : cB + (size_t)(t + 2) * kstep;
            const char* a3 = a2 + kstep; const char* b3 = b2 + kstep;
            PG8_LDB(B0, 0, 0); PG8_LDB(B1, 0, 1); PG8_SCHED; PG8_LDA(At, 0, 0); PG8_STAGE(PG8_SA(1, 1), a1 + hstep, voffA);
            PG8_WAIT_V(8); PG8_WAIT_L(0); PG8_BAR; PG8_MMA(0, 0, At, B0); PG8_MMA(0, 1, At, B1); PG8_BAR; PG8_SCHED;
            PG8_LDA(At, 0, 1); PG8_STAGE(PG8_SB(0, 0), b2, voffB); PG8_STAGE(PG8_SB(0, 1), b2 + hstep, voffB); PG8_STAGE(PG8_SA(0, 0), a2, voffA);
            PG8_WAIT_V(8); PG8_WAIT_L(0); PG8_BAR; PG8_MMA(1, 0, At, B0); PG8_MMA(1, 1, At, B1); PG8_BAR; PG8_SCHED;
            PG8_LDB(B0, 1, 0); PG8_LDB(B1, 1, 1); PG8_SCHED; PG8_LDA(At, 1, 0); PG8_STAGE(PG8_SA(0, 1), a2 + hstep, voffA);
            PG8_WAIT_V(8); PG8_WAIT_L(0); PG8_BAR; PG8_MMA(0, 0, At, B0); PG8_MMA(0, 1, At, B1); PG8_BAR; PG8_SCHED;
            PG8_LDA(At, 1, 1); PG8_STAGE(PG8_SB(1, 0), b3, voffB); PG8_STAGE(PG8_SB(1, 1), b3 + hstep, voffB); PG8_STAGE(PG8_SA(1, 0), a3, voffA);
            PG8_WAIT_V(8); PG8_WAIT_L(0); PG8_BAR; PG8_MMA(1, 0, At, B0); PG8_MMA(1, 1, At, B1); PG8_BAR; PG8_SCHED;
        }
        if (wr == 0) PG8_BAR;
        E(acc, cur, wr, wc, fr, fq, lds, tid);
        if (!has_next) break;
#pragma unroll
        for (int a = 0; a < 2; ++a)
#pragma unroll
            for (int b = 0; b < 2; ++b)
#pragma unroll
                for (int m = 0; m < 4; ++m)
#pragma unroll
                    for (int n = 0; n < 2; ++n) acc[a][b][m][n] = (f32x4){0.f, 0.f, 0.f, 0.f};
        cur = nxt; cA = nA; cB = nB; ++ui;
        if (wr == 1) PG8_BAR;
    }
    PG8_WAIT_V(0);
    PG8_BAR;
#undef PG8_SA
#undef PG8_SB
#undef PG8_STAGE
#undef PG8_LDA
#undef PG8_LDB
#undef PG8_MMA
#undef PG8_WAIT_V
#undef PG8_WAIT_L
#undef PG8_BAR
#undef PG8_SCHED
}
}

typedef f32x4 AccT[2][2][4][2];

__device__ __forceinline__ void rs_table(LAS unsigned char* lds, const float* ssq, int tok0, int tid) {
    LAS float* rst = (LAS float*)(lds + L_RSTAB);
    if (tid < 256) { int tok = tok0 + tid; tok = tok < 0 ? 0 : (tok >= MT ? MT - 1 : tok);
        const float s = (ssq[tok] + ssq[MT + tok]) + (ssq[2 * MT + tok] + ssq[3 * MT + tok]); rst[tid] = 1.0f / sqrtf(s * (1.0f / D) + EPS); }
    RAW_BAR();
}

struct EpiQKV {
    static constexpr bool PERM = true;
    bf16_t* O; size_t split_stride; const float* ssq; float* okp; float* ovp;
    __device__ __forceinline__ void operator()(const AccT& acc, const pg8::Unit& u, int wr, int wc, int fr, int fq, LAS unsigned char* lds, int tid) const {
        rs_table(lds, ssq, u.pm * 256, tid);
        const LAS float* rst = (const LAS float*)(lds + L_RSTAB);
        const int t = u.pn >> 2, colt = (u.pn & 3) * 256; bf16_t* base = O + (size_t)t * split_stride; const float sc = (t == 0) ? C2 : 1.0f;
        const bool side = (t >= 1) && ((u.pm & 31) >= 30);
        float* sp = (t == 1 ? okp : ovp) + ((size_t)((u.pm >> 5) * CA + (u.pm & 1) * 256)) * D;
        const int col0 = colt + wc * 32 + 8 * fq;
#pragma unroll
        for (int ai = 0; ai < 2; ++ai)
#pragma unroll
            for (int m = 0; m < 4; ++m) { const int r = ai * 128 + wr * 64 + m * 16 + fr; const float rs = rst[r] * sc; bf16_t* rowp = base + (size_t)(u.pm * 256 + r) * D + col0;
#pragma unroll
                for (int bj = 0; bj < 2; ++bj) { const f32x4 v0 = acc[ai][bj][m][0] * rs, v1 = acc[ai][bj][m][1] * rs;
                    u32x4 w; w.x = cvt_pk_bf16(v0[0], v0[1]); w.y = cvt_pk_bf16(v0[2], v0[3]); w.z = cvt_pk_bf16(v1[0], v1[1]); w.w = cvt_pk_bf16(v1[2], v1[3]);
                    *(u32x4*)(rowp + bj * 128) = w;
                    if (side) { float* s = sp + (size_t)r * D + col0 + bj * 128; *(f32x4*)s = v0; *(f32x4*)(s + 4) = v1; } } }
    }
};

struct EpiRes {
    static constexpr bool PERM = false;
    bf16_t* xb; float* ssq;
    __device__ __forceinline__ void operator()(const AccT& acc, const pg8::Unit& u, int wr, int wc, int fr, int fq, LAS unsigned char* lds, int tid) const {
        LAS float* P = (LAS float*)(lds + L_PTAB);
        const int col0 = u.pn * 256 + wc * 32 + 4 * fq;
#pragma unroll
        for (int ai = 0; ai < 2; ++ai)
#pragma unroll
            for (int m = 0; m < 4; ++m) { const int r = ai * 128 + wr * 64 + m * 16 + fr; const size_t off = (size_t)(u.pm * 256 + r) * D + col0; float s = 0.f;
                u32x2 bb[2][2];
#pragma unroll
                for (int bj = 0; bj < 2; ++bj)
#pragma unroll
                    for (int n = 0; n < 2; ++n) bb[bj][n] = *(const u32x2*)(xb + off + bj * 128 + n * 16);
#pragma unroll
                for (int bj = 0; bj < 2; ++bj)
#pragma unroll
                    for (int n = 0; n < 2; ++n) { const f32x4 a4 = acc[ai][bj][m][n]; const u32x2 b2 = bb[bj][n];
                        const float v0 = bf2f(b2.x & 0xffffu) + a4[0], v1 = bf2f(b2.x >> 16) + a4[1], v2 = bf2f(b2.y & 0xffffu) + a4[2], v3 = bf2f(b2.y >> 16) + a4[3];
                        s += (v0 * v0 + v1 * v1) + (v2 * v2 + v3 * v3);
                        u32x2 w; w.x = cvt_pk_bf16(v0, v1); w.y = cvt_pk_bf16(v2, v3); *(u32x2*)(xb + off + bj * 128 + n * 16) = w; }
                s += __shfl_xor(s, 16); s += __shfl_xor(s, 32);
                if (fq == 0) P[r * 4 + wc] = s; }
        RAW_BAR();
        if (tid < 256) { const f32x4 p = *(const LAS f32x4*)(P + tid * 4); ssq[(size_t)u.pn * MT + u.pm * 256 + tid] = (p[0] + p[1]) + (p[2] + p[3]); }
    }
};

struct EpiIn {
    static constexpr bool PERM = true;
    bf16_t* O; size_t split_stride; const float* ssq; float* ssqv;
    __device__ __forceinline__ void operator()(const AccT& acc, const pg8::Unit& u, int wr, int wc, int fr, int fq, LAS unsigned char* lds, int tid) const {
        rs_table(lds, ssq, u.pm * 256, tid);
        const LAS float* rst = (const LAS float*)(lds + L_RSTAB); LAS float* P = (LAS float*)(lds + L_PTAB);
        const int t = u.pn >> 2, colt = (u.pn & 3) * 256; bf16_t* base = O + (size_t)t * split_stride;
        const int col0 = colt + wc * 32 + 8 * fq;
#pragma unroll
        for (int ai = 0; ai < 2; ++ai)
#pragma unroll
            for (int m = 0; m < 4; ++m) { const int r = ai * 128 + wr * 64 + m * 16 + fr; const float rs = rst[r]; bf16_t* rowp = base + (size_t)(u.pm * 256 + r) * D + col0; float s = 0.f;
#pragma unroll
                for (int bj = 0; bj < 2; ++bj) { const f32x4 x0 = acc[ai][bj][m][0] * rs, x1 = acc[ai][bj][m][1] * rs;
                    const f32x2 a = gelu_pk((f32x2){x0[0], x0[1]}), b = gelu_pk((f32x2){x0[2], x0[3]}), c = gelu_pk((f32x2){x1[0], x1[1]}), d = gelu_pk((f32x2){x1[2], x1[3]});
                    s += (a.x * a.x + a.y * a.y) + (b.x * b.x + b.y * b.y) + (c.x * c.x + c.y * c.y) + (d.x * d.x + d.y * d.y);
                    u32x4 w; w.x = cvt_pk_bf16(a.x, a.y); w.y = cvt_pk_bf16(b.x, b.y); w.z = cvt_pk_bf16(c.x, c.y); w.w = cvt_pk_bf16(d.x, d.y);
                    *(u32x4*)(rowp + bj * 128) = w; }
                if (t == 1) { s += __shfl_xor(s, 16); s += __shfl_xor(s, 32); if (fq == 0) P[r * 4 + wc] = s; } }
        if (t == 1) { RAW_BAR();
            if (tid < 256) { const f32x4 p = *(const LAS f32x4*)(P + tid * 4); ssqv[(size_t)(u.pn & 3) * MT + u.pm * 256 + tid] = (p[0] + p[1]) + (p[2] + p[3]); } }
    }
};

__device__ __forceinline__ float dpp_shr1(float v) { return __builtin_bit_cast(float, __builtin_amdgcn_update_dpp(0, __builtin_bit_cast(int, v), 0x111, 0xf, 0xf, true)); }
__device__ __forceinline__ float dpp_shr2(float v) { return __builtin_bit_cast(float, __builtin_amdgcn_update_dpp(0, __builtin_bit_cast(int, v), 0x112, 0xf, 0xf, true)); }
__device__ __forceinline__ float dpp_shl15(float v) { return __builtin_bit_cast(float, __builtin_amdgcn_update_dpp(0, __builtin_bit_cast(int, v), 0x10f, 0xf, 0xf, true)); }
__device__ __forceinline__ float dpp_shl14(float v) { return __builtin_bit_cast(float, __builtin_amdgcn_update_dpp(0, __builtin_bit_cast(int, v), 0x10e, 0xf, 0xf, true)); }

struct EpiUp {
    static constexpr bool PERM = true;
    bf16_t* G; const float* ssq; const float* cw; const float* cb; float* ocp;
    __device__ __forceinline__ void operator()(AccT& acc, const pg8::Unit& u, int wr, int wc, int fr, int fq, LAS unsigned char* lds, int tid) const {
        const int b = u.pm / 33, j = u.pm % 33, tok0 = u.arow;
        rs_table(lds, ssq, tok0, tid);
        const LAS float* rst = (const LAS float*)(lds + L_RSTAB); LAS float* xbuf = (LAS float*)(lds + L_XBUF);
#pragma unroll
        for (int ai = 0; ai < 2; ++ai)
#pragma unroll
            for (int m = 0; m < 4; ++m) { const float rs = rst[ai * 128 + wr * 64 + m * 16 + fr];
#pragma unroll
                for (int bj = 0; bj < 2; ++bj)
#pragma unroll
                    for (int n = 0; n < 2; ++n) acc[ai][bj][m][n] *= rs; }
        if (j == 0 && wr == 0 && fr < 2) {
#pragma unroll
            for (int bj = 0; bj < 2; ++bj)
#pragma unroll
                for (int n = 0; n < 2; ++n) acc[0][bj][0][n] = (f32x4){0.f, 0.f, 0.f, 0.f}; }
        const int cl = wc * 32 + 8 * fq;
        if (j == 32 && wr == 1 && fr < 2) {
#pragma unroll
            for (int bj = 0; bj < 2; ++bj)
#pragma unroll
                for (int n = 0; n < 2; ++n) *(f32x4*)(ocp + (size_t)(b * 2 + fr) * FF2 + bj * FF + u.pn * 128 + cl + 4 * n) = acc[0][bj][0][n]; }
        if (fr >= 14) {
#pragma unroll
            for (int ai = 0; ai < 2; ++ai)
#pragma unroll
                for (int bj = 0; bj < 2; ++bj)
#pragma unroll
                    for (int n = 0; n < 2; ++n) *(LAS f32x4*)(xbuf + ((2 * ai + wr) * 2 + (fr - 14)) * 256 + bj * 128 + cl + 4 * n) = acc[ai][bj][3][n]; }
        RAW_BAR();
        const int bend = (b + 1) * SEQ;
#pragma unroll
        for (int n = 0; n < 2; ++n) {
            f32x4 w0[2], w1[2], w2[2], cbv[2];
#pragma unroll
            for (int bj = 0; bj < 2; ++bj) { const int oc = bj * FF + u.pn * 128 + cl + 4 * n;
                w0[bj] = *(const f32x4*)(cw + oc); w1[bj] = *(const f32x4*)(cw + FF2 + oc); w2[bj] = *(const f32x4*)(cw + 2 * FF2 + oc); cbv[bj] = *(const f32x4*)(cb + oc); }
#pragma unroll
            for (int ai = 0; ai < 2; ++ai) {
                const int ps = (2 * ai + wr + 3) & 3;
#pragma unroll
                for (int m = 3; m >= 0; --m) {
                    f32x4 c[2];
#pragma unroll
                    for (int bj = 0; bj < 2; ++bj) {
                        const f32x4 cur = acc[ai][bj][m][n];
                        f32x4 prv; if (m > 0) prv = acc[ai][bj][m - 1][n]; else prv = *(const LAS f32x4*)(xbuf + (ps * 2 + (fr & 1)) * 256 + bj * 128 + cl + 4 * n);
                        f32x4 o;
#pragma unroll
                        for (int e = 0; e < 4; ++e) { float v = cbv[bj][e] + w2[bj][e] * cur[e];
                            v += w1[bj][e] * (dpp_shr1(cur[e]) + dpp_shl15(prv[e]));
                            v += w0[bj][e] * (dpp_shr2(cur[e]) + dpp_shl14(prv[e])); o[e] = v; }
                        c[bj] = o; }
                    const int tr = ai * 128 + wr * 64 + m * 16 + fr, tok = tok0 + tr;
                    if (tr >= 2 && tok < bend) {
                        u32x2 w;
                        w.x = cvt_pk_bf16(silu1(c[0][0]) * c[1][0], silu1(c[0][1]) * c[1][1]); w.y = cvt_pk_bf16(silu1(c[0][2]) * c[1][2], silu1(c[0][3]) * c[1][3]);
                        *(u32x2*)(G + (size_t)tok * FF + u.pn * 128 + cl + 4 * n) = w; }
                }
            }
        }
    }
};

constexpr int L_SPART = 0, L_SC = 32768, L_SRS = 40960;
template <int K, class BRow>
__device__ __forceinline__ void stask_mm(LAS unsigned char* lds, const bf16_t* A, int arow0, const bf16_t* Bt, BRow brow, const int tid) {
    const int lane = tid & 63, r32 = lane & 31, hi = lane >> 5, w = tid >> 6;
    constexpr int KW = K / 8, NK = KW / 16;
    const bf16_t* ap = A + (size_t)(arow0 + r32) * K + w * KW + hi * 8;
    const bf16_t* bp = Bt + (size_t)brow(r32) * K + w * KW + hi * 8;
    f32x16 acc;
#pragma unroll
    for (int r = 0; r < 16; ++r) acc[r] = 0.f;
#pragma unroll 11
    for (int ks = 0; ks < NK; ++ks) { const bf16x8 a = *(const bf16x8*)(ap + ks * 16), b = *(const bf16x8*)(bp + ks * 16); acc = __builtin_amdgcn_mfma_f32_32x32x16_bf16(a, b, acc, 0, 0, 0); }
    LAS float* part = (LAS float*)(lds + L_SPART) + w * 1024;
#pragma unroll
    for (int r = 0; r < 16; ++r) part[crow(r, hi) * 32 + r32] = acc[r];
    __syncthreads();
    LAS float* C = (LAS float*)(lds + L_SC); const LAS float* P0 = (const LAS float*)(lds + L_SPART);
#pragma unroll
    for (int i = 0; i < 2; ++i) { const int e = tid + i * 512; float s = 0.f;
#pragma unroll
        for (int ww = 0; ww < 8; ++ww) s += P0[ww * 1024 + e];
        C[(e >> 5) * 33 + (e & 31)] = s; }
    __syncthreads();
}
__device__ __forceinline__ void srs_table(LAS unsigned char* lds, const float* ssqs, int mt, int tid) {
    const int row = tid >> 4, jj = tid & 15; float s = ssqs[(size_t)jj * MS + mt * 32 + row] + ssqs[(size_t)(jj + 16) * MS + mt * 32 + row];
    s += __shfl_xor(s, 1); s += __shfl_xor(s, 2); s += __shfl_xor(s, 4); s += __shfl_xor(s, 8);
    if (jj == 0) ((LAS float*)(lds + L_SRS))[row] = 1.0f / sqrtf(s * (1.0f / D) + EPS);
}

namespace att {
constexpr int NS = 6, SLOTB = 8192;
constexpr int L_K = 0, L_V = NS * SLOTB, L_OST = 2 * NS * SLOTB, L_BIAS = 131072, L_WSF = 132352;
#define SBAR() __builtin_amdgcn_sched_barrier(0)
__device__ __forceinline__ void glds16(const void* gsrc, unsigned lds_dst) { unsigned keep;
    asm volatile("s_mov_b32 %0, m0\n\ts_mov_b32 m0, %2\n\ts_nop 0\n\tglobal_load_lds_dwordx4 %1, off\n\ts_mov_b32 m0, %0" : "=&s"(keep) : "v"(gsrc), "s"(lds_dst) : "memory"); }
#define WAIT_BAR(N) asm volatile("s_waitcnt vmcnt(" #N ") lgkmcnt(0)\n\ts_barrier" ::: "memory")

struct State { float m, l; f32x16 o[2]; };

__device__ __forceinline__ void tile(State& st, const bf16x8 (&qr)[4], unsigned kslot, unsigned vslot, float cinit, bool near, int base, bool mask1, const LAS float* tab, LAS float* wsf, int r32, int hi, int lane) {
    f32x16 p0, p1;
    { const LAS char* kb = (const LAS char*)(uintptr_t)kslot + hi * 1024 + r32 * 16;
        f32x16 ci;
#pragma unroll
        for (int r = 0; r < 16; ++r) ci[r] = cinit;
#pragma unroll
        for (int d0 = 0; d0 < 4; ++d0) { const bf16x8 b0 = *(const LAS bf16x8*)(kb + d0 * 2048), b1 = *(const LAS bf16x8*)(kb + d0 * 2048 + 512);
            if (d0 == 0) { p0 = __builtin_amdgcn_mfma_f32_32x32x16_bf16(b0, qr[0], ci, 0, 0, 0); p1 = __builtin_amdgcn_mfma_f32_32x32x16_bf16(b1, qr[0], ci, 0, 0, 0); }
            else { p0 = __builtin_amdgcn_mfma_f32_32x32x16_bf16(b0, qr[d0], p0, 0, 0, 0); p1 = __builtin_amdgcn_mfma_f32_32x32x16_bf16(b1, qr[d0], p1, 0, 0, 0); } } }
    if (near) {
#pragma unroll
        for (int r = 0; r < 16; ++r) { int i0 = base - crow(r, hi), i1 = i0 - 32; i0 = i0 < 0 ? 0 : (i0 > 256 ? 256 : i0); i1 = i1 < 0 ? 0 : (i1 > 256 ? 256 : i1); p0[r] += tab[i0]; p1[r] += tab[i1]; } }
    if (mask1) {
#pragma unroll
        for (int r = 0; r < 16; ++r) p1[r] = -1e30f; }
    float rm = fmaxf(p0[0], p1[0]);
#pragma unroll
    for (int r = 1; r < 16; ++r) rm = fmaxf(rm, fmaxf(p0[r], p1[r]));
    rm = fmaxf(rm, __shfl_xor(rm, 32));
    const float mn = fmaxf(st.m, rm);
    if (__any(mn > st.m)) {
        const float f = __builtin_amdgcn_exp2f(st.m - mn); st.l *= f; st.m = mn;
        if (hi == 0) wsf[r32] = f;
        LDS_WAIT();
#pragma unroll
        for (int g = 0; g < 4; ++g) { const f32x4 fv = *(const LAS f32x4*)(wsf + 8 * g + 4 * hi);
#pragma unroll
            for (int e = 0; e < 4; ++e) { st.o[0][4 * g + e] *= fv[e]; st.o[1][4 * g + e] *= fv[e]; } }
    }
    float sacc = 0.f;
#pragma unroll
    for (int r = 0; r < 16; ++r) { p0[r] = __builtin_amdgcn_exp2f(p0[r] - st.m); p1[r] = __builtin_amdgcn_exp2f(p1[r] - st.m); sacc += p0[r] + p1[r]; }
    st.l += sacc;
    u32x4 pw[4];
#pragma unroll
    for (int k = 0; k < 2; ++k) { pw[k] = (u32x4){cvt_pk_bf16(p0[8 * k], p0[8 * k + 1]), cvt_pk_bf16(p0[8 * k + 2], p0[8 * k + 3]), cvt_pk_bf16(p0[8 * k + 4], p0[8 * k + 5]), cvt_pk_bf16(p0[8 * k + 6], p0[8 * k + 7])};
        pw[2 + k] = (u32x4){cvt_pk_bf16(p1[8 * k], p1[8 * k + 1]), cvt_pk_bf16(p1[8 * k + 2], p1[8 * k + 3]), cvt_pk_bf16(p1[8 * k + 4], p1[8 * k + 5]), cvt_pk_bf16(p1[8 * k + 6], p1[8 * k + 7])}; }
    const int vb = (int)vslot + ((lane >> 4) & 1) * 32 + (lane & 3) * 8 + (4 * hi + ((lane & 15) >> 2)) * 64;
#pragma unroll
    for (int d0 = 0; d0 < 2; ++d0) { s16x4 lo[4], hh[4];
#pragma unroll
        for (int ks = 0; ks < 4; ++ks) {
            asm volatile("ds_read_b64_tr_b16 %0,%1 offset:%c2" : "=&v"(lo[ks]) : "v"(vb), "i"(d0 * 4096 + ks * 1024) : "memory");
            asm volatile("ds_read_b64_tr_b16 %0,%1 offset:%c2" : "=&v"(hh[ks]) : "v"(vb), "i"(d0 * 4096 + ks * 1024 + 512) : "memory"); }
        asm volatile("s_waitcnt lgkmcnt(0)" ::: "memory"); SBAR();
#pragma unroll
        for (int ks = 0; ks < 4; ++ks) { const bf16x8 vf = (bf16x8){lo[ks][0], lo[ks][1], lo[ks][2], lo[ks][3], hh[ks][0], hh[ks][1], hh[ks][2], hh[ks][3]};
            st.o[d0] = __builtin_amdgcn_mfma_f32_32x32x16_bf16(__builtin_bit_cast(bf16x8, pw[ks]), vf, st.o[d0], 0, 0, 0); }
    }
}

__device__ __forceinline__ void prompt_unit(int b, int h, int qg, const bf16_t* Q, const bf16_t* Kg, const bf16_t* Vg, bf16_t* O, LAS unsigned char* lds, const int tid) {
    const int lane = tid & 63, r32 = lane & 31, hi = lane >> 5; const int wid = __builtin_amdgcn_readfirstlane(tid >> 6);
    const int c0 = 4 * qg, pj = wid >> 1, half = wid & 1; const long rowbase = (long)b * SEQ;
    const unsigned lds0 = (unsigned)(uintptr_t)lds;
    const LAS float* tab = (const LAS float*)(lds + L_BIAS); LAS float* wsf = (LAS float*)(lds + L_WSF) + wid * 64;
    const bf16_t* Qw = Q + (rowbase + 64 * (c0 + pj) + 32 * half) * D + h * HD;
    const bf16_t* Kh = Kg + rowbase * D + h * HD; const bf16_t* Vh = Vg + rowbase * D + h * HD;
#define DMA_T(i) do { int ck_ = c0 - 8 + (i); ck_ = ck_ < 0 ? 0 : ck_; const unsigned so_ = (unsigned)(((i) % NS) * SLOTB + wid * 1024); \
        glds16(Kh + (long)(64 * ck_ + lane) * D + wid * 8, (unsigned)__builtin_amdgcn_readfirstlane(lds0 + L_K + so_)); \
        glds16(Vh + (long)(64 * ck_ + 16 * (wid & 3) + (lane >> 2)) * D + (wid >> 2) * 32 + (lane & 3) * 8, (unsigned)__builtin_amdgcn_readfirstlane(lds0 + L_V + so_)); } while (0)
    DMA_T(0); DMA_T(1); DMA_T(2); DMA_T(3); DMA_T(4);
    bf16x8 qr[4];
#pragma unroll
    for (int d0 = 0; d0 < 4; ++d0) qr[d0] = *(const bf16x8*)(Qw + (long)r32 * D + d0 * 16 + hi * 8);
    State st; st.m = -1e30f; st.l = 0.f;
#pragma unroll
    for (int r = 0; r < 16; ++r) { st.o[0][r] = 0.f; st.o[1][r] = 0.f; }
    const float cfar = tab[256];
    const int ql = 32 * half + r32;
    for (int s = 0; s < 9; ++s) {
        if (s == 0) { WAIT_BAR(0); asm volatile("" : "+v"(qr[0]), "+v"(qr[1]), "+v"(qr[2]), "+v"(qr[3])); }
        else if (s < 8) WAIT_BAR(2); else WAIT_BAR(0);
        if (s + 5 < 12) DMA_T(s + 5);
        const int ck = c0 - 8 + s + pj;
        if (ck >= 0) { const int sl = (s + pj) % NS; const bool near = s >= 6;
            tile(st, qr, lds0 + L_K + sl * SLOTB, lds0 + L_V + sl * SLOTB, near ? 0.f : cfar, near, 64 * (8 - s) + ql + 128, false, tab, wsf, r32, hi, lane); }
    }
#undef DMA_T
    float l = st.l + __shfl_xor(st.l, 32);
    if (hi == 0) wsf[32 + r32] = l;
    LDS_WAIT();
    float rli[16];
#pragma unroll
    for (int r = 0; r < 16; ++r) rli[r] = __builtin_amdgcn_rcpf(wsf[32 + crow(r, hi)]);
    bf16_t* Ow = O + (rowbase + 64 * (c0 + pj) + 32 * half) * D + h * HD;
    { LAS bf16_t* stg = (LAS bf16_t*)(lds + L_OST) + wid * 2048;
#pragma unroll
        for (int r = 0; r < 16; ++r) { const int orow = crow(r, hi);
#pragma unroll
            for (int d0 = 0; d0 < 2; ++d0) stg[orow * 64 + d0 * 32 + r32] = (bf16_t)(cvt_pk_bf16(st.o[d0][r] * rli[r], 0.f) & 0xffffu); }
        LDS_WAIT();
#pragma unroll
        for (int i = 0; i < 4; ++i) { const int row = i * 8 + (lane >> 3), ch = lane & 7; const u32x4 v = *(const LAS u32x4*)(stg + row * 64 + ch * 8); *(u32x4*)(Ow + (long)row * D + ch * 8) = v; } }
    asm volatile("s_waitcnt lgkmcnt(0)\n\ts_barrier" ::: "memory");
}

__device__ __forceinline__ void sample_unit(int b, int h, const bf16_t* Q, const bf16_t* Kg, const bf16_t* Vg, const bf16_t* CK, const bf16_t* CV, bf16_t* O, LAS unsigned char* lds, const int tid) {
    const int lane = tid & 63, r32 = lane & 31, hi = lane >> 5; const int wid = __builtin_amdgcn_readfirstlane(tid >> 6);
    const unsigned lds0 = (unsigned)(uintptr_t)lds;
    const LAS float* tab = (const LAS float*)(lds + L_BIAS); LAS float* wsf = (LAS float*)(lds + L_WSF) + wid * 64;
    const long srow = (long)MP + 32 * b;
    const bf16_t* Qw = Q + srow * D + h * HD;
    const unsigned ks = lds0 + wid * 16384, vs = ks + 8192;
    { const bf16_t* Kc = CK + ((long)b * CA + 64 * wid) * D + h * HD; const bf16_t* Vc = CV + ((long)b * CA + 64 * wid) * D + h * HD;
#pragma unroll
        for (int p = 0; p < 8; ++p) { glds16(Kc + (long)lane * D + p * 8, (unsigned)__builtin_amdgcn_readfirstlane(ks + p * 1024));
            glds16(Vc + (long)(16 * (p & 3) + (lane >> 2)) * D + (p >> 2) * 32 + (lane & 3) * 8, (unsigned)__builtin_amdgcn_readfirstlane(vs + p * 1024)); } }
    bf16x8 qr[4];
#pragma unroll
    for (int d0 = 0; d0 < 4; ++d0) qr[d0] = *(const bf16x8*)(Qw + (long)r32 * D + d0 * 16 + hi * 8);
    State st; st.m = -1e30f; st.l = 0.f;
#pragma unroll
    for (int r = 0; r < 16; ++r) { st.o[0][r] = 0.f; st.o[1][r] = 0.f; }
    asm volatile("s_waitcnt vmcnt(0)" ::: "memory"); asm volatile("" : "+v"(qr[0]), "+v"(qr[1]), "+v"(qr[2]), "+v"(qr[3]));
    { const bool near = wid >= 6; tile(st, qr, ks, vs, near ? 0.f : tab[256], near, r32 + 512 - 64 * wid + 128, false, tab, wsf, r32, hi, lane); }
    if (wid == 0) {
        const bf16_t* Kn = Kg + srow * D + h * HD; const bf16_t* Vn = Vg + srow * D + h * HD;
#pragma unroll
        for (int p = 0; p < 8; ++p) { const int kr = lane < 32 ? lane : 31; const int vr0 = 16 * (p & 3) + (lane >> 2), vr = vr0 < 32 ? vr0 : 31;
            glds16(Kn + (long)kr * D + p * 8, (unsigned)__builtin_amdgcn_readfirstlane(ks + p * 1024));
            glds16(Vn + (long)vr * D + (p >> 2) * 32 + (lane & 3) * 8, (unsigned)__builtin_amdgcn_readfirstlane(vs + p * 1024)); }
        asm volatile("s_waitcnt vmcnt(0)" ::: "memory");
        tile(st, qr, ks, vs, 0.f, true, r32 + 128, true, tab, wsf, r32, hi, lane);
    }
    const float l = st.l + __shfl_xor(st.l, 32);
    asm volatile("s_waitcnt lgkmcnt(0)\n\ts_barrier" ::: "memory");
    LAS float* OP = (LAS float*)lds;
    LAS float* MLp = (LAS float*)(lds + 65536);
#pragma unroll
    for (int r = 0; r < 16; ++r) { const int q = crow(r, hi); OP[(wid * 32 + q) * 64 + r32] = st.o[0][r]; OP[(wid * 32 + q) * 64 + 32 + r32] = st.o[1][r]; }
    if (hi == 0) { MLp[wid * 32 + r32] = st.m; MLp[256 + wid * 32 + r32] = l; }
    __syncthreads();
    { const int q = tid >> 4, d4 = (tid & 15) * 4; float mg = -1e30f;
#pragma unroll
        for (int w = 0; w < 8; ++w) mg = fmaxf(mg, MLp[w * 32 + q]);
        f32x4 num = (f32x4){0.f, 0.f, 0.f, 0.f}; float den = 0.f;
#pragma unroll
        for (int w = 0; w < 8; ++w) { const float f = __builtin_amdgcn_exp2f(MLp[w * 32 + q] - mg); den += f * MLp[256 + w * 32 + q]; num += *(const LAS f32x4*)(OP + (w * 32 + q) * 64 + d4) * f; }
        const float rd = 1.0f / den; u32x2 w2; w2.x = cvt_pk_bf16(num[0] * rd, num[1] * rd); w2.y = cvt_pk_bf16(num[2] * rd, num[3] * rd);
        *(u32x2*)(O + (srow + q) * D + h * HD + d4) = w2; }
    __syncthreads();
}
#undef WAIT_BAR
}

namespace gate {
constexpr int L_VS = 0, L_STG = 32768, L_RV = 98304;
__device__ __forceinline__ void unit(bool sample, int nb, int gp, bf16_t* U, const bf16_t* Vv, const float* ssqv, const float* ssqvs, const float* vgain, const float* wsp, const float* bsp, float* ogv, LAS unsigned char* lds, const int tid) {
    const int lane = tid & 63, r32 = lane & 31, hi = lane >> 5; const int wid = __builtin_amdgcn_readfirstlane(tid >> 6);
    const long tok0 = sample ? (long)MP + 32 * nb : (long)128 * nb; const int nrows = sample ? 32 : 128;
    LAS float* rv = (LAS float*)(lds + L_RV);
    if (!sample) { if (tid < 128) { const long t = tok0 + tid; const float s = (ssqv[t] + ssqv[MT + t]) + (ssqv[2 * MT + t] + ssqv[3 * MT + t]); rv[tid] = 1.0f / sqrtf(s * (1.0f / D) + EPS); } }
    else { const int row = tid >> 4, jj = tid & 15; float s = ssqvs[(size_t)jj * MS + nb * 32 + row] + ssqvs[(size_t)(jj + 16) * MS + nb * 32 + row];
        s += __shfl_xor(s, 1); s += __shfl_xor(s, 2); s += __shfl_xor(s, 4); s += __shfl_xor(s, 8); if (jj == 0) rv[row] = 1.0f / sqrtf(s * (1.0f / D) + EPS); }
    __syncthreads();
    for (int pi = wid; pi < 32; pi += 8) { const int gi = pi >> 4, qt = (pi >> 3) & 1, dh = (pi >> 2) & 1, rg = pi & 3;
        const int row = 64 * qt + 16 * rg + (lane >> 2), col = 64 * (2 * gp + gi) + 32 * dh + 8 * (lane & 3);
        if (row < nrows) { const u32x4 raw = *(const u32x4*)(Vv + (tok0 + row) * D + col); const float rs = rv[row];
            const f32x4 g0 = *(const f32x4*)(vgain + col), g1 = *(const f32x4*)(vgain + col + 4);
            float f[8]; f[0] = bf2f(raw.x & 0xffffu) * rs * g0[0]; f[1] = bf2f(raw.x >> 16) * rs * g0[1]; f[2] = bf2f(raw.y & 0xffffu) * rs * g0[2]; f[3] = bf2f(raw.y >> 16) * rs * g0[3];
            f[4] = bf2f(raw.z & 0xffffu) * rs * g1[0]; f[5] = bf2f(raw.z >> 16) * rs * g1[1]; f[6] = bf2f(raw.w & 0xffffu) * rs * g1[2]; f[7] = bf2f(raw.w >> 16) * rs * g1[3];
            u32x4 w; w.x = cvt_pk_bf16(f[0], f[1]); w.y = cvt_pk_bf16(f[2], f[3]); w.z = cvt_pk_bf16(f[4], f[5]); w.w = cvt_pk_bf16(f[6], f[7]);
            *(LAS u32x4*)(lds + L_VS + (gi * 2 + qt) * 8192 + (dh * 4 + rg) * 1024 + lane * 16) = w;
            if (sample) { float* o = ogv + (size_t)(nb * 32 + row) * D + col; *(f32x4*)o = (f32x4){f[0], f[1], f[2], f[3]}; *(f32x4*)(o + 4) = (f32x4){f[4], f[5], f[6], f[7]}; } } }
    __syncthreads();
    const int gi = wid >> 2, pb = wid & 3, g = 2 * gp + gi;
    if (pb * 32 < nrows) {
        const int nks = sample ? 2 : (pb < 2 ? 4 : 8);
        f32x16 o[2];
#pragma unroll
        for (int r = 0; r < 16; ++r) { o[0][r] = 0.f; o[1][r] = 0.f; }
        const float* wrow = wsp + ((size_t)g * 128 + 32 * pb + r32) * 128 + 4 * hi;
        const unsigned lds0 = (unsigned)(uintptr_t)lds;
        for (int ks = 0; ks < nks; ++ks) {
            const f32x4 a0 = *(const f32x4*)(wrow + 16 * ks), a1 = *(const f32x4*)(wrow + 16 * ks + 8);
            u32x4 pa; pa.x = cvt_pk_bf16(a0[0], a0[1]); pa.y = cvt_pk_bf16(a0[2], a0[3]); pa.z = cvt_pk_bf16(a1[0], a1[1]); pa.w = cvt_pk_bf16(a1[2], a1[3]);
            const int vb = (int)(lds0 + L_VS + (gi * 2 + (ks >> 2)) * 8192 + (ks & 3) * 1024) + ((lane >> 4) & 1) * 32 + (lane & 3) * 8 + (4 * hi + ((lane & 15) >> 2)) * 64;
            s16x4 lo[2], hh[2];
#pragma unroll
            for (int d0 = 0; d0 < 2; ++d0) {
                asm volatile("ds_read_b64_tr_b16 %0,%1 offset:%c2" : "=&v"(lo[d0]) : "v"(vb), "i"(d0 * 4096) : "memory");
                asm volatile("ds_read_b64_tr_b16 %0,%1 offset:%c2" : "=&v"(hh[d0]) : "v"(vb), "i"(d0 * 4096 + 512) : "memory"); }
            asm volatile("s_waitcnt lgkmcnt(0)" ::: "memory"); __builtin_amdgcn_sched_barrier(0);
#pragma unroll
            for (int d0 = 0; d0 < 2; ++d0) { const bf16x8 vf = (bf16x8){lo[d0][0], lo[d0][1], lo[d0][2], lo[d0][3], hh[d0][0], hh[d0][1], hh[d0][2], hh[d0][3]};
                o[d0] = __builtin_amdgcn_mfma_f32_32x32x16_bf16(__builtin_bit_cast(bf16x8, pa), vf, o[d0], 0, 0, 0); }
        }
        LAS float* stg = (LAS float*)(lds + L_STG) + wid * 2048;
        const float* bs = bsp + g * 128 + 32 * pb;
#pragma unroll
        for (int r = 0; r < 16; ++r) { const int q = crow(r, hi); const float bq = bs[q]; stg[q * 64 + r32] = o[0][r] + bq; stg[q * 64 + 32 + r32] = o[1][r] + bq; }
        LDS_WAIT();
#pragma unroll
        for (int i = 0; i < 4; ++i) { const int row = i * 8 + (lane >> 3), ch = lane & 7;
            const f32x4 m0 = *(const LAS f32x4*)(stg + row * 64 + ch * 8), m1 = *(const LAS f32x4*)(stg + row * 64 + ch * 8 + 4);
            bf16_t* up = U + (tok0 + 32 * pb + row) * D + 64 * g + ch * 8; const u32x4 uu = *(const u32x4*)up;
            u32x4 w; w.x = cvt_pk_bf16(bf2f(uu.x & 0xffffu) * m0[0], bf2f(uu.x >> 16) * m0[1]); w.y = cvt_pk_bf16(bf2f(uu.y & 0xffffu) * m0[2], bf2f(uu.y >> 16) * m0[3]);
            w.z = cvt_pk_bf16(bf2f(uu.z & 0xffffu) * m1[0], bf2f(uu.z >> 16) * m1[1]); w.w = cvt_pk_bf16(bf2f(uu.w & 0xffffu) * m1[2], bf2f(uu.w >> 16) * m1[3]);
            *(u32x4*)up = w; }
    }
    __syncthreads();
}
}

template <bool UP>
__device__ __forceinline__ void transpose_item(const float* W, int K, int N, const float* gain, bf16_t* WT, LAS float* scr, int item, int lane) {
    const int nblk = N / 32, kb = item / nblk, nb = item % nblk, k0 = 64 * kb, n0 = 32 * nb;
#pragma unroll 8
    for (int i = 0; i < 32; ++i) { const int kk = 2 * i + (lane >> 5); const float gk = gain ? gain[k0 + kk] : 1.0f; scr[kk * 33 + (lane & 31)] = W[(size_t)(k0 + kk) * N + n0 + (lane & 31)] * gk; }
    LDS_WAIT(); asm volatile("" ::: "memory");
    const int c = lane & 7;
#pragma unroll
    for (int jj = 0; jj < 4; ++jj) { const int n = (lane >> 3) + 8 * jj; const LAS float* s = scr + (8 * c) * 33 + n;
        u32x4 o; o.x = cvt_pk_bf16(s[0 * 33], s[1 * 33]); o.y = cvt_pk_bf16(s[2 * 33], s[3 * 33]); o.z = cvt_pk_bf16(s[4 * 33], s[5 * 33]); o.w = cvt_pk_bf16(s[6 * 33], s[7 * 33]);
        int dn = n0 + n; if (UP) { const int v = dn >= FF ? 1 : 0, gc = dn - v * FF; dn = 256 * (gc >> 7) + 128 * v + (gc & 127); }
        *(u32x4*)(WT + (size_t)dn * K + k0 + 8 * c) = o; }
    LDS_WAIT(); asm volatile("" ::: "memory");
}

#define XB_TMO      128
#define XB_XCNT(j)  (256  + 64 * (j))
#define XB_XSUB(j)  (1280 + 64 * (j))
#define XB_XGEN(j)  (2304 + 64 * (j))
#define XB_TOP      3328
#define XB_TOPGEN   3392
#define XCD_BAR_WORDS 3456
#define XB_SPIN_CAP (1u << 18)
__device__ __forceinline__ unsigned xb_ld(unsigned* p)              { return __hip_atomic_load(p, __ATOMIC_RELAXED, __HIP_MEMORY_SCOPE_AGENT); }
__device__ __forceinline__ unsigned xb_add(unsigned* p, unsigned v) { return __hip_atomic_fetch_add(p, v, __ATOMIC_RELAXED, __HIP_MEMORY_SCOPE_AGENT); }
__device__ __forceinline__ unsigned xb_xcc_id() { return (unsigned)__builtin_amdgcn_s_getreg((3 << 11) | 20) & 0xFu; }
#define XB_SPIN(cond, bar) do { unsigned _sp = 0; while (cond) { __builtin_amdgcn_s_sleep(1); \
    if ((++_sp & 255u) == 0u) { if (xb_ld(&(bar)[XB_TMO])) break; if (_sp > XB_SPIN_CAP) { atomicAdd(&(bar)[XB_TMO], 1u); break; } } } } while (0)
struct XcdBarrier { unsigned* bar; unsigned x; volatile LAS unsigned* st; };
__device__ __forceinline__ void xcd_barrier_complete(unsigned* bar, unsigned x, unsigned& nloc, unsigned& nx) {
    const unsigned G = gridDim.x * gridDim.y * gridDim.z;
    unsigned sum, cnt, mine, sp = 0u;
    for (;;) {
        sum = 0u; cnt = 0u; mine = 0u;
#pragma unroll
        for (unsigned j = 0; j < 16; ++j) { const unsigned c = xb_ld(&bar[XB_XCNT(j)]); sum += c; cnt += (c > 0u) ? 1u : 0u; mine = (j == x) ? c : mine; }
        if (sum == G) break;
        __builtin_amdgcn_s_sleep(1);
        if ((++sp & 255u) == 0u) { if (xb_ld(&bar[XB_TMO])) break; if (sp > XB_SPIN_CAP) { atomicAdd(&bar[XB_TMO], 1u); break; } }
    }
    nloc = mine > 0u ? mine : 1u; nx = cnt > 0u ? cnt : 1u;
}
__device__ __forceinline__ void xcd_barrier(const XcdBarrier& b, const int tid) {
    asm volatile("s_waitcnt vmcnt(0)" ::: "memory");
    __syncthreads();
    if (tid == 0) {
        unsigned* bar = b.bar;
        __builtin_amdgcn_s_waitcnt(0);
        unsigned nloc = b.st[0], nx = b.st[1];
        if (nloc == 0u) { xcd_barrier_complete(bar, b.x, nloc, nx); b.st[0] = nloc; b.st[1] = nx; }
        const unsigned old = xb_add(&bar[XB_XSUB(b.x)], 1u);
        const unsigned gen = old / nloc;
        if (old + 1u == (gen + 1u) * nloc) {
            __builtin_amdgcn_fence(__ATOMIC_RELEASE, "agent");
            asm volatile("s_waitcnt vmcnt(0)" ::: "memory");
            const unsigned og = xb_add(&bar[XB_TOP], 1u);
            const unsigned tg = og / nx;
            if (og + 1u == (tg + 1u) * nx) xb_add(&bar[XB_TOPGEN], 1u);
            else XB_SPIN(xb_ld(&bar[XB_TOPGEN]) == tg, bar);
            __builtin_amdgcn_fence(__ATOMIC_ACQUIRE, "agent");
            xb_add(&bar[XB_XGEN(b.x)], 1u);
            asm volatile("s_waitcnt vmcnt(0)" ::: "memory");
        } else {
            XB_SPIN(xb_ld(&bar[XB_XGEN(b.x)]) == gen, bar);
            __builtin_amdgcn_fence(__ATOMIC_ACQUIRE, "agent");
            asm volatile("s_waitcnt vmcnt(0)" ::: "memory");
        }
    }
    __syncthreads();
}

#define PH(k)
struct Args { const float* in[20]; float* out; unsigned char* ws; };

__global__ void __launch_bounds__(NTHR, 2) fwd_kernel(Args a) {
    extern __shared__ __attribute__((aligned(16))) unsigned char lds_raw[];
    LAS unsigned char* lds = (LAS unsigned char*)lds_raw;
    const int wave0 = __builtin_amdgcn_readfirstlane((int)threadIdx.x >> 6);
    XcdBarrier bar;
    { volatile LAS unsigned* MISC = (volatile LAS unsigned*)(lds + L_MISC);
        if (threadIdx.x < 4) MISC[threadIdx.x] = 0u;
        __syncthreads();
        bar.bar = (unsigned*)(a.ws + WS_CTL); bar.x = xb_xcc_id(); bar.st = MISC;
        if (threadIdx.x == 0) (void)xb_add(&bar.bar[XB_XCNT(bar.x)], 1u); }
#define GRID_BAR() do { PHASE_VARS xcd_barrier(bar, tid); } while (0)
#define PHASE_VARS int tid; asm volatile("v_mbcnt_lo_u32_b32 %0, -1, 0\n\tv_mbcnt_hi_u32_b32 %0, -1, %0" : "=v"(tid)); tid |= wave0 << 6; const int lane = tid & 63, wave = wave0; (void)lane; (void)wave;
    const int G = gridDim.x, bx = blockIdx.x; const int vcu = (G % 8 == 0) ? (bx % 8) * (G / 8) + bx / 8 : bx;
    unsigned char* ws = a.ws; float* out = a.out;
    const float *x_prompt = a.in[0], *x_sample = a.in[1], *cache_k = a.in[2], *cache_v = a.in[3], *state_conv = a.in[4], *ln_mix = a.in[5], *ln_ffn = a.in[6], *ln_final = a.in[7],
                *w_qkv = a.in[8], *rel_bias = a.in[9], *w_o = a.in[10], *w_in = a.in[11], *v_norm = a.in[12], *w_s = a.in[13], *bias_s = a.in[14], *w_out = a.in[15],
                *w_up = a.in[16], *conv_w = a.in[17], *conv_b = a.in[18], *w_down = a.in[19];
    bf16_t *Wqkv_t = (bf16_t*)(ws + WS_WQKV), *Wo_t = (bf16_t*)(ws + WS_WO), *Win_t = (bf16_t*)(ws + WS_WIN), *Wout_t = (bf16_t*)(ws + WS_WOUT);
    bf16_t *XB = (bf16_t*)(ws + WS_XB), *QB = (bf16_t*)(ws + WS_Q), *KB = (bf16_t*)(ws + WS_K), *VB = (bf16_t*)(ws + WS_V), *GB = (bf16_t*)(ws + WS_G), *CKB = (bf16_t*)(ws + WS_CK), *CVB = (bf16_t*)(ws + WS_CV), *OB = (bf16_t*)(ws + WS_OB);
    float *SSQ = (float*)(ws + WS_SSQ), *SSQV = (float*)(ws + WS_SSQV), *SSQS = (float*)(ws + WS_SSQS), *SSQVS = (float*)(ws + WS_SSQVS);

    PH(0) { PHASE_VARS
        LAS float* scr = (LAS float*)(lds + wave * 16384);
        const int gw = vcu * NWAVES + wave, NGW = G * NWAVES;
        constexpr int I_QKV = (D / 64) * (3 * D / 32), I_O = (D / 64) * (D / 32), I_IN = (D / 64) * (2 * D / 32), I_UP = (D / 64) * (FF2 / 32), I_DN = (FF / 64) * (D / 32);
        constexpr int NITEMS = I_QKV + 2 * I_O + I_IN + 2 * I_UP + 2 * I_DN;
        for (int it = gw; it < NITEMS; it += NGW) {
            int r = it;
            if (r < I_QKV) { transpose_item<false>(w_qkv, D, 3 * D, ln_mix, Wqkv_t, scr, r, lane); continue; } r -= I_QKV;
            if (r < I_O) { transpose_item<false>(w_o, D, D, nullptr, Wo_t, scr, r, lane); continue; } r -= I_O;
            if (r < I_IN) { transpose_item<false>(w_in, D, 2 * D, ln_mix + D, Win_t, scr, r, lane); continue; } r -= I_IN;
            if (r < I_O) { transpose_item<false>(w_out, D, D, nullptr, Wout_t, scr, r, lane); continue; } r -= I_O;
            if (r < 2 * I_UP) { const int l = r / I_UP; transpose_item<true>(w_up + (size_t)l * D * FF2, D, FF2, ln_ffn + l * D, (bf16_t*)(ws + WS_WUP + l * WUP_L), scr, r % I_UP, lane); continue; } r -= 2 * I_UP;
            { const int l = r / I_DN; transpose_item<false>(w_down + (size_t)l * FF * D, FF, D, nullptr, (bf16_t*)(ws + WS_WDN + l * WDN_L), scr, r % I_DN, lane); }
        }
        for (int m = gw; m < MT; m += NGW) {
            const float* xr = m < MP ? x_prompt + (size_t)m * D : x_sample + (size_t)(m - MP) * D;
            f32x4 v[4]; float s = 0.f;
#pragma unroll
            for (int jj = 0; jj < 4; ++jj) { v[jj] = ((const f32x4*)xr)[lane + 64 * jj]; s += (v[jj][0] * v[jj][0] + v[jj][1] * v[jj][1]) + (v[jj][2] * v[jj][2] + v[jj][3] * v[jj][3]); }
            s = wave_sum(s);
#pragma unroll
            for (int jj = 0; jj < 4; ++jj) { u32x2 w; w.x = cvt_pk_bf16(v[jj][0], v[jj][1]); w.y = cvt_pk_bf16(v[jj][2], v[jj][3]); ((u32x2*)(XB + (size_t)m * D))[lane + 64 * jj] = w; }
            if (m < MP) { if (lane < 4) SSQ[(size_t)lane * MT + m] = lane == 0 ? s : 0.f; }
            else { if (lane < 32) SSQS[(size_t)lane * MS + (m - MP)] = lane == 0 ? s : 0.f; }
        }
        for (int m = gw; m < 2 * DB * CA; m += NGW) { const int which = m >= DB * CA, rr = m - which * DB * CA; const float* src = (which ? cache_v : cache_k) + (size_t)rr * D; bf16_t* dst = (which ? CVB : CKB) + (size_t)rr * D;
#pragma unroll
            for (int jj = 0; jj < 4; ++jj) { const f32x4 v = ((const f32x4*)src)[lane + 64 * jj]; u32x2 w; w.x = cvt_pk_bf16(v[0], v[1]); w.y = cvt_pk_bf16(v[2], v[3]); ((u32x2*)dst)[lane + 64 * jj] = w; } }
    }
    GRID_BAR();

    PH(1) { PHASE_VARS
        for (int task = vcu; task < DB * 96; task += G) { const int mt = task / 96, nt = task % 96;
            srs_table(lds, SSQS, mt, tid);
            stask_mm<D>(lds, XB, MP + 32 * mt, Wqkv_t, [&](int jn) { return 32 * nt + jn; }, tid);
            const LAS float* C = (const LAS float*)(lds + L_SC); const LAS float* rs = (const LAS float*)(lds + L_SRS);
            const int row = tid >> 4, c0 = (tid & 15) * 2, n = 32 * nt + c0, t = n >> 10, nn = n & 1023; const float r_ = rs[row];
            const float v0 = C[row * 33 + c0] * r_, v1 = C[row * 33 + c0 + 1] * r_; const float sc = t == 0 ? C2 : 1.0f;
            bf16_t* dst = (t == 0 ? QB : (t == 1 ? KB : VB)) + (size_t)(MP + 32 * mt + row) * D + nn; *(unsigned*)dst = cvt_pk_bf16(v0 * sc, v1 * sc);
            if (t >= 1) { float* o = out + (t == 1 ? O_KS : O_VS) + (size_t)(32 * mt + row) * D + nn; *(f32x2*)o = (f32x2){v0, v1}; }
            __syncthreads();
        }
        pg8::Gemm g{XB, Wqkv_t, D}; pg8::StaticOrder S; S.init(MP / 256, 3 * D / 256, G, bx, 0);
        EpiQKV E{QB, (size_t)(WS_K - WS_Q) / 2, SSQ, out + O_KP, out + O_VP};
        pg8::gemm_phase<EpiQKV, pg8::StaticOrder>(lds, g, S, E, tid);
    }
    GRID_BAR();

    PH(2) { PHASE_VARS
        LAS float* tab = (LAS float*)(lds + att::L_BIAS);
        const int per = (NB * NH * 32 + G - 1) / G;
        int lasth = -1;
        for (int id = vcu * per; id < (vcu + 1) * per && id < NB * NH * 32; ++id) { const int bh = id >> 5, qg = id & 31, b = bh / NH, h = bh % NH;
            if (h != lasth) { __syncthreads(); for (int i = tid; i < NREL; i += NTHR) tab[i] = rel_bias[h * NREL + i] * LOG2E; __syncthreads(); lasth = h; }
            att::prompt_unit(b, h, qg, QB, KB, VB, OB, lds, tid); }
        for (int id = vcu; id < DB * NH; id += G) { const int b = id / NH, h = id % NH;
            if (h != lasth) { __syncthreads(); for (int i = tid; i < NREL; i += NTHR) tab[i] = rel_bias[h * NREL + i] * LOG2E; __syncthreads(); lasth = h; }
            att::sample_unit(b, h, QB, KB, VB, CKB, CVB, OB, lds, tid); }
    }
    GRID_BAR();

#define RES_PHASE(A_, Wt_, KK) do { \
        for (int task = vcu; task < DB * 32; task += G) { const int mt = task / 32, nt = task % 32; \
            stask_mm<KK>(lds, A_, MP + 32 * mt, Wt_, [&](int jn) { return 32 * nt + jn; }, tid); \
            const LAS float* C = (const LAS float*)(lds + L_SC); \
            const int row = tid >> 4, c0 = (tid & 15) * 2, n = 32 * nt + c0; unsigned* xp_ = (unsigned*)(XB + (size_t)(MP + 32 * mt + row) * D + n); \
            const unsigned bb = *xp_; const float v0 = bf2f(bb & 0xffffu) + C[row * 33 + c0], v1 = bf2f(bb >> 16) + C[row * 33 + c0 + 1]; \
            *xp_ = cvt_pk_bf16(v0, v1); \
            float s_ = v0 * v0 + v1 * v1; s_ += __shfl_xor(s_, 1); s_ += __shfl_xor(s_, 2); s_ += __shfl_xor(s_, 4); s_ += __shfl_xor(s_, 8); \
            if ((tid & 15) == 0) SSQS[(size_t)nt * MS + 32 * mt + row] = s_; \
            __syncthreads(); } \
        pg8::Gemm g{A_, Wt_, KK}; pg8::StaticOrder S; S.init(MP / 256, D / 256, G, bx, 0); \
        EpiRes E{XB, SSQ}; \
        pg8::gemm_phase<EpiRes, pg8::StaticOrder>(lds, g, S, E, tid); } while (0)
    PH(3) { PHASE_VARS RES_PHASE(OB, Wo_t, D); }
    GRID_BAR();

#define UP_PHASE(L_) do { \
        const bf16_t* Wup_ = (const bf16_t*)(ws + WS_WUP + (L_) * WUP_L); const float* cw_ = conv_w + (size_t)(L_) * 3 * FF2; const float* cb_ = conv_b + (size_t)(L_) * FF2; \
        for (int task = vcu; task < DB * 176; task += G) { const int mt = task / 176, nt = task % 176; \
            srs_table(lds, SSQS, mt, tid); \
            stask_mm<D>(lds, XB, MP + 32 * mt, Wup_, [&](int jn) { const int gc = 16 * nt + (jn & 15); return 256 * (gc >> 7) + (gc & 127) + 128 * (jn >> 4); }, tid); \
            LAS float* C = (LAS float*)(lds + L_SC); const LAS float* rs = (const LAS float*)(lds + L_SRS); \
            { const int row = tid >> 4, c0 = (tid & 15) * 2; const float r_ = rs[row]; C[row * 33 + c0] *= r_; C[row * 33 + c0 + 1] *= r_; } \
            __syncthreads(); \
            { const int row = tid >> 4, jn = tid & 15, gc = 16 * nt + jn; const float* hs = state_conv + ((size_t)((L_) * DB + mt) * 2) * FF2; float cc[2]; \
                _Pragma("unroll") for (int v = 0; v < 2; ++v) { const int oc = v * FF + gc, tc = jn + 16 * v; \
                    const float a0 = C[row * 33 + tc], a1 = row >= 1 ? C[(row - 1) * 33 + tc] : hs[FF2 + oc], a2 = row >= 2 ? C[(row - 2) * 33 + tc] : hs[(size_t)row * FF2 + oc]; \
                    cc[v] = cb_[oc] + cw_[oc] * a2 + cw_[FF2 + oc] * a1 + cw_[2 * FF2 + oc] * a0; \
                    if (row >= 30) out[O_CS + ((size_t)((L_) * DB + mt) * 2 + (row - 30)) * FF2 + oc] = a0; } \
                GB[(size_t)(MP + 32 * mt + row) * FF + gc] = (bf16_t)(cvt_pk_bf16(silu1(cc[0]) * cc[1], 0.f) & 0xffffu); } \
            __syncthreads(); } \
        pg8::Gemm g{XB, Wup_, D}; pg8::StaticOrder S; S.init(66, FF2 / 256, G, bx, 1); \
        EpiUp E{GB, SSQ, cw_, cb_, out + O_CP + (size_t)(L_) * NB * 2 * FF2}; \
        pg8::gemm_phase<EpiUp, pg8::StaticOrder>(lds, g, S, E, tid); } while (0)
    PH(4) { PHASE_VARS UP_PHASE(0); }
    GRID_BAR();
    PH(5) { PHASE_VARS RES_PHASE(GB, (const bf16_t*)(ws + WS_WDN), FF); }
    GRID_BAR();

    PH(6) { PHASE_VARS
        for (int task = vcu; task < DB * 64; task += G) { const int mt = task / 64, nt = task % 64;
            srs_table(lds, SSQS, mt, tid);
            stask_mm<D>(lds, XB, MP + 32 * mt, Win_t, [&](int jn) { return 32 * nt + jn; }, tid);
            const LAS float* C = (const LAS float*)(lds + L_SC); const LAS float* rs = (const LAS float*)(lds + L_SRS);
            const int row = tid >> 4, c0 = (tid & 15) * 2, n = 32 * nt + c0, t = n >> 10, nn = n & 1023; const float r_ = rs[row];
            const f32x2 z = gelu_pk((f32x2){C[row * 33 + c0] * r_, C[row * 33 + c0 + 1] * r_});
            *(unsigned*)((t == 0 ? QB : KB) + (size_t)(MP + 32 * mt + row) * D + nn) = cvt_pk_bf16(z.x, z.y);
            if (t == 1) { float s_ = z.x * z.x + z.y * z.y; s_ += __shfl_xor(s_, 1); s_ += __shfl_xor(s_, 2); s_ += __shfl_xor(s_, 4); s_ += __shfl_xor(s_, 8);
                if ((tid & 15) == 0) SSQVS[(size_t)(nt - 32) * MS + 32 * mt + row] = s_; }
            __syncthreads();
        }
        pg8::Gemm g{XB, Win_t, D}; pg8::StaticOrder S; S.init(MP / 256, 2 * D / 256, G, bx, 0);
        EpiIn E{QB, (size_t)(WS_K - WS_Q) / 2, SSQ, SSQV};
        pg8::gemm_phase<EpiIn, pg8::StaticOrder>(lds, g, S, E, tid);
    }
    GRID_BAR();

    PH(7) { PHASE_VARS
        const int per = (128 * 8 + G - 1) / G;
        for (int id = vcu * per; id < (vcu + 1) * per && id < 128 * 8; ++id) gate::unit(false, id >> 3, id & 7, QB, KB, SSQV, SSQVS, v_norm, w_s, bias_s, out + O_GV, lds, tid);
        for (int id = vcu; id < DB * 8; id += G) gate::unit(true, id >> 3, id & 7, QB, KB, SSQV, SSQVS, v_norm, w_s, bias_s, out + O_GV, lds, tid);
    }
    GRID_BAR();

    PH(8) { PHASE_VARS RES_PHASE(QB, Wout_t, D); }
    GRID_BAR();
    PH(9) { PHASE_VARS UP_PHASE(1); }
    GRID_BAR();
    PH(10) { PHASE_VARS RES_PHASE(GB, (const bf16_t*)(ws + WS_WDN + WDN_L), FF); }
    GRID_BAR();

    PH(11) { PHASE_VARS
        const int gw = vcu * NWAVES + wave, NGW = G * NWAVES;
        f32x4 gn[4];
#pragma unroll
        for (int jj = 0; jj < 4; ++jj) gn[jj] = ((const f32x4*)ln_final)[lane + 64 * jj];
        for (int m = gw; m < MT; m += NGW) {
            float s;
            if (m < MP) s = (SSQ[m] + SSQ[MT + m]) + (SSQ[2 * MT + m] + SSQ[3 * MT + m]);
            else { s = lane < 32 ? SSQS[(size_t)lane * MS + (m - MP)] : 0.f; s = wave_sum(s); }
            const float rs = 1.0f / sqrtf(s * (1.0f / D) + EPS);
            const u32x2* xr = (const u32x2*)(XB + (size_t)m * D); f32x4* yr = (f32x4*)(out + (size_t)m * D);
#pragma unroll
            for (int jj = 0; jj < 4; ++jj) { const u32x2 b2 = xr[lane + 64 * jj]; f32x4 v = (f32x4){bf2f(b2.x & 0xffffu), bf2f(b2.x >> 16), bf2f(b2.y & 0xffffu), bf2f(b2.y >> 16)}; yr[lane + 64 * jj] = v * rs * gn[jj]; }
        }
    }
}

extern "C" void kernel_launch(void* const* d_in, const int* in_sizes, int n_in, void* d_out, int out_size, void* d_ws, size_t ws_size, hipStream_t stream) {
    static int grid = 0;
    if (grid == 0) {
        if (n_in != 20 || (size_t)out_size != O_END || ws_size < WS_END) { fprintf(stderr, "kernel_launch: unexpected sizes n_in %d out %d ws %zu\n", n_in, out_size, ws_size); grid = -1; return; }
        int dev = 0, cus = 0, per_cu = 0;
        if (hipGetDevice(&dev) != hipSuccess || hipDeviceGetAttribute(&cus, hipDeviceAttributeMultiprocessorCount, dev) != hipSuccess) { grid = -1; return; }
        if (hipFuncSetAttribute((const void*)fwd_kernel, hipFuncAttributeMaxDynamicSharedMemorySize, LDS_BYTES) != hipSuccess) { fprintf(stderr, "kernel_launch: hipFuncSetAttribute failed\n"); grid = -1; return; }
        if (hipOccupancyMaxActiveBlocksPerMultiprocessor(&per_cu, (const void*)fwd_kernel, NTHR, LDS_BYTES) != hipSuccess || per_cu < 1) { fprintf(stderr, "kernel_launch: occupancy query says %d\n", per_cu); per_cu = 1; }
        (void)hipGetLastError();
        grid = cus;
    }
    if (grid < 0) return;
    Args a{};
    for (int i = 0; i < 20; ++i) a.in[i] = (const float*)d_in[i];
    a.out = (float*)d_out; a.ws = (unsigned char*)d_ws;
    if (hipMemsetAsync((char*)d_ws + WS_CTL, 0, 16384, stream) != hipSuccess) { fprintf(stderr, "kernel_launch: memset of the barrier words failed\n"); return; }
    hipLaunchKernelGGL(fwd_kernel, dim3(grid), dim3(NTHR), LDS_BYTES, stream, a);
    const hipError_t e = hipPeekAtLastError();
    if (e != hipSuccess) fprintf(stderr, "kernel_launch: launch failed: %s (grid %d)\n", hipGetErrorName(e), grid);
}
```

```cpp
#include <hip/hip_runtime.h>
#include <cstdio>
#include <cstdint>

#define LAS __attribute__((address_space(3)))
typedef unsigned short bf16_t;
typedef short bf16x8 __attribute__((ext_vector_type(8)));
typedef short s16x4 __attribute__((ext_vector_type(4)));
typedef float f32x2 __attribute__((ext_vector_type(2)));
typedef float f32x4 __attribute__((ext_vector_type(4)));
typedef float f32x16 __attribute__((ext_vector_type(16)));
typedef unsigned u32x2 __attribute__((ext_vector_type(2)));
typedef unsigned u32x4 __attribute__((ext_vector_type(4)));

constexpr int D = 1024, SEQ = 8192, NB = 2, MP = NB * SEQ, DB = 8, DT = 32, MS = DB * DT, MT = MP + MS;
constexpr int NH = 16, HD = 64, FF = 2816, FF2 = 5632, CA = 512, NREL = 257;
constexpr float EPS = 1e-6f, LOG2E = 1.4426950408889634f, C2 = 0.125f * LOG2E;
constexpr int NWAVES = 8, NTHR = 512;

constexpr size_t MiB = 1u << 20;
constexpr size_t WS_CTL = 0;
constexpr size_t WS_WQKV = 1 * MiB, WS_WO = 7 * MiB, WS_WIN = 9 * MiB, WS_WOUT = 13 * MiB, WS_WUP = 15 * MiB, WS_WDN = 37 * MiB;
constexpr size_t WUP_L = (size_t)FF2 * D * 2, WDN_L = (size_t)D * FF * 2;
constexpr size_t WS_XB = 48 * MiB + 65536;
constexpr size_t WS_Q = 82 * MiB, WS_K = 116 * MiB, WS_V = 150 * MiB;
constexpr size_t WS_G = 82 * MiB;
constexpr size_t WS_CK = 184 * MiB, WS_CV = 192 * MiB;
constexpr size_t WS_SSQ = 200 * MiB;
constexpr size_t WS_SSQV = 201 * MiB;
constexpr size_t WS_SSQS = 202 * MiB;
constexpr size_t WS_SSQVS = 202 * MiB + 65536;
constexpr size_t WS_OB = 204 * MiB;
constexpr size_t WS_END = 238 * MiB;

constexpr size_t O_YP = 0, O_YS = O_YP + (size_t)MP * D, O_KP = O_YS + (size_t)MS * D, O_VP = O_KP + (size_t)NB * CA * D, O_KS = O_VP + (size_t)NB * CA * D,
                 O_VS = O_KS + (size_t)MS * D, O_GV = O_VS + (size_t)MS * D, O_CP = O_GV + (size_t)MS * D, O_CS = O_CP + (size_t)2 * NB * 2 * FF2, O_END = O_CS + (size_t)2 * DB * 2 * FF2;

constexpr int RING_BYTES = 131072;
constexpr int L_XBUF = 131072, L_RSTAB = 147456, L_PTAB = 148480;
constexpr int L_MISC = 152576;
constexpr int LDS_BYTES = 155648;

__device__ __forceinline__ unsigned cvt_pk_bf16(float lo, float hi) { unsigned r; asm volatile("v_cvt_pk_bf16_f32 %0, %1, %2" : "=v"(r) : "v"(lo), "v"(hi)); return r; }
__device__ __forceinline__ float bf2f(unsigned h) { return __uint_as_float(h << 16); }
__device__ __forceinline__ int crow(int r, int hi) { return (r & 3) + 8 * (r >> 2) + 4 * hi; }
#define LDS_WAIT() asm volatile("s_waitcnt lgkmcnt(0)" ::: "memory")
#define VM_WAIT() asm volatile("s_waitcnt vmcnt(0)" ::: "memory")
#define RAW_BAR() do { asm volatile("s_waitcnt lgkmcnt(0)" ::: "memory"); __builtin_amdgcn_s_barrier(); asm volatile("" ::: "memory"); } while (0)
__device__ __forceinline__ float wave_sum(float v) {
#pragma unroll
    for (int o = 1; o < 64; o <<= 1) v += __shfl_xor(v, o);
    return v;
}
__device__ __forceinline__ f32x2 gelu_pk(f32x2 v) {
    const f32x2 av = __builtin_elementwise_abs(v), d = av * 0.2316418882f + 1.0f;
    f32x2 t; t.x = __builtin_amdgcn_rcpf(d.x); t.y = __builtin_amdgcn_rcpf(d.y);
    f32x2 q = t * 0.5307027145f + (-0.7265760135f); q = q * t + 0.7107068705f; q = q * t + (-0.142248368f); q = q * t + 0.127414796f; q = q * t;
    const f32x2 s = (v * v) * (-0.72134752044f);
    f32x2 e; e.x = __builtin_amdgcn_exp2f(s.x); e.y = __builtin_amdgcn_exp2f(s.y);
    const f32x2 m = v * (q * e), r = v - m;
    f32x2 o; o.x = v.x < 0.f ? m.x : r.x; o.y = v.y < 0.f ? m.y : r.y; return o;
}
__device__ __forceinline__ float gelu1(float x) { f32x2 r = gelu_pk((f32x2){x, x}); return r.x; }
__device__ __forceinline__ float silu1(float x) { return x * __builtin_amdgcn_rcpf(1.0f + __builtin_amdgcn_exp2f(-x * LOG2E)); }

namespace pg8 {
constexpr int BM = 256, BK = 64, HALF = 128, HTB = HALF * BK * 2, NXCD = 8, WGM = 8;
__host__ __device__ __forceinline__ int lds_byte(int r, int c) { const int st = (r >> 4) * 2 + (c >> 5), rr = r & 15, cc = c & 31, ob = rr * 64 + cc * 2; return st * 1024 + (ob ^ (((ob >> 9) & 1) << 5)); }
__host__ __device__ __forceinline__ void stage_rc(int b, int& R, int& C) { const int st = b / 1024, sb = b % 1024, swz = sb ^ (((sb >> 9) & 1) << 5); R = (st >> 1) * 16 + swz / 64; C = (st & 1) * 32 + (swz % 64) / 2; }
__host__ __device__ __forceinline__ int perm32(int rho) { const int n = rho >> 4, i = rho & 15; return 8 * (i >> 2) + 4 * n + (i & 3); }

struct Unit { int pm, pn, arow; };
struct Gemm { const bf16_t* A; const bf16_t* Bt; int K; };

struct StaticOrder {
    int nM, nN, nwg, G, c, up;
    __device__ void init(int nM_, int nN_, int G_, int c_, int up_) { nM = nM_; nN = nN_; nwg = nM * nN; G = G_; c = c_; up = up_; }
    __device__ bool next(int i, Unit& u) const {
        const long L = (long)i * G + c; if (L >= nwg) return false;
        int wgid = (int)L; { const int q = nwg / NXCD, r = nwg % NXCD, xcd = wgid % NXCD, off = wgid / NXCD; wgid = (xcd < r ? xcd * (q + 1) : r * (q + 1) + (xcd - r) * q) + off; }
        const int nig = WGM * nN, gid = wgid / nig, fm = gid * WGM, gsz = (nM - fm) < WGM ? (nM - fm) : WGM;
        u.pm = fm + ((wgid % nig) % gsz); u.pn = (wgid % nig) / gsz;
        u.arow = up ? (u.pm == 66 ? MP : (u.pm / 33) * SEQ + 254 * (u.pm % 33) - 2) : u.pm * BM;
        return true;
    }
};

template <class Epi, class Sched>
__device__ __forceinline__ void gemm_phase(LAS unsigned char* lds, const Gemm g, const Sched& S, const Epi& E, const int tid) {
    const int wid = __builtin_amdgcn_readfirstlane(tid >> 6), lane = tid & 63, wr = wid >> 2, wc = wid & 3, fr = lane & 15, fq = lane >> 4;
    const int K = g.K, nt = K / BK;
    unsigned voffA[2], voffB[2];
#pragma unroll
    for (int i = 0; i < 2; ++i) { int R, C; stage_rc(tid * 16 + i * 8192, R, C); const int Rb = Epi::PERM ? ((R & ~31) + perm32(R & 31)) : R;
        voffA[i] = (unsigned)(R * K + C) * 2u; voffB[i] = (unsigned)(Rb * K + C) * 2u; }
    const size_t kstep = (size_t)(BK * 2);
    const size_t hstep = (size_t)HALF * K * 2;
    const size_t tstep = 2 * hstep;
    const size_t rstep = (size_t)K * 2;
    const unsigned ldsw = (unsigned)wid * 1024u;
    const int aoff = lds_byte(wr * 64 + fr, fq * 8), boff = lds_byte(wc * 32 + fr, fq * 8);
#define PG8_SA(b, h) (((b) * 2 + (h)) * HTB)
#define PG8_SB(b, h) ((4 + (b) * 2 + (h)) * HTB)
#define PG8_STAGE(bufoff, gbase, voff) do { _Pragma("unroll") for (int _i = 0; _i < 2; ++_i) \
        __builtin_amdgcn_global_load_lds((const unsigned*)((const char*)(gbase) + (voff)[_i]), (LAS unsigned*)(lds + (bufoff) + ldsw + _i * 8192), 16, 0, 0); } while (0)
#define PG8_LDA(dst, b, h) do { _Pragma("unroll") for (int m = 0; m < 4; ++m) _Pragma("unroll") for (int k = 0; k < 2; ++k) dst[m][k] = *(const LAS bf16x8*)(lds + PG8_SA(b, h) + aoff + m * 2048 + k * 1024); } while (0)
#define PG8_LDB(dst, b, h) do { _Pragma("unroll") for (int n = 0; n < 2; ++n) _Pragma("unroll") for (int k = 0; k < 2; ++k) dst[n][k] = *(const LAS bf16x8*)(lds + PG8_SB(b, h) + boff + n * 2048 + k * 1024); } while (0)
#define PG8_MMA(ai, bj, At, Bt) do { __builtin_amdgcn_s_setprio(1); _Pragma("unroll") for (int m = 0; m < 4; ++m) _Pragma("unroll") for (int n = 0; n < 2; ++n) _Pragma("unroll") for (int k = 0; k < 2; ++k) \
        acc[ai][bj][m][n] = __builtin_amdgcn_mfma_f32_16x16x32_bf16(Bt[n][k], At[m][k], acc[ai][bj][m][n], 0, 0, 0); __builtin_amdgcn_s_setprio(0); } while (0)
#define PG8_WAIT_V(n) asm volatile("s_waitcnt vmcnt(" #n ")" ::: "memory")
#define PG8_WAIT_L(n) asm volatile("s_waitcnt lgkmcnt(" #n ")" ::: "memory")
#define PG8_BAR __builtin_amdgcn_s_barrier()
#define PG8_SCHED __builtin_amdgcn_sched_barrier(0)
    Unit cur, nxt; int ui = 0;
    if (!S.next(0, cur)) return;
    f32x4 acc[2][2][4][2];
#pragma unroll
    for (int a = 0; a < 2; ++a)
#pragma unroll
        for (int b = 0; b < 2; ++b)
#pragma unroll
            for (int m = 0; m < 4; ++m)
#pragma unroll
                for (int n = 0; n < 2; ++n) acc[a][b][m][n] = (f32x4){0.f, 0.f, 0.f, 0.f};
    bf16x8 At[4][2], B0[2][2], B1[2][2];
    const char* cA = (const char*)g.A + (ptrdiff_t)cur.arow * (ptrdiff_t)rstep; const char* cB = (const char*)g.Bt + (size_t)cur.pn * tstep;
    PG8_STAGE(PG8_SB(0, 0), cB, voffB); PG8_STAGE(PG8_SB(0, 1), cB + hstep, voffB); PG8_STAGE(PG8_SA(0, 0), cA, voffA); PG8_STAGE(PG8_SA(0, 1), cA + hstep, voffA);
    if (wr == 1) PG8_BAR;
    PG8_WAIT_V(2); PG8_BAR;
    PG8_STAGE(PG8_SB(1, 0), cB + kstep, voffB); PG8_STAGE(PG8_SA(1, 0), cA + kstep, voffA); PG8_STAGE(PG8_SB(1, 1), cB + hstep + kstep, voffB);
    PG8_WAIT_V(6); PG8_BAR;
    for (;;) {
        const bool has_next = S.next(ui + 1, nxt);
        const char* nA = has_next ? (const char*)g.A + (ptrdiff_t)nxt.arow * (ptrdiff_t)rstep : cA; const char* nB = has_next ? (const char*)g.Bt + (size_t)nxt.pn * tstep : cB;
        for (int t = 0; t < nt; t += 2) {
            const bool last = (t == nt - 2);
            const char* a1 = cA + (size_t)(t + 1) * kstep;
            const char* a2 = last ? nA : cA + (size_t)(t + 2) * kstep; const char* b2 = last ? nB : cB + (size_t)(t + 2) * kstep;
            const char* a3 = a2 + kstep; const char* b3 = b2 + kstep;
            PG8_LDB(B0, 0, 0); PG8_LDB(B1, 0, 1); PG8_SCHED; PG8_LDA(At, 0, 0); PG8_STAGE(PG8_SA(1, 1), a1 + hstep, voffA);
            PG8_WAIT_V(8); PG8_WAIT_L(0); PG8_BAR; PG8_MMA(0, 0, At, B0); PG8_MMA(0, 1, At, B1); PG8_BAR; PG8_SCHED;
            PG8_LDA(At, 0, 1); PG8_STAGE(PG8_SB(0, 0), b2, voffB); PG8_STAGE(PG8_SB(0, 1), b2 + hstep, voffB); PG8_STAGE(PG8_SA(0, 0), a2, voffA);
            PG8_WAIT_V(8); PG8_WAIT_L(0); PG8_BAR; PG8_MMA(1, 0, At, B0); PG8_MMA(1, 1, At, B1); PG8_BAR; PG8_SCHED;
            PG8_LDB(B0, 1, 0); PG8_LDB(B1, 1, 1); PG8_SCHED; PG8_LDA(At, 1, 0); PG8_STAGE(PG8_SA(0, 1), a2 + hstep, voffA);
            PG8_WAIT_V(8); PG8_WAIT_L(0); PG8_BAR; PG8_MMA(0, 0, At, B0); PG8_MMA(0, 1, At, B1); PG8_BAR; PG8_SCHED;
            PG8_LDA(At, 1, 1); PG8_STAGE(PG8_SB(1, 0), b3, voffB); PG8_STAGE(PG8_SB(1, 1), b3 + hstep, voffB); PG8_STAGE(PG8_SA(1, 0), a3, voffA);
            PG8_WAIT_V(8); PG8_WAIT_L(0); PG8_BAR; PG8_MMA(1, 0, At, B0); PG8_MMA(1, 1, At, B1); PG8_BAR; PG8_SCHED;
        }
        if (wr == 0) PG8_BAR;
        E(acc, cur, wr, wc, fr, fq, lds, tid);
        if (!has_next) break;
#pragma unroll
        for (int a = 0; a < 2; ++a)
#pragma unroll
            for (int b = 0; b < 2; ++b)
#pragma unroll
                for (int m = 0; m < 4; ++m)
#pragma unroll
                    for (int n = 0; n < 2; ++n) acc[a][b][m][n] = (f32x4){0.f, 0.f, 0.f, 0.f};
        cur = nxt; cA = nA; cB = nB; ++ui;
        if (wr == 1) PG8_BAR;
    }
    PG8_WAIT_V(0);
    PG8_BAR;
#undef PG8_SA
#undef PG8_SB
#undef PG8_STAGE
#undef PG8_LDA
#undef PG8_LDB
#undef PG8_MMA
#undef PG8_WAIT_V
#undef PG8_WAIT_L
#undef PG8_BAR
#undef PG8_SCHED
}
}

typedef f32x4 AccT[2][2][4][2];

__device__ __forceinline__ void rs_table(LAS unsigned char* lds, const float* ssq, int tok0, int tid) {
    LAS float* rst = (LAS float*)(lds + L_RSTAB);
    if (tid < 256) { int tok = tok0 + tid; tok = tok < 0 ? 0 : (tok >= MT ? MT - 1 : tok);
        const float s = (ssq[tok] + ssq[MT + tok]) + (ssq[2 * MT + tok] + ssq[3 * MT + tok]); rst[tid] = 1.0f / sqrtf(s * (1.0f / D) + EPS); }
    RAW_BAR();
}

struct EpiQKV {
    static constexpr bool PERM = true;
    bf16_t* O; size_t split_stride; const float* ssq; float* okp; float* ovp;
    __device__ __forceinline__ void operator()(const AccT& acc, const pg8::Unit& u, int wr, int wc, int fr0, int fq0, LAS unsigned char* lds, int tid0) const {
        int fr = fr0, fq = fq0, tid = tid0; asm volatile("" : "+v"(fr), "+v"(fq), "+v"(tid));
        rs_table(lds, ssq, u.pm * 256, tid);
        const LAS float* rst = (const LAS float*)(lds + L_RSTAB);
        const int t = u.pn >> 2, colt = (u.pn & 3) * 256; bf16_t* base = O + (size_t)t * split_stride; const float sc = (t == 0) ? C2 : 1.0f;
        const bool side = (t >= 1) && ((u.pm & 31) >= 30);
        float* sp = (t == 1 ? okp : ovp) + ((size_t)((u.pm >> 5) * CA + (u.pm & 1) * 256)) * D;
        const int col0 = colt + wc * 32 + 8 * fq;
#pragma unroll
        for (int ai = 0; ai < 2; ++ai)
#pragma unroll
            for (int m = 0; m < 4; ++m) { const int r = ai * 128 + wr * 64 + m * 16 + fr; const float rs = rst[r] * sc; bf16_t* rowp = base + (size_t)(u.pm * 256 + r) * D + col0;
#pragma unroll
                for (int bj = 0; bj < 2; ++bj) { const f32x4 v0 = acc[ai][bj][m][0] * rs, v1 = acc[ai][bj][m][1] * rs;
                    u32x4 w; w.x = cvt_pk_bf16(v0[0], v0[1]); w.y = cvt_pk_bf16(v0[2], v0[3]); w.z = cvt_pk_bf16(v1[0], v1[1]); w.w = cvt_pk_bf16(v1[2], v1[3]);
                    *(u32x4*)(rowp + bj * 128) = w;
                    if (side) { float* s = sp + (size_t)r * D + col0 + bj * 128; *(f32x4*)s = v0; *(f32x4*)(s + 4) = v1; } } }
    }
};

struct EpiRes {
    static constexpr bool PERM = false;
    bf16_t* xb; float* ssq;
    __device__ __forceinline__ void operator()(const AccT& acc, const pg8::Unit& u, int wr, int wc, int fr0, int fq0, LAS unsigned char* lds, int tid0) const {
        int fr = fr0, fq = fq0, tid = tid0; asm volatile("" : "+v"(fr), "+v"(fq), "+v"(tid));
        LAS float* P = (LAS float*)(lds + L_PTAB);
        const int col0 = u.pn * 256 + wc * 32 + 4 * fq;
#pragma unroll
        for (int ai = 0; ai < 2; ++ai)
#pragma unroll
            for (int m = 0; m < 4; ++m) { const int r = ai * 128 + wr * 64 + m * 16 + fr; const size_t off = (size_t)(u.pm * 256 + r) * D + col0; float s = 0.f;
                u32x2 bb[2][2];
#pragma unroll
                for (int bj = 0; bj < 2; ++bj)
#pragma unroll
                    for (int n = 0; n < 2; ++n) bb[bj][n] = *(const u32x2*)(xb + off + bj * 128 + n * 16);
#pragma unroll
                for (int bj = 0; bj < 2; ++bj)
#pragma unroll
                    for (int n = 0; n < 2; ++n) { const f32x4 a4 = acc[ai][bj][m][n]; const u32x2 b2 = bb[bj][n];
                        const float v0 = bf2f(b2.x & 0xffffu) + a4[0], v1 = bf2f(b2.x >> 16) + a4[1], v2 = bf2f(b2.y & 0xffffu) + a4[2], v3 = bf2f(b2.y >> 16) + a4[3];
                        s += (v0 * v0 + v1 * v1) + (v2 * v2 + v3 * v3);
                        u32x2 w; w.x = cvt_pk_bf16(v0, v1); w.y = cvt_pk_bf16(v2, v3); *(u32x2*)(xb + off + bj * 128 + n * 16) = w; }
                s += __shfl_xor(s, 16); s += __shfl_xor(s, 32);
                if (fq == 0) P[r * 4 + wc] = s; }
        RAW_BAR();
        if (tid < 256) { const f32x4 p = *(const LAS f32x4*)(P + tid * 4); ssq[(size_t)u.pn * MT + u.pm * 256 + tid] = (p[0] + p[1]) + (p[2] + p[3]); }
    }
};

struct EpiIn {
    static constexpr bool PERM = true;
    bf16_t* O; size_t split_stride; const float* ssq; float* ssqv;
    __device__ __forceinline__ void operator()(const AccT& acc, const pg8::Unit& u, int wr, int wc, int fr0, int fq0, LAS unsigned char* lds, int tid0) const {
        int fr = fr0, fq = fq0, tid = tid0; asm volatile("" : "+v"(fr), "+v"(fq), "+v"(tid));
        rs_table(lds, ssq, u.pm * 256, tid);
        const LAS float* rst = (const LAS float*)(lds + L_RSTAB); LAS float* P = (LAS float*)(lds + L_PTAB);
        const int t = u.pn >> 2, colt = (u.pn & 3) * 256; bf16_t* base = O + (size_t)t * split_stride;
        const int col0 = colt + wc * 32 + 8 * fq;
#pragma unroll
        for (int ai = 0; ai < 2; ++ai)
#pragma unroll
            for (int m = 0; m < 4; ++m) { const int r = ai * 128 + wr * 64 + m * 16 + fr; const float rs = rst[r]; bf16_t* rowp = base + (size_t)(u.pm * 256 + r) * D + col0; float s = 0.f;
#pragma unroll
                for (int bj = 0; bj < 2; ++bj) { const f32x4 x0 = acc[ai][bj][m][0] * rs, x1 = acc[ai][bj][m][1] * rs;
                    const f32x2 a = gelu_pk((f32x2){x0[0], x0[1]}), b = gelu_pk((f32x2){x0[2], x0[3]}), c = gelu_pk((f32x2){x1[0], x1[1]}), d = gelu_pk((f32x2){x1[2], x1[3]});
                    s += (a.x * a.x + a.y * a.y) + (b.x * b.x + b.y * b.y) + (c.x * c.x + c.y * c.y) + (d.x * d.x + d.y * d.y);
                    u32x4 w; w.x = cvt_pk_bf16(a.x, a.y); w.y = cvt_pk_bf16(b.x, b.y); w.z = cvt_pk_bf16(c.x, c.y); w.w = cvt_pk_bf16(d.x, d.y);
                    *(u32x4*)(rowp + bj * 128) = w; }
                if (t == 1) { s += __shfl_xor(s, 16); s += __shfl_xor(s, 32); if (fq == 0) P[r * 4 + wc] = s; } }
        if (t == 1) { RAW_BAR();
            if (tid < 256) { const f32x4 p = *(const LAS f32x4*)(P + tid * 4); ssqv[(size_t)(u.pn & 3) * MT + u.pm * 256 + tid] = (p[0] + p[1]) + (p[2] + p[3]); } }
    }
};

__device__ __forceinline__ float dpp_shr1(float v) { return __builtin_bit_cast(float, __builtin_amdgcn_update_dpp(0, __builtin_bit_cast(int, v), 0x111, 0xf, 0xf, true)); }
__device__ __forceinline__ float dpp_shr2(float v) { return __builtin_bit_cast(float, __builtin_amdgcn_update_dpp(0, __builtin_bit_cast(int, v), 0x112, 0xf, 0xf, true)); }
__device__ __forceinline__ float dpp_shl15(float v) { return __builtin_bit_cast(float, __builtin_amdgcn_update_dpp(0, __builtin_bit_cast(int, v), 0x10f, 0xf, 0xf, true)); }
__device__ __forceinline__ float dpp_shl14(float v) { return __builtin_bit_cast(float, __builtin_amdgcn_update_dpp(0, __builtin_bit_cast(int, v), 0x10e, 0xf, 0xf, true)); }

struct EpiUp {
    static constexpr bool PERM = true;
    bf16_t* G; const float* ssq; const float* ssqs; const float* cw; const float* cb; float* ocp; const float* hist; float* ocs;
    __device__ __forceinline__ void operator()(AccT& acc, const pg8::Unit& u, int wr, int wc, int fr0, int fq0, LAS unsigned char* lds, int tid0) const {
        int fr = fr0, fq = fq0, tid = tid0; asm volatile("" : "+v"(fr), "+v"(fq), "+v"(tid));
        const bool smp = u.pm == 66;
        const int b = u.pm / 33, j = smp ? 1 : u.pm % 33, tok0 = u.arow;
        if (!smp) rs_table(lds, ssq, tok0, tid);
        else { LAS float* rst_ = (LAS float*)(lds + L_RSTAB);
            if (tid < 256) { float s = 0.f;
#pragma unroll 8
                for (int jj = 0; jj < 32; ++jj) s += ssqs[(size_t)jj * MS + tid];
                rst_[tid] = 1.0f / sqrtf(s * (1.0f / D) + EPS); }
            RAW_BAR(); }
        const LAS float* rst = (const LAS float*)(lds + L_RSTAB); LAS float* xbuf = (LAS float*)(lds + L_XBUF);
#pragma unroll
        for (int ai = 0; ai < 2; ++ai)
#pragma unroll
            for (int m = 0; m < 4; ++m) { const float rs = rst[ai * 128 + wr * 64 + m * 16 + fr];
#pragma unroll
                for (int bj = 0; bj < 2; ++bj)
#pragma unroll
                    for (int n = 0; n < 2; ++n) acc[ai][bj][m][n] *= rs; }
        if (j == 0 && wr == 0 && fr < 2) {
#pragma unroll
            for (int bj = 0; bj < 2; ++bj)
#pragma unroll
                for (int n = 0; n < 2; ++n) acc[0][bj][0][n] = (f32x4){0.f, 0.f, 0.f, 0.f}; }
        const int cl = wc * 32 + 8 * fq;
        if (j == 32 && wr == 1 && fr < 2) {
#pragma unroll
            for (int bj = 0; bj < 2; ++bj)
#pragma unroll
                for (int n = 0; n < 2; ++n) *(f32x4*)(ocp + (size_t)(b * 2 + fr) * FF2 + bj * FF + u.pn * 128 + cl + 4 * n) = acc[0][bj][0][n]; }
        if (smp && fr >= 14) {
            const int cl_ = cl;
#pragma unroll
            for (int ai = 0; ai < 2; ++ai)
#pragma unroll
                for (int mh = 0; mh < 2; ++mh)
#pragma unroll
                    for (int bj = 0; bj < 2; ++bj)
#pragma unroll
                        for (int n = 0; n < 2; ++n) *(f32x4*)(ocs + (size_t)((4 * ai + 2 * wr + mh) * 2 + (fr - 14)) * FF2 + bj * FF + u.pn * 128 + cl_ + 4 * n) = acc[ai][bj][2 * mh + 1][n]; }
        if (fr >= 14) {
            if (!smp) {
#pragma unroll
                for (int ai = 0; ai < 2; ++ai)
#pragma unroll
                    for (int bj = 0; bj < 2; ++bj)
#pragma unroll
                        for (int n = 0; n < 2; ++n) {
                            *(LAS f32x4*)(xbuf + (((2 * ai + wr) * 2 + 1) * 2 + (fr - 14)) * 256 + bj * 128 + cl + 4 * n) = acc[ai][bj][1][n];
                            if (2 * ai + wr < 3) *(LAS f32x4*)(xbuf + (((2 * ai + wr + 1) * 2) * 2 + (fr - 14)) * 256 + bj * 128 + cl + 4 * n) = acc[ai][bj][3][n]; }
            } else {
#pragma unroll 1
                for (int q4 = 0; q4 < 4; ++q4) { const int q = (q4 >> 1) * 4 + wr * 2 + (q4 & 1);
#pragma unroll 1
                    for (int bj = 0; bj < 2; ++bj) { const f32x4 h0 = *(const f32x4*)(hist + (size_t)(q * 2 + (fr - 14)) * FF2 + bj * FF + u.pn * 128 + cl), h1 = *(const f32x4*)(hist + (size_t)(q * 2 + (fr - 14)) * FF2 + bj * FF + u.pn * 128 + cl + 4);
                        *(LAS f32x4*)(xbuf + (q * 2 + (fr - 14)) * 256 + bj * 128 + cl) = h0; *(LAS f32x4*)(xbuf + (q * 2 + (fr - 14)) * 256 + bj * 128 + cl + 4) = h1; } }
            }
        }
        RAW_BAR();
        const int bend = smp ? MT : (b + 1) * SEQ;
#pragma unroll
        for (int n = 0; n < 2; ++n) {
            f32x4 w0[2], w1[2], w2[2], cbv[2];
#pragma unroll
            for (int bj = 0; bj < 2; ++bj) { const int oc = bj * FF + u.pn * 128 + cl + 4 * n;
                w0[bj] = *(const f32x4*)(cw + oc); w1[bj] = *(const f32x4*)(cw + FF2 + oc); w2[bj] = *(const f32x4*)(cw + 2 * FF2 + oc); cbv[bj] = *(const f32x4*)(cb + oc); }
#pragma unroll
            for (int ai = 0; ai < 2; ++ai) {
#pragma unroll
                for (int m = 3; m >= 0; --m) {
                    f32x4 c[2];
#pragma unroll
                    for (int bj = 0; bj < 2; ++bj) {
                        const f32x4 cur = acc[ai][bj][m][n];
                        f32x4 prv;
                        if (m & 1) prv = acc[ai][bj][m - 1][n];
                        else prv = *(const LAS f32x4*)(xbuf + (((2 * ai + wr) * 2 + (m >> 1)) * 2 + (fr & 1)) * 256 + bj * 128 + cl + 4 * n);
                        f32x4 o;
#pragma unroll
                        for (int e = 0; e < 4; ++e) { float v = cbv[bj][e] + w2[bj][e] * cur[e];
                            v += w1[bj][e] * (dpp_shr1(cur[e]) + dpp_shl15(prv[e]));
                            v += w0[bj][e] * (dpp_shr2(cur[e]) + dpp_shl14(prv[e])); o[e] = v; }
                        c[bj] = o; }
                    const int tr = ai * 128 + wr * 64 + m * 16 + fr, tok = tok0 + tr;
                    if ((smp || tr >= 2) && tok < bend) {
                        u32x2 w;
                        w.x = cvt_pk_bf16(silu1(c[0][0]) * c[1][0], silu1(c[0][1]) * c[1][1]); w.y = cvt_pk_bf16(silu1(c[0][2]) * c[1][2], silu1(c[0][3]) * c[1][3]);
                        *(u32x2*)(G + (size_t)tok * FF + u.pn * 128 + cl + 4 * n) = w; }
                }
            }
        }
    }
};

constexpr int L_SPART = 0, L_SC = 32768, L_SRS = 40960;
template <int K, class BRow>
__device__ __forceinline__ void stask_mm(LAS unsigned char* lds, const bf16_t* A, int arow0, const bf16_t* Bt, BRow brow, const int tid) {
    const int lane = tid & 63, r32 = lane & 31, hi = lane >> 5, w = tid >> 6;
    constexpr int KW = K / 8, NK = KW / 16;
    const bf16_t* ap = A + (size_t)(arow0 + r32) * K + w * KW + hi * 8;
    const bf16_t* bp = Bt + (size_t)brow(r32) * K + w * KW + hi * 8;
    f32x16 acc;
#pragma unroll
    for (int r = 0; r < 16; ++r) acc[r] = 0.f;
#pragma unroll 11
    for (int ks = 0; ks < NK; ++ks) { const bf16x8 a = *(const bf16x8*)(ap + ks * 16), b = *(const bf16x8*)(bp + ks * 16); acc = __builtin_amdgcn_mfma_f32_32x32x16_bf16(a, b, acc, 0, 0, 0); }
    LAS float* part = (LAS float*)(lds + L_SPART) + w * 1024;
#pragma unroll
    for (int r = 0; r < 16; ++r) part[crow(r, hi) * 32 + r32] = acc[r];
    __syncthreads();
    LAS float* C = (LAS float*)(lds + L_SC); const LAS float* P0 = (const LAS float*)(lds + L_SPART);
#pragma unroll
    for (int i = 0; i < 2; ++i) { const int e = tid + i * 512; float s = 0.f;
#pragma unroll
        for (int ww = 0; ww < 8; ++ww) s += P0[ww * 1024 + e];
        C[(e >> 5) * 33 + (e & 31)] = s; }
    __syncthreads();
}
__device__ __forceinline__ void srs_table(LAS unsigned char* lds, const float* ssqs, int mt, int tid) {
    const int row = tid >> 4, jj = tid & 15; float s = ssqs[(size_t)jj * MS + mt * 32 + row] + ssqs[(size_t)(jj + 16) * MS + mt * 32 + row];
    s += __shfl_xor(s, 1); s += __shfl_xor(s, 2); s += __shfl_xor(s, 4); s += __shfl_xor(s, 8);
    if (jj == 0) ((LAS float*)(lds + L_SRS))[row] = 1.0f / sqrtf(s * (1.0f / D) + EPS);
}

namespace att {
constexpr int NS = 6, SLOTB = 8192;
constexpr int L_K = 0, L_V = NS * SLOTB, L_OST = 2 * NS * SLOTB, L_BIAS = 131072, L_WSF = 132352;
#define SBAR() __builtin_amdgcn_sched_barrier(0)
__device__ __forceinline__ void glds16(const void* gsrc, unsigned lds_dst) { unsigned keep;
    asm volatile("s_mov_b32 %0, m0\n\ts_mov_b32 m0, %2\n\ts_nop 0\n\tglobal_load_lds_dwordx4 %1, off\n\ts_mov_b32 m0, %0" : "=&s"(keep) : "v"(gsrc), "s"(lds_dst) : "memory"); }
#define WAIT_BAR(N) asm volatile("s_waitcnt vmcnt(" #N ") lgkmcnt(0)\n\ts_barrier" ::: "memory")

struct State { float m, l; f32x16 o[2]; };

__device__ __forceinline__ void tile(State& st, const bf16x8 (&qr)[4], unsigned kslot, unsigned vslot, float cinit, bool near, int base, bool mask1, const LAS float* tab, LAS float* wsf, int r32, int hi, int lane) {
    f32x16 p0, p1;
    { const LAS char* kb = (const LAS char*)(uintptr_t)kslot + hi * 1024 + r32 * 16;
        f32x16 ci;
#pragma unroll
        for (int r = 0; r < 16; ++r) ci[r] = cinit;
#pragma unroll
        for (int d0 = 0; d0 < 4; ++d0) { const bf16x8 b0 = *(const LAS bf16x8*)(kb + d0 * 2048), b1 = *(const LAS bf16x8*)(kb + d0 * 2048 + 512);
            if (d0 == 0) { p0 = __builtin_amdgcn_mfma_f32_32x32x16_bf16(b0, qr[0], ci, 0, 0, 0); p1 = __builtin_amdgcn_mfma_f32_32x32x16_bf16(b1, qr[0], ci, 0, 0, 0); }
            else { p0 = __builtin_amdgcn_mfma_f32_32x32x16_bf16(b0, qr[d0], p0, 0, 0, 0); p1 = __builtin_amdgcn_mfma_f32_32x32x16_bf16(b1, qr[d0], p1, 0, 0, 0); } } }
    if (near) {
#pragma unroll
        for (int r = 0; r < 16; ++r) { int i0 = base - crow(r, hi), i1 = i0 - 32; i0 = i0 < 0 ? 0 : (i0 > 256 ? 256 : i0); i1 = i1 < 0 ? 0 : (i1 > 256 ? 256 : i1); p0[r] += tab[i0]; p1[r] += tab[i1]; } }
    if (mask1) {
#pragma unroll
        for (int r = 0; r < 16; ++r) p1[r] = -1e30f; }
    float rm = fmaxf(p0[0], p1[0]);
#pragma unroll
    for (int r = 1; r < 16; ++r) rm = fmaxf(rm, fmaxf(p0[r], p1[r]));
    rm = fmaxf(rm, __shfl_xor(rm, 32));
    const float mn = fmaxf(st.m, rm);
    if (__any(mn > st.m)) {
        const float f = __builtin_amdgcn_exp2f(st.m - mn); st.l *= f; st.m = mn;
        if (hi == 0) wsf[r32] = f;
        LDS_WAIT();
#pragma unroll
        for (int g = 0; g < 4; ++g) { const f32x4 fv = *(const LAS f32x4*)(wsf + 8 * g + 4 * hi);
#pragma unroll
            for (int e = 0; e < 4; ++e) { st.o[0][4 * g + e] *= fv[e]; st.o[1][4 * g + e] *= fv[e]; } }
    }
    float sacc = 0.f;
#pragma unroll
    for (int r = 0; r < 16; ++r) { p0[r] = __builtin_amdgcn_exp2f(p0[r] - st.m); p1[r] = __builtin_amdgcn_exp2f(p1[r] - st.m); sacc += p0[r] + p1[r]; }
    st.l += sacc;
    u32x4 pw[4];
#pragma unroll
    for (int k = 0; k < 2; ++k) { pw[k] = (u32x4){cvt_pk_bf16(p0[8 * k], p0[8 * k + 1]), cvt_pk_bf16(p0[8 * k + 2], p0[8 * k + 3]), cvt_pk_bf16(p0[8 * k + 4], p0[8 * k + 5]), cvt_pk_bf16(p0[8 * k + 6], p0[8 * k + 7])};
        pw[2 + k] = (u32x4){cvt_pk_bf16(p1[8 * k], p1[8 * k + 1]), cvt_pk_bf16(p1[8 * k + 2], p1[8 * k + 3]), cvt_pk_bf16(p1[8 * k + 4], p1[8 * k + 5]), cvt_pk_bf16(p1[8 * k + 6], p1[8 * k + 7])}; }
    const int vb = (int)vslot + ((lane >> 4) & 1) * 32 + (lane & 3) * 8 + (4 * hi + ((lane & 15) >> 2)) * 64;
#pragma unroll
    for (int d0 = 0; d0 < 2; ++d0) { s16x4 lo[4], hh[4];
#pragma unroll
        for (int ks = 0; ks < 4; ++ks) {
            asm volatile("ds_read_b64_tr_b16 %0,%1 offset:%c2" : "=&v"(lo[ks]) : "v"(vb), "i"(d0 * 4096 + ks * 1024) : "memory");
            asm volatile("ds_read_b64_tr_b16 %0,%1 offset:%c2" : "=&v"(hh[ks]) : "v"(vb), "i"(d0 * 4096 + ks * 1024 + 512) : "memory"); }
        asm volatile("s_waitcnt lgkmcnt(0)" ::: "memory"); SBAR();
#pragma unroll
        for (int ks = 0; ks < 4; ++ks) { const bf16x8 vf = (bf16x8){lo[ks][0], lo[ks][1], lo[ks][2], lo[ks][3], hh[ks][0], hh[ks][1], hh[ks][2], hh[ks][3]};
            st.o[d0] = __builtin_amdgcn_mfma_f32_32x32x16_bf16(__builtin_bit_cast(bf16x8, pw[ks]), vf, st.o[d0], 0, 0, 0); }
    }
}

__device__ __forceinline__ void prompt_unit(int b, int h, int qg, const bf16_t* Q, const bf16_t* Kg, const bf16_t* Vg, bf16_t* O, LAS unsigned char* lds, const int tid) {
    const int lane = tid & 63, r32 = lane & 31, hi = lane >> 5; const int wid = __builtin_amdgcn_readfirstlane(tid >> 6);
    const int c0 = 4 * qg, pj = wid >> 1, half = wid & 1; const long rowbase = (long)b * SEQ;
    const unsigned lds0 = (unsigned)(uintptr_t)lds;
    const LAS float* tab = (const LAS float*)(lds + L_BIAS); LAS float* wsf = (LAS float*)(lds + L_WSF) + wid * 64;
    const bf16_t* Qw = Q + (rowbase + 64 * (c0 + pj) + 32 * half) * D + h * HD;
    const bf16_t* Kh = Kg + rowbase * D + h * HD; const bf16_t* Vh = Vg + rowbase * D + h * HD;
#define DMA_T(i) do { int ck_ = c0 - 8 + (i); ck_ = ck_ < 0 ? 0 : ck_; const unsigned so_ = (unsigned)(((i) % NS) * SLOTB + wid * 1024); \
        glds16(Kh + (long)(64 * ck_ + lane) * D + wid * 8, (unsigned)__builtin_amdgcn_readfirstlane(lds0 + L_K + so_)); \
        glds16(Vh + (long)(64 * ck_ + 16 * (wid & 3) + (lane >> 2)) * D + (wid >> 2) * 32 + (lane & 3) * 8, (unsigned)__builtin_amdgcn_readfirstlane(lds0 + L_V + so_)); } while (0)
    DMA_T(0); DMA_T(1); DMA_T(2); DMA_T(3); DMA_T(4);
    bf16x8 qr[4];
#pragma unroll
    for (int d0 = 0; d0 < 4; ++d0) qr[d0] = *(const bf16x8*)(Qw + (long)r32 * D + d0 * 16 + hi * 8);
    State st; st.m = -1e30f; st.l = 0.f;
#pragma unroll
    for (int r = 0; r < 16; ++r) { st.o[0][r] = 0.f; st.o[1][r] = 0.f; }
    const float cfar = tab[256];
    const int ql = 32 * half + r32;
    for (int s = 0; s < 9; ++s) {
        if (s == 0) { WAIT_BAR(0); asm volatile("" : "+v"(qr[0]), "+v"(qr[1]), "+v"(qr[2]), "+v"(qr[3])); }
        else if (s < 8) WAIT_BAR(2); else WAIT_BAR(0);
        if (s + 5 < 12) DMA_T(s + 5);
        const int ck = c0 - 8 + s + pj;
        if (ck >= 0) { const int sl = (s + pj) % NS; const bool near = s >= 6;
            tile(st, qr, lds0 + L_K + sl * SLOTB, lds0 + L_V + sl * SLOTB, near ? 0.f : cfar, near, 64 * (8 - s) + ql + 128, false, tab, wsf, r32, hi, lane); }
    }
#undef DMA_T
    float l = st.l + __shfl_xor(st.l, 32);
    if (hi == 0) wsf[32 + r32] = l;
    LDS_WAIT();
    float rli[16];
#pragma unroll
    for (int r = 0; r < 16; ++r) rli[r] = __builtin_amdgcn_rcpf(wsf[32 + crow(r, hi)]);
    bf16_t* Ow = O + (rowbase + 64 * (c0 + pj) + 32 * half) * D + h * HD;
    { LAS bf16_t* stg = (LAS bf16_t*)(lds + L_OST) + wid * 2048;
#pragma unroll
        for (int r = 0; r < 16; ++r) { const int orow = crow(r, hi);
#pragma unroll
            for (int d0 = 0; d0 < 2; ++d0) stg[orow * 64 + d0 * 32 + r32] = (bf16_t)(cvt_pk_bf16(st.o[d0][r] * rli[r], 0.f) & 0xffffu); }
        LDS_WAIT();
#pragma unroll
        for (int i = 0; i < 4; ++i) { const int row = i * 8 + (lane >> 3), ch = lane & 7; const u32x4 v = *(const LAS u32x4*)(stg + row * 64 + ch * 8); *(u32x4*)(Ow + (long)row * D + ch * 8) = v; } }
    asm volatile("s_waitcnt lgkmcnt(0)\n\ts_barrier" ::: "memory");
}

__device__ __forceinline__ void sample_unit(int b, int h, const bf16_t* Q, const bf16_t* Kg, const bf16_t* Vg, const bf16_t* CK, const bf16_t* CV, bf16_t* O, LAS unsigned char* lds, const int tid) {
    const int lane = tid & 63, r32 = lane & 31, hi = lane >> 5; const int wid = __builtin_amdgcn_readfirstlane(tid >> 6);
    const unsigned lds0 = (unsigned)(uintptr_t)lds;
    const LAS float* tab = (const LAS float*)(lds + L_BIAS); LAS float* wsf = (LAS float*)(lds + L_WSF) + wid * 64;
    const long srow = (long)MP + 32 * b;
    const bf16_t* Qw = Q + srow * D + h * HD;
    const unsigned ks = lds0 + wid * 16384, vs = ks + 8192;
    { const bf16_t* Kc = CK + ((long)b * CA + 64 * wid) * D + h * HD; const bf16_t* Vc = CV + ((long)b * CA + 64 * wid) * D + h * HD;
#pragma unroll
        for (int p = 0; p < 8; ++p) { glds16(Kc + (long)lane * D + p * 8, (unsigned)__builtin_amdgcn_readfirstlane(ks + p * 1024));
            glds16(Vc + (long)(16 * (p & 3) + (lane >> 2)) * D + (p >> 2) * 32 + (lane & 3) * 8, (unsigned)__builtin_amdgcn_readfirstlane(vs + p * 1024)); } }
    bf16x8 qr[4];
#pragma unroll
    for (int d0 = 0; d0 < 4; ++d0) qr[d0] = *(const bf16x8*)(Qw + (long)r32 * D + d0 * 16 + hi * 8);
    State st; st.m = -1e30f; st.l = 0.f;
#pragma unroll
    for (int r = 0; r < 16; ++r) { st.o[0][r] = 0.f; st.o[1][r] = 0.f; }
    asm volatile("s_waitcnt vmcnt(0)" ::: "memory"); asm volatile("" : "+v"(qr[0]), "+v"(qr[1]), "+v"(qr[2]), "+v"(qr[3]));
    { const bool near = wid >= 6; tile(st, qr, ks, vs, near ? 0.f : tab[256], near, r32 + 512 - 64 * wid + 128, false, tab, wsf, r32, hi, lane); }
    if (wid == 0) {
        const bf16_t* Kn = Kg + srow * D + h * HD; const bf16_t* Vn = Vg + srow * D + h * HD;
#pragma unroll
        for (int p = 0; p < 8; ++p) { const int kr = lane < 32 ? lane : 31; const int vr0 = 16 * (p & 3) + (lane >> 2), vr = vr0 < 32 ? vr0 : 31;
            glds16(Kn + (long)kr * D + p * 8, (unsigned)__builtin_amdgcn_readfirstlane(ks + p * 1024));
            glds16(Vn + (long)vr * D + (p >> 2) * 32 + (lane & 3) * 8, (unsigned)__builtin_amdgcn_readfirstlane(vs + p * 1024)); }
        asm volatile("s_waitcnt vmcnt(0)" ::: "memory");
        tile(st, qr, ks, vs, 0.f, true, r32 + 128, true, tab, wsf, r32, hi, lane);
    }
    const float l = st.l + __shfl_xor(st.l, 32);
    asm volatile("s_waitcnt lgkmcnt(0)\n\ts_barrier" ::: "memory");
    LAS float* OP = (LAS float*)lds;
    LAS float* MLp = (LAS float*)(lds + 65536);
#pragma unroll
    for (int r = 0; r < 16; ++r) { const int q = crow(r, hi); OP[(wid * 32 + q) * 64 + r32] = st.o[0][r]; OP[(wid * 32 + q) * 64 + 32 + r32] = st.o[1][r]; }
    if (hi == 0) { MLp[wid * 32 + r32] = st.m; MLp[256 + wid * 32 + r32] = l; }
    __syncthreads();
    { const int q = tid >> 4, d4 = (tid & 15) * 4; float mg = -1e30f;
#pragma unroll
        for (int w = 0; w < 8; ++w) mg = fmaxf(mg, MLp[w * 32 + q]);
        f32x4 num = (f32x4){0.f, 0.f, 0.f, 0.f}; float den = 0.f;
#pragma unroll
        for (int w = 0; w < 8; ++w) { const float f = __builtin_amdgcn_exp2f(MLp[w * 32 + q] - mg); den += f * MLp[256 + w * 32 + q]; num += *(const LAS f32x4*)(OP + (w * 32 + q) * 64 + d4) * f; }
        const float rd = 1.0f / den; u32x2 w2; w2.x = cvt_pk_bf16(num[0] * rd, num[1] * rd); w2.y = cvt_pk_bf16(num[2] * rd, num[3] * rd);
        *(u32x2*)(O + (srow + q) * D + h * HD + d4) = w2; }
    __syncthreads();
}
#undef WAIT_BAR
}

namespace gate {
constexpr int L_VS = 0, L_STG = 32768, L_RV = 98304;
__device__ __forceinline__ void unit(bool sample, int nb, int gp, bf16_t* U, const bf16_t* Vv, const float* ssqv, const float* ssqvs, const float* vgain, const float* wsp, const float* bsp, float* ogv, LAS unsigned char* lds, const int tid) {
    const int lane = tid & 63, r32 = lane & 31, hi = lane >> 5; const int wid = __builtin_amdgcn_readfirstlane(tid >> 6);
    const long tok0 = sample ? (long)MP + 32 * nb : (long)128 * nb; const int nrows = sample ? 32 : 128;
    LAS float* rv = (LAS float*)(lds + L_RV);
    if (!sample) { if (tid < 128) { const long t = tok0 + tid; const float s = (ssqv[t] + ssqv[MT + t]) + (ssqv[2 * MT + t] + ssqv[3 * MT + t]); rv[tid] = 1.0f / sqrtf(s * (1.0f / D) + EPS); } }
    else { const int row = tid >> 4, jj = tid & 15; float s = ssqvs[(size_t)jj * MS + nb * 32 + row] + ssqvs[(size_t)(jj + 16) * MS + nb * 32 + row];
        s += __shfl_xor(s, 1); s += __shfl_xor(s, 2); s += __shfl_xor(s, 4); s += __shfl_xor(s, 8); if (jj == 0) rv[row] = 1.0f / sqrtf(s * (1.0f / D) + EPS); }
    __syncthreads();
    for (int pi = wid; pi < 32; pi += 8) { const int gi = pi >> 4, qt = (pi >> 3) & 1, dh = (pi >> 2) & 1, rg = pi & 3;
        const int row = 64 * qt + 16 * rg + (lane >> 2), col = 64 * (2 * gp + gi) + 32 * dh + 8 * (lane & 3);
        if (row < nrows) { const u32x4 raw = *(const u32x4*)(Vv + (tok0 + row) * D + col); const float rs = rv[row];
            const f32x4 g0 = *(const f32x4*)(vgain + col), g1 = *(const f32x4*)(vgain + col + 4);
            float f[8]; f[0] = bf2f(raw.x & 0xffffu) * rs * g0[0]; f[1] = bf2f(raw.x >> 16) * rs * g0[1]; f[2] = bf2f(raw.y & 0xffffu) * rs * g0[2]; f[3] = bf2f(raw.y >> 16) * rs * g0[3];
            f[4] = bf2f(raw.z & 0xffffu) * rs * g1[0]; f[5] = bf2f(raw.z >> 16) * rs * g1[1]; f[6] = bf2f(raw.w & 0xffffu) * rs * g1[2]; f[7] = bf2f(raw.w >> 16) * rs * g1[3];
            u32x4 w; w.x = cvt_pk_bf16(f[0], f[1]); w.y = cvt_pk_bf16(f[2], f[3]); w.z = cvt_pk_bf16(f[4], f[5]); w.w = cvt_pk_bf16(f[6], f[7]);
            *(LAS u32x4*)(lds + L_VS + (gi * 2 + qt) * 8192 + (dh * 4 + rg) * 1024 + lane * 16) = w;
            if (sample) { float* o = ogv + (size_t)(nb * 32 + row) * D + col; *(f32x4*)o = (f32x4){f[0], f[1], f[2], f[3]}; *(f32x4*)(o + 4) = (f32x4){f[4], f[5], f[6], f[7]}; } } }
    __syncthreads();
    const int gi = wid >> 2, pb = wid & 3, g = 2 * gp + gi;
    if (pb * 32 < nrows) {
        const int nks = sample ? 2 : (pb < 2 ? 4 : 8);
        f32x16 o[2];
#pragma unroll
        for (int r = 0; r < 16; ++r) { o[0][r] = 0.f; o[1][r] = 0.f; }
        const float* wrow = wsp + ((size_t)g * 128 + 32 * pb + r32) * 128 + 4 * hi;
        const unsigned lds0 = (unsigned)(uintptr_t)lds;
        for (int ks = 0; ks < nks; ++ks) {
            const f32x4 a0 = *(const f32x4*)(wrow + 16 * ks), a1 = *(const f32x4*)(wrow + 16 * ks + 8);
            u32x4 pa; pa.x = cvt_pk_bf16(a0[0], a0[1]); pa.y = cvt_pk_bf16(a0[2], a0[3]); pa.z = cvt_pk_bf16(a1[0], a1[1]); pa.w = cvt_pk_bf16(a1[2], a1[3]);
            const int vb = (int)(lds0 + L_VS + (gi * 2 + (ks >> 2)) * 8192 + (ks & 3) * 1024) + ((lane >> 4) & 1) * 32 + (lane & 3) * 8 + (4 * hi + ((lane & 15) >> 2)) * 64;
            s16x4 lo[2], hh[2];
#pragma unroll
            for (int d0 = 0; d0 < 2; ++d0) {
                asm volatile("ds_read_b64_tr_b16 %0,%1 offset:%c2" : "=&v"(lo[d0]) : "v"(vb), "i"(d0 * 4096) : "memory");
                asm volatile("ds_read_b64_tr_b16 %0,%1 offset:%c2" : "=&v"(hh[d0]) : "v"(vb), "i"(d0 * 4096 + 512) : "memory"); }
            asm volatile("s_waitcnt lgkmcnt(0)" ::: "memory"); __builtin_amdgcn_sched_barrier(0);
#pragma unroll
            for (int d0 = 0; d0 < 2; ++d0) { const bf16x8 vf = (bf16x8){lo[d0][0], lo[d0][1], lo[d0][2], lo[d0][3], hh[d0][0], hh[d0][1], hh[d0][2], hh[d0][3]};
                o[d0] = __builtin_amdgcn_mfma_f32_32x32x16_bf16(__builtin_bit_cast(bf16x8, pa), vf, o[d0], 0, 0, 0); }
        }
        LAS float* stg = (LAS float*)(lds + L_STG) + wid * 2048;
        const float* bs = bsp + g * 128 + 32 * pb;
#pragma unroll
        for (int r = 0; r < 16; ++r) { const int q = crow(r, hi); const float bq = bs[q]; stg[q * 64 + r32] = o[0][r] + bq; stg[q * 64 + 32 + r32] = o[1][r] + bq; }
        LDS_WAIT();
#pragma unroll
        for (int i = 0; i < 4; ++i) { const int row = i * 8 + (lane >> 3), ch = lane & 7;
            const f32x4 m0 = *(const LAS f32x4*)(stg + row * 64 + ch * 8), m1 = *(const LAS f32x4*)(stg + row * 64 + ch * 8 + 4);
            bf16_t* up = U + (tok0 + 32 * pb + row) * D + 64 * g + ch * 8; const u32x4 uu = *(const u32x4*)up;
            u32x4 w; w.x = cvt_pk_bf16(bf2f(uu.x & 0xffffu) * m0[0], bf2f(uu.x >> 16) * m0[1]); w.y = cvt_pk_bf16(bf2f(uu.y & 0xffffu) * m0[2], bf2f(uu.y >> 16) * m0[3]);
            w.z = cvt_pk_bf16(bf2f(uu.z & 0xffffu) * m1[0], bf2f(uu.z >> 16) * m1[1]); w.w = cvt_pk_bf16(bf2f(uu.w & 0xffffu) * m1[2], bf2f(uu.w >> 16) * m1[3]);
            *(u32x4*)up = w; }
    }
    __syncthreads();
}
}

template <bool UP>
__device__ __forceinline__ void transpose_item(const float* W, int K, int N, const float* gain, bf16_t* WT, LAS float* scr, int item, int lane) {
    const int nblk = N / 32, kb = item / nblk, nb = item % nblk, k0 = 64 * kb, n0 = 32 * nb;
#pragma unroll 8
    for (int i = 0; i < 32; ++i) { const int kk = 2 * i + (lane >> 5); const float gk = gain ? gain[k0 + kk] : 1.0f; scr[kk * 33 + (lane & 31)] = W[(size_t)(k0 + kk) * N + n0 + (lane & 31)] * gk; }
    LDS_WAIT(); asm volatile("" ::: "memory");
    const int c = lane & 7;
#pragma unroll
    for (int jj = 0; jj < 4; ++jj) { const int n = (lane >> 3) + 8 * jj; const LAS float* s = scr + (8 * c) * 33 + n;
        u32x4 o; o.x = cvt_pk_bf16(s[0 * 33], s[1 * 33]); o.y = cvt_pk_bf16(s[2 * 33], s[3 * 33]); o.z = cvt_pk_bf16(s[4 * 33], s[5 * 33]); o.w = cvt_pk_bf16(s[6 * 33], s[7 * 33]);
        int dn = n0 + n; if (UP) { const int v = dn >= FF ? 1 : 0, gc = dn - v * FF; dn = 256 * (gc >> 7) + 128 * v + (gc & 127); }
        *(u32x4*)(WT + (size_t)dn * K + k0 + 8 * c) = o; }
    LDS_WAIT(); asm volatile("" ::: "memory");
}

#define XB_TMO      128
#define XB_XCNT(j)  (256  + 64 * (j))
#define XB_XSUB(j)  (1280 + 64 * (j))
#define XB_XGEN(j)  (2304 + 64 * (j))
#define XB_TOP      3328
#define XB_TOPGEN   3392
#define XCD_BAR_WORDS 3456
#define XB_SPIN_CAP (1u << 18)
__device__ __forceinline__ unsigned xb_ld(unsigned* p)              { return __hip_atomic_load(p, __ATOMIC_RELAXED, __HIP_MEMORY_SCOPE_AGENT); }
__device__ __forceinline__ unsigned xb_add(unsigned* p, unsigned v) { return __hip_atomic_fetch_add(p, v, __ATOMIC_RELAXED, __HIP_MEMORY_SCOPE_AGENT); }
__device__ __forceinline__ unsigned xb_xcc_id() { return (unsigned)__builtin_amdgcn_s_getreg((3 << 11) | 20) & 0xFu; }
#define XB_SPIN(cond, bar) do { unsigned _sp = 0; while (cond) { __builtin_amdgcn_s_sleep(1); \
    if ((++_sp & 255u) == 0u) { if (xb_ld(&(bar)[XB_TMO])) break; if (_sp > XB_SPIN_CAP) { atomicAdd(&(bar)[XB_TMO], 1u); break; } } } } while (0)
struct XcdBarrier { unsigned* bar; unsigned x; volatile LAS unsigned* st; };
__device__ __forceinline__ void xcd_barrier_complete(unsigned* bar, unsigned x, unsigned& nloc, unsigned& nx) {
    const unsigned G = gridDim.x * gridDim.y * gridDim.z;
    unsigned sum, cnt, mine, sp = 0u;
    for (;;) {
        sum = 0u; cnt = 0u; mine = 0u;
#pragma unroll
        for (unsigned j = 0; j < 16; ++j) { const unsigned c = xb_ld(&bar[XB_XCNT(j)]); sum += c; cnt += (c > 0u) ? 1u : 0u; mine = (j == x) ? c : mine; }
        if (sum == G) break;
        __builtin_amdgcn_s_sleep(1);
        if ((++sp & 255u) == 0u) { if (xb_ld(&bar[XB_TMO])) break; if (sp > XB_SPIN_CAP) { atomicAdd(&bar[XB_TMO], 1u); break; } }
    }
    nloc = mine > 0u ? mine : 1u; nx = cnt > 0u ? cnt : 1u;
}
__device__ __forceinline__ void xcd_barrier(const XcdBarrier& b, const int tid) {
    asm volatile("s_waitcnt vmcnt(0)" ::: "memory");
    __syncthreads();
    if (tid == 0) {
        unsigned* bar = b.bar;
        __builtin_amdgcn_s_waitcnt(0);
        unsigned nloc = b.st[0], nx = b.st[1];
        if (nloc == 0u) { xcd_barrier_complete(bar, b.x, nloc, nx); b.st[0] = nloc; b.st[1] = nx; }
        const unsigned old = xb_add(&bar[XB_XSUB(b.x)], 1u);
        const unsigned gen = old / nloc;
        if (old + 1u == (gen + 1u) * nloc) {
            __builtin_amdgcn_fence(__ATOMIC_RELEASE, "agent");
            asm volatile("s_waitcnt vmcnt(0)" ::: "memory");
            const unsigned og = xb_add(&bar[XB_TOP], 1u);
            const unsigned tg = og / nx;
            if (og + 1u == (tg + 1u) * nx) xb_add(&bar[XB_TOPGEN], 1u);
            else XB_SPIN(xb_ld(&bar[XB_TOPGEN]) == tg, bar);
            __builtin_amdgcn_fence(__ATOMIC_ACQUIRE, "agent");
            xb_add(&bar[XB_XGEN(b.x)], 1u);
            asm volatile("s_waitcnt vmcnt(0)" ::: "memory");
        } else {
            XB_SPIN(xb_ld(&bar[XB_XGEN(b.x)]) == gen, bar);
            __builtin_amdgcn_fence(__ATOMIC_ACQUIRE, "agent");
            asm volatile("s_waitcnt vmcnt(0)" ::: "memory");
        }
    }
    __syncthreads();
}

#define PH(k)
struct Args { const float* in[20]; float* out; unsigned char* ws; };

__global__ void __launch_bounds__(NTHR, 2) fwd_kernel(Args a) {
    extern __shared__ __attribute__((aligned(16))) unsigned char lds_raw[];
    LAS unsigned char* lds = (LAS unsigned char*)lds_raw;
    const int wave0 = __builtin_amdgcn_readfirstlane((int)threadIdx.x >> 6);
    XcdBarrier bar;
    { volatile LAS unsigned* MISC = (volatile LAS unsigned*)(lds + L_MISC);
        if (threadIdx.x < 4) MISC[threadIdx.x] = 0u;
        __syncthreads();
        bar.bar = (unsigned*)(a.ws + WS_CTL); bar.x = xb_xcc_id(); bar.st = MISC;
        if (threadIdx.x == 0) (void)xb_add(&bar.bar[XB_XCNT(bar.x)], 1u); }
#define GRID_BAR() do { PHASE_VARS xcd_barrier(bar, tid); } while (0)
#define PHASE_VARS int tid; asm volatile("v_mbcnt_lo_u32_b32 %0, -1, 0\n\tv_mbcnt_hi_u32_b32 %0, -1, %0" : "=v"(tid)); tid |= wave0 << 6; const int lane = tid & 63, wave = wave0; (void)lane; (void)wave;
    const int G = gridDim.x, bx = blockIdx.x; const int vcu = (G % 8 == 0) ? (bx % 8) * (G / 8) + bx / 8 : bx;
    unsigned char* ws = a.ws; float* out = a.out;
    const float *x_prompt = a.in[0], *x_sample = a.in[1], *cache_k = a.in[2], *cache_v = a.in[3], *state_conv = a.in[4], *ln_mix = a.in[5], *ln_ffn = a.in[6], *ln_final = a.in[7],
                *w_qkv = a.in[8], *rel_bias = a.in[9], *w_o = a.in[10], *w_in = a.in[11], *v_norm = a.in[12], *w_s = a.in[13], *bias_s = a.in[14], *w_out = a.in[15],
                *w_up = a.in[16], *conv_w = a.in[17], *conv_b = a.in[18], *w_down = a.in[19];
    bf16_t *Wqkv_t = (bf16_t*)(ws + WS_WQKV), *Wo_t = (bf16_t*)(ws + WS_WO), *Win_t = (bf16_t*)(ws + WS_WIN), *Wout_t = (bf16_t*)(ws + WS_WOUT);
    bf16_t *XB = (bf16_t*)(ws + WS_XB), *QB = (bf16_t*)(ws + WS_Q), *KB = (bf16_t*)(ws + WS_K), *VB = (bf16_t*)(ws + WS_V), *GB = (bf16_t*)(ws + WS_G), *CKB = (bf16_t*)(ws + WS_CK), *CVB = (bf16_t*)(ws + WS_CV), *OB = (bf16_t*)(ws + WS_OB);
    float *SSQ = (float*)(ws + WS_SSQ), *SSQV = (float*)(ws + WS_SSQV), *SSQS = (float*)(ws + WS_SSQS), *SSQVS = (float*)(ws + WS_SSQVS);

    PH(0) { PHASE_VARS
        LAS float* scr = (LAS float*)(lds + wave * 16384);
        const int gw = vcu * NWAVES + wave, NGW = G * NWAVES;
        constexpr int I_QKV = (D / 64) * (3 * D / 32), I_O = (D / 64) * (D / 32), I_IN = (D / 64) * (2 * D / 32), I_UP = (D / 64) * (FF2 / 32), I_DN = (FF / 64) * (D / 32);
        constexpr int NITEMS = I_QKV + 2 * I_O + I_IN + 2 * I_UP + 2 * I_DN;
        for (int it = gw; it < NITEMS; it += NGW) {
            int r = it;
            if (r < I_QKV) { transpose_item<false>(w_qkv, D, 3 * D, ln_mix, Wqkv_t, scr, r, lane); continue; } r -= I_QKV;
            if (r < I_O) { transpose_item<false>(w_o, D, D, nullptr, Wo_t, scr, r, lane); continue; } r -= I_O;
            if (r < I_IN) { transpose_item<false>(w_in, D, 2 * D, ln_mix + D, Win_t, scr, r, lane); continue; } r -= I_IN;
            if (r < I_O) { transpose_item<false>(w_out, D, D, nullptr, Wout_t, scr, r, lane); continue; } r -= I_O;
            if (r < 2 * I_UP) { const int l = r / I_UP; transpose_item<true>(w_up + (size_t)l * D * FF2, D, FF2, ln_ffn + l * D, (bf16_t*)(ws + WS_WUP + l * WUP_L), scr, r % I_UP, lane); continue; } r -= 2 * I_UP;
            { const int l = r / I_DN; transpose_item<false>(w_down + (size_t)l * FF * D, FF, D, nullptr, (bf16_t*)(ws + WS_WDN + l * WDN_L), scr, r % I_DN, lane); }
        }
        for (int m = gw; m < MT; m += NGW) {
            const float* xr = m < MP ? x_prompt + (size_t)m * D : x_sample + (size_t)(m - MP) * D;
            f32x4 v[4]; float s = 0.f;
#pragma unroll
            for (int jj = 0; jj < 4; ++jj) { v[jj] = ((const f32x4*)xr)[lane + 64 * jj]; s += (v[jj][0] * v[jj][0] + v[jj][1] * v[jj][1]) + (v[jj][2] * v[jj][2] + v[jj][3] * v[jj][3]); }
            s = wave_sum(s);
#pragma unroll
            for (int jj = 0; jj < 4; ++jj) { u32x2 w; w.x = cvt_pk_bf16(v[jj][0], v[jj][1]); w.y = cvt_pk_bf16(v[jj][2], v[jj][3]); ((u32x2*)(XB + (size_t)m * D))[lane + 64 * jj] = w; }
            if (m < MP) { if (lane < 4) SSQ[(size_t)lane * MT + m] = lane == 0 ? s : 0.f; }
            else { if (lane < 32) SSQS[(size_t)lane * MS + (m - MP)] = lane == 0 ? s : 0.f; }
        }
        for (int m = gw; m < 2 * DB * CA; m += NGW) { const int which = m >= DB * CA, rr = m - which * DB * CA; const float* src = (which ? cache_v : cache_k) + (size_t)rr * D; bf16_t* dst = (which ? CVB : CKB) + (size_t)rr * D;
#pragma unroll
            for (int jj = 0; jj < 4; ++jj) { const f32x4 v = ((const f32x4*)src)[lane + 64 * jj]; u32x2 w; w.x = cvt_pk_bf16(v[0], v[1]); w.y = cvt_pk_bf16(v[2], v[3]); ((u32x2*)dst)[lane + 64 * jj] = w; } }
    }
    GRID_BAR();

    PH(1) { PHASE_VARS
        for (int task = vcu; task < DB * 96; task += G) { const int mt = task / 96, nt = task % 96;
            srs_table(lds, SSQS, mt, tid);
            stask_mm<D>(lds, XB, MP + 32 * mt, Wqkv_t, [&](int jn) { return 32 * nt + jn; }, tid);
            const LAS float* C = (const LAS float*)(lds + L_SC); const LAS float* rs = (const LAS float*)(lds + L_SRS);
            const int row = tid >> 4, c0 = (tid & 15) * 2, n = 32 * nt + c0, t = n >> 10, nn = n & 1023; const float r_ = rs[row];
            const float v0 = C[row * 33 + c0] * r_, v1 = C[row * 33 + c0 + 1] * r_; const float sc = t == 0 ? C2 : 1.0f;
            bf16_t* dst = (t == 0 ? QB : (t == 1 ? KB : VB)) + (size_t)(MP + 32 * mt + row) * D + nn; *(unsigned*)dst = cvt_pk_bf16(v0 * sc, v1 * sc);
            if (t >= 1) { float* o = out + (t == 1 ? O_KS : O_VS) + (size_t)(32 * mt + row) * D + nn; *(f32x2*)o = (f32x2){v0, v1}; }
            __syncthreads();
        }
        pg8::Gemm g{XB, Wqkv_t, D}; pg8::StaticOrder S; S.init(MP / 256, 3 * D / 256, G, bx, 0);
        EpiQKV E{QB, (size_t)(WS_K - WS_Q) / 2, SSQ, out + O_KP, out + O_VP};
        pg8::gemm_phase<EpiQKV, pg8::StaticOrder>(lds, g, S, E, tid);
    }
    GRID_BAR();

    PH(2) { PHASE_VARS
        LAS float* tab = (LAS float*)(lds + att::L_BIAS);
        const int per = (NB * NH * 32 + G - 1) / G;
        int lasth = -1;
        for (int id = vcu * per; id < (vcu + 1) * per && id < NB * NH * 32; ++id) { const int bh = id >> 5, qg = id & 31, b = bh / NH, h = bh % NH;
            if (h != lasth) { __syncthreads(); for (int i = tid; i < NREL; i += NTHR) tab[i] = rel_bias[h * NREL + i] * LOG2E; __syncthreads(); lasth = h; }
            att::prompt_unit(b, h, qg, QB, KB, VB, OB, lds, tid); }
        for (int id = vcu; id < DB * NH; id += G) { const int b = id / NH, h = id % NH;
            if (h != lasth) { __syncthreads(); for (int i = tid; i < NREL; i += NTHR) tab[i] = rel_bias[h * NREL + i] * LOG2E; __syncthreads(); lasth = h; }
            att::sample_unit(b, h, QB, KB, VB, CKB, CVB, OB, lds, tid); }
    }
    GRID_BAR();

#define RES_PHASE(A_, Wt_, KK) do { \
        for (int task = vcu; task < DB * 32; task += G) { const int mt = task / 32, nt = task % 32; \
            stask_mm<KK>(lds, A_, MP + 32 * mt, Wt_, [&](int jn) { return 32 * nt + jn; }, tid); \
            const LAS float* C = (const LAS float*)(lds + L_SC); \
            const int row = tid >> 4, c0 = (tid & 15) * 2, n = 32 * nt + c0; unsigned* xp_ = (unsigned*)(XB + (size_t)(MP + 32 * mt + row) * D + n); \
            const unsigned bb = *xp_; const float v0 = bf2f(bb & 0xffffu) + C[row * 33 + c0], v1 = bf2f(bb >> 16) + C[row * 33 + c0 + 1]; \
            *xp_ = cvt_pk_bf16(v0, v1); \
            float s_ = v0 * v0 + v1 * v1; s_ += __shfl_xor(s_, 1); s_ += __shfl_xor(s_, 2); s_ += __shfl_xor(s_, 4); s_ += __shfl_xor(s_, 8); \
            if ((tid & 15) == 0) SSQS[(size_t)nt * MS + 32 * mt + row] = s_; \
            __syncthreads(); } \
        pg8::Gemm g{A_, Wt_, KK}; pg8::StaticOrder S; S.init(MP / 256, D / 256, G, bx, 0); \
        EpiRes E{XB, SSQ}; \
        pg8::gemm_phase<EpiRes, pg8::StaticOrder>(lds, g, S, E, tid); } while (0)
    PH(3) { PHASE_VARS RES_PHASE(OB, Wo_t, D); }
    GRID_BAR();

#define UP_PHASE(L_) do { \
        const bf16_t* Wup_ = (const bf16_t*)(ws + WS_WUP + (L_) * WUP_L); const float* cw_ = conv_w + (size_t)(L_) * 3 * FF2; const float* cb_ = conv_b + (size_t)(L_) * FF2; \
        pg8::Gemm g{XB, Wup_, D}; pg8::StaticOrder S; S.init(67, FF2 / 256, G, bx, 1); \
        EpiUp E{GB, SSQ, SSQS, cw_, cb_, out + O_CP + (size_t)(L_) * NB * 2 * FF2, state_conv + (size_t)(L_) * DB * 2 * FF2, out + O_CS + (size_t)(L_) * DB * 2 * FF2}; \
        pg8::gemm_phase<EpiUp, pg8::StaticOrder>(lds, g, S, E, tid); } while (0)
    PH(4) { PHASE_VARS UP_PHASE(0); }
    GRID_BAR();
    PH(5) { PHASE_VARS RES_PHASE(GB, (const bf16_t*)(ws + WS_WDN), FF); }
    GRID_BAR();

    PH(6) { PHASE_VARS
        for (int task = vcu; task < DB * 64; task += G) { const int mt = task / 64, nt = task % 64;
            srs_table(lds, SSQS, mt, tid);
            stask_mm<D>(lds, XB, MP + 32 * mt, Win_t, [&](int jn) { return 32 * nt + jn; }, tid);
            const LAS float* C = (const LAS float*)(lds + L_SC); const LAS float* rs = (const LAS float*)(lds + L_SRS);
            const int row = tid >> 4, c0 = (tid & 15) * 2, n = 32 * nt + c0, t = n >> 10, nn = n & 1023; const float r_ = rs[row];
            const f32x2 z = gelu_pk((f32x2){C[row * 33 + c0] * r_, C[row * 33 + c0 + 1] * r_});
            *(unsigned*)((t == 0 ? QB : KB) + (size_t)(MP + 32 * mt + row) * D + nn) = cvt_pk_bf16(z.x, z.y);
            if (t == 1) { float s_ = z.x * z.x + z.y * z.y; s_ += __shfl_xor(s_, 1); s_ += __shfl_xor(s_, 2); s_ += __shfl_xor(s_, 4); s_ += __shfl_xor(s_, 8);
                if ((tid & 15) == 0) SSQVS[(size_t)(nt - 32) * MS + 32 * mt + row] = s_; }
            __syncthreads();
        }
        pg8::Gemm g{XB, Win_t, D}; pg8::StaticOrder S; S.init(MP / 256, 2 * D / 256, G, bx, 0);
        EpiIn E{QB, (size_t)(WS_K - WS_Q) / 2, SSQ, SSQV};
        pg8::gemm_phase<EpiIn, pg8::StaticOrder>(lds, g, S, E, tid);
    }
    GRID_BAR();

    PH(7) { PHASE_VARS
        const int per = (128 * 8 + G - 1) / G;
        for (int id = vcu * per; id < (vcu + 1) * per && id < 128 * 8; ++id) gate::unit(false, id >> 3, id & 7, QB, KB, SSQV, SSQVS, v_norm, w_s, bias_s, out + O_GV, lds, tid);
        for (int id = vcu; id < DB * 8; id += G) gate::unit(true, id >> 3, id & 7, QB, KB, SSQV, SSQVS, v_norm, w_s, bias_s, out + O_GV, lds, tid);
    }
    GRID_BAR();

    PH(8) { PHASE_VARS RES_PHASE(QB, Wout_t, D); }
    GRID_BAR();
    PH(9) { PHASE_VARS UP_PHASE(1); }
    GRID_BAR();
    PH(10) { PHASE_VARS RES_PHASE(GB, (const bf16_t*)(ws + WS_WDN + WDN_L), FF); }
    GRID_BAR();

    PH(11) { PHASE_VARS
        const int gw = vcu * NWAVES + wave, NGW = G * NWAVES;
        f32x4 gn[4];
#pragma unroll
        for (int jj = 0; jj < 4; ++jj) gn[jj] = ((const f32x4*)ln_final)[lane + 64 * jj];
        for (int m = gw; m < MT; m += NGW) {
            float s;
            if (m < MP) s = (SSQ[m] + SSQ[MT + m]) + (SSQ[2 * MT + m] + SSQ[3 * MT + m]);
            else { s = lane < 32 ? SSQS[(size_t)lane * MS + (m - MP)] : 0.f; s = wave_sum(s); }
            const float rs = 1.0f / sqrtf(s * (1.0f / D) + EPS);
            const u32x2* xr = (const u32x2*)(XB + (size_t)m * D); f32x4* yr = (f32x4*)(out + (size_t)m * D);
#pragma unroll
            for (int jj = 0; jj < 4; ++jj) { const u32x2 b2 = xr[lane + 64 * jj]; f32x4 v = (f32x4){bf2f(b2.x & 0xffffu), bf2f(b2.x >> 16), bf2f(b2.y & 0xffffu), bf2f(b2.y >> 16)}; yr[lane + 64 * jj] = v * rs * gn[jj]; }
        }
    }
}

extern "C" void kernel_launch(void* const* d_in, const int* in_sizes, int n_in, void* d_out, int out_size, void* d_ws, size_t ws_size, hipStream_t stream) {
    static int grid = 0;
    if (grid == 0) {
        if (n_in != 20 || (size_t)out_size != O_END || ws_size < WS_END) { fprintf(stderr, "kernel_launch: unexpected sizes n_in %d out %d ws %zu\n", n_in, out_size, ws_size); grid = -1; return; }
        int dev = 0, cus = 0, per_cu = 0;
        if (hipGetDevice(&dev) != hipSuccess || hipDeviceGetAttribute(&cus, hipDeviceAttributeMultiprocessorCount, dev) != hipSuccess) { grid = -1; return; }
        if (hipFuncSetAttribute((const void*)fwd_kernel, hipFuncAttributeMaxDynamicSharedMemorySize, LDS_BYTES) != hipSuccess) { fprintf(stderr, "kernel_launch: hipFuncSetAttribute failed\n"); grid = -1; return; }
        if (hipOccupancyMaxActiveBlocksPerMultiprocessor(&per_cu, (const void*)fwd_kernel, NTHR, LDS_BYTES) != hipSuccess || per_cu < 1) { fprintf(stderr, "kernel_launch: occupancy query says %d\n", per_cu); per_cu = 1; }
        (void)hipGetLastError();
        grid = cus;
    }
    if (grid < 0) return;
    Args a{};
    for (int i = 0; i < 20; ++i) a.in[i] = (const float*)d_in[i];
    a.out = (float*)d_out; a.ws = (unsigned char*)d_ws;
    if (hipMemsetAsync((char*)d_ws + WS_CTL, 0, 16384, stream) != hipSuccess) { fprintf(stderr, "kernel_launch: memset of the barrier words failed\n"); return; }
    hipLaunchKernelGGL(fwd_kernel, dim3(grid), dim3(NTHR), LDS_BYTES, stream, a);
    const hipError_t e = hipPeekAtLastError();
    if (e != hipSuccess) fprintf(stderr, "kernel_launch: launch failed: %s (grid %d)\n", hipGetErrorName(e), grid);
}
```

```cpp
#include <hip/hip_runtime.h>
#include <cstdio>
#include <cstdint>

#define LAS __attribute__((address_space(3)))
typedef unsigned short bf16_t;
typedef short bf16x8 __attribute__((ext_vector_type(8)));
typedef short s16x4 __attribute__((ext_vector_type(4)));
typedef float f32x2 __attribute__((ext_vector_type(2)));
typedef float f32x4 __attribute__((ext_vector_type(4)));
typedef float f32x16 __attribute__((ext_vector_type(16)));
typedef unsigned u32x2 __attribute__((ext_vector_type(2)));
typedef unsigned u32x4 __attribute__((ext_vector_type(4)));

constexpr int D = 1024, SEQ = 8192, NB = 2, MP = NB * SEQ, DB = 8, DT = 32, MS = DB * DT, MT = MP + MS;
constexpr int NH = 16, HD = 64, FF = 2816, FF2 = 5632, CA = 512, NREL = 257;
constexpr float EPS = 1e-6f, LOG2E = 1.4426950408889634f, C2 = 0.125f * LOG2E;
constexpr int NWAVES = 8, NTHR = 512;

constexpr size_t MiB = 1u << 20;
constexpr size_t WS_CTL = 0;
constexpr int CW_PANEL = 4096, CW_SPANEL = 4096 + 64 * 64;
constexpr int CW_QUEUE = 4096 + 64 * 64 + 64 * 8, CW_QUEUE0 = CW_QUEUE + 64 * 16;
constexpr size_t CTL_BYTES = 65536;
constexpr size_t WS_WQKV = 1 * MiB, WS_WO = 7 * MiB, WS_WIN = 9 * MiB, WS_WOUT = 13 * MiB, WS_WUP = 15 * MiB, WS_WDN = 37 * MiB;
constexpr size_t WUP_L = (size_t)FF2 * D * 2, WDN_L = (size_t)D * FF * 2;
constexpr size_t WS_XB = 48 * MiB + 65536;
constexpr size_t WS_Q = 82 * MiB, WS_K = 116 * MiB, WS_V = 150 * MiB;
constexpr size_t WS_G = 82 * MiB;
constexpr size_t WS_SSQ = 200 * MiB;
constexpr size_t WS_SSQV = 201 * MiB;
constexpr size_t WS_SSQS = 202 * MiB;
constexpr size_t WS_SSQVS = 202 * MiB + 65536;
constexpr size_t WS_XCH = 203 * MiB, WS_XCHS = 203 * MiB + 512 * 1024;
constexpr size_t WS_OB = 204 * MiB;
constexpr size_t WS_WSB = 237 * MiB;
constexpr size_t WS_END = 238 * MiB;

constexpr size_t O_YP = 0, O_YS = O_YP + (size_t)MP * D, O_KP = O_YS + (size_t)MS * D, O_VP = O_KP + (size_t)NB * CA * D, O_KS = O_VP + (size_t)NB * CA * D,
                 O_VS = O_KS + (size_t)MS * D, O_GV = O_VS + (size_t)MS * D, O_CP = O_GV + (size_t)MS * D, O_CS = O_CP + (size_t)2 * NB * 2 * FF2, O_END = O_CS + (size_t)2 * DB * 2 * FF2;

constexpr int RING_BYTES = 131072;
constexpr int L_XBUF = 131072, L_PTAB = 147456, L_CTAB = 151552, L_RSTAB = 159744, L_RIDER = 131072;
constexpr int L_MISC = 161792;
constexpr int LDS_BYTES = 163840;

__device__ __forceinline__ unsigned cvt_pk_bf16(float lo, float hi) { unsigned r; asm volatile("v_cvt_pk_bf16_f32 %0, %1, %2" : "=v"(r) : "v"(lo), "v"(hi)); return r; }
__device__ __forceinline__ float bf2f(unsigned h) { return __uint_as_float(h << 16); }
__device__ __forceinline__ int crow(int r, int hi) { return (r & 3) + 8 * (r >> 2) + 4 * hi; }
#define LDS_WAIT() asm volatile("s_waitcnt lgkmcnt(0)" ::: "memory")
#define VM_WAIT() asm volatile("s_waitcnt vmcnt(0)" ::: "memory")
#define RAW_BAR() do { asm volatile("s_waitcnt lgkmcnt(0)" ::: "memory"); __builtin_amdgcn_s_barrier(); asm volatile("" ::: "memory"); } while (0)
template <int CTRL> __device__ __forceinline__ float dpp_mov(float x) { return __int_as_float(__builtin_amdgcn_update_dpp(0, __float_as_int(x), CTRL, 0xf, 0xf, true)); }
__device__ __forceinline__ float sum16(float s) { s += dpp_mov<0xB1>(s); s += dpp_mov<0x4E>(s); s += dpp_mov<0x141>(s); s += dpp_mov<0x140>(s); return s; }
__device__ __forceinline__ float xsum16(float x) { auto r = __builtin_amdgcn_permlane16_swap(__float_as_uint(x), __float_as_uint(x), false, false); return __uint_as_float(r[0]) + __uint_as_float(r[1]); }
__device__ __forceinline__ float xsum32(float x) { auto r = __builtin_amdgcn_permlane32_swap(__float_as_uint(x), __float_as_uint(x), false, false); return __uint_as_float(r[0]) + __uint_as_float(r[1]); }
__device__ __forceinline__ float xmax32(float x) { auto r = __builtin_amdgcn_permlane32_swap(__float_as_uint(x), __float_as_uint(x), false, false); return __builtin_fmaxf(__uint_as_float(r[0]), __uint_as_float(r[1])); }
__device__ __forceinline__ float wave_sum(float v) { return xsum32(xsum16(sum16(v))); }
__device__ __forceinline__ f32x2 gelu_pk(f32x2 v) {
    const f32x2 av = __builtin_elementwise_abs(v), d = av * 0.2316418882f + 1.0f;
    f32x2 t; t.x = __builtin_amdgcn_rcpf(d.x); t.y = __builtin_amdgcn_rcpf(d.y);
    f32x2 q = t * 0.5307027145f + (-0.7265760135f); q = q * t + 0.7107068705f; q = q * t + (-0.142248368f); q = q * t + 0.127414796f; q = q * t;
    const f32x2 s = (v * v) * (-0.72134752044f);
    f32x2 e; e.x = __builtin_amdgcn_exp2f(s.x); e.y = __builtin_amdgcn_exp2f(s.y);
    const f32x2 m = v * (q * e), r = v - m;
    f32x2 o; o.x = v.x < 0.f ? m.x : r.x; o.y = v.y < 0.f ? m.y : r.y; return o;
}
__device__ __forceinline__ float gelu1(float x) { f32x2 r = gelu_pk((f32x2){x, x}); return r.x; }
__device__ __forceinline__ float dpp_shr1(float x) { return __int_as_float(__builtin_amdgcn_update_dpp(0, __float_as_int(x), 0x111, 0xf, 0xf, true)); }
__device__ __forceinline__ float silu1(float x) { return x * __builtin_amdgcn_rcpf(1.0f + __builtin_amdgcn_exp2f(-x * LOG2E)); }

namespace pg8 {
constexpr int BM = 256, BK = 64, HALF = 128, HTB = HALF * BK * 2, NXCD = 8;
__host__ __device__ __forceinline__ int lds_byte(int r, int c) { const int st = (r >> 4) * 2 + (c >> 5), rr = r & 15, cc = c & 31, ob = rr * 64 + cc * 2; return st * 1024 + (ob ^ (((ob >> 9) & 1) << 5)); }
__host__ __device__ __forceinline__ void stage_rc(int b, int& R, int& C) { const int st = b / 1024, sb = b % 1024, swz = sb ^ (((sb >> 9) & 1) << 5); R = (st >> 1) * 16 + swz / 64; C = (st & 1) * 32 + (swz % 64) / 2; }
__host__ __device__ __forceinline__ int perm32(int rho) { const int n = rho >> 4, i = rho & 15; return 8 * (i >> 2) + 4 * n + (i & 3); }

struct Unit { int pm, pn, arow, seq; };
struct Gemm { const bf16_t* A; const bf16_t* Bt; int K; };

struct StaticOrder {
    int nM, nN, nwg, G, c, up, WGM;
    __device__ void init(int nM_, int nN_, int G_, int c_, int up_, int wgm_) { nM = nM_; nN = nN_; nwg = nM * nN; G = G_; c = c_; up = up_; WGM = wgm_; }
    __device__ bool next(int i, Unit& u) const {
        const long L = (long)i * G + c; if (L >= nwg) return false;
        u.seq = (int)L;
        int wgid = (int)L; { const int q = nwg / NXCD, r = nwg % NXCD, xcd = wgid % NXCD, off = wgid / NXCD; wgid = (xcd < r ? xcd * (q + 1) : r * (q + 1) + (xcd - r) * q) + off; }
        const int nig = WGM * nN, gid = wgid / nig, fm = gid * WGM, gsz = (nM - fm) < WGM ? (nM - fm) : WGM;
        u.pm = fm + ((wgid % nig) % gsz); u.pn = (wgid % nig) / gsz;
        u.arow = up ? (u.pm == 66 ? MP : (u.pm / 33) * SEQ + 254 * (u.pm % 33) - 2) : u.pm * BM;
        return true;
    }
};

struct NoRider { static constexpr bool ON = false; };
template <class E, class = void> struct aperm_t { static constexpr bool v = false; };
template <class E> struct aperm_t<E, decltype((void)E::APERM)> { static constexpr bool v = E::APERM; };
template <class E> __host__ __device__ constexpr bool aperm_of() { return aperm_t<E>::v; }
template <class Epi, class Sched, class Rider = NoRider>
__device__ __forceinline__ void gemm_phase(LAS unsigned char* lds, const Gemm g, const Sched& S, const Epi& E, const int tid, const Rider R = Rider()) {
    const int wid = __builtin_amdgcn_readfirstlane(tid >> 6), lane = tid & 63, wr = wid >> 2, wc = wid & 3, fr = lane & 15, fq = lane >> 4;
    const int K = g.K, nt = K / BK;
    unsigned voffA[2], voffB[2];
#pragma unroll
    for (int i = 0; i < 2; ++i) { int R, C; stage_rc(tid * 16 + i * 8192, R, C); const int Rb = Epi::PERM ? ((R & ~31) + perm32(R & 31)) : R;
        const int Ra = aperm_of<Epi>() ? ((R & 64) + 4 * (R & 15) + ((R >> 4) & 3)) : R;
        voffA[i] = (unsigned)(Ra * K + C) * 2u; voffB[i] = (unsigned)(Rb * K + C) * 2u; }
    const size_t kstep = (size_t)(BK * 2);
    const size_t hstep = (size_t)HALF * K * 2;
    const size_t tstep = 2 * hstep;
    const size_t rstep = (size_t)K * 2;
    const unsigned ldsw = (unsigned)wid * 1024u, ldsu = (unsigned)(uintptr_t)lds;
    const int aoff = lds_byte(wr * 64 + fr, fq * 8), boff = lds_byte(wc * 32 + fr, fq * 8);
#define PG8_SA(b, h) (((b) * 2 + (h)) * HTB)
#define PG8_SB(b, h) ((4 + (b) * 2 + (h)) * HTB)
#define PG8_GLDS(voff_, sbase_, ldsdst_) do { unsigned keep_; asm volatile("s_mov_b32 %0, m0\n\ts_mov_b32 m0, %3\n\ts_nop 0\n\tglobal_load_lds_dwordx4 %1, %2\n\ts_mov_b32 m0, %0" \
        : "=&s"(keep_) : "v"(voff_), "s"(sbase_), "s"(ldsdst_) : "memory"); } while (0)
#define PG8_STAGE(bufoff, gbase, voff) do { const char* sb_ = (const char*)(gbase); _Pragma("unroll") for (int _i = 0; _i < 2; ++_i) \
        PG8_GLDS((voff)[_i], sb_, (unsigned)__builtin_amdgcn_readfirstlane((int)(ldsu + (unsigned)(bufoff) + ldsw + (unsigned)(_i * 8192)))); } while (0)
#define PG8_LDA(dst, b, h) do { _Pragma("unroll") for (int m = 0; m < 4; ++m) _Pragma("unroll") for (int k = 0; k < 2; ++k) dst[m][k] = *(const LAS bf16x8*)(lds + PG8_SA(b, h) + aoff + m * 2048 + k * 1024); } while (0)
#define PG8_LDB(dst, b, h) do { _Pragma("unroll") for (int n = 0; n < 2; ++n) _Pragma("unroll") for (int k = 0; k < 2; ++k) dst[n][k] = *(const LAS bf16x8*)(lds + PG8_SB(b, h) + boff + n * 2048 + k * 1024); } while (0)
#define PG8_MMA(ai, bj, At, Bt) do { __builtin_amdgcn_s_setprio(1); _Pragma("unroll") for (int m = 0; m < 4; ++m) _Pragma("unroll") for (int n = 0; n < 2; ++n) _Pragma("unroll") for (int k = 0; k < 2; ++k) \
        acc[ai][bj][m][n] = __builtin_amdgcn_mfma_f32_16x16x32_bf16(Bt[n][k], At[m][k], acc[ai][bj][m][n], 0, 0, 0); __builtin_amdgcn_s_setprio(0); } while (0)
#define PG8_WAIT_V(n) asm volatile("s_waitcnt vmcnt(" #n ")" ::: "memory")
#define PG8_WAIT_L(n) asm volatile("s_waitcnt lgkmcnt(" #n ")" ::: "memory")
#define PG8_BAR __builtin_amdgcn_s_barrier()
#define PG8_SCHED __builtin_amdgcn_sched_barrier(0)
    Unit cur, nxt; int ui = 0;
    if (!S.next(0, cur)) return;
    f32x4 acc[2][2][4][2];
    u32x4 xin[2][4][2];
    if constexpr (Epi::INIT) E.init_load(xin, cur, wr, wc, fr, fq);
    E.first(cur, lds, tid);
    f32x16 racc; const char* rpa = nullptr; const char* rpb = nullptr; unsigned rvoff = 0u;
    if constexpr (Rider::ON) {
#pragma unroll
        for (int r = 0; r < 16; ++r) racc[r] = 0.f;
        rvoff = (unsigned)(((lane & 31) * Rider::K + (lane >> 5) * 8) * 2);
        R.ptrs(cur.seq, wid, rpa, rpb); }
    bf16x8 At[4][2], B0[2][2], B1[2][2];
    const char* cA = (const char*)g.A + (ptrdiff_t)cur.arow * (ptrdiff_t)rstep; const char* cB = (const char*)g.Bt + (size_t)cur.pn * tstep;
    PG8_STAGE(PG8_SB(0, 0), cB, voffB); PG8_STAGE(PG8_SB(0, 1), cB + hstep, voffB); PG8_STAGE(PG8_SA(0, 0), cA, voffA); PG8_STAGE(PG8_SA(0, 1), cA + hstep, voffA);
#pragma unroll
    for (int a = 0; a < 2; ++a)
#pragma unroll
        for (int m = 0; m < 4; ++m)
#pragma unroll
            for (int b = 0; b < 2; ++b) {
                if constexpr (Epi::INIT) { const u32x4 x4 = xin[a][m][b];
                    acc[a][b][m][0] = (f32x4){bf2f(x4.x & 0xffffu), bf2f(x4.x >> 16), bf2f(x4.y & 0xffffu), bf2f(x4.y >> 16)};
                    acc[a][b][m][1] = (f32x4){bf2f(x4.z & 0xffffu), bf2f(x4.z >> 16), bf2f(x4.w & 0xffffu), bf2f(x4.w >> 16)}; }
                else { acc[a][b][m][0] = (f32x4){0.f, 0.f, 0.f, 0.f}; acc[a][b][m][1] = (f32x4){0.f, 0.f, 0.f, 0.f}; } }
    if (wr == 1) PG8_BAR;
    PG8_WAIT_V(2); PG8_BAR;
    PG8_STAGE(PG8_SB(1, 0), cB + kstep, voffB); PG8_STAGE(PG8_SA(1, 0), cA + kstep, voffA); PG8_STAGE(PG8_SB(1, 1), cB + hstep + kstep, voffB);
    PG8_WAIT_V(6); PG8_BAR;
    for (;;) {
        const bool has_next = S.next(ui + 1, nxt);
        const char* nA = has_next ? (const char*)g.A + (ptrdiff_t)nxt.arow * (ptrdiff_t)rstep : cA; const char* nB = has_next ? (const char*)g.Bt + (size_t)nxt.pn * tstep : cB;
        for (int t = 0; t < nt; t += 2) {
            const bool last = (t == nt - 2);
            const char* a1 = cA + (size_t)(t + 1) * kstep;
            const char* a2 = last ? nA : cA + (size_t)(t + 2) * kstep; const char* b2 = last ? nB : cB + (size_t)(t + 2) * kstep;
            const char* a3 = a2 + kstep; const char* b3 = b2 + kstep;
            bf16x8 ra, rb;
            if constexpr (Rider::ON) { const char* pa_ = rpa + (size_t)t * 16; const char* pb_ = rpb + (size_t)t * 16;
                asm volatile("s_nop 4\n\tglobal_load_dwordx4 %0, %2, %3\n\tglobal_load_dwordx4 %1, %2, %4" : "=&v"(ra), "=&v"(rb) : "v"(rvoff), "s"(pa_), "s"(pb_) : "memory"); }
            PG8_LDB(B0, 0, 0); PG8_LDB(B1, 0, 1); PG8_SCHED; PG8_LDA(At, 0, 0); PG8_STAGE(PG8_SA(1, 1), a1 + hstep, voffA);
            if constexpr (Rider::ON) PG8_WAIT_V(10); else PG8_WAIT_V(8);
            PG8_WAIT_L(0); PG8_BAR; PG8_MMA(0, 0, At, B0); PG8_MMA(0, 1, At, B1); PG8_BAR; PG8_SCHED;
            PG8_LDA(At, 0, 1); PG8_STAGE(PG8_SB(0, 0), b2, voffB); PG8_STAGE(PG8_SB(0, 1), b2 + hstep, voffB); PG8_STAGE(PG8_SA(0, 0), a2, voffA);
            PG8_WAIT_V(8); if constexpr (Rider::ON) asm volatile("" : "+v"(ra), "+v"(rb)); PG8_WAIT_L(0); PG8_BAR; PG8_MMA(1, 0, At, B0); PG8_MMA(1, 1, At, B1); PG8_BAR; PG8_SCHED;
            PG8_LDB(B0, 1, 0); PG8_LDB(B1, 1, 1); PG8_SCHED; PG8_LDA(At, 1, 0); PG8_STAGE(PG8_SA(0, 1), a2 + hstep, voffA);
            PG8_WAIT_V(8); PG8_WAIT_L(0); PG8_BAR; PG8_MMA(0, 0, At, B0); PG8_MMA(0, 1, At, B1); PG8_BAR; PG8_SCHED;
            PG8_LDA(At, 1, 1); PG8_STAGE(PG8_SB(1, 0), b3, voffB); PG8_STAGE(PG8_SB(1, 1), b3 + hstep, voffB); PG8_STAGE(PG8_SA(1, 0), a3, voffA);
            PG8_WAIT_V(8); PG8_WAIT_L(0); PG8_BAR; PG8_MMA(1, 0, At, B0); PG8_MMA(1, 1, At, B1);
            if constexpr (Rider::ON) racc = __builtin_amdgcn_mfma_f32_32x32x16_bf16(ra, rb, racc, 0, 0, 0);
            PG8_BAR; PG8_SCHED;
        }
        if (wr == 0) PG8_BAR;
        E(acc, cur, nxt, has_next, ui & 1, wr, wc, fr, fq, lds, tid);
        if constexpr (Rider::ON) { R.finish(racc, cur.seq, lds, tid);
#pragma unroll
            for (int r = 0; r < 16; ++r) racc[r] = 0.f;
            if (has_next) R.ptrs(nxt.seq, wid, rpa, rpb); }
        if (!has_next) break;
        if constexpr (Epi::INIT) E.init_load(xin, nxt, wr, wc, fr, fq);
#pragma unroll
        for (int a = 0; a < 2; ++a)
#pragma unroll
            for (int m = 0; m < 4; ++m)
#pragma unroll
                for (int b = 0; b < 2; ++b) {
                    if constexpr (Epi::INIT) { const u32x4 x4 = xin[a][m][b];
                        acc[a][b][m][0] = (f32x4){bf2f(x4.x & 0xffffu), bf2f(x4.x >> 16), bf2f(x4.y & 0xffffu), bf2f(x4.y >> 16)};
                        acc[a][b][m][1] = (f32x4){bf2f(x4.z & 0xffffu), bf2f(x4.z >> 16), bf2f(x4.w & 0xffffu), bf2f(x4.w >> 16)}; }
                    else { acc[a][b][m][0] = (f32x4){0.f, 0.f, 0.f, 0.f}; acc[a][b][m][1] = (f32x4){0.f, 0.f, 0.f, 0.f}; } }
        cur = nxt; cA = nA; cB = nB; ++ui;
        if (wr == 1) PG8_BAR;
    }
    PG8_WAIT_V(0);
    PG8_BAR;
#undef PG8_SA
#undef PG8_SB
#undef PG8_STAGE
#undef PG8_GLDS
#undef PG8_LDA
#undef PG8_LDB
#undef PG8_MMA
#undef PG8_WAIT_V
#undef PG8_WAIT_L
#undef PG8_BAR
#undef PG8_SCHED
}
}

typedef f32x4 AccT[2][2][4][2];

__device__ __forceinline__ float rs_issue(const float* ssq, int tok0, int tid) {
    float s = 0.f;
    if (tid < 256) { int tok = tok0 + tid; tok = tok < 0 ? 0 : (tok >= MT ? MT - 1 : tok); s = (ssq[tok] + ssq[MT + tok]) + (ssq[2 * MT + tok] + ssq[3 * MT + tok]); }
    return s;
}
__device__ __forceinline__ void rs_commit(LAS unsigned char* lds, int slot, float s, int tid) { if (tid < 256) ((LAS float*)(lds + L_RSTAB))[slot * 256 + tid] = 1.0f / sqrtf(s * (1.0f / D) + EPS); }

struct EpiQKV {
    static constexpr bool PERM = true, INIT = false;
    bf16_t* O; size_t split_stride; const float* ssq; float* okp; float* ovp;
    __device__ __forceinline__ void first(const pg8::Unit& u, LAS unsigned char* lds, int tid) const { rs_commit(lds, 0, rs_issue(ssq, u.pm * 256, tid), tid); RAW_BAR(); }
    __device__ __forceinline__ void operator()(const AccT& acc, const pg8::Unit& u, const pg8::Unit& nx, bool has_next, int slot, int wr, int wc, int fr0, int fq0, LAS unsigned char* lds, int tid0) const {
        int fr = fr0, fq = fq0, tid = tid0; asm volatile("" : "+v"(fr), "+v"(fq), "+v"(tid));
        float sn = 0.f; if (has_next) sn = rs_issue(ssq, nx.pm * 256, tid);
        const LAS float* rst = (const LAS float*)(lds + L_RSTAB) + slot * 256;
        const int t = u.pn >> 2, colt = (u.pn & 3) * 256; bf16_t* base = O + (size_t)t * split_stride; const float sc = (t == 0) ? C2 : 1.0f;
        const bool side = (t >= 1) && ((u.pm & 31) >= 30);
        float* sp = (t == 1 ? okp : ovp) + ((size_t)((u.pm >> 5) * CA + (u.pm & 1) * 256)) * D;
        const int col0 = colt + wc * 32 + 8 * fq;
#pragma unroll
        for (int ai = 0; ai < 2; ++ai)
#pragma unroll
            for (int m = 0; m < 4; ++m) { const int r = ai * 128 + wr * 64 + m * 16 + fr; const float rs = rst[r] * sc; bf16_t* rowp = base + (size_t)(u.pm * 256 + r) * D + col0;
#pragma unroll
                for (int bj = 0; bj < 2; ++bj) { const f32x4 v0 = acc[ai][bj][m][0] * rs, v1 = acc[ai][bj][m][1] * rs;
                    u32x4 w; w.x = cvt_pk_bf16(v0[0], v0[1]); w.y = cvt_pk_bf16(v0[2], v0[3]); w.z = cvt_pk_bf16(v1[0], v1[1]); w.w = cvt_pk_bf16(v1[2], v1[3]);
                    *(u32x4*)(rowp + bj * 128) = w;
                    if (side) { float* s = sp + (size_t)r * D + col0 + bj * 128; *(f32x4*)s = v0; *(f32x4*)(s + 4) = v1; } } }
        if (has_next) rs_commit(lds, slot ^ 1, sn, tid);
    }
};

__device__ __forceinline__ void res_init_load(u32x4 (&xin)[2][4][2], const bf16_t* xb, const pg8::Unit& u, int wr, int wc, int fr0, int fq0) {
    int fr = fr0, fq = fq0; asm volatile("" : "+v"(fr), "+v"(fq));
    const int col0 = u.pn * 256 + wc * 32 + 8 * fq;
#pragma unroll
    for (int ai = 0; ai < 2; ++ai)
#pragma unroll
        for (int m = 0; m < 4; ++m) { const size_t off = (size_t)(u.pm * 256 + ai * 128 + wr * 64 + m * 16 + fr) * D + col0;
#pragma unroll
            for (int bj = 0; bj < 2; ++bj) xin[ai][m][bj] = *(const u32x4*)(xb + off + bj * 128); }
}
struct EpiRes {
    static constexpr bool PERM = true, INIT = true;
    const bf16_t* xb; bf16_t* xo; float* ssq;
    __device__ __forceinline__ void first(const pg8::Unit&, LAS unsigned char*, int) const {}
    __device__ __forceinline__ void init_load(u32x4 (&xin)[2][4][2], const pg8::Unit& u, int wr, int wc, int fr, int fq) const { res_init_load(xin, xb, u, wr, wc, fr, fq); }
    __device__ __forceinline__ void operator()(const AccT& acc, const pg8::Unit& u, const pg8::Unit&, bool, int, int wr, int wc, int fr0, int fq0, LAS unsigned char* lds, int tid0) const {
        int fr = fr0, fq = fq0, tid = tid0; asm volatile("" : "+v"(fr), "+v"(fq), "+v"(tid));
        LAS float* P = (LAS float*)(lds + L_PTAB);
        const int col0 = u.pn * 256 + wc * 32 + 8 * fq;
#pragma unroll
        for (int ai = 0; ai < 2; ++ai)
#pragma unroll
            for (int m = 0; m < 4; ++m) { const int r = ai * 128 + wr * 64 + m * 16 + fr; const size_t off = (size_t)(u.pm * 256 + r) * D + col0; float s = 0.f;
#pragma unroll
                for (int bj = 0; bj < 2; ++bj) { const f32x4 a0 = acc[ai][bj][m][0], a1 = acc[ai][bj][m][1];
                    s += ((a0[0] * a0[0] + a0[1] * a0[1]) + (a0[2] * a0[2] + a0[3] * a0[3])) + ((a1[0] * a1[0] + a1[1] * a1[1]) + (a1[2] * a1[2] + a1[3] * a1[3]));
                    u32x4 w; w.x = cvt_pk_bf16(a0[0], a0[1]); w.y = cvt_pk_bf16(a0[2], a0[3]); w.z = cvt_pk_bf16(a1[0], a1[1]); w.w = cvt_pk_bf16(a1[2], a1[3]); *(u32x4*)(xo + off + bj * 128) = w; }
                s = xsum32(xsum16(s));
                if (fq == 0) P[r * 4 + wc] = s; }
        RAW_BAR();
        if (tid < 256) { const f32x4 p = *(const LAS f32x4*)(P + tid * 4); ssq[(size_t)u.pn * MT + u.pm * 256 + tid] = (p[0] + p[1]) + (p[2] + p[3]); }
    }
};

__device__ __forceinline__ void wait_count(unsigned* cnt, unsigned want, int tid) {
    if (tid == 0) { unsigned sp = 0;
        while (__hip_atomic_load(cnt, __ATOMIC_RELAXED, __HIP_MEMORY_SCOPE_AGENT) < want) { __builtin_amdgcn_s_sleep(2); if (++sp > (1u << 22)) break; }
        __builtin_amdgcn_fence(__ATOMIC_ACQUIRE, "agent"); }
    asm volatile("s_waitcnt vmcnt(0)" ::: "memory");
    RAW_BAR();
}
struct EpiFinal {
    static constexpr bool PERM = true, INIT = true;
    const bf16_t* xb; float* out; float* ssq; unsigned* cnt; const float* gfin;
    __device__ __forceinline__ void first(const pg8::Unit&, LAS unsigned char*, int) const {}
    __device__ __forceinline__ void init_load(u32x4 (&xin)[2][4][2], const pg8::Unit& u, int wr, int wc, int fr, int fq) const { res_init_load(xin, xb, u, wr, wc, fr, fq); }
    __device__ __forceinline__ void operator()(AccT& acc, const pg8::Unit& u, const pg8::Unit&, bool, int, int wr, int wc, int fr0, int fq0, LAS unsigned char* lds, int tid0) const {
        int fr = fr0, fq = fq0, tid = tid0; asm volatile("" : "+v"(fr), "+v"(fq), "+v"(tid));
        LAS float* P = (LAS float*)(lds + L_PTAB); LAS float* rst = (LAS float*)(lds + L_RSTAB);
        const int col0 = u.pn * 256 + wc * 32 + 8 * fq;
#pragma unroll
        for (int ai = 0; ai < 2; ++ai)
#pragma unroll
            for (int m = 0; m < 4; ++m) { const int r = ai * 128 + wr * 64 + m * 16 + fr; float s = 0.f;
#pragma unroll
                for (int bj = 0; bj < 2; ++bj) { const f32x4 a0 = acc[ai][bj][m][0], a1 = acc[ai][bj][m][1];
                    s += ((a0[0] * a0[0] + a0[1] * a0[1]) + (a0[2] * a0[2] + a0[3] * a0[3])) + ((a1[0] * a1[0] + a1[1] * a1[1]) + (a1[2] * a1[2] + a1[3] * a1[3])); }
                s = xsum32(xsum16(s));
                if (fq == 0) P[r * 4 + wc] = s; }
        RAW_BAR();
        if (tid < 256) { const f32x4 p = *(const LAS f32x4*)(P + tid * 4);
            __hip_atomic_store(ssq + (size_t)u.pn * MT + u.pm * 256 + tid, (p[0] + p[1]) + (p[2] + p[3]), __ATOMIC_RELAXED, __HIP_MEMORY_SCOPE_AGENT); }
        asm volatile("s_waitcnt vmcnt(0)" ::: "memory");
        RAW_BAR();
        if (tid == 0) __hip_atomic_fetch_add(cnt + 64 * u.pm, 1u, __ATOMIC_RELAXED, __HIP_MEMORY_SCOPE_AGENT);
        wait_count(cnt + 64 * u.pm, 4u, tid);
        if (tid < 256) { float s = 0.f;
#pragma unroll
            for (int t = 0; t < 4; ++t) s += __hip_atomic_load(ssq + (size_t)t * MT + u.pm * 256 + tid, __ATOMIC_RELAXED, __HIP_MEMORY_SCOPE_AGENT);
            rst[tid] = 1.0f / sqrtf(s * (1.0f / D) + EPS); }
        RAW_BAR();
        f32x4 gv[2][2];
#pragma unroll
        for (int bj = 0; bj < 2; ++bj)
#pragma unroll
            for (int n = 0; n < 2; ++n) gv[bj][n] = *(const f32x4*)(gfin + col0 + bj * 128 + n * 4);
#pragma unroll
        for (int ai = 0; ai < 2; ++ai)
#pragma unroll
            for (int m = 0; m < 4; ++m) { const int r = ai * 128 + wr * 64 + m * 16 + fr; const float rs = rst[r]; const size_t off = (size_t)(u.pm * 256 + r) * D + col0;
#pragma unroll
                for (int bj = 0; bj < 2; ++bj)
#pragma unroll
                    for (int n = 0; n < 2; ++n) *(f32x4*)(out + off + bj * 128 + n * 4) = acc[ai][bj][m][n] * rs * gv[bj][n]; }
    }
};

struct EpiIn {
    static constexpr bool PERM = true, INIT = false;
    bf16_t* O; size_t split_stride; const float* ssq; float* ssqv;
    __device__ __forceinline__ void first(const pg8::Unit& u, LAS unsigned char* lds, int tid) const { rs_commit(lds, 0, rs_issue(ssq, u.pm * 256, tid), tid); RAW_BAR(); }
    __device__ __forceinline__ void operator()(const AccT& acc, const pg8::Unit& u, const pg8::Unit& nx, bool has_next, int slot, int wr, int wc, int fr0, int fq0, LAS unsigned char* lds, int tid0) const {
        int fr = fr0, fq = fq0, tid = tid0; asm volatile("" : "+v"(fr), "+v"(fq), "+v"(tid));
        float sn = 0.f; if (has_next) sn = rs_issue(ssq, nx.pm * 256, tid);
        const LAS float* rst = (const LAS float*)(lds + L_RSTAB) + slot * 256; LAS float* P = (LAS float*)(lds + L_PTAB);
        const int t = u.pn >> 2, colt = (u.pn & 3) * 256; bf16_t* base = O + (size_t)t * split_stride;
        const int col0 = colt + wc * 32 + 8 * fq;
#pragma unroll
        for (int ai = 0; ai < 2; ++ai)
#pragma unroll
            for (int m = 0; m < 4; ++m) { const int r = ai * 128 + wr * 64 + m * 16 + fr; const float rs = rst[r]; bf16_t* rowp = base + (size_t)(u.pm * 256 + r) * D + col0; float s = 0.f;
#pragma unroll
                for (int bj = 0; bj < 2; ++bj) { const f32x4 x0 = acc[ai][bj][m][0] * rs, x1 = acc[ai][bj][m][1] * rs;
                    const f32x2 a = gelu_pk((f32x2){x0[0], x0[1]}), b = gelu_pk((f32x2){x0[2], x0[3]}), c = gelu_pk((f32x2){x1[0], x1[1]}), d = gelu_pk((f32x2){x1[2], x1[3]});
                    s += (a.x * a.x + a.y * a.y) + (b.x * b.x + b.y * b.y) + (c.x * c.x + c.y * c.y) + (d.x * d.x + d.y * d.y);
                    u32x4 w; w.x = cvt_pk_bf16(a.x, a.y); w.y = cvt_pk_bf16(b.x, b.y); w.z = cvt_pk_bf16(c.x, c.y); w.w = cvt_pk_bf16(d.x, d.y);
                    *(u32x4*)(rowp + bj * 128) = w; }
                if (t == 1) { s = xsum32(xsum16(s)); if (fq == 0) P[r * 4 + wc] = s; } }
        if (t == 1) { RAW_BAR();
            if (tid < 256) { const f32x4 p = *(const LAS f32x4*)(P + tid * 4); ssqv[(size_t)(u.pn & 3) * MT + u.pm * 256 + tid] = (p[0] + p[1]) + (p[2] + p[3]); } }
        if (has_next) rs_commit(lds, slot ^ 1, sn, tid);
    }
};

__device__ __forceinline__ void conv_dpp(f32x4& o, const f32x4 cur, const f32x4 prv, const f32x4 w1, const f32x4 w0) {
#define CONV1(e) "v_fmac_f32_dpp %" #e ", %[c" #e "], %[a" #e "] row_shr:1 row_mask:0xf bank_mask:0xf bound_ctrl:1\n\t" \
                 "v_fmac_f32_dpp %" #e ", %[p" #e "], %[a" #e "] row_shl:15 row_mask:0xf bank_mask:0xf bound_ctrl:1\n\t" \
                 "v_fmac_f32_dpp %" #e ", %[c" #e "], %[b" #e "] row_shr:2 row_mask:0xf bank_mask:0xf bound_ctrl:1\n\t" \
                 "v_fmac_f32_dpp %" #e ", %[p" #e "], %[b" #e "] row_shl:14 row_mask:0xf bank_mask:0xf bound_ctrl:1\n\t"
    float o0 = o[0], o1 = o[1], o2 = o[2], o3 = o[3];
    asm("s_nop 1\n\t" CONV1(0) CONV1(1) CONV1(2) CONV1(3)
        : "+v"(o0), "+v"(o1), "+v"(o2), "+v"(o3)
        : [c0] "v"(cur[0]), [c1] "v"(cur[1]), [c2] "v"(cur[2]), [c3] "v"(cur[3]), [p0] "v"(prv[0]), [p1] "v"(prv[1]), [p2] "v"(prv[2]), [p3] "v"(prv[3]),
          [a0] "v"(w1[0]), [a1] "v"(w1[1]), [a2] "v"(w1[2]), [a3] "v"(w1[3]), [b0] "v"(w0[0]), [b1] "v"(w0[1]), [b2] "v"(w0[2]), [b3] "v"(w0[3]));
    o = (f32x4){o0, o1, o2, o3};
#undef CONV1
}

struct EpiUp {
    static constexpr bool PERM = true, INIT = false, APERM = true;
    bf16_t* G; const float* ssq; const float* ssqs; const float* cw; const float* cb; float* ocp; const float* hist; float* ocs;
    __device__ __forceinline__ float rs_iss(const pg8::Unit& u, int tid) const {
        if (u.pm != 66) return rs_issue(ssq, u.arow, tid);
        float s = 0.f;
        if (tid < 256) {
#pragma unroll 8
            for (int jj = 0; jj < 32; ++jj) s += ssqs[(size_t)jj * MS + tid]; }
        return s;
    }
    __device__ __forceinline__ f32x2 ct_iss(const pg8::Unit& u, int tid) const {
        const int c = tid & 255, wh = tid >> 8, oc = (c >> 7) * FF + u.pn * 128 + (c & 127);
        f32x2 r; r.x = cw[(size_t)wh * FF2 + oc]; r.y = wh == 0 ? cw[(size_t)2 * FF2 + oc] : cb[oc]; return r;
    }
    __device__ __forceinline__ void ct_commit(LAS unsigned char* lds, int slot, f32x2 v, int tid) const {
        LAS float* ct = (LAS float*)(lds + L_CTAB) + slot * 1024; const int c = tid & 255, wh = tid >> 8;
        const float sc = (c >> 7) ? -1.0f / LOG2E : -LOG2E;
        ct[wh * 256 + c] = v.x * sc; ct[(wh == 0 ? 2 : 3) * 256 + c] = v.y * sc;
    }
    __device__ __forceinline__ void first(const pg8::Unit& u, LAS unsigned char* lds, int tid) const { rs_commit(lds, 0, rs_iss(u, tid), tid); ct_commit(lds, 0, ct_iss(u, tid), tid); RAW_BAR(); }
    __device__ __forceinline__ void operator()(AccT& acc, const pg8::Unit& u, const pg8::Unit& nx, bool has_next, int slot, int wr, int wc, int fr0, int fq0, LAS unsigned char* lds, int tid0) const {
        int fr = fr0, fq = fq0, tid = tid0; asm volatile("" : "+v"(fr), "+v"(fq), "+v"(tid));
        float sn = 0.f; f32x2 cn = (f32x2){0.f, 0.f};
        if (has_next) { sn = rs_iss(nx, tid); cn = ct_iss(nx, tid); }
        const bool smp = u.pm == 66;
        const int b = u.pm / 33, j = smp ? 1 : u.pm % 33, tok0 = u.arow;
        const LAS float* rst = (const LAS float*)(lds + L_RSTAB) + slot * 256; LAS float* xbuf = (LAS float*)(lds + L_XBUF); const LAS float* ct = (const LAS float*)(lds + L_CTAB) + slot * 1024;
#pragma unroll
        for (int ai = 0; ai < 2; ++ai) { const f32x4 rs4 = *(const LAS f32x4*)(rst + ai * 128 + wr * 64 + 4 * fr);
#pragma unroll
            for (int m = 0; m < 4; ++m)
#pragma unroll
                for (int bj = 0; bj < 2; ++bj)
#pragma unroll
                    for (int n = 0; n < 2; ++n) acc[ai][bj][m][n] *= rs4[m]; }
        if (j == 0 && wr == 0 && fr == 0) {
#pragma unroll
            for (int bj = 0; bj < 2; ++bj)
#pragma unroll
                for (int n = 0; n < 2; ++n) { acc[0][bj][0][n] = (f32x4){0.f, 0.f, 0.f, 0.f}; acc[0][bj][1][n] = (f32x4){0.f, 0.f, 0.f, 0.f}; } }
        const int cl = wc * 32 + 8 * fq;
        if (j == 32 && wr == 1 && fr == 0) {
#pragma unroll
            for (int r = 0; r < 2; ++r)
#pragma unroll
                for (int bj = 0; bj < 2; ++bj)
#pragma unroll
                    for (int n = 0; n < 2; ++n) *(f32x4*)(ocp + (size_t)(b * 2 + r) * FF2 + bj * FF + u.pn * 128 + cl + 4 * n) = acc[0][bj][r][n]; }
        if (smp && (fr & 7) == 7) {
            const int cl_ = cl;
#pragma unroll
            for (int ai = 0; ai < 2; ++ai)
#pragma unroll
                for (int r = 0; r < 2; ++r)
#pragma unroll
                    for (int bj = 0; bj < 2; ++bj)
#pragma unroll
                        for (int n = 0; n < 2; ++n) *(f32x4*)(ocs + (size_t)((2 * (2 * ai + wr) + (fr >> 3)) * 2 + r) * FF2 + bj * FF + u.pn * 128 + cl_ + 4 * n) = acc[ai][bj][2 + r][n]; }
        if (!smp) {
            if (fr == 15) {
#pragma unroll
                for (int ai = 0; ai < 2; ++ai)
                    if (2 * ai + wr < 3) {
#pragma unroll
                        for (int r = 0; r < 2; ++r)
#pragma unroll
                            for (int bj = 0; bj < 2; ++bj)
#pragma unroll
                                for (int n = 0; n < 2; ++n) *(LAS f32x4*)(xbuf + ((2 * (2 * ai + wr + 1)) * 2 + r) * 256 + bj * 128 + cl + 4 * n) = acc[ai][bj][2 + r][n]; } }
        } else if (fr >= 14) {
#pragma unroll 1
            for (int q4 = 0; q4 < 4; ++q4) { const int q = (q4 >> 1) * 4 + wr * 2 + (q4 & 1);
#pragma unroll 1
                for (int bj = 0; bj < 2; ++bj) { const f32x4 h0 = *(const f32x4*)(hist + (size_t)(q * 2 + (fr - 14)) * FF2 + bj * FF + u.pn * 128 + cl), h1 = *(const f32x4*)(hist + (size_t)(q * 2 + (fr - 14)) * FF2 + bj * FF + u.pn * 128 + cl + 4);
                    *(LAS f32x4*)(xbuf + (q * 2 + (fr - 14)) * 256 + bj * 128 + cl) = h0; *(LAS f32x4*)(xbuf + (q * 2 + (fr - 14)) * 256 + bj * 128 + cl + 4) = h1; } }
        }
        RAW_BAR();
        const int bend = smp ? MT : (b + 1) * SEQ;
        const bool edge = smp ? ((fr & 7) == 0) : (fr == 0);
        const int hq = smp ? (fr >> 3) : 0;
        u32x2 wlo[2][4];
#pragma unroll
        for (int n = 0; n < 2; ++n) {
            f32x4 w0[2], w1[2], w2[2], cbv[2];
#pragma unroll
            for (int bj = 0; bj < 2; ++bj) { const int tc = bj * 128 + cl + 4 * n;
                w0[bj] = *(const LAS f32x4*)(ct + tc); w1[bj] = *(const LAS f32x4*)(ct + 256 + tc); w2[bj] = *(const LAS f32x4*)(ct + 512 + tc); cbv[bj] = *(const LAS f32x4*)(ct + 768 + tc); }
#pragma unroll
            for (int ai = 0; ai < 2; ++ai) {
                f32x4 c[4][2];
#pragma unroll
                for (int bj = 0; bj < 2; ++bj) {
                    const f32x4 a0 = acc[ai][bj][0][n], a1 = acc[ai][bj][1][n], a2 = acc[ai][bj][2][n], a3 = acc[ai][bj][3][n];
                    const LAS float* hp = xbuf + ((2 * (2 * ai + wr) + hq) * 2) * 256 + bj * 128 + cl + 4 * n;
                    const f32x4 h2 = *(const LAS f32x4*)hp, h1 = *(const LAS f32x4*)(hp + 256);
                    f32x4 s1, s2;
#pragma unroll
                    for (int e = 0; e < 4; ++e) { const float t1 = dpp_shr1(a3[e]), t2 = dpp_shr1(a2[e]); s1[e] = edge ? h1[e] : t1; s2[e] = edge ? h2[e] : t2; }
                    c[3][bj] = cbv[bj] + w2[bj] * a3 + w1[bj] * a2 + w0[bj] * a1;
                    c[2][bj] = cbv[bj] + w2[bj] * a2 + w1[bj] * a1 + w0[bj] * a0;
                    c[1][bj] = cbv[bj] + w2[bj] * a1 + w1[bj] * a0 + w0[bj] * s1;
                    c[0][bj] = cbv[bj] + w2[bj] * a0 + w1[bj] * s1 + w0[bj] * s2; }
#pragma unroll
                for (int m = 0; m < 4; ++m) {
                    const int tr = ai * 128 + wr * 64 + 4 * fr + m, tok = tok0 + tr;
                    u32x2 w;
                    const f32x4 t_ = c[m][0]; f32x4 e_ = (f32x4){__builtin_amdgcn_exp2f(t_[0]), __builtin_amdgcn_exp2f(t_[1]), __builtin_amdgcn_exp2f(t_[2]), __builtin_amdgcn_exp2f(t_[3])};
                    e_ += 1.0f; const f32x4 r_ = (f32x4){__builtin_amdgcn_rcpf(e_[0]), __builtin_amdgcn_rcpf(e_[1]), __builtin_amdgcn_rcpf(e_[2]), __builtin_amdgcn_rcpf(e_[3])};
                    const f32x4 g_ = (t_ * c[m][1]) * r_;
                    w.x = cvt_pk_bf16(g_[0], g_[1]); w.y = cvt_pk_bf16(g_[2], g_[3]);
                    if (n == 0) wlo[ai][m] = w;
                    else if ((smp || tr >= 2) && tok < bend) { const u32x2 w0_ = wlo[ai][m]; *(u32x4*)(G + (size_t)tok * FF + u.pn * 128 + cl) = (u32x4){w0_.x, w0_.y, w.x, w.y}; }
                }
            }
        }
        if (has_next) { rs_commit(lds, slot ^ 1, sn, tid); ct_commit(lds, slot ^ 1, cn, tid); }
    }
};

__device__ __forceinline__ float srs_load(const float* ssqs, int mt, int tid) { const int row = tid >> 4, jj = tid & 15; return ssqs[(size_t)jj * MS + mt * 32 + row] + ssqs[(size_t)(jj + 16) * MS + mt * 32 + row]; }
__device__ __forceinline__ float srs_finish(float s) { s = sum16(s); return 1.0f / sqrtf(s * (1.0f / D) + EPS); }

template <int K_, int NTN, class SEpi> struct SampleRider {
    static constexpr bool ON = true; static constexpr int K = K_;
    const bf16_t* A; const bf16_t* Bt; SEpi epi;
    __device__ __forceinline__ void ptrs(int seq, int wid, const char*& pa, const char*& pb) const {
        const int mt = seq / NTN, nt = seq % NTN;
        pa = (const char*)(A + ((size_t)(MP + 32 * mt) * K + wid * (K / 8)));
        pb = (const char*)(Bt + ((size_t)(32 * nt) * K + wid * (K / 8)));
    }
    __device__ __forceinline__ void finish(const f32x16& racc, int seq, LAS unsigned char* lds, int tid0) const {
        int tid = tid0; asm volatile("" : "+v"(tid));
        const int lane = tid & 63, r32 = lane & 31, hi = lane >> 5, w = tid >> 6, mt = seq / NTN, nt = seq % NTN;
        const float pre = epi.pre(mt, nt, tid);
#define RSLOT(i) ((LAS float*)(lds + ((i) < 4 ? L_XBUF + (i) * 4096 : L_CTAB + ((i) - 4) * 4096)))
        if (w < 6) { LAS float* part = RSLOT(w);
#pragma unroll
            for (int r = 0; r < 16; ++r) part[crow(r, hi) * 32 + r32] = racc[r]; }
        RAW_BAR();
        if (w >= 6) { LAS float* part = RSLOT(w - 2);
#pragma unroll
            for (int r = 0; r < 16; ++r) part[crow(r, hi) * 32 + r32] += racc[r]; }
        RAW_BAR();
        const int row = tid >> 4, c0 = (tid & 15) * 2; f32x2 v = (f32x2){0.f, 0.f};
#pragma unroll
        for (int sl = 0; sl < 6; ++sl) v += *(const LAS f32x2*)(RSLOT(sl) + row * 32 + c0);
#undef RSLOT
        epi(mt, nt, row, c0, v.x, v.y, pre, tid);
    }
};
struct SQkv {
    const float* ssqs; bf16_t* QB; bf16_t* KB; bf16_t* VB; float* oks; float* ovs;
    __device__ __forceinline__ float pre(int mt, int, int tid) const { return srs_load(ssqs, mt, tid); }
    __device__ __forceinline__ void operator()(int mt, int nt, int row, int c0, float a0, float a1, float pre, int tid) const {
        const float r_ = srs_finish(pre); const int n = 32 * nt + c0, t = n >> 10, nn = n & 1023; const float v0 = a0 * r_, v1 = a1 * r_, sc = t == 0 ? C2 : 1.0f;
        bf16_t* dst = QB + (size_t)t * ((WS_K - WS_Q) / 2) + (size_t)(MP + 32 * mt + row) * D + nn; *(unsigned*)dst = cvt_pk_bf16(v0 * sc, v1 * sc);
        if (t >= 1) { float* o = oks + (size_t)(t - 1) * (O_VS - O_KS) + (size_t)(32 * mt + row) * D + nn; *(f32x2*)o = (f32x2){v0, v1}; }
    }
};
struct SRes {
    const bf16_t* XB; bf16_t* XO; float* ssqs;
    __device__ __forceinline__ float pre(int mt, int nt, int tid) const { return __uint_as_float(*(const unsigned*)(XB + (size_t)(MP + 32 * mt + (tid >> 4)) * D + 32 * nt + (tid & 15) * 2)); }
    __device__ __forceinline__ void operator()(int mt, int nt, int row, int c0, float a0, float a1, float pre, int tid) const {
        const size_t xo_ = (size_t)(MP + 32 * mt + row) * D + 32 * nt + c0; const unsigned bb = __float_as_uint(pre);
        const float v0 = bf2f(bb & 0xffffu) + a0, v1 = bf2f(bb >> 16) + a1; *(unsigned*)(XO + xo_) = cvt_pk_bf16(v0, v1);
        float s_ = v0 * v0 + v1 * v1; s_ = sum16(s_);
        if ((tid & 15) == 0) ssqs[(size_t)nt * MS + 32 * mt + row] = s_;
    }
};
struct SIn {
    const float* ssqs; bf16_t* UB; bf16_t* VB; float* ssqvs;
    __device__ __forceinline__ float pre(int mt, int, int tid) const { return srs_load(ssqs, mt, tid); }
    __device__ __forceinline__ void operator()(int mt, int nt, int row, int c0, float a0, float a1, float pre, int tid) const {
        const float r_ = srs_finish(pre); const int n = 32 * nt + c0, t = n >> 10, nn = n & 1023;
        const f32x2 z = gelu_pk((f32x2){a0 * r_, a1 * r_});
        *(unsigned*)(UB + (size_t)t * ((WS_K - WS_Q) / 2) + (size_t)(MP + 32 * mt + row) * D + nn) = cvt_pk_bf16(z.x, z.y);
        if (t == 1) { float s_ = z.x * z.x + z.y * z.y; s_ = sum16(s_);
            if ((tid & 15) == 0) ssqvs[(size_t)(nt - 32) * MS + 32 * mt + row] = s_; }
    }
};

struct SFin {
    const bf16_t* XB; float* xchs; unsigned* cnt; const float* gfin; float* ys;
    __device__ __forceinline__ float pre(int mt, int nt, int tid) const { return __uint_as_float(*(const unsigned*)(XB + (size_t)(MP + 32 * mt + (tid >> 4)) * D + 32 * nt + (tid & 15) * 2)); }
    __device__ __forceinline__ void operator()(int mt, int nt, int row, int c0, float a0, float a1, float pre, int tid) const {
        const int n = 32 * nt + c0; const unsigned bb = __float_as_uint(pre);
        const float v0 = bf2f(bb & 0xffffu) + a0, v1 = bf2f(bb >> 16) + a1;
        float s_ = v0 * v0 + v1 * v1; s_ = sum16(s_);
        if ((tid & 15) == 0) __hip_atomic_store(xchs + (size_t)nt * MS + 32 * mt + row, s_, __ATOMIC_RELAXED, __HIP_MEMORY_SCOPE_AGENT);
        asm volatile("s_waitcnt vmcnt(0)" ::: "memory");
        RAW_BAR();
        if (tid == 0) __hip_atomic_fetch_add(cnt + 64 * mt, 1u, __ATOMIC_RELAXED, __HIP_MEMORY_SCOPE_AGENT);
        wait_count(cnt + 64 * mt, 32u, tid);
        const int jj = tid & 15; float t_ = __hip_atomic_load(xchs + (size_t)jj * MS + 32 * mt + row, __ATOMIC_RELAXED, __HIP_MEMORY_SCOPE_AGENT) + __hip_atomic_load(xchs + (size_t)(jj + 16) * MS + 32 * mt + row, __ATOMIC_RELAXED, __HIP_MEMORY_SCOPE_AGENT);
        t_ = sum16(t_);
        const float rs = 1.0f / sqrtf(t_ * (1.0f / D) + EPS);
        *(f32x2*)(ys + (size_t)(32 * mt + row) * D + n) = (f32x2){v0 * rs * gfin[n], v1 * rs * gfin[n + 1]};
    }
};

namespace att {
constexpr int NS = 6, SLOTB = 8192;
constexpr int L_K = 0, L_V = NS * SLOTB, L_OST = 2 * NS * SLOTB, L_BIAS = 131072, L_WSF = 132352, L_BIAS2 = 134400;
#define SBAR() __builtin_amdgcn_sched_barrier(0)
__device__ __forceinline__ void glds16(const void* gsrc, unsigned lds_dst) { unsigned keep;
    asm volatile("s_mov_b32 %0, m0\n\ts_mov_b32 m0, %2\n\ts_nop 0\n\tglobal_load_lds_dwordx4 %1, off\n\ts_mov_b32 m0, %0" : "=&s"(keep) : "v"(gsrc), "s"(lds_dst) : "memory"); }
#define WAIT_BAR(N) asm volatile("s_waitcnt vmcnt(" #N ") lgkmcnt(0)\n\ts_barrier" ::: "memory")

struct State { float m, l; f32x16 o[2]; };

__device__ __forceinline__ void tile(State& st, const bf16x8 (&qr)[4], unsigned kslot, unsigned vslot, float cinit, bool near, int base, bool mask1, const LAS float* tab, LAS float* wsf, int r32, int hi, int lane) {
    f32x16 p0, p1;
    { const LAS char* kb = (const LAS char*)(uintptr_t)kslot + hi * 1024 + r32 * 16;
        f32x16 ci;
#pragma unroll
        for (int r = 0; r < 16; ++r) ci[r] = cinit;
#pragma unroll
        for (int d0 = 0; d0 < 4; ++d0) { const bf16x8 b0 = *(const LAS bf16x8*)(kb + d0 * 2048), b1 = *(const LAS bf16x8*)(kb + d0 * 2048 + 512);
            if (d0 == 0) { p0 = __builtin_amdgcn_mfma_f32_32x32x16_bf16(b0, qr[0], ci, 0, 0, 0); p1 = __builtin_amdgcn_mfma_f32_32x32x16_bf16(b1, qr[0], ci, 0, 0, 0); }
            else { p0 = __builtin_amdgcn_mfma_f32_32x32x16_bf16(b0, qr[d0], p0, 0, 0, 0); p1 = __builtin_amdgcn_mfma_f32_32x32x16_bf16(b1, qr[d0], p1, 0, 0, 0); } } }
    if (near) {
#pragma unroll
        for (int r = 0; r < 16; ++r) { const LAS float* tb = tab + (319 - base) + 4 * hi; p0[r] += tb[(r & 3) + 8 * (r >> 2)]; p1[r] += tb[32 + (r & 3) + 8 * (r >> 2)]; } }
    if (mask1) {
#pragma unroll
        for (int r = 0; r < 16; ++r) p1[r] = -1e30f; }
    float rm = fmaxf(p0[0], p1[0]);
#pragma unroll
    for (int r = 1; r < 16; ++r) rm = fmaxf(rm, fmaxf(p0[r], p1[r]));
    rm = xmax32(rm);
    const float mn = fmaxf(st.m, rm);
    if (__any(mn > st.m)) {
        const float f = __builtin_amdgcn_exp2f(st.m - mn); st.l *= f; st.m = mn;
        if (hi == 0) wsf[r32] = f;
        LDS_WAIT();
#pragma unroll
        for (int g = 0; g < 4; ++g) { const f32x4 fv = *(const LAS f32x4*)(wsf + 8 * g + 4 * hi);
#pragma unroll
            for (int e = 0; e < 4; ++e) { st.o[0][4 * g + e] *= fv[e]; st.o[1][4 * g + e] *= fv[e]; } }
    }
    float sacc = 0.f;
#pragma unroll
    for (int r = 0; r < 16; ++r) { p0[r] = __builtin_amdgcn_exp2f(p0[r] - st.m); p1[r] = __builtin_amdgcn_exp2f(p1[r] - st.m); sacc += p0[r] + p1[r]; }
    st.l += sacc;
    u32x4 pw[4];
#pragma unroll
    for (int k = 0; k < 2; ++k) { pw[k] = (u32x4){cvt_pk_bf16(p0[8 * k], p0[8 * k + 1]), cvt_pk_bf16(p0[8 * k + 2], p0[8 * k + 3]), cvt_pk_bf16(p0[8 * k + 4], p0[8 * k + 5]), cvt_pk_bf16(p0[8 * k + 6], p0[8 * k + 7])};
        pw[2 + k] = (u32x4){cvt_pk_bf16(p1[8 * k], p1[8 * k + 1]), cvt_pk_bf16(p1[8 * k + 2], p1[8 * k + 3]), cvt_pk_bf16(p1[8 * k + 4], p1[8 * k + 5]), cvt_pk_bf16(p1[8 * k + 6], p1[8 * k + 7])}; }
    const int vb = (int)vslot + ((lane >> 4) & 1) * 32 + (lane & 3) * 8 + (4 * hi + ((lane & 15) >> 2)) * 64;
#pragma unroll
    for (int d0 = 0; d0 < 2; ++d0) { s16x4 lo[4], hh[4];
#pragma unroll
        for (int ks = 0; ks < 4; ++ks) {
            asm volatile("ds_read_b64_tr_b16 %0,%1 offset:%c2" : "=&v"(lo[ks]) : "v"(vb), "i"(d0 * 4096 + ks * 1024) : "memory");
            asm volatile("ds_read_b64_tr_b16 %0,%1 offset:%c2" : "=&v"(hh[ks]) : "v"(vb), "i"(d0 * 4096 + ks * 1024 + 512) : "memory"); }
        asm volatile("s_waitcnt lgkmcnt(0)" ::: "memory"); SBAR();
#pragma unroll
        for (int ks = 0; ks < 4; ++ks) { const bf16x8 vf = (bf16x8){lo[ks][0], lo[ks][1], lo[ks][2], lo[ks][3], hh[ks][0], hh[ks][1], hh[ks][2], hh[ks][3]};
            st.o[d0] = __builtin_amdgcn_mfma_f32_32x32x16_bf16(__builtin_bit_cast(bf16x8, pw[ks]), vf, st.o[d0], 0, 0, 0); }
    }
}

__device__ __forceinline__ void prompt_unit(int b, int h, int qg, const bf16_t* Q, const bf16_t* Kg, const bf16_t* Vg, bf16_t* O, LAS unsigned char* lds, const int tid0) {
    int tid = tid0; asm volatile("" : "+v"(tid));
    const int lane = tid & 63, r32 = lane & 31, hi = lane >> 5; const int wid = __builtin_amdgcn_readfirstlane(tid >> 6);
    const int c0 = 4 * qg, pj = wid >> 1, half = wid & 1; const long rowbase = (long)b * SEQ;
    const unsigned lds0 = (unsigned)(uintptr_t)lds;
    const LAS float* tab = (const LAS float*)(lds + L_BIAS); LAS float* wsf = (LAS float*)(lds + L_WSF) + wid * 64;
    const bf16_t* Qw = Q + (rowbase + 64 * (c0 + pj) + 32 * half) * D + h * HD;
    const bf16_t* Kh = Kg + rowbase * D + h * HD; const bf16_t* Vh = Vg + rowbase * D + h * HD;
#define DMA_T(i) do { int ck_ = c0 - 8 + (i); ck_ = ck_ < 0 ? 0 : ck_; const unsigned so_ = (unsigned)(((i) % NS) * SLOTB + wid * 1024); \
        glds16(Kh + (long)(64 * ck_ + lane) * D + wid * 8, (unsigned)__builtin_amdgcn_readfirstlane(lds0 + L_K + so_)); \
        glds16(Vh + (long)(64 * ck_ + 16 * (wid & 3) + (lane >> 2)) * D + (wid >> 2) * 32 + (lane & 3) * 8, (unsigned)__builtin_amdgcn_readfirstlane(lds0 + L_V + so_)); } while (0)
    DMA_T(0); DMA_T(1); DMA_T(2); DMA_T(3); DMA_T(4);
    bf16x8 qr[4];
#pragma unroll
    for (int d0 = 0; d0 < 4; ++d0) qr[d0] = *(const bf16x8*)(Qw + (long)r32 * D + d0 * 16 + hi * 8);
    State st; st.m = -1e30f; st.l = 0.f;
#pragma unroll
    for (int r = 0; r < 16; ++r) { st.o[0][r] = 0.f; st.o[1][r] = 0.f; }
    const float cfar = tab[63];
    const int ql = 32 * half + r32;
    for (int s = 0; s < 9; ++s) {
        if (s == 0) { WAIT_BAR(0); asm volatile("" : "+v"(qr[0]), "+v"(qr[1]), "+v"(qr[2]), "+v"(qr[3])); }
        else if (s < 8) WAIT_BAR(2); else WAIT_BAR(0);
        if (s + 5 < 12) DMA_T(s + 5);
        const int ck = c0 - 8 + s + pj;
        if (ck >= 0) { const int sl = (s + pj) % NS; const bool near = s >= 6;
            tile(st, qr, lds0 + L_K + sl * SLOTB, lds0 + L_V + sl * SLOTB, near ? 0.f : cfar, near, 64 * (8 - s) + ql + 128, false, tab, wsf, r32, hi, lane); }
    }
#undef DMA_T
    float l = xsum32(st.l);
    if (hi == 0) wsf[32 + r32] = l;
    LDS_WAIT();
    float rli[16];
#pragma unroll
    for (int r = 0; r < 16; ++r) rli[r] = __builtin_amdgcn_rcpf(wsf[32 + crow(r, hi)]);
    bf16_t* Ow = O + (rowbase + 64 * (c0 + pj) + 32 * half) * D + h * HD;
    { LAS bf16_t* stg = (LAS bf16_t*)(lds + L_OST) + wid * 2048;
#pragma unroll
        for (int r = 0; r < 16; ++r) { const int orow = crow(r, hi);
#pragma unroll
            for (int d0 = 0; d0 < 2; ++d0) stg[orow * 64 + d0 * 32 + r32] = (bf16_t)(cvt_pk_bf16(st.o[d0][r] * rli[r], 0.f) & 0xffffu); }
        LDS_WAIT();
#pragma unroll
        for (int i = 0; i < 4; ++i) { const int row = i * 8 + (lane >> 3), ch = lane & 7; const u32x4 v = *(const LAS u32x4*)(stg + row * 64 + ch * 8); *(u32x4*)(Ow + (long)row * D + ch * 8) = v; } }
    asm volatile("s_waitcnt lgkmcnt(0)\n\ts_barrier" ::: "memory");
}

typedef const LAS char* lds_cptr;
typedef short v4i16_t __attribute__((ext_vector_type(4)));
__device__ __forceinline__ void kload8(bf16x8* kf, lds_cptr kp) {
    kf[0] = *(const LAS bf16x8*)(kp);        kf[1] = *(const LAS bf16x8*)(kp + 512);
    kf[2] = *(const LAS bf16x8*)(kp + 2048); kf[3] = *(const LAS bf16x8*)(kp + 2560);
    kf[4] = *(const LAS bf16x8*)(kp + 4096); kf[5] = *(const LAS bf16x8*)(kp + 4608);
    kf[6] = *(const LAS bf16x8*)(kp + 6144); kf[7] = *(const LAS bf16x8*)(kp + 6656);
}
__device__ __forceinline__ void kload2(bf16x8* kf, lds_cptr kp, int j) { kf[2 * j] = *(const LAS bf16x8*)(kp + j * 2048); kf[2 * j + 1] = *(const LAS bf16x8*)(kp + j * 2048 + 512); }
__device__ __forceinline__ s16x4 vtr(lds_cptr p) { return __builtin_bit_cast(s16x4, __builtin_amdgcn_ds_read_tr16_b64_v4i16((LAS v4i16_t*)p)); }
__device__ __forceinline__ float max3f(float a, float b, float c) { float r; asm("v_max3_f32 %0, %1, %2, %3" : "=v"(r) : "v"(a), "v"(b), "v"(c)); return r; }
__device__ __forceinline__ float max2f(float a, float b) { float r; asm("v_max_f32_e32 %0, %1, %2" : "=v"(r) : "v"(a), "v"(b)); return r; }
__device__ __forceinline__ float fadd_s(float a, float b) { float r; asm("v_add_f32_e32 %0, %1, %2" : "=v"(r) : "v"(a), "v"(b)); return r; }
__device__ __forceinline__ float fsub_s(float a, float b) { float r; asm("v_sub_f32_e32 %0, %1, %2" : "=v"(r) : "v"(a), "v"(b)); return r; }
typedef float f32x2_t __attribute__((ext_vector_type(2))); typedef __bf16 bf16x2_t __attribute__((ext_vector_type(2)));
__device__ __forceinline__ unsigned cvtpk_s(float lo, float hi) { f32x2_t v = {lo, hi}; bf16x2_t b = __builtin_convertvector(v, bf16x2_t); return __builtin_bit_cast(unsigned, b); }
#define WAIT_BAR2(N) asm volatile("s_waitcnt vmcnt(" #N ") lgkmcnt(0)\n\ts_barrier" ::: "memory")

template <int THRL>
__device__ __forceinline__ void prompt_unit_fast(int b, int h, int qg, const int nun, const bf16_t* Q, const bf16_t* Kg, const bf16_t* Vg, bf16_t* O, LAS unsigned char* lds, const int tid) {
    const int wid = __builtin_amdgcn_readfirstlane(tid >> 6);
    const int c0 = 4 * qg, pj = wid >> 1, half = wid & 1; const long rowbase = (long)b * SEQ;
    const unsigned lds0 = (unsigned)(uintptr_t)lds;
    const LAS float* tab = (const LAS float*)(lds + L_BIAS); const LAS float* tab2 = (const LAS float*)(lds + L_BIAS2);
    const bf16_t* Qw = Q + (rowbase + 64 * (c0 + pj) + 32 * half) * D + h * HD;
    const bf16_t* Kh = Kg + (rowbase + 64 * (c0 - 8)) * D + h * HD; const bf16_t* Vh = Vg + (rowbase + 64 * (c0 - 8)) * D + h * HD;
#define SLOT(i) ((unsigned)(((i) % NS) * SLOTB))
#define DMA_K(i) glds16(ksrc + uo + (long)(i) * 64 * D, (unsigned)__builtin_amdgcn_readfirstlane(lds0 + L_K + SLOT(i) + wid * 1024))
#define DMA_V(i) glds16(vsrc + uo + (long)(i) * 64 * D, (unsigned)__builtin_amdgcn_readfirstlane(lds0 + L_V + SLOT(i) + wid * 1024))
#define DMA_KN(i) glds16(ksrc + uo + (long)((i) + 4) * 64 * D, (unsigned)__builtin_amdgcn_readfirstlane(lds0 + L_K + SLOT(i) + wid * 1024))
#define DMA_VN(i) glds16(vsrc + uo + (long)((i) + 4) * 64 * D, (unsigned)__builtin_amdgcn_readfirstlane(lds0 + L_V + SLOT(i) + wid * 1024))
    bf16x8 qr[4];
    const float cfar = tab[63];
#pragma unroll 1
  for (int un = 0; un < nun; ++un) {
    const bool more = un + 1 < nun; const long uo = (long)un * 256 * D;
    int tl_ = tid; asm volatile("" : "+v"(tl_));
    const int lane = tl_ & 63, r32 = lane & 31, hi = lane >> 5;
    LAS float* wsf = (LAS float*)(lds + L_WSF) + wid * 64;
    const bf16_t* ksrc = Kh + (long)lane * D + wid * 8;
    const bf16_t* vsrc = Vh + (long)(16 * (wid & 3) + (lane >> 2)) * D + (wid >> 2) * 32 + (lane & 3) * 8;
    const lds_cptr kp0 = (lds_cptr)lds + L_K + hi * 1024 + r32 * 16;
    const lds_cptr vp0 = (lds_cptr)lds + L_V + ((lane >> 4) & 1) * 32 + (lane & 3) * 8 + (4 * hi + ((lane & 15) >> 2)) * 64;
    const int ql = 32 * half + r32;
    if (un == 0) { DMA_K(0); DMA_K(1); DMA_K(2); DMA_K(3); DMA_K(4); DMA_K(5); DMA_V(0); DMA_V(1); DMA_V(2); DMA_V(3);
#pragma unroll
        for (int d0 = 0; d0 < 4; ++d0) qr[d0] = *(const bf16x8*)(Qw + (long)r32 * D + d0 * 16 + hi * 8); }
    float mhat = 0.f, l_reg = 0.f; f32x16 o[2];
#pragma unroll
    for (int r = 0; r < 16; ++r) { o[0][r] = 0.f; o[1][r] = 0.f; }
    f32x16 negm;
#pragma unroll
    for (int r = 0; r < 16; ++r) negm[r] = cfar;
    asm volatile("" : "+v"(negm));
    bf16x8 kf[8];
    if (un == 0) WAIT_BAR2(0); else WAIT_BAR2(3);
    asm volatile("" : "+v"(qr[0]), "+v"(qr[1]), "+v"(qr[2]), "+v"(qr[3]));
    kload8(kf, kp0 + SLOT(pj));
    if (un == 0) WAIT_BAR2(0); else WAIT_BAR2(3);
    bool resc = false;
    f32x16 pA0, pA1, pB0, pB1;
    s16x4 vlo[8], vhi[8]; u32x4 pw0, pw1, pw2, pw3;
#define PKW(P, B) cvtpk_s(P[B], P[B + 1])
#define PAF(k) __builtin_bit_cast(bf16x8, pw##k)
#define VFR(i) (bf16x8){vlo[i][0], vlo[i][1], vlo[i][2], vlo[i][3], vhi[i][0], vhi[i][1], vhi[i][2], vhi[i][3]}
#define PIN(x) asm volatile("" : "+v"(x))
#define MX3(a, b, c) __builtin_fmaxf(__builtin_fmaxf((a), (b)), (c))
#define MF(a, b, c) __builtin_amdgcn_mfma_f32_32x32x16_bf16(a, b, c, 0, 0, 0)
#define GAPA(MFX, A0, A1, A2, A3, W0, W1, PW) do { MFX; sacc += A0; sacc += A1; sacc += A2; sacc += A3; PIN(sacc); W0; W1; PIN(PW); SBAR(); } while (0)
#define EX(v) __builtin_amdgcn_exp2f(v)
#define GAPB(MFX, X, B) do { MFX; X[B] = EX(X[B]); X[B + 1] = EX(X[B + 1]); X[B + 2] = EX(X[B + 2]); X[B + 3] = EX(X[B + 3]); PIN(X); SBAR(); } while (0)
#define VRD(i) do { vlo[i] = vtr(vp_ + (((i) >> 2) * 4096 + ((i) & 3) * 1024)); vhi[i] = vtr(vp_ + (((i) >> 2) * 4096 + ((i) & 3) * 1024 + 512)); } while (0)
#define KRD(GL, j) do { if (GL) { kload2(kf, kn_, j); SBAR(); } } while (0)
#define NEARB(C0, C1, s) do { if ((s) >= 6) { const LAS float* tb_ = tab2 + (319 - (64 * (8 - (s)) + ql + 128)) + 4 * hi; \
        _Pragma("unroll") for (int r = 0; r < 16; ++r) { C0[r] += tb_[(r & 3) + 8 * (r >> 2)]; C1[r] += tb_[32 + (r & 3) + 8 * (r >> 2)]; } } } while (0)
#define DECIDE(C0, C1) do { float a_ = MX3(C0[0], C0[1], C1[0]), b_ = MX3(C0[2], C0[3], C1[1]); a_ = MX3(a_, C1[2], C1[3]); \
        _Pragma("unroll") for (int r = 4; r < 16; r += 4) { a_ = MX3(a_, C0[r], C0[r + 1]); b_ = MX3(b_, C0[r + 2], C0[r + 3]); a_ = MX3(a_, C1[r], C1[r + 1]); b_ = MX3(b_, C1[r + 2], C1[r + 3]); } \
        float rm_ = __builtin_fmaxf(a_, b_); rm_ = xmax32(rm_); \
        resc = false; \
        if (__builtin_expect(__any(rm_ > (float)THRL), 0)) { const float dl_ = __builtin_fmaxf(rm_, 0.f); mhat += dl_; \
            _Pragma("unroll") for (int r = 0; r < 16; ++r) { C0[r] -= dl_; C1[r] -= dl_; } \
            _Pragma("unroll") for (int r = 0; r < 16; ++r) negm[r] = cfar - mhat; asm volatile("" : "+v"(negm)); \
            const float f_ = __builtin_amdgcn_exp2f(-dl_); l_reg *= f_; if (hi == 0) wsf[r32] = f_; resc = true; } } while (0)
#define RESC() do { if (resc) { asm volatile("s_waitcnt lgkmcnt(0)" ::: "memory"); \
        _Pragma("unroll") for (int g_ = 0; g_ < 4; ++g_) { const f32x4 fv_ = *(const LAS f32x4*)(wsf + 8 * g_ + 4 * hi); \
            _Pragma("unroll") for (int e_ = 0; e_ < 4; ++e_) { o[0][4 * g_ + e_] *= fv_[e_]; o[1][4 * g_ + e_] *= fv_[e_]; } } } } while (0)
#define STEP(C0, C1, P0, P1, t, GK, GV, GL) do { SBAR(); \
        const lds_cptr vp_ = vp0 + SLOT((t) - 1 + pj); const lds_cptr kn_ = kp0 + SLOT((t) + 1 + pj); \
        VRD(0); SBAR(); float sacc = (P0[0] + P0[1]); \
        GAPA(C0 = MF(kf[0], qr[0], negm), P0[2], P0[3], P0[4], P0[5],     pw0[0] = PKW(P0, 0), pw0[1] = PKW(P0, 2), pw0); \
        VRD(4); SBAR(); GAPA(C1 = MF(kf[1], qr[0], negm), P0[6], P0[7], P0[8], P0[9],     pw0[2] = PKW(P0, 4), pw0[3] = PKW(P0, 6), pw0); \
        VRD(1); SBAR(); GAPA(C0 = MF(kf[2], qr[1], C0),   P0[10], P0[11], P0[12], P0[13], pw1[0] = PKW(P0, 8), pw1[1] = PKW(P0, 10), pw1); \
        VRD(5); SBAR(); GAPA(C1 = MF(kf[3], qr[1], C1),   P0[14], P0[15], P1[0], P1[1],   pw1[2] = PKW(P0, 12), pw1[3] = PKW(P0, 14), pw1); \
        VRD(2); SBAR(); GAPA(C0 = MF(kf[4], qr[2], C0),   P1[2], P1[3], P1[4], P1[5],     pw2[0] = PKW(P1, 0), pw2[1] = PKW(P1, 2), pw2); \
        VRD(6); SBAR(); GAPA(C1 = MF(kf[5], qr[2], C1),   P1[6], P1[7], P1[8], P1[9],     pw2[2] = PKW(P1, 4), pw2[3] = PKW(P1, 6), pw2); \
        VRD(3); SBAR(); GAPA(C0 = MF(kf[6], qr[3], C0),   P1[10], P1[11], P1[12], P1[13], pw3[0] = PKW(P1, 8), pw3[1] = PKW(P1, 10), pw3); \
        VRD(7); SBAR(); GAPA(C1 = MF(kf[7], qr[3], C1),   P1[14], P1[15], 0.f, 0.f,       pw3[2] = PKW(P1, 12), pw3[3] = PKW(P1, 14), pw3); \
        l_reg += sacc; \
        if (GK) { DMA_K((t) + 6); } if (GV) { DMA_V((t) + 4); } \
        NEARB(C0, C1, t); \
        DECIDE(C0, C1); \
        SBAR(); \
        GAPB(o[0] = MF(PAF(0), VFR(0), o[0]), C0, 0); \
        GAPB(o[1] = MF(PAF(0), VFR(4), o[1]), C0, 4); \
        KRD(GL, 0); GAPB(o[0] = MF(PAF(1), VFR(1), o[0]), C0, 8); \
        KRD(GL, 1); GAPB(o[1] = MF(PAF(1), VFR(5), o[1]), C0, 12); \
        KRD(GL, 2); GAPB(o[0] = MF(PAF(2), VFR(2), o[0]), C1, 0); \
        KRD(GL, 3); GAPB(o[1] = MF(PAF(2), VFR(6), o[1]), C1, 4); \
        GAPB(o[0] = MF(PAF(3), VFR(3), o[0]), C1, 8); \
        GAPB(o[1] = MF(PAF(3), VFR(7), o[1]), C1, 12); \
    } while (0)
    DMA_K(6); DMA_V(4);
    {
#pragma unroll
        for (int d0 = 0; d0 < 4; ++d0) {
            if (d0 == 0) { pA0 = MF(kf[0], qr[0], negm); pA1 = MF(kf[1], qr[0], negm); }
            else { pA0 = MF(kf[2 * d0], qr[d0], pA0); pA1 = MF(kf[2 * d0 + 1], qr[d0], pA1); } }
        float rm = fmaxf(pA0[0], pA1[0]);
#pragma unroll
        for (int r = 1; r < 16; ++r) rm = fmaxf(rm, fmaxf(pA0[r], pA1[r]));
        rm = xmax32(rm);
        mhat = rm;
#pragma unroll
        for (int r = 0; r < 16; ++r) { pA0[r] = __builtin_amdgcn_exp2f(pA0[r] - rm); pA1[r] = __builtin_amdgcn_exp2f(pA1[r] - rm); }
#pragma unroll
        for (int r = 0; r < 16; ++r) negm[r] = cfar - mhat;
        asm volatile("" : "+v"(negm));
    }
    kload8(kf, kp0 + SLOT(1 + pj));
    WAIT_BAR2(2);
    STEP(pB0, pB1, pA0, pA1, 1, true, true, true);   WAIT_BAR2(2); RESC();
    STEP(pA0, pA1, pB0, pB1, 2, true, true, true);   WAIT_BAR2(2); RESC();
    STEP(pB0, pB1, pA0, pA1, 3, true, true, true);   WAIT_BAR2(2); RESC();
    STEP(pA0, pA1, pB0, pB1, 4, true, true, true);   WAIT_BAR2(2); RESC();
    STEP(pB0, pB1, pA0, pA1, 5, true, true, true);   WAIT_BAR2(2); RESC();
    STEP(pA0, pA1, pB0, pB1, 6, false, true, true);  WAIT_BAR2(1); RESC();
    STEP(pB0, pB1, pA0, pA1, 7, false, true, true);  WAIT_BAR2(1); RESC();
    if (more) { DMA_KN(0); DMA_KN(1); DMA_KN(2); DMA_KN(3); DMA_KN(4); DMA_KN(5); DMA_VN(0); }
    STEP(pA0, pA1, pB0, pB1, 8, false, false, false); WAIT_BAR2(0); RESC();
    if (more) {
#pragma unroll
        for (int d0 = 0; d0 < 4; ++d0) qr[d0] = *(const bf16x8*)(Qw + uo + (long)(256 + r32) * D + d0 * 16 + hi * 8); }
    { float sacc = pA0[0] + pA0[1];
#pragma unroll
        for (int r = 2; r < 16; ++r) sacc += pA0[r];
#pragma unroll
        for (int r = 0; r < 16; ++r) sacc += pA1[r];
        l_reg += sacc;
        pw0 = (u32x4){PKW(pA0, 0), PKW(pA0, 2), PKW(pA0, 4), PKW(pA0, 6)}; pw1 = (u32x4){PKW(pA0, 8), PKW(pA0, 10), PKW(pA0, 12), PKW(pA0, 14)};
        pw2 = (u32x4){PKW(pA1, 0), PKW(pA1, 2), PKW(pA1, 4), PKW(pA1, 6)}; pw3 = (u32x4){PKW(pA1, 8), PKW(pA1, 10), PKW(pA1, 12), PKW(pA1, 14)};
        SBAR();
        const int vb = (int)(lds0 + L_V + SLOT(8 + pj)) + ((lane >> 4) & 1) * 32 + (lane & 3) * 8 + (4 * hi + ((lane & 15) >> 2)) * 64;
#pragma unroll
        for (int d0 = 0; d0 < 2; ++d0) { s16x4 lo[4], hh[4];
#pragma unroll
            for (int ks = 0; ks < 4; ++ks) {
                asm volatile("ds_read_b64_tr_b16 %0,%1 offset:%c2" : "=&v"(lo[ks]) : "v"(vb), "i"(d0 * 4096 + ks * 1024) : "memory");
                asm volatile("ds_read_b64_tr_b16 %0,%1 offset:%c2" : "=&v"(hh[ks]) : "v"(vb), "i"(d0 * 4096 + ks * 1024 + 512) : "memory"); }
            asm volatile("s_waitcnt lgkmcnt(0)" ::: "memory"); SBAR();
            o[d0] = MF(PAF(0), ((bf16x8){lo[0][0], lo[0][1], lo[0][2], lo[0][3], hh[0][0], hh[0][1], hh[0][2], hh[0][3]}), o[d0]);
            o[d0] = MF(PAF(1), ((bf16x8){lo[1][0], lo[1][1], lo[1][2], lo[1][3], hh[1][0], hh[1][1], hh[1][2], hh[1][3]}), o[d0]);
            o[d0] = MF(PAF(2), ((bf16x8){lo[2][0], lo[2][1], lo[2][2], lo[2][3], hh[2][0], hh[2][1], hh[2][2], hh[2][3]}), o[d0]);
            o[d0] = MF(PAF(3), ((bf16x8){lo[3][0], lo[3][1], lo[3][2], lo[3][3], hh[3][0], hh[3][1], hh[3][2], hh[3][3]}), o[d0]); } }
    { float l = xsum32(l_reg);
        if (hi == 0) wsf[32 + r32] = l;
        LDS_WAIT();
        float rli[16];
#pragma unroll
        for (int r = 0; r < 16; ++r) rli[r] = __builtin_amdgcn_rcpf(wsf[32 + crow(r, hi)]);
        bf16_t* Ow = O + uo + (rowbase + 64 * (c0 + pj) + 32 * half) * D + h * HD;
        LAS bf16_t* stg = (LAS bf16_t*)(lds + L_OST) + wid * 2048;
#pragma unroll
        for (int r = 0; r < 16; ++r) { const int orow = crow(r, hi);
#pragma unroll
            for (int d0 = 0; d0 < 2; ++d0) stg[orow * 64 + d0 * 32 + r32] = (bf16_t)(cvt_pk_bf16(o[d0][r] * rli[r], 0.f) & 0xffffu); }
        LDS_WAIT();
#pragma unroll
        for (int i = 0; i < 4; ++i) { const int row = i * 8 + (lane >> 3), ch = lane & 7; const u32x4 v = *(const LAS u32x4*)(stg + row * 64 + ch * 8); *(u32x4*)(Ow + (long)row * D + ch * 8) = v; } }
    asm volatile("s_waitcnt lgkmcnt(0)\n\ts_barrier" ::: "memory");
    if (more) { DMA_VN(1); DMA_VN(2); DMA_VN(3); }
  }
#undef SLOT
#undef DMA_K
#undef DMA_V
#undef DMA_KN
#undef DMA_VN
#undef PKW
#undef PAF
#undef VFR
#undef PIN
#undef MX3
#undef MF
#undef GAPA
#undef EX
#undef GAPB
#undef VRD
#undef KRD
#undef NEARB
#undef DECIDE
#undef RESC
#undef STEP
}
#undef WAIT_BAR2

__device__ __forceinline__ void sample_unit(int b, int h, const bf16_t* Q, const bf16_t* Kg, const bf16_t* Vg, const float* CKf, const float* CVf, bf16_t* O, LAS unsigned char* lds, const int tid0) {
    int tid = tid0; asm volatile("" : "+v"(tid));
    const int lane = tid & 63, r32 = lane & 31, hi = lane >> 5; const int wid = __builtin_amdgcn_readfirstlane(tid >> 6);
    const unsigned lds0 = (unsigned)(uintptr_t)lds;
    const LAS float* tab = (const LAS float*)(lds + L_BIAS); LAS float* wsf = (LAS float*)(lds + L_WSF) + wid * 64;
    const long srow = (long)MP + 32 * b;
    const bf16_t* Qw = Q + srow * D + h * HD;
    const unsigned ks = lds0 + wid * 16384, vs = ks + 8192;
    const unsigned ks9 = lds0 + 136192;
    if (wid == 0) {
        const bf16_t* Kn = Kg + srow * D + h * HD; const bf16_t* Vn = Vg + srow * D + h * HD;
#pragma unroll
        for (int p = 0; p < 8; ++p) { const int kr = lane < 32 ? lane : 31; const int vr0 = 16 * (p & 3) + (lane >> 2), vr = vr0 < 32 ? vr0 : 31;
            glds16(Kn + (long)kr * D + p * 8, (unsigned)__builtin_amdgcn_readfirstlane(ks9 + p * 1024));
            glds16(Vn + (long)vr * D + (p >> 2) * 32 + (lane & 3) * 8, (unsigned)__builtin_amdgcn_readfirstlane(ks9 + 8192 + p * 1024)); } }
    { const float* Kc = CKf + ((long)b * CA + 64 * wid) * D + h * HD; const float* Vc = CVf + ((long)b * CA + 64 * wid) * D + h * HD;
        LAS unsigned char* kl = lds + wid * 16384; LAS unsigned char* vl = kl + 8192;
        f32x4 t0[8], t1[8], u0[8], u1[8];
#pragma unroll
        for (int p = 0; p < 8; ++p) { const float* src = Kc + (long)lane * D + p * 8; t0[p] = *(const f32x4*)src; t1[p] = *(const f32x4*)(src + 4); }
#pragma unroll
        for (int p = 0; p < 8; ++p) { const float* src = Vc + (long)(16 * (p & 3) + (lane >> 2)) * D + (p >> 2) * 32 + (lane & 3) * 8; u0[p] = *(const f32x4*)src; u1[p] = *(const f32x4*)(src + 4); }
#pragma unroll
        for (int p = 0; p < 8; ++p) { u32x4 w; w.x = cvt_pk_bf16(t0[p][0], t0[p][1]); w.y = cvt_pk_bf16(t0[p][2], t0[p][3]); w.z = cvt_pk_bf16(t1[p][0], t1[p][1]); w.w = cvt_pk_bf16(t1[p][2], t1[p][3]);
            *(LAS u32x4*)(kl + p * 1024 + lane * 16) = w; }
#pragma unroll
        for (int p = 0; p < 8; ++p) { u32x4 w; w.x = cvt_pk_bf16(u0[p][0], u0[p][1]); w.y = cvt_pk_bf16(u0[p][2], u0[p][3]); w.z = cvt_pk_bf16(u1[p][0], u1[p][1]); w.w = cvt_pk_bf16(u1[p][2], u1[p][3]);
            *(LAS u32x4*)(vl + p * 1024 + lane * 16) = w; } }
    bf16x8 qr[4];
#pragma unroll
    for (int d0 = 0; d0 < 4; ++d0) qr[d0] = *(const bf16x8*)(Qw + (long)r32 * D + d0 * 16 + hi * 8);
    State st; st.m = -1e30f; st.l = 0.f;
#pragma unroll
    for (int r = 0; r < 16; ++r) { st.o[0][r] = 0.f; st.o[1][r] = 0.f; }
    asm volatile("s_waitcnt vmcnt(0) lgkmcnt(0)" ::: "memory"); asm volatile("" : "+v"(qr[0]), "+v"(qr[1]), "+v"(qr[2]), "+v"(qr[3]));
    { const bool near = wid >= 6; tile(st, qr, ks, vs, near ? 0.f : tab[63], near, r32 + 512 - 64 * wid + 128, false, tab, wsf, r32, hi, lane); }
    if (wid == 0) tile(st, qr, ks9, ks9 + 8192, 0.f, true, r32 + 128, true, tab, wsf, r32, hi, lane);
    const float l = xsum32(st.l);
    asm volatile("s_waitcnt lgkmcnt(0)\n\ts_barrier" ::: "memory");
    LAS float* OP = (LAS float*)lds;
    LAS float* MLp = (LAS float*)(lds + 65536);
#pragma unroll
    for (int r = 0; r < 16; ++r) { const int q = crow(r, hi); OP[(wid * 32 + q) * 64 + r32] = st.o[0][r]; OP[(wid * 32 + q) * 64 + 32 + r32] = st.o[1][r]; }
    if (hi == 0) { MLp[wid * 32 + r32] = st.m; MLp[256 + wid * 32 + r32] = l; }
    __syncthreads();
    { const int q = tid >> 4, d4 = (tid & 15) * 4; float mg = -1e30f;
#pragma unroll
        for (int w = 0; w < 8; ++w) mg = fmaxf(mg, MLp[w * 32 + q]);
        f32x4 num = (f32x4){0.f, 0.f, 0.f, 0.f}; float den = 0.f;
#pragma unroll
        for (int w = 0; w < 8; ++w) { const float f = __builtin_amdgcn_exp2f(MLp[w * 32 + q] - mg); den += f * MLp[256 + w * 32 + q]; num += *(const LAS f32x4*)(OP + (w * 32 + q) * 64 + d4) * f; }
        const float rd = 1.0f / den; u32x2 w2; w2.x = cvt_pk_bf16(num[0] * rd, num[1] * rd); w2.y = cvt_pk_bf16(num[2] * rd, num[3] * rd);
        *(u32x2*)(O + (srow + q) * D + h * HD + d4) = w2; }
    __syncthreads();
}
#undef WAIT_BAR
}

namespace gate {
constexpr int L_VS = 0, L_STG = 32768, L_RV = 98304;
__device__ __forceinline__ void unit(bool sample, int nb, int gp, const bf16_t* U, bf16_t* Og, const bf16_t* Vv, const float* ssqv, const float* ssqvs, const float* vgain, const bf16_t* wsb, const float* bsp, float* ogv, LAS unsigned char* lds, const int tid) {
    const int lane = tid & 63, r32 = lane & 31, hi = lane >> 5; const int wid = __builtin_amdgcn_readfirstlane(tid >> 6);
    const long tok0 = sample ? (long)MP + 32 * nb : (long)128 * nb; const int nrows = sample ? 32 : 128;
    const int gi = wid >> 2, pb = wid & 3, g = 2 * gp + gi; const bool act = pb * 32 < nrows; const int nks = sample ? 2 : (pb < 2 ? 4 : 8);
    bf16x8 pa[8]; f32x4 bq[4]; u32x4 uu[4];
    if (act) { const bf16x8* wp = (const bf16x8*)wsb + ((size_t)(g * 128 + 32 * pb + r32) * 8) * 2 + hi;
#pragma unroll
        for (int ks = 0; ks < 8; ++ks) pa[ks] = wp[ks * 2];
#pragma unroll
        for (int gq = 0; gq < 4; ++gq) bq[gq] = *(const f32x4*)(bsp + g * 128 + 32 * pb + 8 * gq + 4 * hi);
#pragma unroll
        for (int i = 0; i < 4; ++i) uu[i] = *(const u32x4*)(U + (size_t)(tok0 + 32 * pb + i * 8 + (lane >> 3)) * D + 64 * g + (lane & 7) * 8); }
    LAS float* rv = (LAS float*)(lds + L_RV);
    if (!sample) { if (tid < 128) { const long t = tok0 + tid; const float s = (ssqv[t] + ssqv[MT + t]) + (ssqv[2 * MT + t] + ssqv[3 * MT + t]); rv[tid] = 1.0f / sqrtf(s * (1.0f / D) + EPS); } }
    else { const int row = tid >> 4, jj = tid & 15; float s = ssqvs[(size_t)jj * MS + nb * 32 + row] + ssqvs[(size_t)(jj + 16) * MS + nb * 32 + row];
        s = sum16(s); if (jj == 0) rv[row] = 1.0f / sqrtf(s * (1.0f / D) + EPS); }
    u32x4 raw[4]; f32x4 g0[4], g1[4];
#pragma unroll
    for (int i = 0; i < 4; ++i) { const int pi = wid + 8 * i, gi2 = pi >> 4, qt = (pi >> 3) & 1, dh = (pi >> 2) & 1, rg = pi & 3;
        const int row = 64 * qt + 16 * rg + (lane >> 2), col = 64 * (2 * gp + gi2) + 32 * dh + 8 * (lane & 3);
        const int rowc = row < nrows ? row : nrows - 1;
        raw[i] = *(const u32x4*)(Vv + (tok0 + rowc) * D + col); g0[i] = *(const f32x4*)(vgain + col); g1[i] = *(const f32x4*)(vgain + col + 4); }
    __syncthreads();
#pragma unroll
    for (int i = 0; i < 4; ++i) { const int pi = wid + 8 * i, gi2 = pi >> 4, qt = (pi >> 3) & 1, dh = (pi >> 2) & 1, rg = pi & 3;
        const int row = 64 * qt + 16 * rg + (lane >> 2), col = 64 * (2 * gp + gi2) + 32 * dh + 8 * (lane & 3);
        if (row < nrows) { const float rs = rv[row]; const u32x4 rw = raw[i];
            float f[8]; f[0] = bf2f(rw.x & 0xffffu) * rs * g0[i][0]; f[1] = bf2f(rw.x >> 16) * rs * g0[i][1]; f[2] = bf2f(rw.y & 0xffffu) * rs * g0[i][2]; f[3] = bf2f(rw.y >> 16) * rs * g0[i][3];
            f[4] = bf2f(rw.z & 0xffffu) * rs * g1[i][0]; f[5] = bf2f(rw.z >> 16) * rs * g1[i][1]; f[6] = bf2f(rw.w & 0xffffu) * rs * g1[i][2]; f[7] = bf2f(rw.w >> 16) * rs * g1[i][3];
            u32x4 w; w.x = cvt_pk_bf16(f[0], f[1]); w.y = cvt_pk_bf16(f[2], f[3]); w.z = cvt_pk_bf16(f[4], f[5]); w.w = cvt_pk_bf16(f[6], f[7]);
            *(LAS u32x4*)(lds + L_VS + (gi2 * 2 + qt) * 8192 + (dh * 4 + rg) * 1024 + lane * 16) = w;
            if (sample) { float* o = ogv + (size_t)(nb * 32 + row) * D + col; *(f32x4*)o = (f32x4){f[0], f[1], f[2], f[3]}; *(f32x4*)(o + 4) = (f32x4){f[4], f[5], f[6], f[7]}; } } }
    __syncthreads();
    if (act) {
        f32x16 o[2];
#pragma unroll
        for (int r = 0; r < 16; ++r) { o[0][r] = 0.f; o[1][r] = 0.f; }
        const unsigned lds0 = (unsigned)(uintptr_t)lds;
#pragma unroll
        for (int ks = 0; ks < 8; ++ks) if (ks < nks) {
            const int vb = (int)(lds0 + L_VS + (gi * 2 + (ks >> 2)) * 8192 + (ks & 3) * 1024) + ((lane >> 4) & 1) * 32 + (lane & 3) * 8 + (4 * hi + ((lane & 15) >> 2)) * 64;
            s16x4 lo[2], hh[2];
#pragma unroll
            for (int d0 = 0; d0 < 2; ++d0) {
                asm volatile("ds_read_b64_tr_b16 %0,%1 offset:%c2" : "=&v"(lo[d0]) : "v"(vb), "i"(d0 * 4096) : "memory");
                asm volatile("ds_read_b64_tr_b16 %0,%1 offset:%c2" : "=&v"(hh[d0]) : "v"(vb), "i"(d0 * 4096 + 512) : "memory"); }
            asm volatile("s_waitcnt lgkmcnt(0)" ::: "memory"); __builtin_amdgcn_sched_barrier(0);
#pragma unroll
            for (int d0 = 0; d0 < 2; ++d0) { const bf16x8 vf = (bf16x8){lo[d0][0], lo[d0][1], lo[d0][2], lo[d0][3], hh[d0][0], hh[d0][1], hh[d0][2], hh[d0][3]};
                o[d0] = __builtin_amdgcn_mfma_f32_32x32x16_bf16(pa[ks], vf, o[d0], 0, 0, 0); }
        }
        LAS float* stg = (LAS float*)(lds + L_STG) + wid * 2048;
#pragma unroll
        for (int r = 0; r < 16; ++r) { const int q = crow(r, hi); const float b_ = bq[r >> 2][r & 3]; stg[q * 64 + r32] = o[0][r] + b_; stg[q * 64 + 32 + r32] = o[1][r] + b_; }
        LDS_WAIT();
#pragma unroll
        for (int i = 0; i < 4; ++i) { const int row = i * 8 + (lane >> 3), ch = lane & 7;
            const f32x4 m0 = *(const LAS f32x4*)(stg + row * 64 + ch * 8), m1 = *(const LAS f32x4*)(stg + row * 64 + ch * 8 + 4);
            const size_t uo = (size_t)(tok0 + 32 * pb + row) * D + 64 * g + ch * 8; const u32x4 u4 = uu[i];
            u32x4 w; w.x = cvt_pk_bf16(bf2f(u4.x & 0xffffu) * m0[0], bf2f(u4.x >> 16) * m0[1]); w.y = cvt_pk_bf16(bf2f(u4.y & 0xffffu) * m0[2], bf2f(u4.y >> 16) * m0[3]);
            w.z = cvt_pk_bf16(bf2f(u4.z & 0xffffu) * m1[0], bf2f(u4.z >> 16) * m1[1]); w.w = cvt_pk_bf16(bf2f(u4.w & 0xffffu) * m1[2], bf2f(u4.w >> 16) * m1[3]);
            *(u32x4*)(Og + uo) = w; }
    }
    __syncthreads();
}
}

template <bool UP, bool GAIN>
__device__ __forceinline__ void transpose_item(const float* W, int K, int N, const float* gain, bf16_t* WT, LAS float* scr, int item, int lane) {
    const int nblk = N / 32, kb = item / nblk, nb = item % nblk, k0 = 64 * kb, n0 = 32 * nb;
    f32x4 v[8]; float gk[8];
#pragma unroll
    for (int i = 0; i < 8; ++i) { const int kk = 8 * i + (lane >> 3), n4 = (lane & 7) * 4; v[i] = *(const f32x4*)(W + (size_t)(k0 + kk) * N + n0 + n4); gk[i] = GAIN ? gain[k0 + kk] : 1.0f; }
#pragma unroll
    for (int i = 0; i < 8; ++i) { const int kk = 8 * i + (lane >> 3), n4 = (lane & 7) * 4; const f32x4 x = GAIN ? v[i] * gk[i] : v[i];
        scr[kk * 33 + n4] = x[0]; scr[kk * 33 + n4 + 1] = x[1]; scr[kk * 33 + n4 + 2] = x[2]; scr[kk * 33 + n4 + 3] = x[3]; }
    LDS_WAIT(); asm volatile("" ::: "memory");
    const int c = lane & 7;
#pragma unroll
    for (int jj = 0; jj < 4; ++jj) { const int n = (lane >> 3) + 8 * jj; const LAS float* s = scr + (8 * c) * 33 + n;
        u32x4 o; o.x = cvt_pk_bf16(s[0 * 33], s[1 * 33]); o.y = cvt_pk_bf16(s[2 * 33], s[3 * 33]); o.z = cvt_pk_bf16(s[4 * 33], s[5 * 33]); o.w = cvt_pk_bf16(s[6 * 33], s[7 * 33]);
        int dn = n0 + n; if (UP) { const int v = dn >= FF ? 1 : 0, gc = dn - v * FF; dn = 256 * (gc >> 7) + 128 * v + (gc & 127); }
        *(u32x4*)(WT + (size_t)dn * K + k0 + 8 * c) = o; }
    LDS_WAIT(); asm volatile("" ::: "memory");
}

#define XB_TMO      128
#define XB_XCNT(j)  (256  + 64 * (j))
#define XB_XSUB(j)  (1280 + 64 * (j))
#define XB_XGEN(j)  (2304 + 64 * (j))
#define XB_TOP      3328
#define XB_TOPGEN   3392
#define XCD_BAR_WORDS 3456
#define XB_SPIN_CAP (1u << 18)
__device__ __forceinline__ unsigned xb_ld(unsigned* p)              { return __hip_atomic_load(p, __ATOMIC_RELAXED, __HIP_MEMORY_SCOPE_AGENT); }
__device__ __forceinline__ unsigned xb_add(unsigned* p, unsigned v) { return __hip_atomic_fetch_add(p, v, __ATOMIC_RELAXED, __HIP_MEMORY_SCOPE_AGENT); }
__device__ __forceinline__ unsigned xb_xcc_id() { return (unsigned)__builtin_amdgcn_s_getreg((3 << 11) | 20) & 0xFu; }
#define XB_SPIN(cond, bar) do { unsigned _sp = 0; while (cond) { __builtin_amdgcn_s_sleep(1); \
    if ((++_sp & 255u) == 0u) { if (xb_ld(&(bar)[XB_TMO])) break; if (_sp > XB_SPIN_CAP) { atomicAdd(&(bar)[XB_TMO], 1u); break; } } } } while (0)
struct XcdBarrier { unsigned* bar; unsigned x; volatile LAS unsigned* st; };
__device__ __forceinline__ void xcd_barrier_complete(unsigned* bar, unsigned x, unsigned& nloc, unsigned& nx) {
    const unsigned G = gridDim.x * gridDim.y * gridDim.z;
    unsigned sum, cnt, mine, sp = 0u;
    for (;;) {
        sum = 0u; cnt = 0u; mine = 0u;
#pragma unroll
        for (unsigned j = 0; j < 16; ++j) { const unsigned c = xb_ld(&bar[XB_XCNT(j)]); sum += c; cnt += (c > 0u) ? 1u : 0u; mine = (j == x) ? c : mine; }
        if (sum == G) break;
        __builtin_amdgcn_s_sleep(1);
        if ((++sp & 255u) == 0u) { if (xb_ld(&bar[XB_TMO])) break; if (sp > XB_SPIN_CAP) { atomicAdd(&bar[XB_TMO], 1u); break; } }
    }
    nloc = mine > 0u ? mine : 1u; nx = cnt > 0u ? cnt : 1u;
}
__device__ __forceinline__ void xcd_barrier(const XcdBarrier& b, const int tid) {
    asm volatile("s_waitcnt vmcnt(0)" ::: "memory");
    __syncthreads();
    if (tid == 0) {
        unsigned* bar = b.bar;
        __builtin_amdgcn_s_waitcnt(0);
        unsigned nloc = b.st[0], nx = b.st[1];
        if (nloc == 0u) { xcd_barrier_complete(bar, b.x, nloc, nx); b.st[0] = nloc; b.st[1] = nx; }
        const unsigned old = xb_add(&bar[XB_XSUB(b.x)], 1u);
        const unsigned gen = old / nloc;
        if (old + 1u == (gen + 1u) * nloc) {
            __builtin_amdgcn_fence(__ATOMIC_RELEASE, "agent");
            asm volatile("s_waitcnt vmcnt(0)" ::: "memory");
            const unsigned og = xb_add(&bar[XB_TOP], 1u);
            const unsigned tg = og / nx;
            if (og + 1u == (tg + 1u) * nx) xb_add(&bar[XB_TOPGEN], 1u);
            else XB_SPIN(xb_ld(&bar[XB_TOPGEN]) == tg, bar);
            __builtin_amdgcn_fence(__ATOMIC_ACQUIRE, "agent");
            xb_add(&bar[XB_XGEN(b.x)], 1u);
            asm volatile("s_waitcnt vmcnt(0)" ::: "memory");
        } else {
            XB_SPIN(xb_ld(&bar[XB_XGEN(b.x)]) == gen, bar);
            __builtin_amdgcn_fence(__ATOMIC_ACQUIRE, "agent");
            asm volatile("s_waitcnt vmcnt(0)" ::: "memory");
        }
    }
    __syncthreads();
}

template <int NQ>
__device__ __forceinline__ void p0_rows(const int m0, const int lane, const float* x_prompt, const float* x_sample, bf16_t* XB, float* SSQ, float* SSQS) {
    f32x4 v[NQ][4];
#pragma unroll
    for (int q = 0; q < NQ; ++q) { const int m = m0 + q; const float* xr = m < MP ? x_prompt + (size_t)m * D : x_sample + (size_t)(m - MP) * D;
#pragma unroll
        for (int jj = 0; jj < 4; ++jj) v[q][jj] = ((const f32x4*)xr)[2 * lane + (jj & 1) + 128 * (jj >> 1)]; }
#pragma unroll
    for (int q = 0; q < NQ; ++q) { const int m = m0 + q; float s = 0.f;
#pragma unroll
        for (int jj = 0; jj < 4; ++jj) s += (v[q][jj][0] * v[q][jj][0] + v[q][jj][1] * v[q][jj][1]) + (v[q][jj][2] * v[q][jj][2] + v[q][jj][3] * v[q][jj][3]);
        s = wave_sum(s);
#pragma unroll
        for (int j2 = 0; j2 < 2; ++j2) { u32x4 w; w.x = cvt_pk_bf16(v[q][2 * j2][0], v[q][2 * j2][1]); w.y = cvt_pk_bf16(v[q][2 * j2][2], v[q][2 * j2][3]);
            w.z = cvt_pk_bf16(v[q][2 * j2 + 1][0], v[q][2 * j2 + 1][1]); w.w = cvt_pk_bf16(v[q][2 * j2 + 1][2], v[q][2 * j2 + 1][3]); ((u32x4*)(XB + (size_t)m * D))[lane + 64 * j2] = w; }
        if (m < MP) { if (lane < 4) SSQ[(size_t)lane * MT + m] = lane == 0 ? s : 0.f; }
        else { if (lane < 32) SSQS[(size_t)lane * MS + (m - MP)] = lane == 0 ? s : 0.f; } }
}

constexpr int WGM_QKV = 4, WGM_RES = 4, WGM_UP = 4, WGM_IN = 4;
#define PH(k)
struct Args { const float* in[20]; float* out; unsigned char* ws; };

__global__ void __launch_bounds__(NTHR, 2) fwd_kernel(Args a) {
    extern __shared__ __attribute__((aligned(16))) unsigned char lds_raw[];
    LAS unsigned char* lds = (LAS unsigned char*)lds_raw;
    const int wave0 = __builtin_amdgcn_readfirstlane((int)threadIdx.x >> 6);
    XcdBarrier bar;
    { volatile LAS unsigned* MISC = (volatile LAS unsigned*)(lds + L_MISC);
        if (threadIdx.x < 4) MISC[threadIdx.x] = 0u;
        __syncthreads();
        bar.bar = (unsigned*)(a.ws + WS_CTL); bar.x = xb_xcc_id(); bar.st = MISC;
        if (threadIdx.x == 0) (void)xb_add(&bar.bar[XB_XCNT(bar.x)], 1u); }
#define GRID_BAR() do { PHASE_VARS xcd_barrier(bar, tid); } while (0)
#define PHASE_VARS int tid; asm volatile("v_mbcnt_lo_u32_b32 %0, -1, 0\n\tv_mbcnt_hi_u32_b32 %0, -1, %0" : "=v"(tid)); tid |= wave0 << 6; const int lane = tid & 63, wave = wave0; (void)lane; (void)wave;
    const int G = gridDim.x, bx = blockIdx.x; const int vcu = (G % 8 == 0) ? (bx % 8) * (G / 8) + bx / 8 : bx;
    unsigned char* ws = a.ws; float* out = a.out;
    const float *x_prompt = a.in[0], *x_sample = a.in[1], *cache_k = a.in[2], *cache_v = a.in[3], *state_conv = a.in[4], *ln_mix = a.in[5], *ln_ffn = a.in[6], *ln_final = a.in[7],
                *w_qkv = a.in[8], *rel_bias = a.in[9], *w_o = a.in[10], *w_in = a.in[11], *v_norm = a.in[12], *w_s = a.in[13], *bias_s = a.in[14], *w_out = a.in[15],
                *w_up = a.in[16], *conv_w = a.in[17], *conv_b = a.in[18], *w_down = a.in[19];
    bf16_t *Wqkv_t = (bf16_t*)(ws + WS_WQKV), *Wo_t = (bf16_t*)(ws + WS_WO), *Win_t = (bf16_t*)(ws + WS_WIN), *Wout_t = (bf16_t*)(ws + WS_WOUT);
    bf16_t *XB = (bf16_t*)(ws + WS_XB), *QB = (bf16_t*)(ws + WS_Q), *KB = (bf16_t*)(ws + WS_K), *VB = (bf16_t*)(ws + WS_V), *GB = (bf16_t*)(ws + WS_G), *OB = (bf16_t*)(ws + WS_OB);
    float *SSQ = (float*)(ws + WS_SSQ), *SSQV = (float*)(ws + WS_SSQV), *SSQS = (float*)(ws + WS_SSQS), *SSQVS = (float*)(ws + WS_SSQVS);

    PH(0) { PHASE_VARS
        LAS float* scr = (LAS float*)(lds + wave * 16384);
        const int gw = vcu * NWAVES + wave, NGW = G * NWAVES;
        constexpr int I_QKV = (D / 64) * (3 * D / 32), I_O = (D / 64) * (D / 32), I_IN = (D / 64) * (2 * D / 32), I_UP = (D / 64) * (FF2 / 32), I_DN = (FF / 64) * (D / 32);
        for (int it = gw; it < I_QKV; it += NGW) transpose_item<false, true>(w_qkv, D, 3 * D, ln_mix, Wqkv_t, scr, it, lane);
        for (int m0 = gw * 4; m0 < MP; m0 += NGW * 4) p0_rows<4>(m0, lane, x_prompt, x_sample, XB, SSQ, SSQS);
        for (int m0 = MP + (NGW - 1 - gw); m0 < MT; m0 += NGW) p0_rows<1>(m0, lane, x_prompt, x_sample, XB, SSQ, SSQS);
        for (int c = (vcu * NWAVES + wave) * 64 + lane; c < 16 * 128 * 16; c += G * NTHR) { const int hi_ = c & 1, ks = (c >> 1) & 7, gp_ = c >> 4;
            const float* src = w_s + (size_t)gp_ * 128 + 16 * ks + 4 * hi_; const f32x4 a0 = *(const f32x4*)src, a1 = *(const f32x4*)(src + 8);
            u32x4 w; w.x = cvt_pk_bf16(a0[0], a0[1]); w.y = cvt_pk_bf16(a0[2], a0[3]); w.z = cvt_pk_bf16(a1[0], a1[1]); w.w = cvt_pk_bf16(a1[2], a1[3]);
            ((u32x4*)(ws + WS_WSB))[c] = w; }
    }
    GRID_BAR();

    PH(1) { PHASE_VARS
        pg8::Gemm g{XB, Wqkv_t, D}; pg8::StaticOrder S; S.init(MP / 256, 3 * D / 256, G, bx, 0, WGM_QKV);
        EpiQKV E{QB, (size_t)(WS_K - WS_Q) / 2, SSQ, out + O_KP, out + O_VP};
        typedef SampleRider<D, 96, SQkv> RQ; const RQ R{XB, Wqkv_t, SQkv{SSQS, QB, KB, VB, out + O_KS, out + O_VS}};
        pg8::gemm_phase<EpiQKV, pg8::StaticOrder, RQ>(lds, g, S, E, tid, R);
    }
    GRID_BAR();

    PH(2) { PHASE_VARS
        LAS float* tab = (LAS float*)(lds + att::L_BIAS);
        const int per = (NB * NH * 32 + G - 1) / G;
        int lasth = -1;
        const int id_end = ((vcu + 1) * per < NB * NH * 32) ? (vcu + 1) * per : NB * NH * 32;
        for (int id = vcu * per; id < id_end; ) { const int bh = id >> 5, qg = id & 31, b = bh / NH, h = bh % NH;
            if (h != lasth) { __syncthreads(); for (int i = tid; i < 320; i += NTHR) { const int j = 319 - i; const float tv = rel_bias[h * NREL + (j > 256 ? 256 : j)] * LOG2E; tab[i] = tv; ((LAS float*)(lds + att::L_BIAS2))[i] = tv - rel_bias[h * NREL + 256] * LOG2E; } __syncthreads(); lasth = h; }
            if (qg >= 2) { int nun = id_end - id; if (nun > 32 - qg) nun = 32 - qg;
                att::prompt_unit_fast<8>(b, h, qg, nun, QB, KB, VB, OB, lds, tid); id += nun; }
            else { att::prompt_unit(b, h, qg, QB, KB, VB, OB, lds, tid); ++id; } }
        const bool std_grid = (G == 256);
        for (int n_ = 0; n_ < (std_grid ? ((vcu & 7) < 4 ? 1 : 0) : (DB * NH - vcu + G - 1) / G); ++n_) {
            const int id = std_grid ? 0 : vcu + n_ * G; const int b = std_grid ? (vcu & 3) + 4 * (vcu >> 7) : id / NH, h = std_grid ? ((vcu >> 3) & 15) : id % NH;
            if (h != lasth) { __syncthreads(); for (int i = tid; i < 320; i += NTHR) { const int j = 319 - i; const float tv = rel_bias[h * NREL + (j > 256 ? 256 : j)] * LOG2E; tab[i] = tv; ((LAS float*)(lds + att::L_BIAS2))[i] = tv - rel_bias[h * NREL + 256] * LOG2E; } __syncthreads(); lasth = h; }
            att::sample_unit(b, h, QB, KB, VB, cache_k, cache_v, OB, lds, tid); }
        __syncthreads();
        { constexpr int I_O = (D / 64) * (D / 32), I_UP = (D / 64) * (FF2 / 32), I_DN = (FF / 64) * (D / 32), I_IN = (D / 64) * (2 * D / 32), NIT0 = I_O + I_UP + I_DN + I_IN;
            LAS float* scr = (LAS float*)(lds + wave * 16384);
          for (int sh = 0; sh < (G == 256 ? 1 : 8); ++sh) {
            const int xq = (int)((bar.x + (unsigned)sh) & 7u); unsigned* qh = (unsigned*)(ws + WS_CTL) + CW_QUEUE0 + 64 * xq;
            const int qlo = xq * (NIT0 / 8), qhi = (xq + 1) * (NIT0 / 8);
            for (;;) { unsigned it0 = 0u; if (lane == 0) it0 = __hip_atomic_fetch_add(qh, 1u, __ATOMIC_RELAXED, __HIP_MEMORY_SCOPE_AGENT); it0 = (unsigned)__builtin_amdgcn_readfirstlane((int)it0);
                if ((int)it0 + qlo >= qhi) break;
              for (int sub = 0; sub < 1; ++sub) {
                int r = qlo + (int)it0 + sub; if (r >= qhi) break;
                if (r < I_O) { transpose_item<false, false>(w_o, D, D, nullptr, Wo_t, scr, r, lane); continue; } r -= I_O;
                if (r < I_UP) { transpose_item<true, true>(w_up, D, FF2, ln_ffn, (bf16_t*)(ws + WS_WUP), scr, r, lane); continue; } r -= I_UP;
                if (r < I_DN) { transpose_item<false, false>(w_down, FF, D, nullptr, (bf16_t*)(ws + WS_WDN), scr, r, lane); continue; } r -= I_DN;
                transpose_item<false, true>(w_in, D, 2 * D, ln_mix + D, Win_t, scr, r, lane); } } }
            __syncthreads(); }
}
    GRID_BAR();

#define RES_PHASE(A_, Wt_, KK) RES_PHASE2(A_, Wt_, KK, XB, SSQ, SSQS)
#define RES_PHASE2(A_, Wt_, KK, XO_, SSQO_, SSQSO_) do { \
        pg8::Gemm g{A_, Wt_, KK}; pg8::StaticOrder S; S.init(MP / 256, D / 256, G, bx, 0, WGM_RES); \
        EpiRes E{XB, XO_, SSQO_}; \
        typedef SampleRider<KK, 32, SRes> RR; const RR R{A_, Wt_, SRes{XB, XO_, SSQSO_}};     \
        pg8::gemm_phase<EpiRes, pg8::StaticOrder, RR>(lds, g, S, E, tid, R); } while (0)
    PH(3) { PHASE_VARS RES_PHASE(OB, Wo_t, D); }
    GRID_BAR();

#define UP_PHASE(L_) do { \
        const bf16_t* Wup_ = (const bf16_t*)(ws + WS_WUP + (L_) * WUP_L); const float* cw_ = conv_w + (size_t)(L_) * 3 * FF2; const float* cb_ = conv_b + (size_t)(L_) * FF2; \
        pg8::Gemm g{XB, Wup_, D}; pg8::StaticOrder S; S.init(67, FF2 / 256, G, bx, 1, WGM_UP); \
        EpiUp E{GB, SSQ, SSQS, cw_, cb_, out + O_CP + (size_t)(L_) * NB * 2 * FF2, state_conv + (size_t)(L_) * DB * 2 * FF2, out + O_CS + (size_t)(L_) * DB * 2 * FF2}; \
        pg8::gemm_phase<EpiUp, pg8::StaticOrder>(lds, g, S, E, tid); } while (0)
    PH(4) { PHASE_VARS UP_PHASE(0);
        { constexpr int I_O = (D / 64) * (D / 32), I_IN = (D / 64) * (2 * D / 32), I_UP = (D / 64) * (FF2 / 32), I_DN = (FF / 64) * (D / 32), NIT1 = I_O + I_UP + I_DN;
            LAS float* scr = (LAS float*)(lds + wave * 16384);
          for (int sh = 0; sh < (G == 256 ? 1 : 8); ++sh) {
            const int xq = (int)((bar.x + (unsigned)sh) & 7u); unsigned* qh = (unsigned*)(ws + WS_CTL) + CW_QUEUE + 64 * xq;
            const int qlo = xq * (NIT1 / 8), qhi = (xq + 1) * (NIT1 / 8);
            for (;;) { unsigned it0 = 0u; if (lane == 0) it0 = __hip_atomic_fetch_add(qh, 1u, __ATOMIC_RELAXED, __HIP_MEMORY_SCOPE_AGENT); it0 = (unsigned)__builtin_amdgcn_readfirstlane((int)it0);
                if ((int)it0 + qlo >= qhi) break;
              for (int sub = 0; sub < 1; ++sub) {
                int r = qlo + (int)it0 + sub; if (r >= qhi) break;
                if (r < I_O) { transpose_item<false, false>(w_out, D, D, nullptr, Wout_t, scr, r, lane); continue; } r -= I_O;
                if (r < I_UP) { transpose_item<true, true>(w_up + (size_t)D * FF2, D, FF2, ln_ffn + D, (bf16_t*)(ws + WS_WUP + WUP_L), scr, r, lane); continue; } r -= I_UP;
                transpose_item<false, false>(w_down + (size_t)FF * D, FF, D, nullptr, (bf16_t*)(ws + WS_WDN + WDN_L), scr, r, lane); } } }
            __syncthreads(); } }
    GRID_BAR();
    PH(5) { PHASE_VARS RES_PHASE(GB, (const bf16_t*)(ws + WS_WDN), FF); }
    GRID_BAR();

    PH(6) { PHASE_VARS
        pg8::Gemm g{XB, Win_t, D}; pg8::StaticOrder S; S.init(MP / 256, 2 * D / 256, G, bx, 0, WGM_IN);
        EpiIn E{QB, (size_t)(WS_K - WS_Q) / 2, SSQ, SSQV};
        typedef SampleRider<D, 64, SIn> RI; const RI R{XB, Win_t, SIn{SSQS, QB, KB, SSQVS}};
        pg8::gemm_phase<EpiIn, pg8::StaticOrder, RI>(lds, g, S, E, tid, R);
    }
    GRID_BAR();

    PH(7) { PHASE_VARS
        const int per = (128 * 8 + G - 1) / G;
        for (int id = vcu * per; id < (vcu + 1) * per && id < 128 * 8; ++id) gate::unit(false, id >> 3, id & 7, QB, VB, KB, SSQV, SSQVS, v_norm, (const bf16_t*)(ws + WS_WSB), bias_s, out + O_GV, lds, tid);
        for (int id = vcu; id < DB * 8; id += G) gate::unit(true, id >> 3, id & 7, QB, VB, KB, SSQV, SSQVS, v_norm, (const bf16_t*)(ws + WS_WSB), bias_s, out + O_GV, lds, tid);
    }
    GRID_BAR();

    PH(8) { PHASE_VARS RES_PHASE(VB, Wout_t, D); }
    GRID_BAR();
    PH(9) { PHASE_VARS UP_PHASE(1); }
    GRID_BAR();
    PH(10) { PHASE_VARS
        const bf16_t* Wdn_ = (const bf16_t*)(ws + WS_WDN + WDN_L); unsigned* ctl = (unsigned*)(ws + WS_CTL); float* XCHS = (float*)(ws + WS_XCHS);
        pg8::Gemm g{GB, Wdn_, FF}; pg8::StaticOrder S; S.init(MP / 256, D / 256, G, bx, 0, WGM_RES);
        EpiFinal E{XB, out + O_YP, (float*)(ws + WS_XCH), ctl + CW_PANEL, ln_final};
        typedef SampleRider<FF, 32, SFin> RF; const RF R{GB, Wdn_, SFin{XB, XCHS, ctl + CW_SPANEL, ln_final, out + O_YS}};
        pg8::gemm_phase<EpiFinal, pg8::StaticOrder, RF>(lds, g, S, E, tid, R); }
}

extern "C" void kernel_launch(void* const* d_in, const int* in_sizes, int n_in, void* d_out, int out_size, void* d_ws, size_t ws_size, hipStream_t stream) {
    static int grid = 0;
    if (grid == 0) {
        if (n_in != 20 || (size_t)out_size != O_END || ws_size < WS_END) { fprintf(stderr, "kernel_launch: unexpected sizes n_in %d out %d ws %zu\n", n_in, out_size, ws_size); grid = -1; return; }
        int dev = 0, cus = 0, per_cu = 0;
        if (hipGetDevice(&dev) != hipSuccess || hipDeviceGetAttribute(&cus, hipDeviceAttributeMultiprocessorCount, dev) != hipSuccess) { grid = -1; return; }
        if (hipFuncSetAttribute((const void*)fwd_kernel, hipFuncAttributeMaxDynamicSharedMemorySize, LDS_BYTES) != hipSuccess) { fprintf(stderr, "kernel_launch: hipFuncSetAttribute failed\n"); grid = -1; return; }
        if (hipOccupancyMaxActiveBlocksPerMultiprocessor(&per_cu, (const void*)fwd_kernel, NTHR, LDS_BYTES) != hipSuccess || per_cu < 1) { fprintf(stderr, "kernel_launch: occupancy query says %d\n", per_cu); per_cu = 1; }
        (void)hipGetLastError();
        grid = cus;
    }
    if (grid < 0) return;
    Args a{};
    for (int i = 0; i < 20; ++i) a.in[i] = (const float*)d_in[i];
    a.out = (float*)d_out; a.ws = (unsigned char*)d_ws;
    if (hipMemsetAsync((char*)d_ws + WS_CTL, 0, CTL_BYTES, stream) != hipSuccess) { fprintf(stderr, "kernel_launch: memset of the barrier words failed\n"); return; }
    hipLaunchKernelGGL(fwd_kernel, dim3(grid), dim3(NTHR), LDS_BYTES, stream, a);
    const hipError_t e = hipPeekAtLastError();
    if (e != hipSuccess) fprintf(stderr, "kernel_launch: launch failed: %s (grid %d)\n", hipGetErrorName(e), grid);
}
```

```cpp
#include <hip/hip_runtime.h>
#include <cstdio>
#include <cstdint>

#define LAS __attribute__((address_space(3)))
typedef unsigned short bf16_t;
typedef short bf16x8 __attribute__((ext_vector_type(8)));
typedef short s16x4 __attribute__((ext_vector_type(4)));
typedef float f32x2 __attribute__((ext_vector_type(2)));
typedef float f32x4 __attribute__((ext_vector_type(4)));
typedef float f32x16 __attribute__((ext_vector_type(16)));
typedef unsigned u32x2 __attribute__((ext_vector_type(2)));
typedef unsigned u32x4 __attribute__((ext_vector_type(4)));

constexpr int D = 1024, SEQ = 8192, NB = 2, MP = NB * SEQ, DB = 8, DT = 32, MS = DB * DT, MT = MP + MS;
constexpr int NH = 16, HD = 64, FF = 2816, FF2 = 5632, CA = 512, NREL = 257;
constexpr float EPS = 1e-6f, LOG2E = 1.4426950408889634f, C2 = 0.125f * LOG2E;
constexpr int NWAVES = 8, NTHR = 512;

constexpr size_t MiB = 1u << 20;
constexpr size_t WS_CTL = 0;
constexpr int CW_PANEL = 4096, CW_SPANEL = 4096 + 64 * 64;
constexpr int CW_QUEUE = 4096 + 64 * 64 + 64 * 8, CW_QUEUE0 = CW_QUEUE + 64 * 16;
constexpr size_t CTL_BYTES = 65536;
constexpr size_t WS_WQKV = 1 * MiB, WS_WO = 7 * MiB, WS_WIN = 9 * MiB, WS_WOUT = 13 * MiB, WS_WUP = 15 * MiB, WS_WDN = 37 * MiB;
constexpr size_t WUP_L = (size_t)FF2 * D * 2, WDN_L = (size_t)D * FF * 2;
constexpr size_t WS_XB = 48 * MiB + 65536;
constexpr size_t WS_Q = 82 * MiB, WS_K = 116 * MiB, WS_V = 150 * MiB;
constexpr size_t WS_G = 82 * MiB;
constexpr size_t WS_SSQ = 200 * MiB;
constexpr size_t WS_SSQV = 201 * MiB;
constexpr size_t WS_SSQS = 202 * MiB;
constexpr size_t WS_SSQVS = 202 * MiB + 65536;
constexpr size_t WS_XCH = 203 * MiB, WS_XCHS = 203 * MiB + 512 * 1024;
constexpr size_t WS_OB = 204 * MiB;
constexpr size_t WS_WSB = 237 * MiB;
constexpr size_t WS_END = 238 * MiB;

constexpr size_t O_YP = 0, O_YS = O_YP + (size_t)MP * D, O_KP = O_YS + (size_t)MS * D, O_VP = O_KP + (size_t)NB * CA * D, O_KS = O_VP + (size_t)NB * CA * D,
                 O_VS = O_KS + (size_t)MS * D, O_GV = O_VS + (size_t)MS * D, O_CP = O_GV + (size_t)MS * D, O_CS = O_CP + (size_t)2 * NB * 2 * FF2, O_END = O_CS + (size_t)2 * DB * 2 * FF2;

constexpr int RING_BYTES = 131072;
constexpr int L_XBUF = 131072, L_PTAB = 147456, L_CTAB = 151552, L_RSTAB = 159744, L_RIDER = 131072;
constexpr int L_MISC = 161792;
constexpr int LDS_BYTES = 163840;

__device__ __forceinline__ unsigned cvt_pk_bf16(float lo, float hi) { unsigned r; asm volatile("v_cvt_pk_bf16_f32 %0, %1, %2" : "=v"(r) : "v"(lo), "v"(hi)); return r; }
__device__ __forceinline__ float bf2f(unsigned h) { return __uint_as_float(h << 16); }
__device__ __forceinline__ int crow(int r, int hi) { return (r & 3) + 8 * (r >> 2) + 4 * hi; }
#define LDS_WAIT() asm volatile("s_waitcnt lgkmcnt(0)" ::: "memory")
#define VM_WAIT() asm volatile("s_waitcnt vmcnt(0)" ::: "memory")
#define RAW_BAR() do { asm volatile("s_waitcnt lgkmcnt(0)" ::: "memory"); __builtin_amdgcn_s_barrier(); asm volatile("" ::: "memory"); } while (0)
template <int CTRL> __device__ __forceinline__ float dpp_mov(float x) { return __int_as_float(__builtin_amdgcn_update_dpp(0, __float_as_int(x), CTRL, 0xf, 0xf, true)); }
__device__ __forceinline__ float sum16(float s) { s += dpp_mov<0xB1>(s); s += dpp_mov<0x4E>(s); s += dpp_mov<0x141>(s); s += dpp_mov<0x140>(s); return s; }
__device__ __forceinline__ float xsum16(float x) { auto r = __builtin_amdgcn_permlane16_swap(__float_as_uint(x), __float_as_uint(x), false, false); return __uint_as_float(r[0]) + __uint_as_float(r[1]); }
__device__ __forceinline__ float xsum32(float x) { auto r = __builtin_amdgcn_permlane32_swap(__float_as_uint(x), __float_as_uint(x), false, false); return __uint_as_float(r[0]) + __uint_as_float(r[1]); }
__device__ __forceinline__ float xmax32(float x) { auto r = __builtin_amdgcn_permlane32_swap(__float_as_uint(x), __float_as_uint(x), false, false); return __builtin_fmaxf(__uint_as_float(r[0]), __uint_as_float(r[1])); }
__device__ __forceinline__ float wave_sum(float v) { return xsum32(xsum16(sum16(v))); }
__device__ __forceinline__ f32x2 gelu_pk(f32x2 v) {
    const f32x2 av = __builtin_elementwise_abs(v), d = av * 0.2316418882f + 1.0f;
    f32x2 t; t.x = __builtin_amdgcn_rcpf(d.x); t.y = __builtin_amdgcn_rcpf(d.y);
    f32x2 q = t * 0.5307027145f + (-0.7265760135f); q = q * t + 0.7107068705f; q = q * t + (-0.142248368f); q = q * t + 0.127414796f; q = q * t;
    const f32x2 s = (v * v) * (-0.72134752044f);
    f32x2 e; e.x = __builtin_amdgcn_exp2f(s.x); e.y = __builtin_amdgcn_exp2f(s.y);
    const f32x2 hq = 0.5f - q * e;
    return v * 0.5f + av * hq;
}
__device__ __forceinline__ float gelu1(float x) { f32x2 r = gelu_pk((f32x2){x, x}); return r.x; }
__device__ __forceinline__ float dpp_shr1_old(float old, float x) { return __int_as_float(__builtin_amdgcn_update_dpp(__float_as_int(old), __float_as_int(x), 0x111, 0xf, 0xf, false)); }
__device__ __forceinline__ float dpp_shr1(float x) { return __int_as_float(__builtin_amdgcn_update_dpp(0, __float_as_int(x), 0x111, 0xf, 0xf, true)); }
__device__ __forceinline__ float silu1(float x) { return x * __builtin_amdgcn_rcpf(1.0f + __builtin_amdgcn_exp2f(-x * LOG2E)); }

namespace pg8 {
constexpr int BM = 256, BK = 64, HALF = 128, HTB = HALF * BK * 2, NXCD = 8;
__host__ __device__ __forceinline__ int lds_byte(int r, int c) { const int st = (r >> 4) * 2 + (c >> 5), rr = r & 15, cc = c & 31, ob = rr * 64 + cc * 2; return st * 1024 + (ob ^ (((ob >> 9) & 1) << 5)); }
__host__ __device__ __forceinline__ void stage_rc(int b, int& R, int& C) { const int st = b / 1024, sb = b % 1024, swz = sb ^ (((sb >> 9) & 1) << 5); R = (st >> 1) * 16 + swz / 64; C = (st & 1) * 32 + (swz % 64) / 2; }
__host__ __device__ __forceinline__ int perm32(int rho) { const int n = rho >> 4, i = rho & 15; return 8 * (i >> 2) + 4 * n + (i & 3); }

struct Unit { int pm, pn, arow, seq; };
struct Gemm { const bf16_t* A; const bf16_t* Bt; int K; };

struct StaticOrder {
    int nM, nN, nwg, G, c, up, WGM;
    __device__ void init(int nM_, int nN_, int G_, int c_, int up_, int wgm_) { nM = nM_; nN = nN_; nwg = nM * nN; G = G_; c = c_; up = up_; WGM = wgm_; }
    __device__ bool next(int i, Unit& u) const {
        const long L = (long)i * G + c; if (L >= nwg) return false;
        u.seq = (int)L;
        int wgid = (int)L; { const int q = nwg / NXCD, r = nwg % NXCD, xcd = wgid % NXCD, off = wgid / NXCD; wgid = (xcd < r ? xcd * (q + 1) : r * (q + 1) + (xcd - r) * q) + off; }
        const int nig = WGM * nN, gid = wgid / nig, fm = gid * WGM, gsz = (nM - fm) < WGM ? (nM - fm) : WGM;
        u.pm = fm + ((wgid % nig) % gsz); u.pn = (wgid % nig) / gsz;
        u.arow = up ? (u.pm == 66 ? MP : (u.pm / 33) * SEQ + 254 * (u.pm % 33) - 2) : u.pm * BM;
        return true;
    }
};

struct NoRider { static constexpr bool ON = false; };
template <class E, class = void> struct aperm_t { static constexpr bool v = false; };
template <class E> struct aperm_t<E, decltype((void)E::APERM)> { static constexpr bool v = E::APERM; };
template <class E> __host__ __device__ constexpr bool aperm_of() { return aperm_t<E>::v; }
template <class Epi, class Sched, class Rider = NoRider>
__device__ __forceinline__ void gemm_phase(LAS unsigned char* lds, const Gemm g, const Sched& S, const Epi& E, const int tid, const Rider R = Rider()) {
    const int wid = __builtin_amdgcn_readfirstlane(tid >> 6), lane = tid & 63, wr = wid >> 2, wc = wid & 3, fr = lane & 15, fq = lane >> 4;
    const int K = g.K, nt = K / BK;
    unsigned voffA[2], voffB[2];
#pragma unroll
    for (int i = 0; i < 2; ++i) { int R, C; stage_rc(tid * 16 + i * 8192, R, C); const int Rb = Epi::PERM ? ((R & ~31) + perm32(R & 31)) : R;
        const int Ra = aperm_of<Epi>() ? ((R & 64) + 4 * (R & 15) + ((R >> 4) & 3)) : R;
        voffA[i] = (unsigned)(Ra * K + C) * 2u; voffB[i] = (unsigned)(Rb * K + C) * 2u; }
    const size_t kstep = (size_t)(BK * 2);
    const size_t hstep = (size_t)HALF * K * 2;
    const size_t tstep = 2 * hstep;
    const size_t rstep = (size_t)K * 2;
    const unsigned ldsw = (unsigned)wid * 1024u, ldsu = (unsigned)(uintptr_t)lds;
    const int aoff = lds_byte(wr * 64 + fr, fq * 8), boff = lds_byte(wc * 32 + fr, fq * 8);
#define PG8_SA(b, h) (((b) * 2 + (h)) * HTB)
#define PG8_SB(b, h) ((4 + (b) * 2 + (h)) * HTB)
#define PG8_GLDS(voff_, sbase_, ldsdst_) do { unsigned keep_; asm volatile("s_mov_b32 %0, m0\n\ts_mov_b32 m0, %3\n\ts_nop 0\n\tglobal_load_lds_dwordx4 %1, %2\n\ts_mov_b32 m0, %0" \
        : "=&s"(keep_) : "v"(voff_), "s"(sbase_), "s"(ldsdst_) : "memory"); } while (0)
#define PG8_STAGE(bufoff, gbase, voff) do { const char* sb_ = (const char*)(gbase); _Pragma("unroll") for (int _i = 0; _i < 2; ++_i) \
        PG8_GLDS((voff)[_i], sb_, (unsigned)__builtin_amdgcn_readfirstlane((int)(ldsu + (unsigned)(bufoff) + ldsw + (unsigned)(_i * 8192)))); } while (0)
#define PG8_LDA(dst, b, h) do { _Pragma("unroll") for (int m = 0; m < 4; ++m) _Pragma("unroll") for (int k = 0; k < 2; ++k) dst[m][k] = *(const LAS bf16x8*)(lds + PG8_SA(b, h) + aoff + m * 2048 + k * 1024); } while (0)
#define PG8_LDB(dst, b, h) do { _Pragma("unroll") for (int n = 0; n < 2; ++n) _Pragma("unroll") for (int k = 0; k < 2; ++k) dst[n][k] = *(const LAS bf16x8*)(lds + PG8_SB(b, h) + boff + n * 2048 + k * 1024); } while (0)
#define PG8_MMA(ai, bj, At, Bt) do { __builtin_amdgcn_s_setprio(1); _Pragma("unroll") for (int m = 0; m < 4; ++m) _Pragma("unroll") for (int n = 0; n < 2; ++n) _Pragma("unroll") for (int k = 0; k < 2; ++k) \
        acc[ai][bj][m][n] = __builtin_amdgcn_mfma_f32_16x16x32_bf16(Bt[n][k], At[m][k], acc[ai][bj][m][n], 0, 0, 0); __builtin_amdgcn_s_setprio(0); } while (0)
#define PG8_WAIT_V(n) asm volatile("s_waitcnt vmcnt(" #n ")" ::: "memory")
#define PG8_WAIT_L(n) asm volatile("s_waitcnt lgkmcnt(" #n ")" ::: "memory")
#define PG8_BAR __builtin_amdgcn_s_barrier()
#define PG8_SCHED __builtin_amdgcn_sched_barrier(0)
    Unit cur, nxt; int ui = 0;
    if (!S.next(0, cur)) return;
    f32x4 acc[2][2][4][2];
    u32x4 xin[2][4][2];
    if constexpr (Epi::INIT) E.init_load(xin, cur, wr, wc, fr, fq);
    E.first(cur, lds, tid);
    f32x16 racc; const char* rpa = nullptr; const char* rpb = nullptr; unsigned rvoff = 0u;
    if constexpr (Rider::ON) {
#pragma unroll
        for (int r = 0; r < 16; ++r) racc[r] = 0.f;
        rvoff = (unsigned)(((lane & 31) * Rider::K + (lane >> 5) * 8) * 2);
        R.ptrs(cur.seq, wid, rpa, rpb); }
    bf16x8 At[4][2], B0[2][2], B1[2][2];
    const char* cA = (const char*)g.A + (ptrdiff_t)cur.arow * (ptrdiff_t)rstep; const char* cB = (const char*)g.Bt + (size_t)cur.pn * tstep;
    PG8_STAGE(PG8_SB(0, 0), cB, voffB); PG8_STAGE(PG8_SB(0, 1), cB + hstep, voffB); PG8_STAGE(PG8_SA(0, 0), cA, voffA); PG8_STAGE(PG8_SA(0, 1), cA + hstep, voffA);
#pragma unroll
    for (int a = 0; a < 2; ++a)
#pragma unroll
        for (int m = 0; m < 4; ++m)
#pragma unroll
            for (int b = 0; b < 2; ++b) {
                if constexpr (Epi::INIT) { const u32x4 x4 = xin[a][m][b];
                    acc[a][b][m][0] = (f32x4){bf2f(x4.x & 0xffffu), bf2f(x4.x >> 16), bf2f(x4.y & 0xffffu), bf2f(x4.y >> 16)};
                    acc[a][b][m][1] = (f32x4){bf2f(x4.z & 0xffffu), bf2f(x4.z >> 16), bf2f(x4.w & 0xffffu), bf2f(x4.w >> 16)}; }
                else { acc[a][b][m][0] = (f32x4){0.f, 0.f, 0.f, 0.f}; acc[a][b][m][1] = (f32x4){0.f, 0.f, 0.f, 0.f}; } }
    if (wr == 1) PG8_BAR;
    PG8_WAIT_V(2); PG8_BAR;
    PG8_STAGE(PG8_SB(1, 0), cB + kstep, voffB); PG8_STAGE(PG8_SA(1, 0), cA + kstep, voffA); PG8_STAGE(PG8_SB(1, 1), cB + hstep + kstep, voffB);
    PG8_WAIT_V(6); PG8_BAR;
    for (;;) {
        const bool has_next = S.next(ui + 1, nxt);
        const char* nA = has_next ? (const char*)g.A + (ptrdiff_t)nxt.arow * (ptrdiff_t)rstep : cA; const char* nB = has_next ? (const char*)g.Bt + (size_t)nxt.pn * tstep : cB;
        for (int t = 0; t < nt; t += 2) {
            const bool last = (t == nt - 2);
            const char* a1 = cA + (size_t)(t + 1) * kstep;
            const char* a2 = last ? nA : cA + (size_t)(t + 2) * kstep; const char* b2 = last ? nB : cB + (size_t)(t + 2) * kstep;
            const char* a3 = a2 + kstep; const char* b3 = b2 + kstep;
            bf16x8 ra, rb;
            if constexpr (Rider::ON) { const char* pa_ = rpa + (size_t)t * 16; const char* pb_ = rpb + (size_t)t * 16;
                asm volatile("s_nop 4\n\tglobal_load_dwordx4 %0, %2, %3\n\tglobal_load_dwordx4 %1, %2, %4" : "=&v"(ra), "=&v"(rb) : "v"(rvoff), "s"(pa_), "s"(pb_) : "memory"); }
            PG8_LDB(B0, 0, 0); PG8_LDB(B1, 0, 1); PG8_SCHED; PG8_LDA(At, 0, 0); PG8_STAGE(PG8_SA(1, 1), a1 + hstep, voffA);
            if constexpr (Rider::ON) PG8_WAIT_V(10); else PG8_WAIT_V(8);
            PG8_WAIT_L(0); PG8_BAR; PG8_MMA(0, 0, At, B0); PG8_MMA(0, 1, At, B1); PG8_BAR; PG8_SCHED;
            PG8_LDA(At, 0, 1); PG8_STAGE(PG8_SB(0, 0), b2, voffB); PG8_STAGE(PG8_SB(0, 1), b2 + hstep, voffB); PG8_STAGE(PG8_SA(0, 0), a2, voffA);
            PG8_WAIT_V(8); if constexpr (Rider::ON) asm volatile("" : "+v"(ra), "+v"(rb)); PG8_WAIT_L(0); PG8_BAR; PG8_MMA(1, 0, At, B0); PG8_MMA(1, 1, At, B1); PG8_BAR; PG8_SCHED;
            PG8_LDB(B0, 1, 0); PG8_LDB(B1, 1, 1); PG8_SCHED; PG8_LDA(At, 1, 0); PG8_STAGE(PG8_SA(0, 1), a2 + hstep, voffA);
            PG8_WAIT_V(8); PG8_WAIT_L(0); PG8_BAR; PG8_MMA(0, 0, At, B0); PG8_MMA(0, 1, At, B1); PG8_BAR; PG8_SCHED;
            PG8_LDA(At, 1, 1); PG8_STAGE(PG8_SB(1, 0), b3, voffB); PG8_STAGE(PG8_SB(1, 1), b3 + hstep, voffB); PG8_STAGE(PG8_SA(1, 0), a3, voffA);
            PG8_WAIT_V(8); PG8_WAIT_L(0); PG8_BAR; PG8_MMA(1, 0, At, B0); PG8_MMA(1, 1, At, B1);
            if constexpr (Rider::ON) racc = __builtin_amdgcn_mfma_f32_32x32x16_bf16(ra, rb, racc, 0, 0, 0);
            PG8_BAR; PG8_SCHED;
        }
        if (wr == 0) PG8_BAR;
        E(acc, cur, nxt, has_next, ui & 1, wr, wc, fr, fq, lds, tid);
        if constexpr (Rider::ON) { R.finish(racc, cur.seq, lds, tid);
#pragma unroll
            for (int r = 0; r < 16; ++r) racc[r] = 0.f;
            if (has_next) R.ptrs(nxt.seq, wid, rpa, rpb); }
        if (!has_next) break;
        if constexpr (Epi::INIT) E.init_load(xin, nxt, wr, wc, fr, fq);
#pragma unroll
        for (int a = 0; a < 2; ++a)
#pragma unroll
            for (int m = 0; m < 4; ++m)
#pragma unroll
                for (int b = 0; b < 2; ++b) {
                    if constexpr (Epi::INIT) { const u32x4 x4 = xin[a][m][b];
                        acc[a][b][m][0] = (f32x4){bf2f(x4.x & 0xffffu), bf2f(x4.x >> 16), bf2f(x4.y & 0xffffu), bf2f(x4.y >> 16)};
                        acc[a][b][m][1] = (f32x4){bf2f(x4.z & 0xffffu), bf2f(x4.z >> 16), bf2f(x4.w & 0xffffu), bf2f(x4.w >> 16)}; }
                    else { acc[a][b][m][0] = (f32x4){0.f, 0.f, 0.f, 0.f}; acc[a][b][m][1] = (f32x4){0.f, 0.f, 0.f, 0.f}; } }
        cur = nxt; cA = nA; cB = nB; ++ui;
        if (wr == 1) PG8_BAR;
    }
    PG8_WAIT_V(0);
    PG8_BAR;
#undef PG8_SA
#undef PG8_SB
#undef PG8_STAGE
#undef PG8_GLDS
#undef PG8_LDA
#undef PG8_LDB
#undef PG8_MMA
#undef PG8_WAIT_V
#undef PG8_WAIT_L
#undef PG8_BAR
#undef PG8_SCHED
}
}

typedef f32x4 AccT[2][2][4][2];

__device__ __forceinline__ float rs_issue(const float* ssq, int tok0, int tid) {
    float s = 0.f;
    if (tid < 256) { int tok = tok0 + tid; tok = tok < 0 ? 0 : (tok >= MT ? MT - 1 : tok); s = (ssq[tok] + ssq[MT + tok]) + (ssq[2 * MT + tok] + ssq[3 * MT + tok]); }
    return s;
}
__device__ __forceinline__ void rs_commit(LAS unsigned char* lds, int slot, float s, int tid) { if (tid < 256) ((LAS float*)(lds + L_RSTAB))[slot * 256 + tid] = 1.0f / sqrtf(s * (1.0f / D) + EPS); }

struct EpiQKV {
    static constexpr bool PERM = true, INIT = false;
    bf16_t* O; size_t split_stride; const float* ssq; float* okp; float* ovp;
    __device__ __forceinline__ void first(const pg8::Unit& u, LAS unsigned char* lds, int tid) const { rs_commit(lds, 0, rs_issue(ssq, u.pm * 256, tid), tid); RAW_BAR(); }
    __device__ __forceinline__ void operator()(const AccT& acc, const pg8::Unit& u, const pg8::Unit& nx, bool has_next, int slot, int wr, int wc, int fr0, int fq0, LAS unsigned char* lds, int tid0) const {
        int fr = fr0, fq = fq0, tid = tid0; asm volatile("" : "+v"(fr), "+v"(fq), "+v"(tid));
        float sn = 0.f; if (has_next) sn = rs_issue(ssq, nx.pm * 256, tid);
        const LAS float* rst = (const LAS float*)(lds + L_RSTAB) + slot * 256;
        const int t = u.pn >> 2, colt = (u.pn & 3) * 256; bf16_t* base = O + (size_t)t * split_stride; const float sc = (t == 0) ? C2 : 1.0f;
        const bool side = (t >= 1) && ((u.pm & 31) >= 30);
        float* sp = (t == 1 ? okp : ovp) + ((size_t)((u.pm >> 5) * CA + (u.pm & 1) * 256)) * D;
        const int col0 = colt + wc * 32 + 8 * fq;
#pragma unroll
        for (int ai = 0; ai < 2; ++ai)
#pragma unroll
            for (int m = 0; m < 4; ++m) { const int r = ai * 128 + wr * 64 + m * 16 + fr; const float rs = rst[r] * sc; bf16_t* rowp = base + (size_t)(u.pm * 256 + r) * D + col0;
#pragma unroll
                for (int bj = 0; bj < 2; ++bj) { const f32x4 v0 = acc[ai][bj][m][0] * rs, v1 = acc[ai][bj][m][1] * rs;
                    u32x4 w; w.x = cvt_pk_bf16(v0[0], v0[1]); w.y = cvt_pk_bf16(v0[2], v0[3]); w.z = cvt_pk_bf16(v1[0], v1[1]); w.w = cvt_pk_bf16(v1[2], v1[3]);
                    *(u32x4*)(rowp + bj * 128) = w;
                    if (side) { float* s = sp + (size_t)r * D + col0 + bj * 128; *(f32x4*)s = v0; *(f32x4*)(s + 4) = v1; } } }
        if (has_next) rs_commit(lds, slot ^ 1, sn, tid);
    }
};

__device__ __forceinline__ void res_init_load(u32x4 (&xin)[2][4][2], const bf16_t* xb, const pg8::Unit& u, int wr, int wc, int fr0, int fq0) {
    int fr = fr0, fq = fq0; asm volatile("" : "+v"(fr), "+v"(fq));
    const int col0 = u.pn * 256 + wc * 32 + 8 * fq;
#pragma unroll
    for (int ai = 0; ai < 2; ++ai)
#pragma unroll
        for (int m = 0; m < 4; ++m) { const size_t off = (size_t)(u.pm * 256 + ai * 128 + wr * 64 + m * 16 + fr) * D + col0;
#pragma unroll
            for (int bj = 0; bj < 2; ++bj) xin[ai][m][bj] = *(const u32x4*)(xb + off + bj * 128); }
}
struct EpiRes {
    static constexpr bool PERM = true, INIT = true;
    const bf16_t* xb; bf16_t* xo; float* ssq;
    __device__ __forceinline__ void first(const pg8::Unit&, LAS unsigned char*, int) const {}
    __device__ __forceinline__ void init_load(u32x4 (&xin)[2][4][2], const pg8::Unit& u, int wr, int wc, int fr, int fq) const { res_init_load(xin, xb, u, wr, wc, fr, fq); }
    __device__ __forceinline__ void operator()(const AccT& acc, const pg8::Unit& u, const pg8::Unit&, bool, int, int wr, int wc, int fr0, int fq0, LAS unsigned char* lds, int tid0) const {
        int fr = fr0, fq = fq0, tid = tid0; asm volatile("" : "+v"(fr), "+v"(fq), "+v"(tid));
        LAS float* P = (LAS float*)(lds + L_PTAB);
        const int col0 = u.pn * 256 + wc * 32 + 8 * fq;
#pragma unroll
        for (int ai = 0; ai < 2; ++ai)
#pragma unroll
            for (int m = 0; m < 4; ++m) { const int r = ai * 128 + wr * 64 + m * 16 + fr; const size_t off = (size_t)(u.pm * 256 + r) * D + col0; float s = 0.f;
#pragma unroll
                for (int bj = 0; bj < 2; ++bj) { const f32x4 a0 = acc[ai][bj][m][0], a1 = acc[ai][bj][m][1];
                    s += ((a0[0] * a0[0] + a0[1] * a0[1]) + (a0[2] * a0[2] + a0[3] * a0[3])) + ((a1[0] * a1[0] + a1[1] * a1[1]) + (a1[2] * a1[2] + a1[3] * a1[3]));
                    u32x4 w; w.x = cvt_pk_bf16(a0[0], a0[1]); w.y = cvt_pk_bf16(a0[2], a0[3]); w.z = cvt_pk_bf16(a1[0], a1[1]); w.w = cvt_pk_bf16(a1[2], a1[3]); *(u32x4*)(xo + off + bj * 128) = w; }
                s = xsum32(xsum16(s));
                if (fq == 0) P[r * 4 + wc] = s; }
        RAW_BAR();
        if (tid < 256) { const f32x4 p = *(const LAS f32x4*)(P + tid * 4); ssq[(size_t)u.pn * MT + u.pm * 256 + tid] = (p[0] + p[1]) + (p[2] + p[3]); }
    }
};

__device__ __forceinline__ void wait_count(unsigned* cnt, unsigned want, int tid) {
    if (tid == 0) { unsigned sp = 0;
        while (__hip_atomic_load(cnt, __ATOMIC_RELAXED, __HIP_MEMORY_SCOPE_AGENT) < want) { __builtin_amdgcn_s_sleep(2); if (++sp > (1u << 22)) break; }
        __builtin_amdgcn_fence(__ATOMIC_ACQUIRE, "agent"); }
    asm volatile("s_waitcnt vmcnt(0)" ::: "memory");
    RAW_BAR();
}
struct EpiFinal {
    static constexpr bool PERM = true, INIT = true;
    const bf16_t* xb; float* out; float* ssq; unsigned* cnt; const float* gfin;
    __device__ __forceinline__ void first(const pg8::Unit&, LAS unsigned char*, int) const {}
    __device__ __forceinline__ void init_load(u32x4 (&xin)[2][4][2], const pg8::Unit& u, int wr, int wc, int fr, int fq) const { res_init_load(xin, xb, u, wr, wc, fr, fq); }
    __device__ __forceinline__ void operator()(AccT& acc, const pg8::Unit& u, const pg8::Unit&, bool, int, int wr, int wc, int fr0, int fq0, LAS unsigned char* lds, int tid0) const {
        int fr = fr0, fq = fq0, tid = tid0; asm volatile("" : "+v"(fr), "+v"(fq), "+v"(tid));
        LAS float* P = (LAS float*)(lds + L_PTAB); LAS float* rst = (LAS float*)(lds + L_RSTAB);
        const int col0 = u.pn * 256 + wc * 32 + 8 * fq;
#pragma unroll
        for (int ai = 0; ai < 2; ++ai)
#pragma unroll
            for (int m = 0; m < 4; ++m) { const int r = ai * 128 + wr * 64 + m * 16 + fr; float s = 0.f;
#pragma unroll
                for (int bj = 0; bj < 2; ++bj) { const f32x4 a0 = acc[ai][bj][m][0], a1 = acc[ai][bj][m][1];
                    s += ((a0[0] * a0[0] + a0[1] * a0[1]) + (a0[2] * a0[2] + a0[3] * a0[3])) + ((a1[0] * a1[0] + a1[1] * a1[1]) + (a1[2] * a1[2] + a1[3] * a1[3])); }
                s = xsum32(xsum16(s));
                if (fq == 0) P[r * 4 + wc] = s; }
        RAW_BAR();
        if (tid < 256) { const f32x4 p = *(const LAS f32x4*)(P + tid * 4);
            __hip_atomic_store(ssq + (size_t)u.pn * MT + u.pm * 256 + tid, (p[0] + p[1]) + (p[2] + p[3]), __ATOMIC_RELAXED, __HIP_MEMORY_SCOPE_AGENT); }
        asm volatile("s_waitcnt vmcnt(0)" ::: "memory");
        RAW_BAR();
        if (tid == 0) __hip_atomic_fetch_add(cnt + 64 * u.pm, 1u, __ATOMIC_RELAXED, __HIP_MEMORY_SCOPE_AGENT);
        wait_count(cnt + 64 * u.pm, 4u, tid);
        if (tid < 256) { float s = 0.f;
#pragma unroll
            for (int t = 0; t < 4; ++t) s += __hip_atomic_load(ssq + (size_t)t * MT + u.pm * 256 + tid, __ATOMIC_RELAXED, __HIP_MEMORY_SCOPE_AGENT);
            rst[tid] = 1.0f / sqrtf(s * (1.0f / D) + EPS); }
        RAW_BAR();
        f32x4 gv[2][2];
#pragma unroll
        for (int bj = 0; bj < 2; ++bj)
#pragma unroll
            for (int n = 0; n < 2; ++n) gv[bj][n] = *(const f32x4*)(gfin + col0 + bj * 128 + n * 4);
#pragma unroll
        for (int ai = 0; ai < 2; ++ai)
#pragma unroll
            for (int m = 0; m < 4; ++m) { const int r = ai * 128 + wr * 64 + m * 16 + fr; const float rs = rst[r]; const size_t off = (size_t)(u.pm * 256 + r) * D + col0;
#pragma unroll
                for (int bj = 0; bj < 2; ++bj)
#pragma unroll
                    for (int n = 0; n < 2; ++n) *(f32x4*)(out + off + bj * 128 + n * 4) = acc[ai][bj][m][n] * rs * gv[bj][n]; }
    }
};

struct EpiIn {
    static constexpr bool PERM = true, INIT = false;
    bf16_t* O; size_t split_stride; const float* ssq; float* ssqv;
    __device__ __forceinline__ void first(const pg8::Unit& u, LAS unsigned char* lds, int tid) const { rs_commit(lds, 0, rs_issue(ssq, u.pm * 256, tid), tid); RAW_BAR(); }
    __device__ __forceinline__ void operator()(const AccT& acc, const pg8::Unit& u, const pg8::Unit& nx, bool has_next, int slot, int wr, int wc, int fr0, int fq0, LAS unsigned char* lds, int tid0) const {
        int fr = fr0, fq = fq0, tid = tid0; asm volatile("" : "+v"(fr), "+v"(fq), "+v"(tid));
        float sn = 0.f; if (has_next) sn = rs_issue(ssq, nx.pm * 256, tid);
        const LAS float* rst = (const LAS float*)(lds + L_RSTAB) + slot * 256; LAS float* P = (LAS float*)(lds + L_PTAB);
        const int t = u.pn >> 2, colt = (u.pn & 3) * 256; bf16_t* base = O + (size_t)t * split_stride;
        const int col0 = colt + wc * 32 + 8 * fq;
#pragma unroll
        for (int ai = 0; ai < 2; ++ai)
#pragma unroll
            for (int m = 0; m < 4; ++m) { const int r = ai * 128 + wr * 64 + m * 16 + fr; const float rs = rst[r]; bf16_t* rowp = base + (size_t)(u.pm * 256 + r) * D + col0; float s = 0.f;
#pragma unroll
                for (int bj = 0; bj < 2; ++bj) { const f32x4 x0 = acc[ai][bj][m][0] * rs, x1 = acc[ai][bj][m][1] * rs;
                    const f32x2 a = gelu_pk((f32x2){x0[0], x0[1]}), b = gelu_pk((f32x2){x0[2], x0[3]}), c = gelu_pk((f32x2){x1[0], x1[1]}), d = gelu_pk((f32x2){x1[2], x1[3]});
                    s += (a.x * a.x + a.y * a.y) + (b.x * b.x + b.y * b.y) + (c.x * c.x + c.y * c.y) + (d.x * d.x + d.y * d.y);
                    u32x4 w; w.x = cvt_pk_bf16(a.x, a.y); w.y = cvt_pk_bf16(b.x, b.y); w.z = cvt_pk_bf16(c.x, c.y); w.w = cvt_pk_bf16(d.x, d.y);
                    *(u32x4*)(rowp + bj * 128) = w; }
                if (t == 1) { s = xsum32(xsum16(s)); if (fq == 0) P[r * 4 + wc] = s; } }
        if (t == 1) { RAW_BAR();
            if (tid < 256) { const f32x4 p = *(const LAS f32x4*)(P + tid * 4); ssqv[(size_t)(u.pn & 3) * MT + u.pm * 256 + tid] = (p[0] + p[1]) + (p[2] + p[3]); } }
        if (has_next) rs_commit(lds, slot ^ 1, sn, tid);
    }
};

__device__ __forceinline__ void conv_dpp(f32x4& o, const f32x4 cur, const f32x4 prv, const f32x4 w1, const f32x4 w0) {
#define CONV1(e) "v_fmac_f32_dpp %" #e ", %[c" #e "], %[a" #e "] row_shr:1 row_mask:0xf bank_mask:0xf bound_ctrl:1\n\t" \
                 "v_fmac_f32_dpp %" #e ", %[p" #e "], %[a" #e "] row_shl:15 row_mask:0xf bank_mask:0xf bound_ctrl:1\n\t" \
                 "v_fmac_f32_dpp %" #e ", %[c" #e "], %[b" #e "] row_shr:2 row_mask:0xf bank_mask:0xf bound_ctrl:1\n\t" \
                 "v_fmac_f32_dpp %" #e ", %[p" #e "], %[b" #e "] row_shl:14 row_mask:0xf bank_mask:0xf bound_ctrl:1\n\t"
    float o0 = o[0], o1 = o[1], o2 = o[2], o3 = o[3];
    asm("s_nop 1\n\t" CONV1(0) CONV1(1) CONV1(2) CONV1(3)
        : "+v"(o0), "+v"(o1), "+v"(o2), "+v"(o3)
        : [c0] "v"(cur[0]), [c1] "v"(cur[1]), [c2] "v"(cur[2]), [c3] "v"(cur[3]), [p0] "v"(prv[0]), [p1] "v"(prv[1]), [p2] "v"(prv[2]), [p3] "v"(prv[3]),
          [a0] "v"(w1[0]), [a1] "v"(w1[1]), [a2] "v"(w1[2]), [a3] "v"(w1[3]), [b0] "v"(w0[0]), [b1] "v"(w0[1]), [b2] "v"(w0[2]), [b3] "v"(w0[3]));
    o = (f32x4){o0, o1, o2, o3};
#undef CONV1
}

struct EpiUp {
    static constexpr bool PERM = true, INIT = false, APERM = true;
    bf16_t* G; const float* ssq; const float* ssqs; const float* cw; const float* cb; float* ocp; const float* hist; float* ocs;
    __device__ __forceinline__ float rs_iss(const pg8::Unit& u, int tid) const {
        if (u.pm != 66) return rs_issue(ssq, u.arow, tid);
        float s = 0.f;
        if (tid < 256) {
#pragma unroll 8
            for (int jj = 0; jj < 32; ++jj) s += ssqs[(size_t)jj * MS + tid]; }
        return s;
    }
    __device__ __forceinline__ f32x2 ct_iss(const pg8::Unit& u, int tid) const {
        const int c = tid & 255, wh = tid >> 8, oc = (c >> 7) * FF + u.pn * 128 + (c & 127);
        f32x2 r; r.x = cw[(size_t)wh * FF2 + oc]; r.y = wh == 0 ? cw[(size_t)2 * FF2 + oc] : cb[oc]; return r;
    }
    __device__ __forceinline__ void ct_commit(LAS unsigned char* lds, int slot, f32x2 v, int tid) const {
        LAS float* ct = (LAS float*)(lds + L_CTAB) + slot * 1024; const int c = tid & 255, wh = tid >> 8;
        const float sc = (c >> 7) ? -1.0f / LOG2E : -LOG2E;
        ct[wh * 256 + c] = v.x * sc; ct[(wh == 0 ? 2 : 3) * 256 + c] = v.y * sc;
    }
    __device__ __forceinline__ void first(const pg8::Unit& u, LAS unsigned char* lds, int tid) const { rs_commit(lds, 0, rs_iss(u, tid), tid); ct_commit(lds, 0, ct_iss(u, tid), tid); RAW_BAR(); }
    __device__ __forceinline__ void operator()(AccT& acc, const pg8::Unit& u, const pg8::Unit& nx, bool has_next, int slot, int wr, int wc, int fr0, int fq0, LAS unsigned char* lds, int tid0) const {
        int fr = fr0, fq = fq0, tid = tid0; asm volatile("" : "+v"(fr), "+v"(fq), "+v"(tid));
        float sn = 0.f; f32x2 cn = (f32x2){0.f, 0.f};
        if (has_next) { sn = rs_iss(nx, tid); cn = ct_iss(nx, tid); }
        const bool smp = u.pm == 66;
        const int b = u.pm / 33, j = smp ? 1 : u.pm % 33, tok0 = u.arow;
        const LAS float* rst = (const LAS float*)(lds + L_RSTAB) + slot * 256; LAS float* xbuf = (LAS float*)(lds + L_XBUF); const LAS float* ct = (const LAS float*)(lds + L_CTAB) + slot * 1024;
#pragma unroll
        for (int ai = 0; ai < 2; ++ai) { const f32x4 rs4 = *(const LAS f32x4*)(rst + ai * 128 + wr * 64 + 4 * fr);
#pragma unroll
            for (int m = 0; m < 4; ++m)
#pragma unroll
                for (int bj = 0; bj < 2; ++bj)
#pragma unroll
                    for (int n = 0; n < 2; ++n) acc[ai][bj][m][n] *= rs4[m]; }
        if (j == 0 && wr == 0 && fr == 0) {
#pragma unroll
            for (int bj = 0; bj < 2; ++bj)
#pragma unroll
                for (int n = 0; n < 2; ++n) { acc[0][bj][0][n] = (f32x4){0.f, 0.f, 0.f, 0.f}; acc[0][bj][1][n] = (f32x4){0.f, 0.f, 0.f, 0.f}; } }
        const int cl = wc * 32 + 8 * fq;
        if (j == 32 && wr == 1 && fr == 0) {
#pragma unroll
            for (int r = 0; r < 2; ++r)
#pragma unroll
                for (int bj = 0; bj < 2; ++bj)
#pragma unroll
                    for (int n = 0; n < 2; ++n) *(f32x4*)(ocp + (size_t)(b * 2 + r) * FF2 + bj * FF + u.pn * 128 + cl + 4 * n) = acc[0][bj][r][n]; }
        if (smp && (fr & 7) == 7) {
            const int cl_ = cl;
#pragma unroll
            for (int ai = 0; ai < 2; ++ai)
#pragma unroll
                for (int r = 0; r < 2; ++r)
#pragma unroll
                    for (int bj = 0; bj < 2; ++bj)
#pragma unroll
                        for (int n = 0; n < 2; ++n) *(f32x4*)(ocs + (size_t)((2 * (2 * ai + wr) + (fr >> 3)) * 2 + r) * FF2 + bj * FF + u.pn * 128 + cl_ + 4 * n) = acc[ai][bj][2 + r][n]; }
        if (!smp) {
            if (fr == 15) {
#pragma unroll
                for (int ai = 0; ai < 2; ++ai)
                    if (2 * ai + wr < 3) {
#pragma unroll
                        for (int r = 0; r < 2; ++r)
#pragma unroll
                            for (int bj = 0; bj < 2; ++bj)
#pragma unroll
                                for (int n = 0; n < 2; ++n) *(LAS f32x4*)(xbuf + ((2 * (2 * ai + wr + 1)) * 2 + r) * 256 + bj * 128 + cl + 4 * n) = acc[ai][bj][2 + r][n]; } }
        } else if (fr >= 14) {
#pragma unroll 1
            for (int q4 = 0; q4 < 4; ++q4) { const int q = (q4 >> 1) * 4 + wr * 2 + (q4 & 1);
#pragma unroll 1
                for (int bj = 0; bj < 2; ++bj) { const f32x4 h0 = *(const f32x4*)(hist + (size_t)(q * 2 + (fr - 14)) * FF2 + bj * FF + u.pn * 128 + cl), h1 = *(const f32x4*)(hist + (size_t)(q * 2 + (fr - 14)) * FF2 + bj * FF + u.pn * 128 + cl + 4);
                    *(LAS f32x4*)(xbuf + (q * 2 + (fr - 14)) * 256 + bj * 128 + cl) = h0; *(LAS f32x4*)(xbuf + (q * 2 + (fr - 14)) * 256 + bj * 128 + cl + 4) = h1; } }
        }
        RAW_BAR();
        const int bend = smp ? MT : (b + 1) * SEQ;
        const int hq = smp ? (fr >> 3) : 0;
        u32x2 wlo[2][4];
#pragma unroll
        for (int n = 0; n < 2; ++n) {
            f32x4 w0[2], w1[2], w2[2], cbv[2];
#pragma unroll
            for (int bj = 0; bj < 2; ++bj) { const int tc = bj * 128 + cl + 4 * n;
                w0[bj] = *(const LAS f32x4*)(ct + tc); w1[bj] = *(const LAS f32x4*)(ct + 256 + tc); w2[bj] = *(const LAS f32x4*)(ct + 512 + tc); cbv[bj] = *(const LAS f32x4*)(ct + 768 + tc); }
#pragma unroll
            for (int ai = 0; ai < 2; ++ai) {
                f32x4 c[4][2];
#pragma unroll
                for (int bj = 0; bj < 2; ++bj) {
                    const f32x4 a0 = acc[ai][bj][0][n], a1 = acc[ai][bj][1][n], a2 = acc[ai][bj][2][n], a3 = acc[ai][bj][3][n];
                    const LAS float* hp = xbuf + ((2 * (2 * ai + wr) + hq) * 2) * 256 + bj * 128 + cl + 4 * n;
                    const f32x4 h2 = *(const LAS f32x4*)hp, h1 = *(const LAS f32x4*)(hp + 256);
                    f32x4 s1, s2;
#pragma unroll
                    for (int e = 0; e < 4; ++e) { s1[e] = dpp_shr1_old(h1[e], a3[e]); s2[e] = dpp_shr1_old(h2[e], a2[e]); }
                    if (smp) { asm volatile("" ::: "memory");
                        const f32x4 g2 = *(const LAS f32x4*)hp, g1 = *(const LAS f32x4*)(hp + 256);
#pragma unroll
                        for (int e = 0; e < 4; ++e) { s1[e] = fr == 8 ? g1[e] : s1[e]; s2[e] = fr == 8 ? g2[e] : s2[e]; } }
                    c[3][bj] = cbv[bj] + w2[bj] * a3 + w1[bj] * a2 + w0[bj] * a1;
                    c[2][bj] = cbv[bj] + w2[bj] * a2 + w1[bj] * a1 + w0[bj] * a0;
                    c[1][bj] = cbv[bj] + w2[bj] * a1 + w1[bj] * a0 + w0[bj] * s1;
                    c[0][bj] = cbv[bj] + w2[bj] * a0 + w1[bj] * s1 + w0[bj] * s2; }
#pragma unroll
                for (int m = 0; m < 4; ++m) {
                    const int tr = ai * 128 + wr * 64 + 4 * fr + m, tok = tok0 + tr;
                    u32x2 w;
                    const f32x4 t_ = c[m][0]; f32x4 e_ = (f32x4){__builtin_amdgcn_exp2f(t_[0]), __builtin_amdgcn_exp2f(t_[1]), __builtin_amdgcn_exp2f(t_[2]), __builtin_amdgcn_exp2f(t_[3])};
                    e_ += 1.0f; const f32x4 r_ = (f32x4){__builtin_amdgcn_rcpf(e_[0]), __builtin_amdgcn_rcpf(e_[1]), __builtin_amdgcn_rcpf(e_[2]), __builtin_amdgcn_rcpf(e_[3])};
                    const f32x4 g_ = (t_ * c[m][1]) * r_;
                    w.x = cvt_pk_bf16(g_[0], g_[1]); w.y = cvt_pk_bf16(g_[2], g_[3]);
                    if (n == 0) wlo[ai][m] = w;
                    else if ((smp || tr >= 2) && tok < bend) { const u32x2 w0_ = wlo[ai][m]; *(u32x4*)(G + (size_t)tok * FF + u.pn * 128 + cl) = (u32x4){w0_.x, w0_.y, w.x, w.y}; }
                }
            }
        }
        if (has_next) { rs_commit(lds, slot ^ 1, sn, tid); ct_commit(lds, slot ^ 1, cn, tid); }
    }
};

__device__ __forceinline__ float srs_load(const float* ssqs, int mt, int tid) { const int row = tid >> 4, jj = tid & 15; return ssqs[(size_t)jj * MS + mt * 32 + row] + ssqs[(size_t)(jj + 16) * MS + mt * 32 + row]; }
__device__ __forceinline__ float srs_finish(float s) { s = sum16(s); return 1.0f / sqrtf(s * (1.0f / D) + EPS); }

template <int K_, int NTN, class SEpi> struct SampleRider {
    static constexpr bool ON = true; static constexpr int K = K_;
    const bf16_t* A; const bf16_t* Bt; SEpi epi;
    __device__ __forceinline__ void ptrs(int seq, int wid, const char*& pa, const char*& pb) const {
        const int mt = seq / NTN, nt = seq % NTN;
        pa = (const char*)(A + ((size_t)(MP + 32 * mt) * K + wid * (K / 8)));
        pb = (const char*)(Bt + ((size_t)(32 * nt) * K + wid * (K / 8)));
    }
    __device__ __forceinline__ void finish(const f32x16& racc, int seq, LAS unsigned char* lds, int tid0) const {
        int tid = tid0; asm volatile("" : "+v"(tid));
        const int lane = tid & 63, r32 = lane & 31, hi = lane >> 5, w = tid >> 6, mt = seq / NTN, nt = seq % NTN;
        const float pre = epi.pre(mt, nt, tid);
#define RSLOT(i) ((LAS float*)(lds + ((i) < 4 ? L_XBUF + (i) * 4096 : L_CTAB + ((i) - 4) * 4096)))
        if (w < 6) { LAS float* part = RSLOT(w);
#pragma unroll
            for (int r = 0; r < 16; ++r) part[crow(r, hi) * 32 + r32] = racc[r]; }
        RAW_BAR();
        if (w >= 6) { LAS float* part = RSLOT(w - 2);
#pragma unroll
            for (int r = 0; r < 16; ++r) part[crow(r, hi) * 32 + r32] += racc[r]; }
        RAW_BAR();
        const int row = tid >> 4, c0 = (tid & 15) * 2; f32x2 v = (f32x2){0.f, 0.f};
#pragma unroll
        for (int sl = 0; sl < 6; ++sl) v += *(const LAS f32x2*)(RSLOT(sl) + row * 32 + c0);
#undef RSLOT
        epi(mt, nt, row, c0, v.x, v.y, pre, tid);
    }
};
struct SQkv {
    const float* ssqs; bf16_t* QB; bf16_t* KB; bf16_t* VB; float* oks; float* ovs;
    __device__ __forceinline__ float pre(int mt, int, int tid) const { return srs_load(ssqs, mt, tid); }
    __device__ __forceinline__ void operator()(int mt, int nt, int row, int c0, float a0, float a1, float pre, int tid) const {
        const float r_ = srs_finish(pre); const int n = 32 * nt + c0, t = n >> 10, nn = n & 1023; const float v0 = a0 * r_, v1 = a1 * r_, sc = t == 0 ? C2 : 1.0f;
        bf16_t* dst = QB + (size_t)t * ((WS_K - WS_Q) / 2) + (size_t)(MP + 32 * mt + row) * D + nn; *(unsigned*)dst = cvt_pk_bf16(v0 * sc, v1 * sc);
        if (t >= 1) { float* o = oks + (size_t)(t - 1) * (O_VS - O_KS) + (size_t)(32 * mt + row) * D + nn; *(f32x2*)o = (f32x2){v0, v1}; }
    }
};
struct SRes {
    const bf16_t* XB; bf16_t* XO; float* ssqs;
    __device__ __forceinline__ float pre(int mt, int nt, int tid) const { return __uint_as_float(*(const unsigned*)(XB + (size_t)(MP + 32 * mt + (tid >> 4)) * D + 32 * nt + (tid & 15) * 2)); }
    __device__ __forceinline__ void operator()(int mt, int nt, int row, int c0, float a0, float a1, float pre, int tid) const {
        const size_t xo_ = (size_t)(MP + 32 * mt + row) * D + 32 * nt + c0; const unsigned bb = __float_as_uint(pre);
        const float v0 = bf2f(bb & 0xffffu) + a0, v1 = bf2f(bb >> 16) + a1; *(unsigned*)(XO + xo_) = cvt_pk_bf16(v0, v1);
        float s_ = v0 * v0 + v1 * v1; s_ = sum16(s_);
        if ((tid & 15) == 0) ssqs[(size_t)nt * MS + 32 * mt + row] = s_;
    }
};
struct SIn {
    const float* ssqs; bf16_t* UB; bf16_t* VB; float* ssqvs;
    __device__ __forceinline__ float pre(int mt, int, int tid) const { return srs_load(ssqs, mt, tid); }
    __device__ __forceinline__ void operator()(int mt, int nt, int row, int c0, float a0, float a1, float pre, int tid) const {
        const float r_ = srs_finish(pre); const int n = 32 * nt + c0, t = n >> 10, nn = n & 1023;
        const f32x2 z = gelu_pk((f32x2){a0 * r_, a1 * r_});
        *(unsigned*)(UB + (size_t)t * ((WS_K - WS_Q) / 2) + (size_t)(MP + 32 * mt + row) * D + nn) = cvt_pk_bf16(z.x, z.y);
        if (t == 1) { float s_ = z.x * z.x + z.y * z.y; s_ = sum16(s_);
            if ((tid & 15) == 0) ssqvs[(size_t)(nt - 32) * MS + 32 * mt + row] = s_; }
    }
};

struct SFin {
    const bf16_t* XB; float* xchs; unsigned* cnt; const float* gfin; float* ys;
    __device__ __forceinline__ float pre(int mt, int nt, int tid) const { return __uint_as_float(*(const unsigned*)(XB + (size_t)(MP + 32 * mt + (tid >> 4)) * D + 32 * nt + (tid & 15) * 2)); }
    __device__ __forceinline__ void operator()(int mt, int nt, int row, int c0, float a0, float a1, float pre, int tid) const {
        const int n = 32 * nt + c0; const unsigned bb = __float_as_uint(pre);
        const float v0 = bf2f(bb & 0xffffu) + a0, v1 = bf2f(bb >> 16) + a1;
        float s_ = v0 * v0 + v1 * v1; s_ = sum16(s_);
        if ((tid & 15) == 0) __hip_atomic_store(xchs + (size_t)nt * MS + 32 * mt + row, s_, __ATOMIC_RELAXED, __HIP_MEMORY_SCOPE_AGENT);
        asm volatile("s_waitcnt vmcnt(0)" ::: "memory");
        RAW_BAR();
        if (tid == 0) __hip_atomic_fetch_add(cnt + 64 * mt, 1u, __ATOMIC_RELAXED, __HIP_MEMORY_SCOPE_AGENT);
        wait_count(cnt + 64 * mt, 32u, tid);
        const int jj = tid & 15; float t_ = __hip_atomic_load(xchs + (size_t)jj * MS + 32 * mt + row, __ATOMIC_RELAXED, __HIP_MEMORY_SCOPE_AGENT) + __hip_atomic_load(xchs + (size_t)(jj + 16) * MS + 32 * mt + row, __ATOMIC_RELAXED, __HIP_MEMORY_SCOPE_AGENT);
        t_ = sum16(t_);
        const float rs = 1.0f / sqrtf(t_ * (1.0f / D) + EPS);
        *(f32x2*)(ys + (size_t)(32 * mt + row) * D + n) = (f32x2){v0 * rs * gfin[n], v1 * rs * gfin[n + 1]};
    }
};

namespace att {
constexpr int NS = 6, SLOTB = 8192;
constexpr int L_K = 0, L_V = NS * SLOTB, L_OST = 2 * NS * SLOTB, L_BIAS = 131072, L_WSF = 132352, L_BIAS2 = 134400;
#define SBAR() __builtin_amdgcn_sched_barrier(0)
__device__ __forceinline__ void glds16(const void* gsrc, unsigned lds_dst) { unsigned keep;
    asm volatile("s_mov_b32 %0, m0\n\ts_mov_b32 m0, %2\n\ts_nop 0\n\tglobal_load_lds_dwordx4 %1, off\n\ts_mov_b32 m0, %0" : "=&s"(keep) : "v"(gsrc), "s"(lds_dst) : "memory"); }
#define WAIT_BAR(N) asm volatile("s_waitcnt vmcnt(" #N ") lgkmcnt(0)\n\ts_barrier" ::: "memory")

struct State { float m, l; f32x16 o[2]; };

__device__ __forceinline__ void tile(State& st, const bf16x8 (&qr)[4], unsigned kslot, unsigned vslot, float cinit, bool near, int base, bool mask1, const LAS float* tab, LAS float* wsf, int r32, int hi, int lane) {
    f32x16 p0, p1;
    { const LAS char* kb = (const LAS char*)(uintptr_t)kslot + hi * 1024 + r32 * 16;
        f32x16 ci;
#pragma unroll
        for (int r = 0; r < 16; ++r) ci[r] = cinit;
#pragma unroll
        for (int d0 = 0; d0 < 4; ++d0) { const bf16x8 b0 = *(const LAS bf16x8*)(kb + d0 * 2048), b1 = *(const LAS bf16x8*)(kb + d0 * 2048 + 512);
            if (d0 == 0) { p0 = __builtin_amdgcn_mfma_f32_32x32x16_bf16(b0, qr[0], ci, 0, 0, 0); p1 = __builtin_amdgcn_mfma_f32_32x32x16_bf16(b1, qr[0], ci, 0, 0, 0); }
            else { p0 = __builtin_amdgcn_mfma_f32_32x32x16_bf16(b0, qr[d0], p0, 0, 0, 0); p1 = __builtin_amdgcn_mfma_f32_32x32x16_bf16(b1, qr[d0], p1, 0, 0, 0); } } }
    if (near) {
#pragma unroll
        for (int r = 0; r < 16; ++r) { const LAS float* tb = tab + (319 - base) + 4 * hi; p0[r] += tb[(r & 3) + 8 * (r >> 2)]; p1[r] += tb[32 + (r & 3) + 8 * (r >> 2)]; } }
    if (mask1) {
#pragma unroll
        for (int r = 0; r < 16; ++r) p1[r] = -1e30f; }
    float rm = fmaxf(p0[0], p1[0]);
#pragma unroll
    for (int r = 1; r < 16; ++r) rm = fmaxf(rm, fmaxf(p0[r], p1[r]));
    rm = xmax32(rm);
    const float mn = fmaxf(st.m, rm);
    if (__any(mn > st.m)) {
        const float f = __builtin_amdgcn_exp2f(st.m - mn); st.l *= f; st.m = mn;
        if (hi == 0) wsf[r32] = f;
        LDS_WAIT();
#pragma unroll
        for (int g = 0; g < 4; ++g) { const f32x4 fv = *(const LAS f32x4*)(wsf + 8 * g + 4 * hi);
#pragma unroll
            for (int e = 0; e < 4; ++e) { st.o[0][4 * g + e] *= fv[e]; st.o[1][4 * g + e] *= fv[e]; } }
    }
    float sacc = 0.f;
#pragma unroll
    for (int r = 0; r < 16; ++r) { p0[r] = __builtin_amdgcn_exp2f(p0[r] - st.m); p1[r] = __builtin_amdgcn_exp2f(p1[r] - st.m); sacc += p0[r] + p1[r]; }
    st.l += sacc;
    u32x4 pw[4];
#pragma unroll
    for (int k = 0; k < 2; ++k) { pw[k] = (u32x4){cvt_pk_bf16(p0[8 * k], p0[8 * k + 1]), cvt_pk_bf16(p0[8 * k + 2], p0[8 * k + 3]), cvt_pk_bf16(p0[8 * k + 4], p0[8 * k + 5]), cvt_pk_bf16(p0[8 * k + 6], p0[8 * k + 7])};
        pw[2 + k] = (u32x4){cvt_pk_bf16(p1[8 * k], p1[8 * k + 1]), cvt_pk_bf16(p1[8 * k + 2], p1[8 * k + 3]), cvt_pk_bf16(p1[8 * k + 4], p1[8 * k + 5]), cvt_pk_bf16(p1[8 * k + 6], p1[8 * k + 7])}; }
    const int vb = (int)vslot + ((lane >> 4) & 1) * 32 + (lane & 3) * 8 + (4 * hi + ((lane & 15) >> 2)) * 64;
#pragma unroll
    for (int d0 = 0; d0 < 2; ++d0) { s16x4 lo[4], hh[4];
#pragma unroll
        for (int ks = 0; ks < 4; ++ks) {
            asm volatile("ds_read_b64_tr_b16 %0,%1 offset:%c2" : "=&v"(lo[ks]) : "v"(vb), "i"(d0 * 4096 + ks * 1024) : "memory");
            asm volatile("ds_read_b64_tr_b16 %0,%1 offset:%c2" : "=&v"(hh[ks]) : "v"(vb), "i"(d0 * 4096 + ks * 1024 + 512) : "memory"); }
        asm volatile("s_waitcnt lgkmcnt(0)" ::: "memory"); SBAR();
#pragma unroll
        for (int ks = 0; ks < 4; ++ks) { const bf16x8 vf = (bf16x8){lo[ks][0], lo[ks][1], lo[ks][2], lo[ks][3], hh[ks][0], hh[ks][1], hh[ks][2], hh[ks][3]};
            st.o[d0] = __builtin_amdgcn_mfma_f32_32x32x16_bf16(__builtin_bit_cast(bf16x8, pw[ks]), vf, st.o[d0], 0, 0, 0); }
    }
}

__device__ __forceinline__ void prompt_unit(int b, int h, int qg, const bf16_t* Q, const bf16_t* Kg, const bf16_t* Vg, bf16_t* O, LAS unsigned char* lds, const int tid) {
    const int lane = tid & 63, r32 = lane & 31, hi = lane >> 5; const int wid = __builtin_amdgcn_readfirstlane(tid >> 6);
    const int c0 = 4 * qg, pj = wid >> 1, half = wid & 1; const long rowbase = (long)b * SEQ;
    const unsigned lds0 = (unsigned)(uintptr_t)lds;
    const LAS float* tab = (const LAS float*)(lds + L_BIAS); LAS float* wsf = (LAS float*)(lds + L_WSF) + wid * 64;
    const bf16_t* Qw = Q + (rowbase + 64 * (c0 + pj) + 32 * half) * D + h * HD;
    const bf16_t* Kh = Kg + rowbase * D + h * HD; const bf16_t* Vh = Vg + rowbase * D + h * HD;
#define DMA_T(i) do { int ck_ = c0 - 8 + (i); ck_ = ck_ < 0 ? 0 : ck_; const unsigned so_ = (unsigned)(((i) % NS) * SLOTB + wid * 1024); \
        glds16(Kh + (long)(64 * ck_ + lane) * D + wid * 8, (unsigned)__builtin_amdgcn_readfirstlane(lds0 + L_K + so_)); \
        glds16(Vh + (long)(64 * ck_ + 16 * (wid & 3) + (lane >> 2)) * D + (wid >> 2) * 32 + (lane & 3) * 8, (unsigned)__builtin_amdgcn_readfirstlane(lds0 + L_V + so_)); } while (0)
    DMA_T(0); DMA_T(1); DMA_T(2); DMA_T(3); DMA_T(4);
    bf16x8 qr[4];
#pragma unroll
    for (int d0 = 0; d0 < 4; ++d0) qr[d0] = *(const bf16x8*)(Qw + (long)r32 * D + d0 * 16 + hi * 8);
    State st; st.m = -1e30f; st.l = 0.f;
#pragma unroll
    for (int r = 0; r < 16; ++r) { st.o[0][r] = 0.f; st.o[1][r] = 0.f; }
    const float cfar = tab[63];
    const int ql = 32 * half + r32;
    for (int s = 0; s < 9; ++s) {
        if (s == 0) { WAIT_BAR(0); asm volatile("" : "+v"(qr[0]), "+v"(qr[1]), "+v"(qr[2]), "+v"(qr[3])); }
        else if (s < 8) WAIT_BAR(2); else WAIT_BAR(0);
        if (s + 5 < 12) DMA_T(s + 5);
        const int ck = c0 - 8 + s + pj;
        if (ck >= 0) { const int sl = (s + pj) % NS; const bool near = s >= 6;
            tile(st, qr, lds0 + L_K + sl * SLOTB, lds0 + L_V + sl * SLOTB, near ? 0.f : cfar, near, 64 * (8 - s) + ql + 128, false, tab, wsf, r32, hi, lane); }
    }
#undef DMA_T
    float l = xsum32(st.l);
    if (hi == 0) wsf[32 + r32] = l;
    LDS_WAIT();
    float rli[16];
#pragma unroll
    for (int r = 0; r < 16; ++r) rli[r] = __builtin_amdgcn_rcpf(wsf[32 + crow(r, hi)]);
    bf16_t* Ow = O + (rowbase + 64 * (c0 + pj) + 32 * half) * D + h * HD;
    { LAS bf16_t* stg = (LAS bf16_t*)(lds + L_OST) + wid * 2048;
#pragma unroll
        for (int r = 0; r < 16; ++r) { const int orow = crow(r, hi);
#pragma unroll
            for (int d0 = 0; d0 < 2; ++d0) stg[orow * 64 + d0 * 32 + r32] = (bf16_t)(cvt_pk_bf16(st.o[d0][r] * rli[r], 0.f) & 0xffffu); }
        LDS_WAIT();
#pragma unroll
        for (int i = 0; i < 4; ++i) { const int row = i * 8 + (lane >> 3), ch = lane & 7; const u32x4 v = *(const LAS u32x4*)(stg + row * 64 + ch * 8); *(u32x4*)(Ow + (long)row * D + ch * 8) = v; } }
    asm volatile("s_waitcnt lgkmcnt(0)\n\ts_barrier" ::: "memory");
}

typedef const LAS char* lds_cptr;
typedef short v4i16_t __attribute__((ext_vector_type(4)));
__device__ __forceinline__ void kload8(bf16x8* kf, lds_cptr kp) {
    kf[0] = *(const LAS bf16x8*)(kp);        kf[1] = *(const LAS bf16x8*)(kp + 512);
    kf[2] = *(const LAS bf16x8*)(kp + 2048); kf[3] = *(const LAS bf16x8*)(kp + 2560);
    kf[4] = *(const LAS bf16x8*)(kp + 4096); kf[5] = *(const LAS bf16x8*)(kp + 4608);
    kf[6] = *(const LAS bf16x8*)(kp + 6144); kf[7] = *(const LAS bf16x8*)(kp + 6656);
}
__device__ __forceinline__ void kload2(bf16x8* kf, lds_cptr kp, int j) { kf[2 * j] = *(const LAS bf16x8*)(kp + j * 2048); kf[2 * j + 1] = *(const LAS bf16x8*)(kp + j * 2048 + 512); }
__device__ __forceinline__ s16x4 vtr(lds_cptr p) { return __builtin_bit_cast(s16x4, __builtin_amdgcn_ds_read_tr16_b64_v4i16((LAS v4i16_t*)p)); }
__device__ __forceinline__ float max3f(float a, float b, float c) { float r; asm("v_max3_f32 %0, %1, %2, %3" : "=v"(r) : "v"(a), "v"(b), "v"(c)); return r; }
__device__ __forceinline__ float max2f(float a, float b) { float r; asm("v_max_f32_e32 %0, %1, %2" : "=v"(r) : "v"(a), "v"(b)); return r; }
__device__ __forceinline__ float fadd_s(float a, float b) { float r; asm("v_add_f32_e32 %0, %1, %2" : "=v"(r) : "v"(a), "v"(b)); return r; }
__device__ __forceinline__ float fsub_s(float a, float b) { float r; asm("v_sub_f32_e32 %0, %1, %2" : "=v"(r) : "v"(a), "v"(b)); return r; }
typedef float f32x2_t __attribute__((ext_vector_type(2))); typedef __bf16 bf16x2_t __attribute__((ext_vector_type(2)));
__device__ __forceinline__ unsigned cvtpk_s(float lo, float hi) { f32x2_t v = {lo, hi}; bf16x2_t b = __builtin_convertvector(v, bf16x2_t); return __builtin_bit_cast(unsigned, b); }
#define WAIT_BAR2(N) asm volatile("s_waitcnt vmcnt(" #N ") lgkmcnt(0)\n\ts_barrier" ::: "memory")

template <int THRL>
__device__ __forceinline__ void prompt_unit_fast(int b, int h, int qg, const bf16_t* Q, const bf16_t* Kg, const bf16_t* Vg, bf16_t* O, LAS unsigned char* lds, const int tid) {
    const int lane = tid & 63, r32 = lane & 31, hi = lane >> 5; const int wid = __builtin_amdgcn_readfirstlane(tid >> 6);
    const int c0 = 4 * qg, pj = wid >> 1, half = wid & 1; const long rowbase = (long)b * SEQ;
    const unsigned lds0 = (unsigned)(uintptr_t)lds;
    const LAS float* tab = (const LAS float*)(lds + L_BIAS); const LAS float* tab2 = (const LAS float*)(lds + L_BIAS2); LAS float* wsf = (LAS float*)(lds + L_WSF) + wid * 64;
    const bf16_t* Qw = Q + (rowbase + 64 * (c0 + pj) + 32 * half) * D + h * HD;
    const bf16_t* Kh = Kg + (rowbase + 64 * (c0 - 8)) * D + h * HD; const bf16_t* Vh = Vg + (rowbase + 64 * (c0 - 8)) * D + h * HD;
    const bf16_t* ksrc = Kh + (long)lane * D + wid * 8;
    const bf16_t* vsrc = Vh + (long)(16 * (wid & 3) + (lane >> 2)) * D + (wid >> 2) * 32 + (lane & 3) * 8;
#define SLOT(i) ((unsigned)(((i) % NS) * SLOTB))
#define DMA_K(i) glds16(ksrc + (long)(i) * 64 * D, (unsigned)__builtin_amdgcn_readfirstlane(lds0 + L_K + SLOT(i) + wid * 1024))
#define DMA_V(i) glds16(vsrc + (long)(i) * 64 * D, (unsigned)__builtin_amdgcn_readfirstlane(lds0 + L_V + SLOT(i) + wid * 1024))
    const lds_cptr kp0 = (lds_cptr)lds + L_K + hi * 1024 + r32 * 16;
    const lds_cptr vp0 = (lds_cptr)lds + L_V + ((lane >> 4) & 1) * 32 + (lane & 3) * 8 + (4 * hi + ((lane & 15) >> 2)) * 64;
    DMA_K(0); DMA_K(1); DMA_K(2); DMA_K(3); DMA_K(4); DMA_K(5); DMA_V(0); DMA_V(1); DMA_V(2); DMA_V(3);
    bf16x8 qr[4];
#pragma unroll
    for (int d0 = 0; d0 < 4; ++d0) qr[d0] = *(const bf16x8*)(Qw + (long)r32 * D + d0 * 16 + hi * 8);
    const float cfar = tab[63];
    float mhat = 0.f, l_reg = 0.f; f32x16 o[2];
#pragma unroll
    for (int r = 0; r < 16; ++r) { o[0][r] = 0.f; o[1][r] = 0.f; }
    f32x16 negm;
#pragma unroll
    for (int r = 0; r < 16; ++r) negm[r] = cfar;
    asm volatile("" : "+v"(negm));
    const int ql = 32 * half + r32;
    bf16x8 kf[8];
    WAIT_BAR2(0);
    asm volatile("" : "+v"(qr[0]), "+v"(qr[1]), "+v"(qr[2]), "+v"(qr[3]));
    kload8(kf, kp0 + SLOT(pj));
    WAIT_BAR2(0);
    bool resc = false;
    f32x16 pA0, pA1, pB0, pB1;
    s16x4 vlo[8], vhi[8]; u32x4 pw0, pw1, pw2, pw3;
#define PKW(P, B) cvtpk_s(P[B], P[B + 1])
#define PAF(k) __builtin_bit_cast(bf16x8, pw##k)
#define VFR(i) (bf16x8){vlo[i][0], vlo[i][1], vlo[i][2], vlo[i][3], vhi[i][0], vhi[i][1], vhi[i][2], vhi[i][3]}
#define PIN(x) asm volatile("" : "+v"(x))
#define MX3(a, b, c) __builtin_fmaxf(__builtin_fmaxf((a), (b)), (c))
#define MF(a, b, c) __builtin_amdgcn_mfma_f32_32x32x16_bf16(a, b, c, 0, 0, 0)
#define GAPA(MFX, A0, A1, A2, A3, W0, W1, PW) do { MFX; sacc += A0; sacc += A1; sacc += A2; sacc += A3; PIN(sacc); W0; W1; PIN(PW); SBAR(); } while (0)
#define EX(v) __builtin_amdgcn_exp2f(v)
#define GAPB(MFX, X, B) do { MFX; X[B] = EX(X[B]); X[B + 1] = EX(X[B + 1]); X[B + 2] = EX(X[B + 2]); X[B + 3] = EX(X[B + 3]); PIN(X); SBAR(); } while (0)
#define VRD(i) do { vlo[i] = vtr(vp_ + (((i) >> 2) * 4096 + ((i) & 3) * 1024)); vhi[i] = vtr(vp_ + (((i) >> 2) * 4096 + ((i) & 3) * 1024 + 512)); } while (0)
#define KRD(GL, j) do { if (GL) { kload2(kf, kn_, j); SBAR(); } } while (0)
#define NEARB(C0, C1, s) do { if ((s) >= 6) { const LAS float* tb_ = tab2 + (319 - (64 * (8 - (s)) + ql + 128)) + 4 * hi; \
        _Pragma("unroll") for (int r = 0; r < 16; ++r) { C0[r] += tb_[(r & 3) + 8 * (r >> 2)]; C1[r] += tb_[32 + (r & 3) + 8 * (r >> 2)]; } } } while (0)
#define DECIDE(C0, C1) do { float a_ = MX3(C0[0], C0[1], C1[0]), b_ = MX3(C0[2], C0[3], C1[1]); a_ = MX3(a_, C1[2], C1[3]); \
        _Pragma("unroll") for (int r = 4; r < 16; r += 4) { a_ = MX3(a_, C0[r], C0[r + 1]); b_ = MX3(b_, C0[r + 2], C0[r + 3]); a_ = MX3(a_, C1[r], C1[r + 1]); b_ = MX3(b_, C1[r + 2], C1[r + 3]); } \
        float rm_ = __builtin_fmaxf(a_, b_); rm_ = xmax32(rm_); \
        resc = false; \
        if (__builtin_expect(__any(rm_ > (float)THRL), 0)) { const float dl_ = __builtin_fmaxf(rm_, 0.f); mhat += dl_; \
            _Pragma("unroll") for (int r = 0; r < 16; ++r) { C0[r] -= dl_; C1[r] -= dl_; } \
            _Pragma("unroll") for (int r = 0; r < 16; ++r) negm[r] = cfar - mhat; asm volatile("" : "+v"(negm)); \
            const float f_ = __builtin_amdgcn_exp2f(-dl_); l_reg *= f_; if (hi == 0) wsf[r32] = f_; resc = true; } } while (0)
#define RESC() do { if (resc) { asm volatile("s_waitcnt lgkmcnt(0)" ::: "memory"); \
        _Pragma("unroll") for (int g_ = 0; g_ < 4; ++g_) { const f32x4 fv_ = *(const LAS f32x4*)(wsf + 8 * g_ + 4 * hi); \
            _Pragma("unroll") for (int e_ = 0; e_ < 4; ++e_) { o[0][4 * g_ + e_] *= fv_[e_]; o[1][4 * g_ + e_] *= fv_[e_]; } } } } while (0)
#define STEP(C0, C1, P0, P1, t, GK, GV, GL) do { SBAR(); \
        const lds_cptr vp_ = vp0 + SLOT((t) - 1 + pj); const lds_cptr kn_ = kp0 + SLOT((t) + 1 + pj); \
        VRD(0); SBAR(); float sacc = (P0[0] + P0[1]); \
        GAPA(C0 = MF(kf[0], qr[0], negm), P0[2], P0[3], P0[4], P0[5],     pw0[0] = PKW(P0, 0), pw0[1] = PKW(P0, 2), pw0); \
        VRD(4); SBAR(); GAPA(C1 = MF(kf[1], qr[0], negm), P0[6], P0[7], P0[8], P0[9],     pw0[2] = PKW(P0, 4), pw0[3] = PKW(P0, 6), pw0); \
        VRD(1); SBAR(); GAPA(C0 = MF(kf[2], qr[1], C0),   P0[10], P0[11], P0[12], P0[13], pw1[0] = PKW(P0, 8), pw1[1] = PKW(P0, 10), pw1); \
        VRD(5); SBAR(); GAPA(C1 = MF(kf[3], qr[1], C1),   P0[14], P0[15], P1[0], P1[1],   pw1[2] = PKW(P0, 12), pw1[3] = PKW(P0, 14), pw1); \
        VRD(2); SBAR(); GAPA(C0 = MF(kf[4], qr[2], C0),   P1[2], P1[3], P1[4], P1[5],     pw2[0] = PKW(P1, 0), pw2[1] = PKW(P1, 2), pw2); \
        VRD(6); SBAR(); GAPA(C1 = MF(kf[5], qr[2], C1),   P1[6], P1[7], P1[8], P1[9],     pw2[2] = PKW(P1, 4), pw2[3] = PKW(P1, 6), pw2); \
        VRD(3); SBAR(); GAPA(C0 = MF(kf[6], qr[3], C0),   P1[10], P1[11], P1[12], P1[13], pw3[0] = PKW(P1, 8), pw3[1] = PKW(P1, 10), pw3); \
        VRD(7); SBAR(); GAPA(C1 = MF(kf[7], qr[3], C1),   P1[14], P1[15], 0.f, 0.f,       pw3[2] = PKW(P1, 12), pw3[3] = PKW(P1, 14), pw3); \
        l_reg += sacc; \
        if (GK) { DMA_K((t) + 6); } if (GV) { DMA_V((t) + 4); } \
        NEARB(C0, C1, t); \
        DECIDE(C0, C1); \
        SBAR(); \
        GAPB(o[0] = MF(PAF(0), VFR(0), o[0]), C0, 0); \
        GAPB(o[1] = MF(PAF(0), VFR(4), o[1]), C0, 4); \
        KRD(GL, 0); GAPB(o[0] = MF(PAF(1), VFR(1), o[0]), C0, 8); \
        KRD(GL, 1); GAPB(o[1] = MF(PAF(1), VFR(5), o[1]), C0, 12); \
        KRD(GL, 2); GAPB(o[0] = MF(PAF(2), VFR(2), o[0]), C1, 0); \
        KRD(GL, 3); GAPB(o[1] = MF(PAF(2), VFR(6), o[1]), C1, 4); \
        GAPB(o[0] = MF(PAF(3), VFR(3), o[0]), C1, 8); \
        GAPB(o[1] = MF(PAF(3), VFR(7), o[1]), C1, 12); \
    } while (0)
    DMA_K(6); DMA_V(4);
    {
#pragma unroll
        for (int d0 = 0; d0 < 4; ++d0) {
            if (d0 == 0) { pA0 = MF(kf[0], qr[0], negm); pA1 = MF(kf[1], qr[0], negm); }
            else { pA0 = MF(kf[2 * d0], qr[d0], pA0); pA1 = MF(kf[2 * d0 + 1], qr[d0], pA1); } }
        float rm = fmaxf(pA0[0], pA1[0]);
#pragma unroll
        for (int r = 1; r < 16; ++r) rm = fmaxf(rm, fmaxf(pA0[r], pA1[r]));
        rm = xmax32(rm);
        mhat = rm;
#pragma unroll
        for (int r = 0; r < 16; ++r) { pA0[r] = __builtin_amdgcn_exp2f(pA0[r] - rm); pA1[r] = __builtin_amdgcn_exp2f(pA1[r] - rm); }
#pragma unroll
        for (int r = 0; r < 16; ++r) negm[r] = cfar - mhat;
        asm volatile("" : "+v"(negm));
    }
    kload8(kf, kp0 + SLOT(1 + pj));
    WAIT_BAR2(2);
    STEP(pB0, pB1, pA0, pA1, 1, true, true, true);   WAIT_BAR2(2); RESC();
    STEP(pA0, pA1, pB0, pB1, 2, true, true, true);   WAIT_BAR2(2); RESC();
    STEP(pB0, pB1, pA0, pA1, 3, true, true, true);   WAIT_BAR2(2); RESC();
    STEP(pA0, pA1, pB0, pB1, 4, true, true, true);   WAIT_BAR2(2); RESC();
    STEP(pB0, pB1, pA0, pA1, 5, true, true, true);   WAIT_BAR2(2); RESC();
    STEP(pA0, pA1, pB0, pB1, 6, false, true, true);  WAIT_BAR2(1); RESC();
    STEP(pB0, pB1, pA0, pA1, 7, false, true, true);  WAIT_BAR2(1); RESC();
    STEP(pA0, pA1, pB0, pB1, 8, false, false, false); WAIT_BAR2(0); RESC();
    { float sacc = pA0[0] + pA0[1];
#pragma unroll
        for (int r = 2; r < 16; ++r) sacc += pA0[r];
#pragma unroll
        for (int r = 0; r < 16; ++r) sacc += pA1[r];
        l_reg += sacc;
        pw0 = (u32x4){PKW(pA0, 0), PKW(pA0, 2), PKW(pA0, 4), PKW(pA0, 6)}; pw1 = (u32x4){PKW(pA0, 8), PKW(pA0, 10), PKW(pA0, 12), PKW(pA0, 14)};
        pw2 = (u32x4){PKW(pA1, 0), PKW(pA1, 2), PKW(pA1, 4), PKW(pA1, 6)}; pw3 = (u32x4){PKW(pA1, 8), PKW(pA1, 10), PKW(pA1, 12), PKW(pA1, 14)};
        SBAR();
        const int vb = (int)(lds0 + L_V + SLOT(8 + pj)) + ((lane >> 4) & 1) * 32 + (lane & 3) * 8 + (4 * hi + ((lane & 15) >> 2)) * 64;
#pragma unroll
        for (int d0 = 0; d0 < 2; ++d0) { s16x4 lo[4], hh[4];
#pragma unroll
            for (int ks = 0; ks < 4; ++ks) {
                asm volatile("ds_read_b64_tr_b16 %0,%1 offset:%c2" : "=&v"(lo[ks]) : "v"(vb), "i"(d0 * 4096 + ks * 1024) : "memory");
                asm volatile("ds_read_b64_tr_b16 %0,%1 offset:%c2" : "=&v"(hh[ks]) : "v"(vb), "i"(d0 * 4096 + ks * 1024 + 512) : "memory"); }
            asm volatile("s_waitcnt lgkmcnt(0)" ::: "memory"); SBAR();
            o[d0] = MF(PAF(0), ((bf16x8){lo[0][0], lo[0][1], lo[0][2], lo[0][3], hh[0][0], hh[0][1], hh[0][2], hh[0][3]}), o[d0]);
            o[d0] = MF(PAF(1), ((bf16x8){lo[1][0], lo[1][1], lo[1][2], lo[1][3], hh[1][0], hh[1][1], hh[1][2], hh[1][3]}), o[d0]);
            o[d0] = MF(PAF(2), ((bf16x8){lo[2][0], lo[2][1], lo[2][2], lo[2][3], hh[2][0], hh[2][1], hh[2][2], hh[2][3]}), o[d0]);
            o[d0] = MF(PAF(3), ((bf16x8){lo[3][0], lo[3][1], lo[3][2], lo[3][3], hh[3][0], hh[3][1], hh[3][2], hh[3][3]}), o[d0]); } }
    { float l = xsum32(l_reg);
        if (hi == 0) wsf[32 + r32] = l;
        LDS_WAIT();
        float rli[16];
#pragma unroll
        for (int r = 0; r < 16; ++r) rli[r] = __builtin_amdgcn_rcpf(wsf[32 + crow(r, hi)]);
        bf16_t* Ow = O + (rowbase + 64 * (c0 + pj) + 32 * half) * D + h * HD;
        LAS bf16_t* stg = (LAS bf16_t*)(lds + L_OST) + wid * 2048;
#pragma unroll
        for (int r = 0; r < 16; ++r) { const int orow = crow(r, hi);
#pragma unroll
            for (int d0 = 0; d0 < 2; ++d0) stg[orow * 64 + d0 * 32 + r32] = (bf16_t)(cvt_pk_bf16(o[d0][r] * rli[r], 0.f) & 0xffffu); }
        LDS_WAIT();
#pragma unroll
        for (int i = 0; i < 4; ++i) { const int row = i * 8 + (lane >> 3), ch = lane & 7; const u32x4 v = *(const LAS u32x4*)(stg + row * 64 + ch * 8); *(u32x4*)(Ow + (long)row * D + ch * 8) = v; } }
    asm volatile("s_waitcnt lgkmcnt(0)\n\ts_barrier" ::: "memory");
#undef SLOT
#undef DMA_K
#undef DMA_V
#undef PKW
#undef PAF
#undef VFR
#undef PIN
#undef MX3
#undef MF
#undef GAPA
#undef EX
#undef GAPB
#undef VRD
#undef KRD
#undef NEARB
#undef DECIDE
#undef RESC
#undef STEP
}
#undef WAIT_BAR2

__device__ __forceinline__ void sample_unit(int b, int h, const bf16_t* Q, const bf16_t* Kg, const bf16_t* Vg, const float* CKf, const float* CVf, bf16_t* O, LAS unsigned char* lds, const int tid) {
    const int lane = tid & 63, r32 = lane & 31, hi = lane >> 5; const int wid = __builtin_amdgcn_readfirstlane(tid >> 6);
    const unsigned lds0 = (unsigned)(uintptr_t)lds;
    const LAS float* tab = (const LAS float*)(lds + L_BIAS); LAS float* wsf = (LAS float*)(lds + L_WSF) + wid * 64;
    const long srow = (long)MP + 32 * b;
    const bf16_t* Qw = Q + srow * D + h * HD;
    const unsigned ks = lds0 + wid * 16384, vs = ks + 8192;
    const unsigned ks9 = lds0 + 136192;
    if (wid == 0) {
        const bf16_t* Kn = Kg + srow * D + h * HD; const bf16_t* Vn = Vg + srow * D + h * HD;
#pragma unroll
        for (int p = 0; p < 8; ++p) { const int kr = lane < 32 ? lane : 31; const int vr0 = 16 * (p & 3) + (lane >> 2), vr = vr0 < 32 ? vr0 : 31;
            glds16(Kn + (long)kr * D + p * 8, (unsigned)__builtin_amdgcn_readfirstlane(ks9 + p * 1024));
            glds16(Vn + (long)vr * D + (p >> 2) * 32 + (lane & 3) * 8, (unsigned)__builtin_amdgcn_readfirstlane(ks9 + 8192 + p * 1024)); } }
    { const float* Kc = CKf + ((long)b * CA + 64 * wid) * D + h * HD; const float* Vc = CVf + ((long)b * CA + 64 * wid) * D + h * HD;
        LAS unsigned char* kl = lds + wid * 16384; LAS unsigned char* vl = kl + 8192;
        f32x4 t0[8], t1[8], u0[8], u1[8];
#pragma unroll
        for (int p = 0; p < 8; ++p) { const float* src = Kc + (long)lane * D + p * 8; t0[p] = *(const f32x4*)src; t1[p] = *(const f32x4*)(src + 4); }
#pragma unroll
        for (int p = 0; p < 8; ++p) { const float* src = Vc + (long)(16 * (p & 3) + (lane >> 2)) * D + (p >> 2) * 32 + (lane & 3) * 8; u0[p] = *(const f32x4*)src; u1[p] = *(const f32x4*)(src + 4); }
#pragma unroll
        for (int p = 0; p < 8; ++p) { u32x4 w; w.x = cvt_pk_bf16(t0[p][0], t0[p][1]); w.y = cvt_pk_bf16(t0[p][2], t0[p][3]); w.z = cvt_pk_bf16(t1[p][0], t1[p][1]); w.w = cvt_pk_bf16(t1[p][2], t1[p][3]);
            *(LAS u32x4*)(kl + p * 1024 + lane * 16) = w; }
#pragma unroll
        for (int p = 0; p < 8; ++p) { u32x4 w; w.x = cvt_pk_bf16(u0[p][0], u0[p][1]); w.y = cvt_pk_bf16(u0[p][2], u0[p][3]); w.z = cvt_pk_bf16(u1[p][0], u1[p][1]); w.w = cvt_pk_bf16(u1[p][2], u1[p][3]);
            *(LAS u32x4*)(vl + p * 1024 + lane * 16) = w; } }
    bf16x8 qr[4];
#pragma unroll
    for (int d0 = 0; d0 < 4; ++d0) qr[d0] = *(const bf16x8*)(Qw + (long)r32 * D + d0 * 16 + hi * 8);
    State st; st.m = -1e30f; st.l = 0.f;
#pragma unroll
    for (int r = 0; r < 16; ++r) { st.o[0][r] = 0.f; st.o[1][r] = 0.f; }
    asm volatile("s_waitcnt vmcnt(0) lgkmcnt(0)" ::: "memory"); asm volatile("" : "+v"(qr[0]), "+v"(qr[1]), "+v"(qr[2]), "+v"(qr[3]));
    { const bool near = wid >= 6; tile(st, qr, ks, vs, near ? 0.f : tab[63], near, r32 + 512 - 64 * wid + 128, false, tab, wsf, r32, hi, lane); }
    if (wid == 0) tile(st, qr, ks9, ks9 + 8192, 0.f, true, r32 + 128, true, tab, wsf, r32, hi, lane);
    const float l = xsum32(st.l);
    asm volatile("s_waitcnt lgkmcnt(0)\n\ts_barrier" ::: "memory");
    LAS float* OP = (LAS float*)lds;
    LAS float* MLp = (LAS float*)(lds + 65536);
#pragma unroll
    for (int r = 0; r < 16; ++r) { const int q = crow(r, hi); OP[(wid * 32 + q) * 64 + r32] = st.o[0][r]; OP[(wid * 32 + q) * 64 + 32 + r32] = st.o[1][r]; }
    if (hi == 0) { MLp[wid * 32 + r32] = st.m; MLp[256 + wid * 32 + r32] = l; }
    __syncthreads();
    { const int q = tid >> 4, d4 = (tid & 15) * 4; float mg = -1e30f;
#pragma unroll
        for (int w = 0; w < 8; ++w) mg = fmaxf(mg, MLp[w * 32 + q]);
        f32x4 num = (f32x4){0.f, 0.f, 0.f, 0.f}; float den = 0.f;
#pragma unroll
        for (int w = 0; w < 8; ++w) { const float f = __builtin_amdgcn_exp2f(MLp[w * 32 + q] - mg); den += f * MLp[256 + w * 32 + q]; num += *(const LAS f32x4*)(OP + (w * 32 + q) * 64 + d4) * f; }
        const float rd = 1.0f / den; u32x2 w2; w2.x = cvt_pk_bf16(num[0] * rd, num[1] * rd); w2.y = cvt_pk_bf16(num[2] * rd, num[3] * rd);
        *(u32x2*)(O + (srow + q) * D + h * HD + d4) = w2; }
    __syncthreads();
}
#undef WAIT_BAR
}

namespace gate {
constexpr int L_VS = 0, L_STG = 32768, L_RV = 98304;
__device__ __forceinline__ void unit(bool sample, int nb, int gp, const bf16_t* U, bf16_t* Og, const bf16_t* Vv, const float* ssqv, const float* ssqvs, const float* vgain, const bf16_t* wsb, const float* bsp, float* ogv, LAS unsigned char* lds, const int tid) {
    const int lane = tid & 63, r32 = lane & 31, hi = lane >> 5; const int wid = __builtin_amdgcn_readfirstlane(tid >> 6);
    const long tok0 = sample ? (long)MP + 32 * nb : (long)128 * nb; const int nrows = sample ? 32 : 128;
    const int gi = wid >> 2, pb = wid & 3, g = 2 * gp + gi; const bool act = pb * 32 < nrows; const int nks = sample ? 2 : (pb < 2 ? 4 : 8);
    bf16x8 pa[8]; f32x4 bq[4]; u32x4 uu[4];
    if (act) { const bf16x8* wp = (const bf16x8*)wsb + ((size_t)(g * 128 + 32 * pb + r32) * 8) * 2 + hi;
#pragma unroll
        for (int ks = 0; ks < 8; ++ks) pa[ks] = wp[ks * 2];
#pragma unroll
        for (int gq = 0; gq < 4; ++gq) bq[gq] = *(const f32x4*)(bsp + g * 128 + 32 * pb + 8 * gq + 4 * hi);
#pragma unroll
        for (int i = 0; i < 4; ++i) uu[i] = *(const u32x4*)(U + (size_t)(tok0 + 32 * pb + i * 8 + (lane >> 3)) * D + 64 * g + (lane & 7) * 8); }
    LAS float* rv = (LAS float*)(lds + L_RV);
    if (!sample) { if (tid < 128) { const long t = tok0 + tid; const float s = (ssqv[t] + ssqv[MT + t]) + (ssqv[2 * MT + t] + ssqv[3 * MT + t]); rv[tid] = 1.0f / sqrtf(s * (1.0f / D) + EPS); } }
    else { const int row = tid >> 4, jj = tid & 15; float s = ssqvs[(size_t)jj * MS + nb * 32 + row] + ssqvs[(size_t)(jj + 16) * MS + nb * 32 + row];
        s = sum16(s); if (jj == 0) rv[row] = 1.0f / sqrtf(s * (1.0f / D) + EPS); }
    u32x4 raw[4]; f32x4 g0[4], g1[4];
#pragma unroll
    for (int i = 0; i < 4; ++i) { const int pi = wid + 8 * i, gi2 = pi >> 4, qt = (pi >> 3) & 1, dh = (pi >> 2) & 1, rg = pi & 3;
        const int row = 64 * qt + 16 * rg + (lane >> 2), col = 64 * (2 * gp + gi2) + 32 * dh + 8 * (lane & 3);
        const int rowc = row < nrows ? row : nrows - 1;
        raw[i] = *(const u32x4*)(Vv + (tok0 + rowc) * D + col); g0[i] = *(const f32x4*)(vgain + col); g1[i] = *(const f32x4*)(vgain + col + 4); }
    __syncthreads();
#pragma unroll
    for (int i = 0; i < 4; ++i) { const int pi = wid + 8 * i, gi2 = pi >> 4, qt = (pi >> 3) & 1, dh = (pi >> 2) & 1, rg = pi & 3;
        const int row = 64 * qt + 16 * rg + (lane >> 2), col = 64 * (2 * gp + gi2) + 32 * dh + 8 * (lane & 3);
        if (row < nrows) { const float rs = rv[row]; const u32x4 rw = raw[i];
            float f[8]; f[0] = bf2f(rw.x & 0xffffu) * rs * g0[i][0]; f[1] = bf2f(rw.x >> 16) * rs * g0[i][1]; f[2] = bf2f(rw.y & 0xffffu) * rs * g0[i][2]; f[3] = bf2f(rw.y >> 16) * rs * g0[i][3];
            f[4] = bf2f(rw.z & 0xffffu) * rs * g1[i][0]; f[5] = bf2f(rw.z >> 16) * rs * g1[i][1]; f[6] = bf2f(rw.w & 0xffffu) * rs * g1[i][2]; f[7] = bf2f(rw.w >> 16) * rs * g1[i][3];
            u32x4 w; w.x = cvt_pk_bf16(f[0], f[1]); w.y = cvt_pk_bf16(f[2], f[3]); w.z = cvt_pk_bf16(f[4], f[5]); w.w = cvt_pk_bf16(f[6], f[7]);
            *(LAS u32x4*)(lds + L_VS + (gi2 * 2 + qt) * 8192 + (dh * 4 + rg) * 1024 + lane * 16) = w;
            if (sample) { float* o = ogv + (size_t)(nb * 32 + row) * D + col; *(f32x4*)o = (f32x4){f[0], f[1], f[2], f[3]}; *(f32x4*)(o + 4) = (f32x4){f[4], f[5], f[6], f[7]}; } } }
    __syncthreads();
    if (act) {
        f32x16 o[2];
#pragma unroll
        for (int r = 0; r < 16; ++r) { o[0][r] = 0.f; o[1][r] = 0.f; }
        const unsigned lds0 = (unsigned)(uintptr_t)lds;
#pragma unroll
        for (int ks = 0; ks < 8; ++ks) if (ks < nks) {
            const int vb = (int)(lds0 + L_VS + (gi * 2 + (ks >> 2)) * 8192 + (ks & 3) * 1024) + ((lane >> 4) & 1) * 32 + (lane & 3) * 8 + (4 * hi + ((lane & 15) >> 2)) * 64;
            s16x4 lo[2], hh[2];
#pragma unroll
            for (int d0 = 0; d0 < 2; ++d0) {
                asm volatile("ds_read_b64_tr_b16 %0,%1 offset:%c2" : "=&v"(lo[d0]) : "v"(vb), "i"(d0 * 4096) : "memory");
                asm volatile("ds_read_b64_tr_b16 %0,%1 offset:%c2" : "=&v"(hh[d0]) : "v"(vb), "i"(d0 * 4096 + 512) : "memory"); }
            asm volatile("s_waitcnt lgkmcnt(0)" ::: "memory"); __builtin_amdgcn_sched_barrier(0);
#pragma unroll
            for (int d0 = 0; d0 < 2; ++d0) { const bf16x8 vf = (bf16x8){lo[d0][0], lo[d0][1], lo[d0][2], lo[d0][3], hh[d0][0], hh[d0][1], hh[d0][2], hh[d0][3]};
                o[d0] = __builtin_amdgcn_mfma_f32_32x32x16_bf16(pa[ks], vf, o[d0], 0, 0, 0); }
        }
        LAS float* stg = (LAS float*)(lds + L_STG) + wid * 2048;
#pragma unroll
        for (int r = 0; r < 16; ++r) { const int q = crow(r, hi); const float b_ = bq[r >> 2][r & 3]; stg[q * 64 + r32] = o[0][r] + b_; stg[q * 64 + 32 + r32] = o[1][r] + b_; }
        LDS_WAIT();
#pragma unroll
        for (int i = 0; i < 4; ++i) { const int row = i * 8 + (lane >> 3), ch = lane & 7;
            const f32x4 m0 = *(const LAS f32x4*)(stg + row * 64 + ch * 8), m1 = *(const LAS f32x4*)(stg + row * 64 + ch * 8 + 4);
            const size_t uo = (size_t)(tok0 + 32 * pb + row) * D + 64 * g + ch * 8; const u32x4 u4 = uu[i];
            u32x4 w; w.x = cvt_pk_bf16(bf2f(u4.x & 0xffffu) * m0[0], bf2f(u4.x >> 16) * m0[1]); w.y = cvt_pk_bf16(bf2f(u4.y & 0xffffu) * m0[2], bf2f(u4.y >> 16) * m0[3]);
            w.z = cvt_pk_bf16(bf2f(u4.z & 0xffffu) * m1[0], bf2f(u4.z >> 16) * m1[1]); w.w = cvt_pk_bf16(bf2f(u4.w & 0xffffu) * m1[2], bf2f(u4.w >> 16) * m1[3]);
            *(u32x4*)(Og + uo) = w; }
    }
    __syncthreads();
}
}

template <bool UP, bool GAIN>
__device__ __forceinline__ void transpose_item(const float* W, int K, int N, const float* gain, bf16_t* WT, LAS float* scr, int item, int lane) {
    const int nblk = N / 32, kb = item / nblk, nb = item % nblk, k0 = 64 * kb, n0 = 32 * nb;
    f32x4 v[8]; float gk[8];
#pragma unroll
    for (int i = 0; i < 8; ++i) { const int kk = 8 * i + (lane >> 3), n4 = (lane & 7) * 4; v[i] = *(const f32x4*)(W + (size_t)(k0 + kk) * N + n0 + n4); gk[i] = GAIN ? gain[k0 + kk] : 1.0f; }
#pragma unroll
    for (int i = 0; i < 8; ++i) { const int kk = 8 * i + (lane >> 3), n4 = (lane & 7) * 4; const f32x4 x = GAIN ? v[i] * gk[i] : v[i];
        scr[kk * 33 + n4] = x[0]; scr[kk * 33 + n4 + 1] = x[1]; scr[kk * 33 + n4 + 2] = x[2]; scr[kk * 33 + n4 + 3] = x[3]; }
    LDS_WAIT(); asm volatile("" ::: "memory");
    const int c = lane & 7;
#pragma unroll
    for (int jj = 0; jj < 4; ++jj) { const int n = (lane >> 3) + 8 * jj; const LAS float* s = scr + (8 * c) * 33 + n;
        u32x4 o; o.x = cvt_pk_bf16(s[0 * 33], s[1 * 33]); o.y = cvt_pk_bf16(s[2 * 33], s[3 * 33]); o.z = cvt_pk_bf16(s[4 * 33], s[5 * 33]); o.w = cvt_pk_bf16(s[6 * 33], s[7 * 33]);
        int dn = n0 + n; if (UP) { const int v = dn >= FF ? 1 : 0, gc = dn - v * FF; dn = 256 * (gc >> 7) + 128 * v + (gc & 127); }
        *(u32x4*)(WT + (size_t)dn * K + k0 + 8 * c) = o; }
    LDS_WAIT(); asm volatile("" ::: "memory");
}

#define XB_TMO      128
#define XB_XCNT(j)  (256  + 64 * (j))
#define XB_XSUB(j)  (1280 + 64 * (j))
#define XB_XGEN(j)  (2304 + 64 * (j))
#define XB_TOP      3328
#define XB_TOPGEN   3392
#define XCD_BAR_WORDS 3456
#define XB_SPIN_CAP (1u << 18)
__device__ __forceinline__ unsigned xb_ld(unsigned* p)              { return __hip_atomic_load(p, __ATOMIC_RELAXED, __HIP_MEMORY_SCOPE_AGENT); }
__device__ __forceinline__ unsigned xb_add(unsigned* p, unsigned v) { return __hip_atomic_fetch_add(p, v, __ATOMIC_RELAXED, __HIP_MEMORY_SCOPE_AGENT); }
__device__ __forceinline__ unsigned xb_xcc_id() { return (unsigned)__builtin_amdgcn_s_getreg((3 << 11) | 20) & 0xFu; }
#define XB_SPIN(cond, bar) do { unsigned _sp = 0; while (cond) { __builtin_amdgcn_s_sleep(1); \
    if ((++_sp & 255u) == 0u) { if (xb_ld(&(bar)[XB_TMO])) break; if (_sp > XB_SPIN_CAP) { atomicAdd(&(bar)[XB_TMO], 1u); break; } } } } while (0)
struct XcdBarrier { unsigned* bar; unsigned x; volatile LAS unsigned* st; };
__device__ __forceinline__ void xcd_barrier_complete(unsigned* bar, unsigned x, unsigned& nloc, unsigned& nx) {
    const unsigned G = gridDim.x * gridDim.y * gridDim.z;
    unsigned sum, cnt, mine, sp = 0u;
    for (;;) {
        sum = 0u; cnt = 0u; mine = 0u;
#pragma unroll
        for (unsigned j = 0; j < 16; ++j) { const unsigned c = xb_ld(&bar[XB_XCNT(j)]); sum += c; cnt += (c > 0u) ? 1u : 0u; mine = (j == x) ? c : mine; }
        if (sum == G) break;
        __builtin_amdgcn_s_sleep(1);
        if ((++sp & 255u) == 0u) { if (xb_ld(&bar[XB_TMO])) break; if (sp > XB_SPIN_CAP) { atomicAdd(&bar[XB_TMO], 1u); break; } }
    }
    nloc = mine > 0u ? mine : 1u; nx = cnt > 0u ? cnt : 1u;
}
__device__ __forceinline__ void xcd_barrier(const XcdBarrier& b, const int tid) {
    asm volatile("s_waitcnt vmcnt(0)" ::: "memory");
    __syncthreads();
    if (tid == 0) {
        unsigned* bar = b.bar;
        __builtin_amdgcn_s_waitcnt(0);
        unsigned nloc = b.st[0], nx = b.st[1];
        if (nloc == 0u) { xcd_barrier_complete(bar, b.x, nloc, nx); b.st[0] = nloc; b.st[1] = nx; }
        const unsigned old = xb_add(&bar[XB_XSUB(b.x)], 1u);
        const unsigned gen = old / nloc;
        if (old + 1u == (gen + 1u) * nloc) {
            __builtin_amdgcn_fence(__ATOMIC_RELEASE, "agent");
            asm volatile("s_waitcnt vmcnt(0)" ::: "memory");
            const unsigned og = xb_add(&bar[XB_TOP], 1u);
            const unsigned tg = og / nx;
            if (og + 1u == (tg + 1u) * nx) xb_add(&bar[XB_TOPGEN], 1u);
            else XB_SPIN(xb_ld(&bar[XB_TOPGEN]) == tg, bar);
            __builtin_amdgcn_fence(__ATOMIC_ACQUIRE, "agent");
            xb_add(&bar[XB_XGEN(b.x)], 1u);
            asm volatile("s_waitcnt vmcnt(0)" ::: "memory");
        } else {
            XB_SPIN(xb_ld(&bar[XB_XGEN(b.x)]) == gen, bar);
            __builtin_amdgcn_fence(__ATOMIC_ACQUIRE, "agent");
            asm volatile("s_waitcnt vmcnt(0)" ::: "memory");
        }
    }
    __syncthreads();
}

template <int NQ>
__device__ __forceinline__ void p0_rows(const int m0, const int lane, const float* x_prompt, const float* x_sample, bf16_t* XB, float* SSQ, float* SSQS) {
    f32x4 v[NQ][4];
#pragma unroll
    for (int q = 0; q < NQ; ++q) { const int m = m0 + q; const float* xr = m < MP ? x_prompt + (size_t)m * D : x_sample + (size_t)(m - MP) * D;
#pragma unroll
        for (int jj = 0; jj < 4; ++jj) v[q][jj] = ((const f32x4*)xr)[2 * lane + (jj & 1) + 128 * (jj >> 1)]; }
#pragma unroll
    for (int q = 0; q < NQ; ++q) { const int m = m0 + q; float s = 0.f;
#pragma unroll
        for (int jj = 0; jj < 4; ++jj) s += (v[q][jj][0] * v[q][jj][0] + v[q][jj][1] * v[q][jj][1]) + (v[q][jj][2] * v[q][jj][2] + v[q][jj][3] * v[q][jj][3]);
        s = wave_sum(s);
#pragma unroll
        for (int j2 = 0; j2 < 2; ++j2) { u32x4 w; w.x = cvt_pk_bf16(v[q][2 * j2][0], v[q][2 * j2][1]); w.y = cvt_pk_bf16(v[q][2 * j2][2], v[q][2 * j2][3]);
            w.z = cvt_pk_bf16(v[q][2 * j2 + 1][0], v[q][2 * j2 + 1][1]); w.w = cvt_pk_bf16(v[q][2 * j2 + 1][2], v[q][2 * j2 + 1][3]); ((u32x4*)(XB + (size_t)m * D))[lane + 64 * j2] = w; }
        if (m < MP) { if (lane < 4) SSQ[(size_t)lane * MT + m] = lane == 0 ? s : 0.f; }
        else { if (lane < 32) SSQS[(size_t)lane * MS + (m - MP)] = lane == 0 ? s : 0.f; } }
}

constexpr int WGM_QKV = 4, WGM_RES = 4, WGM_UP = 4, WGM_IN = 4;
#define PH(k)
struct Args { const float* in[20]; float* out; unsigned char* ws; };

__global__ void __launch_bounds__(NTHR, 2) fwd_kernel(Args a) {
    extern __shared__ __attribute__((aligned(16))) unsigned char lds_raw[];
    LAS unsigned char* lds = (LAS unsigned char*)lds_raw;
    const int wave0 = __builtin_amdgcn_readfirstlane((int)threadIdx.x >> 6);
    XcdBarrier bar;
    { volatile LAS unsigned* MISC = (volatile LAS unsigned*)(lds + L_MISC);
        if (threadIdx.x < 4) MISC[threadIdx.x] = 0u;
        __syncthreads();
        bar.bar = (unsigned*)(a.ws + WS_CTL); bar.x = xb_xcc_id(); bar.st = MISC;
        if (threadIdx.x == 0) (void)xb_add(&bar.bar[XB_XCNT(bar.x)], 1u); }
#define GRID_BAR() do { PHASE_VARS xcd_barrier(bar, tid); } while (0)
#define PHASE_VARS int tid; asm volatile("v_mbcnt_lo_u32_b32 %0, -1, 0\n\tv_mbcnt_hi_u32_b32 %0, -1, %0" : "=v"(tid)); tid |= wave0 << 6; const int lane = tid & 63, wave = wave0; (void)lane; (void)wave;
    const int G = gridDim.x, bx = blockIdx.x; const int vcu = (G % 8 == 0) ? (bx % 8) * (G / 8) + bx / 8 : bx;
    unsigned char* ws = a.ws; float* out = a.out;
    const float *x_prompt = a.in[0], *x_sample = a.in[1], *cache_k = a.in[2], *cache_v = a.in[3], *state_conv = a.in[4], *ln_mix = a.in[5], *ln_ffn = a.in[6], *ln_final = a.in[7],
                *w_qkv = a.in[8], *rel_bias = a.in[9], *w_o = a.in[10], *w_in = a.in[11], *v_norm = a.in[12], *w_s = a.in[13], *bias_s = a.in[14], *w_out = a.in[15],
                *w_up = a.in[16], *conv_w = a.in[17], *conv_b = a.in[18], *w_down = a.in[19];
    bf16_t *Wqkv_t = (bf16_t*)(ws + WS_WQKV), *Wo_t = (bf16_t*)(ws + WS_WO), *Win_t = (bf16_t*)(ws + WS_WIN), *Wout_t = (bf16_t*)(ws + WS_WOUT);
    bf16_t *XB = (bf16_t*)(ws + WS_XB), *QB = (bf16_t*)(ws + WS_Q), *KB = (bf16_t*)(ws + WS_K), *VB = (bf16_t*)(ws + WS_V), *GB = (bf16_t*)(ws + WS_G), *OB = (bf16_t*)(ws + WS_OB);
    float *SSQ = (float*)(ws + WS_SSQ), *SSQV = (float*)(ws + WS_SSQV), *SSQS = (float*)(ws + WS_SSQS), *SSQVS = (float*)(ws + WS_SSQVS);

    PH(0) { PHASE_VARS
        LAS float* scr = (LAS float*)(lds + wave * 16384);
        const int gw = vcu * NWAVES + wave, NGW = G * NWAVES;
        constexpr int I_QKV = (D / 64) * (3 * D / 32), I_O = (D / 64) * (D / 32), I_IN = (D / 64) * (2 * D / 32), I_UP = (D / 64) * (FF2 / 32), I_DN = (FF / 64) * (D / 32);
        for (int it = gw; it < I_QKV; it += NGW) transpose_item<false, true>(w_qkv, D, 3 * D, ln_mix, Wqkv_t, scr, it, lane);
        for (int m0 = gw * 4; m0 < MP; m0 += NGW * 4) p0_rows<4>(m0, lane, x_prompt, x_sample, XB, SSQ, SSQS);
        for (int m0 = MP + (NGW - 1 - gw); m0 < MT; m0 += NGW) p0_rows<1>(m0, lane, x_prompt, x_sample, XB, SSQ, SSQS);
        for (int c = (vcu * NWAVES + wave) * 64 + lane; c < 16 * 128 * 16; c += G * NTHR) { const int hi_ = c & 1, ks = (c >> 1) & 7, gp_ = c >> 4;
            const float* src = w_s + (size_t)gp_ * 128 + 16 * ks + 4 * hi_; const f32x4 a0 = *(const f32x4*)src, a1 = *(const f32x4*)(src + 8);
            u32x4 w; w.x = cvt_pk_bf16(a0[0], a0[1]); w.y = cvt_pk_bf16(a0[2], a0[3]); w.z = cvt_pk_bf16(a1[0], a1[1]); w.w = cvt_pk_bf16(a1[2], a1[3]);
            ((u32x4*)(ws + WS_WSB))[c] = w; }
    }
    GRID_BAR();

    PH(1) { PHASE_VARS
        pg8::Gemm g{XB, Wqkv_t, D}; pg8::StaticOrder S; S.init(MP / 256, 3 * D / 256, G, bx, 0, WGM_QKV);
        EpiQKV E{QB, (size_t)(WS_K - WS_Q) / 2, SSQ, out + O_KP, out + O_VP};
        typedef SampleRider<D, 96, SQkv> RQ; const RQ R{XB, Wqkv_t, SQkv{SSQS, QB, KB, VB, out + O_KS, out + O_VS}};
        pg8::gemm_phase<EpiQKV, pg8::StaticOrder, RQ>(lds, g, S, E, tid, R);
    }
    GRID_BAR();

    PH(2) { PHASE_VARS
        LAS float* tab = (LAS float*)(lds + att::L_BIAS);
        const int per = (NB * NH * 32 + G - 1) / G;
        int lasth = -1;
        for (int id = vcu * per; id < (vcu + 1) * per && id < NB * NH * 32; ++id) { const int bh = id >> 5, qg = id & 31, b = bh / NH, h = bh % NH;
            if (h != lasth) { __syncthreads(); for (int i = tid; i < 320; i += NTHR) { const int j = 319 - i; const float tv = rel_bias[h * NREL + (j > 256 ? 256 : j)] * LOG2E; tab[i] = tv; ((LAS float*)(lds + att::L_BIAS2))[i] = tv - rel_bias[h * NREL + 256] * LOG2E; } __syncthreads(); lasth = h; }
            if (qg >= 2) att::prompt_unit_fast<8>(b, h, qg, QB, KB, VB, OB, lds, tid); else att::prompt_unit(b, h, qg, QB, KB, VB, OB, lds, tid); }
        const bool std_grid = (G == 256);
        for (int n_ = 0; n_ < (std_grid ? ((vcu & 7) < 4 ? 1 : 0) : (DB * NH - vcu + G - 1) / G); ++n_) {
            const int id = std_grid ? 0 : vcu + n_ * G; const int b = std_grid ? (vcu & 3) + 4 * (vcu >> 7) : id / NH, h = std_grid ? ((vcu >> 3) & 15) : id % NH;
            if (h != lasth) { __syncthreads(); for (int i = tid; i < 320; i += NTHR) { const int j = 319 - i; const float tv = rel_bias[h * NREL + (j > 256 ? 256 : j)] * LOG2E; tab[i] = tv; ((LAS float*)(lds + att::L_BIAS2))[i] = tv - rel_bias[h * NREL + 256] * LOG2E; } __syncthreads(); lasth = h; }
            att::sample_unit(b, h, QB, KB, VB, cache_k, cache_v, OB, lds, tid); }
        __syncthreads();
        { constexpr int I_O = (D / 64) * (D / 32), I_UP = (D / 64) * (FF2 / 32), I_DN = (FF / 64) * (D / 32), I_IN = (D / 64) * (2 * D / 32), NIT0 = I_O + I_UP + I_DN + I_IN;
            LAS float* scr = (LAS float*)(lds + wave * 16384);
          for (int sh = 0; sh < (G == 256 ? 1 : 8); ++sh) {
            const int xq = (int)((bar.x + (unsigned)sh) & 7u); unsigned* qh = (unsigned*)(ws + WS_CTL) + CW_QUEUE0 + 64 * xq;
            const int qlo = xq * (NIT0 / 8), qhi = (xq + 1) * (NIT0 / 8);
            for (;;) { unsigned it0 = 0u; if (lane == 0) it0 = __hip_atomic_fetch_add(qh, 1u, __ATOMIC_RELAXED, __HIP_MEMORY_SCOPE_AGENT); it0 = (unsigned)__builtin_amdgcn_readfirstlane((int)it0);
                if ((int)it0 + qlo >= qhi) break;
              for (int sub = 0; sub < 1; ++sub) {
                int r = qlo + (int)it0 + sub; if (r >= qhi) break;
                if (r < I_O) { transpose_item<false, false>(w_o, D, D, nullptr, Wo_t, scr, r, lane); continue; } r -= I_O;
                if (r < I_UP) { transpose_item<true, true>(w_up, D, FF2, ln_ffn, (bf16_t*)(ws + WS_WUP), scr, r, lane); continue; } r -= I_UP;
                if (r < I_DN) { transpose_item<false, false>(w_down, FF, D, nullptr, (bf16_t*)(ws + WS_WDN), scr, r, lane); continue; } r -= I_DN;
                transpose_item<false, true>(w_in, D, 2 * D, ln_mix + D, Win_t, scr, r, lane); } } }
            __syncthreads(); }
}
    GRID_BAR();

#define RES_PHASE(A_, Wt_, KK) RES_PHASE2(A_, Wt_, KK, XB, SSQ, SSQS)
#define RES_PHASE2(A_, Wt_, KK, XO_, SSQO_, SSQSO_) do { \
        pg8::Gemm g{A_, Wt_, KK}; pg8::StaticOrder S; S.init(MP / 256, D / 256, G, bx, 0, WGM_RES); \
        EpiRes E{XB, XO_, SSQO_}; \
        typedef SampleRider<KK, 32, SRes> RR; const RR R{A_, Wt_, SRes{XB, XO_, SSQSO_}};     \
        pg8::gemm_phase<EpiRes, pg8::StaticOrder, RR>(lds, g, S, E, tid, R); } while (0)
    PH(3) { PHASE_VARS RES_PHASE(OB, Wo_t, D); }
    GRID_BAR();

#define UP_PHASE(L_) do { \
        const bf16_t* Wup_ = (const bf16_t*)(ws + WS_WUP + (L_) * WUP_L); const float* cw_ = conv_w + (size_t)(L_) * 3 * FF2; const float* cb_ = conv_b + (size_t)(L_) * FF2; \
        pg8::Gemm g{XB, Wup_, D}; pg8::StaticOrder S; S.init(67, FF2 / 256, G, bx, 1, WGM_UP); \
        EpiUp E{GB, SSQ, SSQS, cw_, cb_, out + O_CP + (size_t)(L_) * NB * 2 * FF2, state_conv + (size_t)(L_) * DB * 2 * FF2, out + O_CS + (size_t)(L_) * DB * 2 * FF2}; \
        pg8::gemm_phase<EpiUp, pg8::StaticOrder>(lds, g, S, E, tid); } while (0)
    PH(4) { PHASE_VARS UP_PHASE(0);
        { constexpr int I_O = (D / 64) * (D / 32), I_IN = (D / 64) * (2 * D / 32), I_UP = (D / 64) * (FF2 / 32), I_DN = (FF / 64) * (D / 32), NIT1 = I_O + I_UP + I_DN;
            LAS float* scr = (LAS float*)(lds + wave * 16384);
          for (int sh = 0; sh < (G == 256 ? 1 : 8); ++sh) {
            const int xq = (int)((bar.x + (unsigned)sh) & 7u); unsigned* qh = (unsigned*)(ws + WS_CTL) + CW_QUEUE + 64 * xq;
            const int qlo = xq * (NIT1 / 8), qhi = (xq + 1) * (NIT1 / 8);
            for (;;) { unsigned it0 = 0u; if (lane == 0) it0 = __hip_atomic_fetch_add(qh, 1u, __ATOMIC_RELAXED, __HIP_MEMORY_SCOPE_AGENT); it0 = (unsigned)__builtin_amdgcn_readfirstlane((int)it0);
                if ((int)it0 + qlo >= qhi) break;
              for (int sub = 0; sub < 1; ++sub) {
                int r = qlo + (int)it0 + sub; if (r >= qhi) break;
                if (r < I_O) { transpose_item<false, false>(w_out, D, D, nullptr, Wout_t, scr, r, lane); continue; } r -= I_O;
                if (r < I_UP) { transpose_item<true, true>(w_up + (size_t)D * FF2, D, FF2, ln_ffn + D, (bf16_t*)(ws + WS_WUP + WUP_L), scr, r, lane); continue; } r -= I_UP;
                transpose_item<false, false>(w_down + (size_t)FF * D, FF, D, nullptr, (bf16_t*)(ws + WS_WDN + WDN_L), scr, r, lane); } } }
            __syncthreads(); } }
    GRID_BAR();
    PH(5) { PHASE_VARS RES_PHASE(GB, (const bf16_t*)(ws + WS_WDN), FF); }
    GRID_BAR();

    PH(6) { PHASE_VARS
        pg8::Gemm g{XB, Win_t, D}; pg8::StaticOrder S; S.init(MP / 256, 2 * D / 256, G, bx, 0, WGM_IN);
        EpiIn E{QB, (size_t)(WS_K - WS_Q) / 2, SSQ, SSQV};
        typedef SampleRider<D, 64, SIn> RI; const RI R{XB, Win_t, SIn{SSQS, QB, KB, SSQVS}};
        pg8::gemm_phase<EpiIn, pg8::StaticOrder, RI>(lds, g, S, E, tid, R);
    }
    GRID_BAR();

    PH(7) { PHASE_VARS
        const int per = (128 * 8 + G - 1) / G;
        for (int id = vcu * per; id < (vcu + 1) * per && id < 128 * 8; ++id) gate::unit(false, id >> 3, id & 7, QB, VB, KB, SSQV, SSQVS, v_norm, (const bf16_t*)(ws + WS_WSB), bias_s, out + O_GV, lds, tid);
        for (int id = vcu; id < DB * 8; id += G) gate::unit(true, id >> 3, id & 7, QB, VB, KB, SSQV, SSQVS, v_norm, (const bf16_t*)(ws + WS_WSB), bias_s, out + O_GV, lds, tid);
    }
    GRID_BAR();

    PH(8) { PHASE_VARS RES_PHASE(VB, Wout_t, D); }
    GRID_BAR();
    PH(9) { PHASE_VARS UP_PHASE(1); }
    GRID_BAR();
    PH(10) { PHASE_VARS
        const bf16_t* Wdn_ = (const bf16_t*)(ws + WS_WDN + WDN_L); unsigned* ctl = (unsigned*)(ws + WS_CTL); float* XCHS = (float*)(ws + WS_XCHS);
        pg8::Gemm g{GB, Wdn_, FF}; pg8::StaticOrder S; S.init(MP / 256, D / 256, G, bx, 0, WGM_RES);
        EpiFinal E{XB, out + O_YP, (float*)(ws + WS_XCH), ctl + CW_PANEL, ln_final};
        typedef SampleRider<FF, 32, SFin> RF; const RF R{GB, Wdn_, SFin{XB, XCHS, ctl + CW_SPANEL, ln_final, out + O_YS}};
        pg8::gemm_phase<EpiFinal, pg8::StaticOrder, RF>(lds, g, S, E, tid, R); }
}

extern "C" void kernel_launch(void* const* d_in, const int* in_sizes, int n_in, void* d_out, int out_size, void* d_ws, size_t ws_size, hipStream_t stream) {
    static int grid = 0;
    if (grid == 0) {
        if (n_in != 20 || (size_t)out_size != O_END || ws_size < WS_END) { fprintf(stderr, "kernel_launch: unexpected sizes n_in %d out %d ws %zu\n", n_in, out_size, ws_size); grid = -1; return; }
        int dev = 0, cus = 0, per_cu = 0;
        if (hipGetDevice(&dev) != hipSuccess || hipDeviceGetAttribute(&cus, hipDeviceAttributeMultiprocessorCount, dev) != hipSuccess) { grid = -1; return; }
        if (hipFuncSetAttribute((const void*)fwd_kernel, hipFuncAttributeMaxDynamicSharedMemorySize, LDS_BYTES) != hipSuccess) { fprintf(stderr, "kernel_launch: hipFuncSetAttribute failed\n"); grid = -1; return; }
        if (hipOccupancyMaxActiveBlocksPerMultiprocessor(&per_cu, (const void*)fwd_kernel, NTHR, LDS_BYTES) != hipSuccess || per_cu < 1) { fprintf(stderr, "kernel_launch: occupancy query says %d\n", per_cu); per_cu = 1; }
        (void)hipGetLastError();
        grid = cus;
    }
    if (grid < 0) return;
    Args a{};
    for (int i = 0; i < 20; ++i) a.in[i] = (const float*)d_in[i];
    a.out = (float*)d_out; a.ws = (unsigned char*)d_ws;
    if (hipMemsetAsync((char*)d_ws + WS_CTL, 0, CTL_BYTES, stream) != hipSuccess) { fprintf(stderr, "kernel_launch: memset of the barrier words failed\n"); return; }
    hipLaunchKernelGGL(fwd_kernel, dim3(grid), dim3(NTHR), LDS_BYTES, stream, a);
    const hipError_t e = hipPeekAtLastError();
    if (e != hipSuccess) fprintf(stderr, "kernel_launch: launch failed: %s (grid %d)\n", hipGetErrorName(e), grid);
}
```

```cpp
#include <hip/hip_runtime.h>
#include <cstdio>
#include <cstdint>

#define LAS __attribute__((address_space(3)))
typedef unsigned short bf16_t;
typedef short bf16x8 __attribute__((ext_vector_type(8)));
typedef short s16x4 __attribute__((ext_vector_type(4)));
typedef float f32x2 __attribute__((ext_vector_type(2)));
typedef float f32x4 __attribute__((ext_vector_type(4)));
typedef float f32x16 __attribute__((ext_vector_type(16)));
typedef unsigned u32x2 __attribute__((ext_vector_type(2)));
typedef unsigned u32x4 __attribute__((ext_vector_type(4)));

constexpr int D = 1024, SEQ = 8192, NB = 2, MP = NB * SEQ, DB = 8, DT = 32, MS = DB * DT, MT = MP + MS;
constexpr int NH = 16, HD = 64, FF = 2816, FF2 = 5632, CA = 512, NREL = 257;
constexpr float EPS = 1e-6f, LOG2E = 1.4426950408889634f, C2 = 0.125f * LOG2E;
constexpr int NWAVES = 8, NTHR = 512;

constexpr size_t MiB = 1u << 20;
constexpr size_t WS_CTL = 0;
constexpr int CW_PANEL = 4096, CW_SPANEL = 4096 + 64 * 64;
constexpr int CW_QUEUE = 4096 + 64 * 64 + 64 * 8, CW_QUEUE0 = CW_QUEUE + 64 * 16;
constexpr size_t CTL_BYTES = 65536;
constexpr size_t WS_WQKV = 1 * MiB, WS_WO = 7 * MiB, WS_WIN = 9 * MiB, WS_WOUT = 13 * MiB, WS_WUP = 15 * MiB, WS_WDN = 37 * MiB;
constexpr size_t WUP_L = (size_t)FF2 * D * 2, WDN_L = (size_t)D * FF * 2;
constexpr size_t WS_XB = 48 * MiB + 65536;
constexpr size_t WS_Q = 82 * MiB, WS_K = 116 * MiB, WS_V = 150 * MiB;
constexpr size_t WS_G = 82 * MiB;
constexpr size_t WS_SSQ = 200 * MiB;
constexpr size_t WS_SSQV = 201 * MiB;
constexpr size_t WS_SSQS = 202 * MiB;
constexpr size_t WS_SSQVS = 202 * MiB + 65536;
constexpr size_t WS_XCH = 203 * MiB, WS_XCHS = 203 * MiB + 512 * 1024;
constexpr size_t WS_OB = 204 * MiB;
constexpr size_t WS_WSB = 237 * MiB;
constexpr size_t WS_END = 238 * MiB;

constexpr size_t O_YP = 0, O_YS = O_YP + (size_t)MP * D, O_KP = O_YS + (size_t)MS * D, O_VP = O_KP + (size_t)NB * CA * D, O_KS = O_VP + (size_t)NB * CA * D,
                 O_VS = O_KS + (size_t)MS * D, O_GV = O_VS + (size_t)MS * D, O_CP = O_GV + (size_t)MS * D, O_CS = O_CP + (size_t)2 * NB * 2 * FF2, O_END = O_CS + (size_t)2 * DB * 2 * FF2;

constexpr int RING_BYTES = 131072;
constexpr int L_XBUF = 131072, L_PTAB = 147456, L_CTAB = 151552, L_RSTAB = 159744, L_RIDER = 131072;
constexpr int L_MISC = 161792;
constexpr int LDS_BYTES = 163840;

__device__ __forceinline__ unsigned cvt_pk_bf16(float lo, float hi) { unsigned r; asm volatile("v_cvt_pk_bf16_f32 %0, %1, %2" : "=v"(r) : "v"(lo), "v"(hi)); return r; }
__device__ __forceinline__ float bf2f(unsigned h) { return __uint_as_float(h << 16); }
__device__ __forceinline__ int crow(int r, int hi) { return (r & 3) + 8 * (r >> 2) + 4 * hi; }
#define LDS_WAIT() asm volatile("s_waitcnt lgkmcnt(0)" ::: "memory")
#define VM_WAIT() asm volatile("s_waitcnt vmcnt(0)" ::: "memory")
#define RAW_BAR() do { asm volatile("s_waitcnt lgkmcnt(0)" ::: "memory"); __builtin_amdgcn_s_barrier(); asm volatile("" ::: "memory"); } while (0)
template <int CTRL> __device__ __forceinline__ float dpp_mov(float x) { return __int_as_float(__builtin_amdgcn_update_dpp(0, __float_as_int(x), CTRL, 0xf, 0xf, true)); }
__device__ __forceinline__ float sum16(float s) { s += dpp_mov<0xB1>(s); s += dpp_mov<0x4E>(s); s += dpp_mov<0x141>(s); s += dpp_mov<0x140>(s); return s; }
__device__ __forceinline__ float xsum16(float x) { auto r = __builtin_amdgcn_permlane16_swap(__float_as_uint(x), __float_as_uint(x), false, false); return __uint_as_float(r[0]) + __uint_as_float(r[1]); }
__device__ __forceinline__ float xsum32(float x) { auto r = __builtin_amdgcn_permlane32_swap(__float_as_uint(x), __float_as_uint(x), false, false); return __uint_as_float(r[0]) + __uint_as_float(r[1]); }
__device__ __forceinline__ float xmax32(float x) { auto r = __builtin_amdgcn_permlane32_swap(__float_as_uint(x), __float_as_uint(x), false, false); return __builtin_fmaxf(__uint_as_float(r[0]), __uint_as_float(r[1])); }
__device__ __forceinline__ float wave_sum(float v) { return xsum32(xsum16(sum16(v))); }
__device__ __forceinline__ f32x2 gelu_pk(f32x2 v) {
    const f32x2 av = __builtin_elementwise_abs(v), d = av * 0.2316418882f + 1.0f;
    f32x2 t; t.x = __builtin_amdgcn_rcpf(d.x); t.y = __builtin_amdgcn_rcpf(d.y);
    f32x2 q = t * 0.5307027145f + (-0.7265760135f); q = q * t + 0.7107068705f; q = q * t + (-0.142248368f); q = q * t + 0.127414796f; q = q * t;
    const f32x2 s = (v * v) * (-0.72134752044f);
    f32x2 e; e.x = __builtin_amdgcn_exp2f(s.x); e.y = __builtin_amdgcn_exp2f(s.y);
    const f32x2 hq = 0.5f - q * e;
    return v * 0.5f + av * hq;
}
__device__ __forceinline__ float gelu1(float x) { f32x2 r = gelu_pk((f32x2){x, x}); return r.x; }
__device__ __forceinline__ float dpp_shr1_old(float old, float x) { return __int_as_float(__builtin_amdgcn_update_dpp(__float_as_int(old), __float_as_int(x), 0x111, 0xf, 0xf, false)); }
__device__ __forceinline__ float dpp_shr1(float x) { return __int_as_float(__builtin_amdgcn_update_dpp(0, __float_as_int(x), 0x111, 0xf, 0xf, true)); }
__device__ __forceinline__ float silu1(float x) { return x * __builtin_amdgcn_rcpf(1.0f + __builtin_amdgcn_exp2f(-x * LOG2E)); }

namespace pg8 {
constexpr int BM = 256, BK = 64, HALF = 128, HTB = HALF * BK * 2, NXCD = 8;
__host__ __device__ __forceinline__ int lds_byte(int r, int c) { const int st = (r >> 4) * 2 + (c >> 5), rr = r & 15, cc = c & 31, ob = rr * 64 + cc * 2; return st * 1024 + (ob ^ (((ob >> 9) & 1) << 5)); }
__host__ __device__ __forceinline__ void stage_rc(int b, int& R, int& C) { const int st = b / 1024, sb = b % 1024, swz = sb ^ (((sb >> 9) & 1) << 5); R = (st >> 1) * 16 + swz / 64; C = (st & 1) * 32 + (swz % 64) / 2; }
__host__ __device__ __forceinline__ int perm32(int rho) { const int n = rho >> 4, i = rho & 15; return 8 * (i >> 2) + 4 * n + (i & 3); }

struct Unit { int pm, pn, arow, seq; };
struct Gemm { const bf16_t* A; const bf16_t* Bt; int K; };

struct StaticOrder {
    int nM, nN, nwg, G, c, up, WGM;
    __device__ void init(int nM_, int nN_, int G_, int c_, int up_, int wgm_) { nM = nM_; nN = nN_; nwg = nM * nN; G = G_; c = c_; up = up_; WGM = wgm_; }
    __device__ bool next(int i, Unit& u) const {
        const long L = (long)i * G + c; if (L >= nwg) return false;
        u.seq = (int)L;
        int wgid = (int)L; { const int q = nwg / NXCD, r = nwg % NXCD, xcd = wgid % NXCD, off = wgid / NXCD; wgid = (xcd < r ? xcd * (q + 1) : r * (q + 1) + (xcd - r) * q) + off; }
        const int nig = WGM * nN, gid = wgid / nig, fm = gid * WGM, gsz = (nM - fm) < WGM ? (nM - fm) : WGM;
        u.pm = fm + ((wgid % nig) % gsz); u.pn = (wgid % nig) / gsz;
        u.arow = up ? (u.pm == 66 ? MP : (u.pm / 33) * SEQ + 254 * (u.pm % 33) - 2) : u.pm * BM;
        return true;
    }
};

struct NoRider { static constexpr bool ON = false; };
template <class E, class = void> struct aperm_t { static constexpr bool v = false; };
template <class E> struct aperm_t<E, decltype((void)E::APERM)> { static constexpr bool v = E::APERM; };
template <class E> __host__ __device__ constexpr bool aperm_of() { return aperm_t<E>::v; }
template <class Epi, class Sched, class Rider = NoRider>
__device__ __forceinline__ void gemm_phase(LAS unsigned char* lds, const Gemm g, const Sched& S, const Epi& E, const int tid, const Rider R = Rider()) {
    const int wid = __builtin_amdgcn_readfirstlane(tid >> 6), lane = tid & 63, wr = wid >> 2, wc = wid & 3, fr = lane & 15, fq = lane >> 4;
    const int K = g.K, nt = K / BK;
    unsigned voffA[2], voffB[2];
#pragma unroll
    for (int i = 0; i < 2; ++i) { int R, C; stage_rc(tid * 16 + i * 8192, R, C); const int Rb = Epi::PERM ? ((R & ~31) + perm32(R & 31)) : R;
        const int Ra = aperm_of<Epi>() ? ((R & 64) + 4 * (R & 15) + ((R >> 4) & 3)) : R;
        voffA[i] = (unsigned)(Ra * K + C) * 2u; voffB[i] = (unsigned)(Rb * K + C) * 2u; }
    const size_t kstep = (size_t)(BK * 2);
    const size_t hstep = (size_t)HALF * K * 2;
    const size_t tstep = 2 * hstep;
    const size_t rstep = (size_t)K * 2;
    const unsigned ldsw = (unsigned)wid * 1024u, ldsu = (unsigned)(uintptr_t)lds;
    const int aoff = lds_byte(wr * 64 + fr, fq * 8), boff = lds_byte(wc * 32 + fr, fq * 8);
#define PG8_SA(b, h) (((b) * 2 + (h)) * HTB)
#define PG8_SB(b, h) ((4 + (b) * 2 + (h)) * HTB)
#define PG8_GLDS(voff_, sbase_, ldsdst_) do { unsigned keep_; asm volatile("s_mov_b32 %0, m0\n\ts_mov_b32 m0, %3\n\ts_nop 0\n\tglobal_load_lds_dwordx4 %1, %2\n\ts_mov_b32 m0, %0" \
        : "=&s"(keep_) : "v"(voff_), "s"(sbase_), "s"(ldsdst_) : "memory"); } while (0)
#define PG8_STAGE(bufoff, gbase, voff) do { const char* sb_ = (const char*)(gbase); _Pragma("unroll") for (int _i = 0; _i < 2; ++_i) \
        PG8_GLDS((voff)[_i], sb_, (unsigned)__builtin_amdgcn_readfirstlane((int)(ldsu + (unsigned)(bufoff) + ldsw + (unsigned)(_i * 8192)))); } while (0)
#define PG8_LDA(dst, b, h) do { _Pragma("unroll") for (int m = 0; m < 4; ++m) _Pragma("unroll") for (int k = 0; k < 2; ++k) dst[m][k] = *(const LAS bf16x8*)(lds + PG8_SA(b, h) + aoff + m * 2048 + k * 1024); } while (0)
#define PG8_LDB(dst, b, h) do { _Pragma("unroll") for (int n = 0; n < 2; ++n) _Pragma("unroll") for (int k = 0; k < 2; ++k) dst[n][k] = *(const LAS bf16x8*)(lds + PG8_SB(b, h) + boff + n * 2048 + k * 1024); } while (0)
#define PG8_MMA(ai, bj, At, Bt) do { __builtin_amdgcn_s_setprio(1); _Pragma("unroll") for (int m = 0; m < 4; ++m) _Pragma("unroll") for (int n = 0; n < 2; ++n) _Pragma("unroll") for (int k = 0; k < 2; ++k) \
        acc[ai][bj][m][n] = __builtin_amdgcn_mfma_f32_16x16x32_bf16(Bt[n][k], At[m][k], acc[ai][bj][m][n], 0, 0, 0); __builtin_amdgcn_s_setprio(0); } while (0)
#define PG8_WAIT_V(n) asm volatile("s_waitcnt vmcnt(" #n ")" ::: "memory")
#define PG8_WAIT_L(n) asm volatile("s_waitcnt lgkmcnt(" #n ")" ::: "memory")
#define PG8_BAR __builtin_amdgcn_s_barrier()
#define PG8_SCHED __builtin_amdgcn_sched_barrier(0)
    Unit cur, nxt; int ui = 0;
    if (!S.next(0, cur)) return;
    f32x4 acc[2][2][4][2];
    u32x4 xin[2][4][2];
    if constexpr (Epi::INIT) E.init_load(xin, cur, wr, wc, fr, fq);
    E.first(cur, lds, tid);
    f32x16 racc; const char* rpa = nullptr; const char* rpb = nullptr; unsigned rvoff = 0u;
    if constexpr (Rider::ON) {
#pragma unroll
        for (int r = 0; r < 16; ++r) racc[r] = 0.f;
        rvoff = (unsigned)(((lane & 31) * Rider::K + (lane >> 5) * 8) * 2);
        R.ptrs(cur.seq, wid, rpa, rpb); }
    bf16x8 At[4][2], B0[2][2], B1[2][2];
    const char* cA = (const char*)g.A + (ptrdiff_t)cur.arow * (ptrdiff_t)rstep; const char* cB = (const char*)g.Bt + (size_t)cur.pn * tstep;
    PG8_STAGE(PG8_SB(0, 0), cB, voffB); PG8_STAGE(PG8_SB(0, 1), cB + hstep, voffB); PG8_STAGE(PG8_SA(0, 0), cA, voffA); PG8_STAGE(PG8_SA(0, 1), cA + hstep, voffA);
#pragma unroll
    for (int a = 0; a < 2; ++a)
#pragma unroll
        for (int m = 0; m < 4; ++m)
#pragma unroll
            for (int b = 0; b < 2; ++b) {
                if constexpr (Epi::INIT) { const u32x4 x4 = xin[a][m][b];
                    acc[a][b][m][0] = (f32x4){bf2f(x4.x & 0xffffu), bf2f(x4.x >> 16), bf2f(x4.y & 0xffffu), bf2f(x4.y >> 16)};
                    acc[a][b][m][1] = (f32x4){bf2f(x4.z & 0xffffu), bf2f(x4.z >> 16), bf2f(x4.w & 0xffffu), bf2f(x4.w >> 16)}; }
                else { acc[a][b][m][0] = (f32x4){0.f, 0.f, 0.f, 0.f}; acc[a][b][m][1] = (f32x4){0.f, 0.f, 0.f, 0.f}; } }
    if (wr == 1) PG8_BAR;
    PG8_WAIT_V(2); PG8_BAR;
    PG8_STAGE(PG8_SB(1, 0), cB + kstep, voffB); PG8_STAGE(PG8_SA(1, 0), cA + kstep, voffA); PG8_STAGE(PG8_SB(1, 1), cB + hstep + kstep, voffB);
    PG8_WAIT_V(6); PG8_BAR;
    for (;;) {
        const bool has_next = S.next(ui + 1, nxt);
        const char* nA = has_next ? (const char*)g.A + (ptrdiff_t)nxt.arow * (ptrdiff_t)rstep : cA; const char* nB = has_next ? (const char*)g.Bt + (size_t)nxt.pn * tstep : cB;
        for (int t = 0; t < nt; t += 2) {
            const bool last = (t == nt - 2);
            const char* a1 = cA + (size_t)(t + 1) * kstep;
            const char* a2 = last ? nA : cA + (size_t)(t + 2) * kstep; const char* b2 = last ? nB : cB + (size_t)(t + 2) * kstep;
            const char* a3 = a2 + kstep; const char* b3 = b2 + kstep;
            bf16x8 ra, rb;
            if constexpr (Rider::ON) { const char* pa_ = rpa + (size_t)t * 16; const char* pb_ = rpb + (size_t)t * 16;
                asm volatile("s_nop 4\n\tglobal_load_dwordx4 %0, %2, %3\n\tglobal_load_dwordx4 %1, %2, %4" : "=&v"(ra), "=&v"(rb) : "v"(rvoff), "s"(pa_), "s"(pb_) : "memory"); }
            PG8_LDB(B0, 0, 0); PG8_LDB(B1, 0, 1); PG8_SCHED; PG8_LDA(At, 0, 0); PG8_STAGE(PG8_SA(1, 1), a1 + hstep, voffA);
            if constexpr (Rider::ON) PG8_WAIT_V(10); else PG8_WAIT_V(8);
            PG8_WAIT_L(0); PG8_BAR; PG8_MMA(0, 0, At, B0); PG8_MMA(0, 1, At, B1); PG8_BAR; PG8_SCHED;
            PG8_LDA(At, 0, 1); PG8_STAGE(PG8_SB(0, 0), b2, voffB); PG8_STAGE(PG8_SB(0, 1), b2 + hstep, voffB); PG8_STAGE(PG8_SA(0, 0), a2, voffA);
            PG8_WAIT_V(8); if constexpr (Rider::ON) asm volatile("" : "+v"(ra), "+v"(rb)); PG8_WAIT_L(0); PG8_BAR; PG8_MMA(1, 0, At, B0); PG8_MMA(1, 1, At, B1); PG8_BAR; PG8_SCHED;
            PG8_LDB(B0, 1, 0); PG8_LDB(B1, 1, 1); PG8_SCHED; PG8_LDA(At, 1, 0); PG8_STAGE(PG8_SA(0, 1), a2 + hstep, voffA);
            PG8_WAIT_V(8); PG8_WAIT_L(0); PG8_BAR; PG8_MMA(0, 0, At, B0); PG8_MMA(0, 1, At, B1); PG8_BAR; PG8_SCHED;
            PG8_LDA(At, 1, 1); PG8_STAGE(PG8_SB(1, 0), b3, voffB); PG8_STAGE(PG8_SB(1, 1), b3 + hstep, voffB); PG8_STAGE(PG8_SA(1, 0), a3, voffA);
            PG8_WAIT_V(8); PG8_WAIT_L(0); PG8_BAR; PG8_MMA(1, 0, At, B0); PG8_MMA(1, 1, At, B1);
            if constexpr (Rider::ON) racc = __builtin_amdgcn_mfma_f32_32x32x16_bf16(ra, rb, racc, 0, 0, 0);
            PG8_BAR; PG8_SCHED;
        }
        if (wr == 0) PG8_BAR;
        E(acc, cur, nxt, has_next, ui & 1, wr, wc, fr, fq, lds, tid);
        if constexpr (Rider::ON) { R.finish(racc, cur.seq, lds, tid);
#pragma unroll
            for (int r = 0; r < 16; ++r) racc[r] = 0.f;
            if (has_next) R.ptrs(nxt.seq, wid, rpa, rpb); }
        if (!has_next) break;
        if constexpr (Epi::INIT) E.init_load(xin, nxt, wr, wc, fr, fq);
#pragma unroll
        for (int a = 0; a < 2; ++a)
#pragma unroll
            for (int m = 0; m < 4; ++m)
#pragma unroll
                for (int b = 0; b < 2; ++b) {
                    if constexpr (Epi::INIT) { const u32x4 x4 = xin[a][m][b];
                        acc[a][b][m][0] = (f32x4){bf2f(x4.x & 0xffffu), bf2f(x4.x >> 16), bf2f(x4.y & 0xffffu), bf2f(x4.y >> 16)};
                        acc[a][b][m][1] = (f32x4){bf2f(x4.z & 0xffffu), bf2f(x4.z >> 16), bf2f(x4.w & 0xffffu), bf2f(x4.w >> 16)}; }
                    else { acc[a][b][m][0] = (f32x4){0.f, 0.f, 0.f, 0.f}; acc[a][b][m][1] = (f32x4){0.f, 0.f, 0.f, 0.f}; } }
        cur = nxt; cA = nA; cB = nB; ++ui;
        if (wr == 1) PG8_BAR;
    }
    PG8_WAIT_V(0);
    PG8_BAR;
#undef PG8_SA
#undef PG8_SB
#undef PG8_STAGE
#undef PG8_GLDS
#undef PG8_LDA
#undef PG8_LDB
#undef PG8_MMA
#undef PG8_WAIT_V
#undef PG8_WAIT_L
#undef PG8_BAR
#undef PG8_SCHED
}
}

typedef f32x4 AccT[2][2][4][2];

__device__ __forceinline__ float rs_issue(const float* ssq, int tok0, int tid) {
    float s = 0.f;
    if (tid < 256) { int tok = tok0 + tid; tok = tok < 0 ? 0 : (tok >= MT ? MT - 1 : tok); s = (ssq[tok] + ssq[MT + tok]) + (ssq[2 * MT + tok] + ssq[3 * MT + tok]); }
    return s;
}
__device__ __forceinline__ void rs_commit(LAS unsigned char* lds, int slot, float s, int tid) { if (tid < 256) ((LAS float*)(lds + L_RSTAB))[slot * 256 + tid] = 1.0f / sqrtf(s * (1.0f / D) + EPS); }

struct EpiQKV {
    static constexpr bool PERM = true, INIT = false;
    bf16_t* O; size_t split_stride; const float* ssq; float* okp; float* ovp;
    __device__ __forceinline__ void first(const pg8::Unit& u, LAS unsigned char* lds, int tid) const { rs_commit(lds, 0, rs_issue(ssq, u.pm * 256, tid), tid); RAW_BAR(); }
    __device__ __forceinline__ void operator()(const AccT& acc, const pg8::Unit& u, const pg8::Unit& nx, bool has_next, int slot, int wr, int wc, int fr0, int fq0, LAS unsigned char* lds, int tid0) const {
        int fr = fr0, fq = fq0, tid = tid0; asm volatile("" : "+v"(fr), "+v"(fq), "+v"(tid));
        float sn = 0.f; if (has_next) sn = rs_issue(ssq, nx.pm * 256, tid);
        const LAS float* rst = (const LAS float*)(lds + L_RSTAB) + slot * 256;
        const int t = u.pn >> 2, colt = (u.pn & 3) * 256; bf16_t* base = O + (size_t)t * split_stride; const float sc = (t == 0) ? C2 : 1.0f;
        const bool side = (t >= 1) && ((u.pm & 31) >= 30);
        float* sp = (t == 1 ? okp : ovp) + ((size_t)((u.pm >> 5) * CA + (u.pm & 1) * 256)) * D;
        const int col0 = colt + wc * 32 + 8 * fq;
#pragma unroll
        for (int ai = 0; ai < 2; ++ai)
#pragma unroll
            for (int m = 0; m < 4; ++m) { const int r = ai * 128 + wr * 64 + m * 16 + fr; const float rs = rst[r] * sc; bf16_t* rowp = base + (size_t)(u.pm * 256 + r) * D + col0;
#pragma unroll
                for (int bj = 0; bj < 2; ++bj) { const f32x4 v0 = acc[ai][bj][m][0] * rs, v1 = acc[ai][bj][m][1] * rs;
                    u32x4 w; w.x = cvt_pk_bf16(v0[0], v0[1]); w.y = cvt_pk_bf16(v0[2], v0[3]); w.z = cvt_pk_bf16(v1[0], v1[1]); w.w = cvt_pk_bf16(v1[2], v1[3]);
                    *(u32x4*)(rowp + bj * 128) = w;
                    if (side) { float* s = sp + (size_t)r * D + col0 + bj * 128; *(f32x4*)s = v0; *(f32x4*)(s + 4) = v1; } } }
        if (has_next) rs_commit(lds, slot ^ 1, sn, tid);
    }
};

__device__ __forceinline__ void res_init_load(u32x4 (&xin)[2][4][2], const bf16_t* xb, const pg8::Unit& u, int wr, int wc, int fr0, int fq0) {
    int fr = fr0, fq = fq0; asm volatile("" : "+v"(fr), "+v"(fq));
    const int col0 = u.pn * 256 + wc * 32 + 8 * fq;
#pragma unroll
    for (int ai = 0; ai < 2; ++ai)
#pragma unroll
        for (int m = 0; m < 4; ++m) { const size_t off = (size_t)(u.pm * 256 + ai * 128 + wr * 64 + m * 16 + fr) * D + col0;
#pragma unroll
            for (int bj = 0; bj < 2; ++bj) xin[ai][m][bj] = *(const u32x4*)(xb + off + bj * 128); }
}
struct EpiRes {
    static constexpr bool PERM = true, INIT = true;
    const bf16_t* xb; bf16_t* xo; float* ssq;
    __device__ __forceinline__ void first(const pg8::Unit&, LAS unsigned char*, int) const {}
    __device__ __forceinline__ void init_load(u32x4 (&xin)[2][4][2], const pg8::Unit& u, int wr, int wc, int fr, int fq) const { res_init_load(xin, xb, u, wr, wc, fr, fq); }
    __device__ __forceinline__ void operator()(const AccT& acc, const pg8::Unit& u, const pg8::Unit&, bool, int, int wr, int wc, int fr0, int fq0, LAS unsigned char* lds, int tid0) const {
        int fr = fr0, fq = fq0, tid = tid0; asm volatile("" : "+v"(fr), "+v"(fq), "+v"(tid));
        LAS float* P = (LAS float*)(lds + L_PTAB);
        const int col0 = u.pn * 256 + wc * 32 + 8 * fq;
#pragma unroll
        for (int ai = 0; ai < 2; ++ai)
#pragma unroll
            for (int m = 0; m < 4; ++m) { const int r = ai * 128 + wr * 64 + m * 16 + fr; const size_t off = (size_t)(u.pm * 256 + r) * D + col0; float s = 0.f;
#pragma unroll
                for (int bj = 0; bj < 2; ++bj) { const f32x4 a0 = acc[ai][bj][m][0], a1 = acc[ai][bj][m][1];
                    s += ((a0[0] * a0[0] + a0[1] * a0[1]) + (a0[2] * a0[2] + a0[3] * a0[3])) + ((a1[0] * a1[0] + a1[1] * a1[1]) + (a1[2] * a1[2] + a1[3] * a1[3]));
                    u32x4 w; w.x = cvt_pk_bf16(a0[0], a0[1]); w.y = cvt_pk_bf16(a0[2], a0[3]); w.z = cvt_pk_bf16(a1[0], a1[1]); w.w = cvt_pk_bf16(a1[2], a1[3]); *(u32x4*)(xo + off + bj * 128) = w; }
                s = xsum32(xsum16(s));
                if (fq == 0) P[r * 4 + wc] = s; }
        RAW_BAR();
        if (tid < 256) { const f32x4 p = *(const LAS f32x4*)(P + tid * 4); ssq[(size_t)u.pn * MT + u.pm * 256 + tid] = (p[0] + p[1]) + (p[2] + p[3]); }
    }
};

__device__ __forceinline__ void wait_count(unsigned* cnt, unsigned want, int tid) {
    if (tid == 0) { unsigned sp = 0;
        while (__hip_atomic_load(cnt, __ATOMIC_RELAXED, __HIP_MEMORY_SCOPE_AGENT) < want) { __builtin_amdgcn_s_sleep(2); if (++sp > (1u << 22)) break; }
        __builtin_amdgcn_fence(__ATOMIC_ACQUIRE, "agent"); }
    asm volatile("s_waitcnt vmcnt(0)" ::: "memory");
    RAW_BAR();
}
struct EpiFinal {
    static constexpr bool PERM = true, INIT = true;
    const bf16_t* xb; float* out; float* ssq; unsigned* cnt; const float* gfin;
    __device__ __forceinline__ void first(const pg8::Unit&, LAS unsigned char*, int) const {}
    __device__ __forceinline__ void init_load(u32x4 (&xin)[2][4][2], const pg8::Unit& u, int wr, int wc, int fr, int fq) const { res_init_load(xin, xb, u, wr, wc, fr, fq); }
    __device__ __forceinline__ void operator()(AccT& acc, const pg8::Unit& u, const pg8::Unit&, bool, int, int wr, int wc, int fr0, int fq0, LAS unsigned char* lds, int tid0) const {
        int fr = fr0, fq = fq0, tid = tid0; asm volatile("" : "+v"(fr), "+v"(fq), "+v"(tid));
        LAS float* P = (LAS float*)(lds + L_PTAB); LAS float* rst = (LAS float*)(lds + L_RSTAB);
        const int col0 = u.pn * 256 + wc * 32 + 8 * fq;
#pragma unroll
        for (int ai = 0; ai < 2; ++ai)
#pragma unroll
            for (int m = 0; m < 4; ++m) { const int r = ai * 128 + wr * 64 + m * 16 + fr; float s = 0.f;
#pragma unroll
                for (int bj = 0; bj < 2; ++bj) { const f32x4 a0 = acc[ai][bj][m][0], a1 = acc[ai][bj][m][1];
                    s += ((a0[0] * a0[0] + a0[1] * a0[1]) + (a0[2] * a0[2] + a0[3] * a0[3])) + ((a1[0] * a1[0] + a1[1] * a1[1]) + (a1[2] * a1[2] + a1[3] * a1[3])); }
                s = xsum32(xsum16(s));
                if (fq == 0) P[r * 4 + wc] = s; }
        RAW_BAR();
        if (tid < 256) { const f32x4 p = *(const LAS f32x4*)(P + tid * 4);
            __hip_atomic_store(ssq + (size_t)u.pn * MT + u.pm * 256 + tid, (p[0] + p[1]) + (p[2] + p[3]), __ATOMIC_RELAXED, __HIP_MEMORY_SCOPE_AGENT); }
        asm volatile("s_waitcnt vmcnt(0)" ::: "memory");
        RAW_BAR();
        if (tid == 0) __hip_atomic_fetch_add(cnt + 64 * u.pm, 1u, __ATOMIC_RELAXED, __HIP_MEMORY_SCOPE_AGENT);
        wait_count(cnt + 64 * u.pm, 4u, tid);
        if (tid < 256) { float s = 0.f;
#pragma unroll
            for (int t = 0; t < 4; ++t) s += __hip_atomic_load(ssq + (size_t)t * MT + u.pm * 256 + tid, __ATOMIC_RELAXED, __HIP_MEMORY_SCOPE_AGENT);
            rst[tid] = 1.0f / sqrtf(s * (1.0f / D) + EPS); }
        RAW_BAR();
        f32x4 gv[2][2];
#pragma unroll
        for (int bj = 0; bj < 2; ++bj)
#pragma unroll
            for (int n = 0; n < 2; ++n) gv[bj][n] = *(const f32x4*)(gfin + col0 + bj * 128 + n * 4);
#pragma unroll
        for (int ai = 0; ai < 2; ++ai)
#pragma unroll
            for (int m = 0; m < 4; ++m) { const int r = ai * 128 + wr * 64 + m * 16 + fr; const float rs = rst[r]; const size_t off = (size_t)(u.pm * 256 + r) * D + col0;
#pragma unroll
                for (int bj = 0; bj < 2; ++bj)
#pragma unroll
                    for (int n = 0; n < 2; ++n) *(f32x4*)(out + off + bj * 128 + n * 4) = acc[ai][bj][m][n] * rs * gv[bj][n]; }
    }
};

struct EpiIn {
    static constexpr bool PERM = true, INIT = false;
    bf16_t* O; size_t split_stride; const float* ssq; float* ssqv;
    __device__ __forceinline__ void first(const pg8::Unit& u, LAS unsigned char* lds, int tid) const { rs_commit(lds, 0, rs_issue(ssq, u.pm * 256, tid), tid); RAW_BAR(); }
    __device__ __forceinline__ void operator()(const AccT& acc, const pg8::Unit& u, const pg8::Unit& nx, bool has_next, int slot, int wr, int wc, int fr0, int fq0, LAS unsigned char* lds, int tid0) const {
        int fr = fr0, fq = fq0, tid = tid0; asm volatile("" : "+v"(fr), "+v"(fq), "+v"(tid));
        float sn = 0.f; if (has_next) sn = rs_issue(ssq, nx.pm * 256, tid);
        const LAS float* rst = (const LAS float*)(lds + L_RSTAB) + slot * 256; LAS float* P = (LAS float*)(lds + L_PTAB);
        const int t = u.pn >> 2, colt = (u.pn & 3) * 256; bf16_t* base = O + (size_t)t * split_stride;
        const int col0 = colt + wc * 32 + 8 * fq;
#pragma unroll
        for (int ai = 0; ai < 2; ++ai)
#pragma unroll
            for (int m = 0; m < 4; ++m) { const int r = ai * 128 + wr * 64 + m * 16 + fr; const float rs = rst[r]; bf16_t* rowp = base + (size_t)(u.pm * 256 + r) * D + col0; float s = 0.f;
#pragma unroll
                for (int bj = 0; bj < 2; ++bj) { const f32x4 x0 = acc[ai][bj][m][0] * rs, x1 = acc[ai][bj][m][1] * rs;
                    const f32x2 a = gelu_pk((f32x2){x0[0], x0[1]}), b = gelu_pk((f32x2){x0[2], x0[3]}), c = gelu_pk((f32x2){x1[0], x1[1]}), d = gelu_pk((f32x2){x1[2], x1[3]});
                    s += (a.x * a.x + a.y * a.y) + (b.x * b.x + b.y * b.y) + (c.x * c.x + c.y * c.y) + (d.x * d.x + d.y * d.y);
                    u32x4 w; w.x = cvt_pk_bf16(a.x, a.y); w.y = cvt_pk_bf16(b.x, b.y); w.z = cvt_pk_bf16(c.x, c.y); w.w = cvt_pk_bf16(d.x, d.y);
                    *(u32x4*)(rowp + bj * 128) = w; }
                if (t == 1) { s = xsum32(xsum16(s)); if (fq == 0) P[r * 4 + wc] = s; } }
        if (t == 1) { RAW_BAR();
            if (tid < 256) { const f32x4 p = *(const LAS f32x4*)(P + tid * 4); ssqv[(size_t)(u.pn & 3) * MT + u.pm * 256 + tid] = (p[0] + p[1]) + (p[2] + p[3]); } }
        if (has_next) rs_commit(lds, slot ^ 1, sn, tid);
    }
};

__device__ __forceinline__ void conv_dpp(f32x4& o, const f32x4 cur, const f32x4 prv, const f32x4 w1, const f32x4 w0) {
#define CONV1(e) "v_fmac_f32_dpp %" #e ", %[c" #e "], %[a" #e "] row_shr:1 row_mask:0xf bank_mask:0xf bound_ctrl:1\n\t" \
                 "v_fmac_f32_dpp %" #e ", %[p" #e "], %[a" #e "] row_shl:15 row_mask:0xf bank_mask:0xf bound_ctrl:1\n\t" \
                 "v_fmac_f32_dpp %" #e ", %[c" #e "], %[b" #e "] row_shr:2 row_mask:0xf bank_mask:0xf bound_ctrl:1\n\t" \
                 "v_fmac_f32_dpp %" #e ", %[p" #e "], %[b" #e "] row_shl:14 row_mask:0xf bank_mask:0xf bound_ctrl:1\n\t"
    float o0 = o[0], o1 = o[1], o2 = o[2], o3 = o[3];
    asm("s_nop 1\n\t" CONV1(0) CONV1(1) CONV1(2) CONV1(3)
        : "+v"(o0), "+v"(o1), "+v"(o2), "+v"(o3)
        : [c0] "v"(cur[0]), [c1] "v"(cur[1]), [c2] "v"(cur[2]), [c3] "v"(cur[3]), [p0] "v"(prv[0]), [p1] "v"(prv[1]), [p2] "v"(prv[2]), [p3] "v"(prv[3]),
          [a0] "v"(w1[0]), [a1] "v"(w1[1]), [a2] "v"(w1[2]), [a3] "v"(w1[3]), [b0] "v"(w0[0]), [b1] "v"(w0[1]), [b2] "v"(w0[2]), [b3] "v"(w0[3]));
    o = (f32x4){o0, o1, o2, o3};
#undef CONV1
}

struct EpiUp {
    static constexpr bool PERM = true, INIT = false, APERM = true;
    bf16_t* G; const float* ssq; const float* ssqs; const float* cw; const float* cb; float* ocp; const float* hist; float* ocs;
    __device__ __forceinline__ float rs_iss(const pg8::Unit& u, int tid) const {
        if (u.pm != 66) return rs_issue(ssq, u.arow, tid);
        float s = 0.f;
        if (tid < 256) {
#pragma unroll 8
            for (int jj = 0; jj < 32; ++jj) s += ssqs[(size_t)jj * MS + tid]; }
        return s;
    }
    __device__ __forceinline__ f32x2 ct_iss(const pg8::Unit& u, int tid) const {
        const int c = tid & 255, wh = tid >> 8, oc = (c >> 7) * FF + u.pn * 128 + (c & 127);
        f32x2 r; r.x = cw[(size_t)wh * FF2 + oc]; r.y = wh == 0 ? cw[(size_t)2 * FF2 + oc] : cb[oc]; return r;
    }
    __device__ __forceinline__ void ct_commit(LAS unsigned char* lds, int slot, f32x2 v, int tid) const {
        LAS float* ct = (LAS float*)(lds + L_CTAB) + slot * 1024; const int c = tid & 255, wh = tid >> 8;
        const float sc = (c >> 7) ? -1.0f / LOG2E : -LOG2E;
        ct[wh * 256 + c] = v.x * sc; ct[(wh == 0 ? 2 : 3) * 256 + c] = v.y * sc;
    }
    __device__ __forceinline__ void first(const pg8::Unit& u, LAS unsigned char* lds, int tid) const { rs_commit(lds, 0, rs_iss(u, tid), tid); ct_commit(lds, 0, ct_iss(u, tid), tid); RAW_BAR(); }
    __device__ __forceinline__ void operator()(AccT& acc, const pg8::Unit& u, const pg8::Unit& nx, bool has_next, int slot, int wr, int wc, int fr0, int fq0, LAS unsigned char* lds, int tid0) const {
        int fr = fr0, fq = fq0, tid = tid0; asm volatile("" : "+v"(fr), "+v"(fq), "+v"(tid));
        float sn = 0.f; f32x2 cn = (f32x2){0.f, 0.f};
        if (has_next) { sn = rs_iss(nx, tid); cn = ct_iss(nx, tid); }
        const bool smp = u.pm == 66;
        const int b = u.pm / 33, j = smp ? 1 : u.pm % 33, tok0 = u.arow;
        const LAS float* rst = (const LAS float*)(lds + L_RSTAB) + slot * 256; LAS float* xbuf = (LAS float*)(lds + L_XBUF); const LAS float* ct = (const LAS float*)(lds + L_CTAB) + slot * 1024;
#pragma unroll
        for (int ai = 0; ai < 2; ++ai) { const f32x4 rs4 = *(const LAS f32x4*)(rst + ai * 128 + wr * 64 + 4 * fr);
#pragma unroll
            for (int m = 0; m < 4; ++m)
#pragma unroll
                for (int bj = 0; bj < 2; ++bj)
#pragma unroll
                    for (int n = 0; n < 2; ++n) acc[ai][bj][m][n] *= rs4[m]; }
        if (j == 0 && wr == 0 && fr == 0) {
#pragma unroll
            for (int bj = 0; bj < 2; ++bj)
#pragma unroll
                for (int n = 0; n < 2; ++n) { acc[0][bj][0][n] = (f32x4){0.f, 0.f, 0.f, 0.f}; acc[0][bj][1][n] = (f32x4){0.f, 0.f, 0.f, 0.f}; } }
        const int cl = wc * 32 + 8 * fq;
        if (j == 32 && wr == 1 && fr == 0) {
#pragma unroll
            for (int r = 0; r < 2; ++r)
#pragma unroll
                for (int bj = 0; bj < 2; ++bj)
#pragma unroll
                    for (int n = 0; n < 2; ++n) *(f32x4*)(ocp + (size_t)(b * 2 + r) * FF2 + bj * FF + u.pn * 128 + cl + 4 * n) = acc[0][bj][r][n]; }
        if (smp && (fr & 7) == 7) {
            const int cl_ = cl;
#pragma unroll
            for (int ai = 0; ai < 2; ++ai)
#pragma unroll
                for (int r = 0; r < 2; ++r)
#pragma unroll
                    for (int bj = 0; bj < 2; ++bj)
#pragma unroll
                        for (int n = 0; n < 2; ++n) *(f32x4*)(ocs + (size_t)((2 * (2 * ai + wr) + (fr >> 3)) * 2 + r) * FF2 + bj * FF + u.pn * 128 + cl_ + 4 * n) = acc[ai][bj][2 + r][n]; }
        if (!smp) {
            if (fr == 15) {
#pragma unroll
                for (int ai = 0; ai < 2; ++ai)
                    if (2 * ai + wr < 3) {
#pragma unroll
                        for (int r = 0; r < 2; ++r)
#pragma unroll
                            for (int bj = 0; bj < 2; ++bj)
#pragma unroll
                                for (int n = 0; n < 2; ++n) *(LAS f32x4*)(xbuf + ((2 * (2 * ai + wr + 1)) * 2 + r) * 256 + bj * 128 + cl + 4 * n) = acc[ai][bj][2 + r][n]; } }
        } else if (fr >= 14) {
#pragma unroll 1
            for (int q4 = 0; q4 < 4; ++q4) { const int q = (q4 >> 1) * 4 + wr * 2 + (q4 & 1);
#pragma unroll 1
                for (int bj = 0; bj < 2; ++bj) { const f32x4 h0 = *(const f32x4*)(hist + (size_t)(q * 2 + (fr - 14)) * FF2 + bj * FF + u.pn * 128 + cl), h1 = *(const f32x4*)(hist + (size_t)(q * 2 + (fr - 14)) * FF2 + bj * FF + u.pn * 128 + cl + 4);
                    *(LAS f32x4*)(xbuf + (q * 2 + (fr - 14)) * 256 + bj * 128 + cl) = h0; *(LAS f32x4*)(xbuf + (q * 2 + (fr - 14)) * 256 + bj * 128 + cl + 4) = h1; } }
        }
        RAW_BAR();
        const int bend = smp ? MT : (b + 1) * SEQ;
        const int hq = smp ? (fr >> 3) : 0;
        u32x2 wlo[2][4];
#pragma unroll
        for (int n = 0; n < 2; ++n) {
            f32x4 w0[2], w1[2], w2[2], cbv[2];
#pragma unroll
            for (int bj = 0; bj < 2; ++bj) { const int tc = bj * 128 + cl + 4 * n;
                w0[bj] = *(const LAS f32x4*)(ct + tc); w1[bj] = *(const LAS f32x4*)(ct + 256 + tc); w2[bj] = *(const LAS f32x4*)(ct + 512 + tc); cbv[bj] = *(const LAS f32x4*)(ct + 768 + tc); }
#pragma unroll
            for (int ai = 0; ai < 2; ++ai) {
                f32x4 c[4][2];
#pragma unroll
                for (int bj = 0; bj < 2; ++bj) {
                    const f32x4 a0 = acc[ai][bj][0][n], a1 = acc[ai][bj][1][n], a2 = acc[ai][bj][2][n], a3 = acc[ai][bj][3][n];
                    const LAS float* hp = xbuf + ((2 * (2 * ai + wr) + hq) * 2) * 256 + bj * 128 + cl + 4 * n;
                    const f32x4 h2 = *(const LAS f32x4*)hp, h1 = *(const LAS f32x4*)(hp + 256);
                    f32x4 s1, s2;
#pragma unroll
                    for (int e = 0; e < 4; ++e) { s1[e] = dpp_shr1_old(h1[e], a3[e]); s2[e] = dpp_shr1_old(h2[e], a2[e]); }
                    if (smp) { asm volatile("" ::: "memory");
                        const f32x4 g2 = *(const LAS f32x4*)hp, g1 = *(const LAS f32x4*)(hp + 256);
#pragma unroll
                        for (int e = 0; e < 4; ++e) { s1[e] = fr == 8 ? g1[e] : s1[e]; s2[e] = fr == 8 ? g2[e] : s2[e]; } }
                    c[3][bj] = cbv[bj] + w2[bj] * a3 + w1[bj] * a2 + w0[bj] * a1;
                    c[2][bj] = cbv[bj] + w2[bj] * a2 + w1[bj] * a1 + w0[bj] * a0;
                    c[1][bj] = cbv[bj] + w2[bj] * a1 + w1[bj] * a0 + w0[bj] * s1;
                    c[0][bj] = cbv[bj] + w2[bj] * a0 + w1[bj] * s1 + w0[bj] * s2; }
#pragma unroll
                for (int m = 0; m < 4; ++m) {
                    const int tr = ai * 128 + wr * 64 + 4 * fr + m, tok = tok0 + tr;
                    u32x2 w;
                    const f32x4 t_ = c[m][0]; f32x4 e_ = (f32x4){__builtin_amdgcn_exp2f(t_[0]), __builtin_amdgcn_exp2f(t_[1]), __builtin_amdgcn_exp2f(t_[2]), __builtin_amdgcn_exp2f(t_[3])};
                    e_ += 1.0f; const f32x4 r_ = (f32x4){__builtin_amdgcn_rcpf(e_[0]), __builtin_amdgcn_rcpf(e_[1]), __builtin_amdgcn_rcpf(e_[2]), __builtin_amdgcn_rcpf(e_[3])};
                    const f32x4 g_ = (t_ * c[m][1]) * r_;
                    w.x = cvt_pk_bf16(g_[0], g_[1]); w.y = cvt_pk_bf16(g_[2], g_[3]);
                    if (n == 0) wlo[ai][m] = w;
                    else if ((smp || tr >= 2) && tok < bend) { const u32x2 w0_ = wlo[ai][m]; *(u32x4*)(G + (size_t)tok * FF + u.pn * 128 + cl) = (u32x4){w0_.x, w0_.y, w.x, w.y}; }
                }
            }
        }
        if (has_next) { rs_commit(lds, slot ^ 1, sn, tid); ct_commit(lds, slot ^ 1, cn, tid); }
    }
};

__device__ __forceinline__ float srs_load(const float* ssqs, int mt, int tid) { const int row = tid >> 4, jj = tid & 15; return ssqs[(size_t)jj * MS + mt * 32 + row] + ssqs[(size_t)(jj + 16) * MS + mt * 32 + row]; }
__device__ __forceinline__ float srs_finish(float s) { s = sum16(s); return 1.0f / sqrtf(s * (1.0f / D) + EPS); }

template <int K_, int NTN, class SEpi> struct SampleRider {
    static constexpr bool ON = true; static constexpr int K = K_;
    const bf16_t* A; const bf16_t* Bt; SEpi epi;
    __device__ __forceinline__ void ptrs(int seq, int wid, const char*& pa, const char*& pb) const {
        const int mt = seq / NTN, nt = seq % NTN;
        pa = (const char*)(A + ((size_t)(MP + 32 * mt) * K + wid * (K / 8)));
        pb = (const char*)(Bt + ((size_t)(32 * nt) * K + wid * (K / 8)));
    }
    __device__ __forceinline__ void finish(const f32x16& racc, int seq, LAS unsigned char* lds, int tid0) const {
        int tid = tid0; asm volatile("" : "+v"(tid));
        const int lane = tid & 63, r32 = lane & 31, hi = lane >> 5, w = tid >> 6, mt = seq / NTN, nt = seq % NTN;
        const float pre = epi.pre(mt, nt, tid);
#define RSLOT(i) ((LAS float*)(lds + ((i) < 4 ? L_XBUF + (i) * 4096 : L_CTAB + ((i) - 4) * 4096)))
        if (w < 6) { LAS float* part = RSLOT(w);
#pragma unroll
            for (int r = 0; r < 16; ++r) part[crow(r, hi) * 32 + r32] = racc[r]; }
        RAW_BAR();
        if (w >= 6) { LAS float* part = RSLOT(w - 2);
#pragma unroll
            for (int r = 0; r < 16; ++r) part[crow(r, hi) * 32 + r32] += racc[r]; }
        RAW_BAR();
        const int row = tid >> 4, c0 = (tid & 15) * 2; f32x2 v = (f32x2){0.f, 0.f};
#pragma unroll
        for (int sl = 0; sl < 6; ++sl) v += *(const LAS f32x2*)(RSLOT(sl) + row * 32 + c0);
#undef RSLOT
        epi(mt, nt, row, c0, v.x, v.y, pre, tid);
    }
};
struct SQkv {
    const float* ssqs; bf16_t* QB; bf16_t* KB; bf16_t* VB; float* oks; float* ovs;
    __device__ __forceinline__ float pre(int mt, int, int tid) const { return srs_load(ssqs, mt, tid); }
    __device__ __forceinline__ void operator()(int mt, int nt, int row, int c0, float a0, float a1, float pre, int tid) const {
        const float r_ = srs_finish(pre); const int n = 32 * nt + c0, t = n >> 10, nn = n & 1023; const float v0 = a0 * r_, v1 = a1 * r_, sc = t == 0 ? C2 : 1.0f;
        bf16_t* dst = QB + (size_t)t * ((WS_K - WS_Q) / 2) + (size_t)(MP + 32 * mt + row) * D + nn; *(unsigned*)dst = cvt_pk_bf16(v0 * sc, v1 * sc);
        if (t >= 1) { float* o = oks + (size_t)(t - 1) * (O_VS - O_KS) + (size_t)(32 * mt + row) * D + nn; *(f32x2*)o = (f32x2){v0, v1}; }
    }
};
struct SRes {
    const bf16_t* XB; bf16_t* XO; float* ssqs;
    __device__ __forceinline__ float pre(int mt, int nt, int tid) const { return __uint_as_float(*(const unsigned*)(XB + (size_t)(MP + 32 * mt + (tid >> 4)) * D + 32 * nt + (tid & 15) * 2)); }
    __device__ __forceinline__ void operator()(int mt, int nt, int row, int c0, float a0, float a1, float pre, int tid) const {
        const size_t xo_ = (size_t)(MP + 32 * mt + row) * D + 32 * nt + c0; const unsigned bb = __float_as_uint(pre);
        const float v0 = bf2f(bb & 0xffffu) + a0, v1 = bf2f(bb >> 16) + a1; *(unsigned*)(XO + xo_) = cvt_pk_bf16(v0, v1);
        float s_ = v0 * v0 + v1 * v1; s_ = sum16(s_);
        if ((tid & 15) == 0) ssqs[(size_t)nt * MS + 32 * mt + row] = s_;
    }
};
struct SIn {
    const float* ssqs; bf16_t* UB; bf16_t* VB; float* ssqvs;
    __device__ __forceinline__ float pre(int mt, int, int tid) const { return srs_load(ssqs, mt, tid); }
    __device__ __forceinline__ void operator()(int mt, int nt, int row, int c0, float a0, float a1, float pre, int tid) const {
        const float r_ = srs_finish(pre); const int n = 32 * nt + c0, t = n >> 10, nn = n & 1023;
        const f32x2 z = gelu_pk((f32x2){a0 * r_, a1 * r_});
        *(unsigned*)(UB + (size_t)t * ((WS_K - WS_Q) / 2) + (size_t)(MP + 32 * mt + row) * D + nn) = cvt_pk_bf16(z.x, z.y);
        if (t == 1) { float s_ = z.x * z.x + z.y * z.y; s_ = sum16(s_);
            if ((tid & 15) == 0) ssqvs[(size_t)(nt - 32) * MS + 32 * mt + row] = s_; }
    }
};

struct SFin {
    const bf16_t* XB; float* xchs; unsigned* cnt; const float* gfin; float* ys;
    __device__ __forceinline__ float pre(int mt, int nt, int tid) const { return __uint_as_float(*(const unsigned*)(XB + (size_t)(MP + 32 * mt + (tid >> 4)) * D + 32 * nt + (tid & 15) * 2)); }
    __device__ __forceinline__ void operator()(int mt, int nt, int row, int c0, float a0, float a1, float pre, int tid) const {
        const int n = 32 * nt + c0; const unsigned bb = __float_as_uint(pre);
        const float v0 = bf2f(bb & 0xffffu) + a0, v1 = bf2f(bb >> 16) + a1;
        float s_ = v0 * v0 + v1 * v1; s_ = sum16(s_);
        if ((tid & 15) == 0) __hip_atomic_store(xchs + (size_t)nt * MS + 32 * mt + row, s_, __ATOMIC_RELAXED, __HIP_MEMORY_SCOPE_AGENT);
        asm volatile("s_waitcnt vmcnt(0)" ::: "memory");
        RAW_BAR();
        if (tid == 0) __hip_atomic_fetch_add(cnt + 64 * mt, 1u, __ATOMIC_RELAXED, __HIP_MEMORY_SCOPE_AGENT);
        wait_count(cnt + 64 * mt, 32u, tid);
        const int jj = tid & 15; float t_ = __hip_atomic_load(xchs + (size_t)jj * MS + 32 * mt + row, __ATOMIC_RELAXED, __HIP_MEMORY_SCOPE_AGENT) + __hip_atomic_load(xchs + (size_t)(jj + 16) * MS + 32 * mt + row, __ATOMIC_RELAXED, __HIP_MEMORY_SCOPE_AGENT);
        t_ = sum16(t_);
        const float rs = 1.0f / sqrtf(t_ * (1.0f / D) + EPS);
        *(f32x2*)(ys + (size_t)(32 * mt + row) * D + n) = (f32x2){v0 * rs * gfin[n], v1 * rs * gfin[n + 1]};
    }
};

namespace att {
constexpr int NS = 6, SLOTB = 8192;
constexpr int L_K = 0, L_V = NS * SLOTB, L_OST = 2 * NS * SLOTB, L_BIAS = 131072, L_WSF = 132352, L_BIAS2 = 134400;
#define SBAR() __builtin_amdgcn_sched_barrier(0)
__device__ __forceinline__ void glds16(const void* gsrc, unsigned lds_dst) { unsigned keep;
    asm volatile("s_mov_b32 %0, m0\n\ts_mov_b32 m0, %2\n\ts_nop 0\n\tglobal_load_lds_dwordx4 %1, off\n\ts_mov_b32 m0, %0" : "=&s"(keep) : "v"(gsrc), "s"(lds_dst) : "memory"); }
#define WAIT_BAR(N) asm volatile("s_waitcnt vmcnt(" #N ") lgkmcnt(0)\n\ts_barrier" ::: "memory")

struct State { float m, l; f32x16 o[2]; };

__device__ __forceinline__ void tile(State& st, const bf16x8 (&qr)[4], unsigned kslot, unsigned vslot, float cinit, bool near, int base, bool mask1, const LAS float* tab, LAS float* wsf, int r32, int hi, int lane) {
    f32x16 p0, p1;
    { const LAS char* kb = (const LAS char*)(uintptr_t)kslot + hi * 1024 + r32 * 16;
        f32x16 ci;
#pragma unroll
        for (int r = 0; r < 16; ++r) ci[r] = cinit;
#pragma unroll
        for (int d0 = 0; d0 < 4; ++d0) { const bf16x8 b0 = *(const LAS bf16x8*)(kb + d0 * 2048), b1 = *(const LAS bf16x8*)(kb + d0 * 2048 + 512);
            if (d0 == 0) { p0 = __builtin_amdgcn_mfma_f32_32x32x16_bf16(b0, qr[0], ci, 0, 0, 0); p1 = __builtin_amdgcn_mfma_f32_32x32x16_bf16(b1, qr[0], ci, 0, 0, 0); }
            else { p0 = __builtin_amdgcn_mfma_f32_32x32x16_bf16(b0, qr[d0], p0, 0, 0, 0); p1 = __builtin_amdgcn_mfma_f32_32x32x16_bf16(b1, qr[d0], p1, 0, 0, 0); } } }
    if (near) {
#pragma unroll
        for (int r = 0; r < 16; ++r) { const LAS float* tb = tab + (319 - base) + 4 * hi; p0[r] += tb[(r & 3) + 8 * (r >> 2)]; p1[r] += tb[32 + (r & 3) + 8 * (r >> 2)]; } }
    if (mask1) {
#pragma unroll
        for (int r = 0; r < 16; ++r) p1[r] = -1e30f; }
    float rm = fmaxf(p0[0], p1[0]);
#pragma unroll
    for (int r = 1; r < 16; ++r) rm = fmaxf(rm, fmaxf(p0[r], p1[r]));
    rm = xmax32(rm);
    const float mn = fmaxf(st.m, rm);
    if (__any(mn > st.m)) {
        const float f = __builtin_amdgcn_exp2f(st.m - mn); st.l *= f; st.m = mn;
        if (hi == 0) wsf[r32] = f;
        LDS_WAIT();
#pragma unroll
        for (int g = 0; g < 4; ++g) { const f32x4 fv = *(const LAS f32x4*)(wsf + 8 * g + 4 * hi);
#pragma unroll
            for (int e = 0; e < 4; ++e) { st.o[0][4 * g + e] *= fv[e]; st.o[1][4 * g + e] *= fv[e]; } }
    }
    float sacc = 0.f;
#pragma unroll
    for (int r = 0; r < 16; ++r) { p0[r] = __builtin_amdgcn_exp2f(p0[r] - st.m); p1[r] = __builtin_amdgcn_exp2f(p1[r] - st.m); sacc += p0[r] + p1[r]; }
    st.l += sacc;
    u32x4 pw[4];
#pragma unroll
    for (int k = 0; k < 2; ++k) { pw[k] = (u32x4){cvt_pk_bf16(p0[8 * k], p0[8 * k + 1]), cvt_pk_bf16(p0[8 * k + 2], p0[8 * k + 3]), cvt_pk_bf16(p0[8 * k + 4], p0[8 * k + 5]), cvt_pk_bf16(p0[8 * k + 6], p0[8 * k + 7])};
        pw[2 + k] = (u32x4){cvt_pk_bf16(p1[8 * k], p1[8 * k + 1]), cvt_pk_bf16(p1[8 * k + 2], p1[8 * k + 3]), cvt_pk_bf16(p1[8 * k + 4], p1[8 * k + 5]), cvt_pk_bf16(p1[8 * k + 6], p1[8 * k + 7])}; }
    const int vb = (int)vslot + ((lane >> 4) & 1) * 32 + (lane & 3) * 8 + (4 * hi + ((lane & 15) >> 2)) * 64;
#pragma unroll
    for (int d0 = 0; d0 < 2; ++d0) { s16x4 lo[4], hh[4];
#pragma unroll
        for (int ks = 0; ks < 4; ++ks) {
            asm volatile("ds_read_b64_tr_b16 %0,%1 offset:%c2" : "=&v"(lo[ks]) : "v"(vb), "i"(d0 * 4096 + ks * 1024) : "memory");
            asm volatile("ds_read_b64_tr_b16 %0,%1 offset:%c2" : "=&v"(hh[ks]) : "v"(vb), "i"(d0 * 4096 + ks * 1024 + 512) : "memory"); }
        asm volatile("s_waitcnt lgkmcnt(0)" ::: "memory"); SBAR();
#pragma unroll
        for (int ks = 0; ks < 4; ++ks) { const bf16x8 vf = (bf16x8){lo[ks][0], lo[ks][1], lo[ks][2], lo[ks][3], hh[ks][0], hh[ks][1], hh[ks][2], hh[ks][3]};
            st.o[d0] = __builtin_amdgcn_mfma_f32_32x32x16_bf16(__builtin_bit_cast(bf16x8, pw[ks]), vf, st.o[d0], 0, 0, 0); }
    }
}

__device__ __forceinline__ void prompt_unit(int b, int h, int qg, const bf16_t* Q, const bf16_t* Kg, const bf16_t* Vg, bf16_t* O, LAS unsigned char* lds, const int tid0) {
    int tid = tid0; asm volatile("" : "+v"(tid));
    const int lane = tid & 63, r32 = lane & 31, hi = lane >> 5; const int wid = __builtin_amdgcn_readfirstlane(tid >> 6);
    const int c0 = 4 * qg, pj = wid >> 1, half = wid & 1; const long rowbase = (long)b * SEQ;
    const unsigned lds0 = (unsigned)(uintptr_t)lds;
    const LAS float* tab = (const LAS float*)(lds + L_BIAS); LAS float* wsf = (LAS float*)(lds + L_WSF) + wid * 64;
    const bf16_t* Qw = Q + (rowbase + 64 * (c0 + pj) + 32 * half) * D + h * HD;
    const bf16_t* Kh = Kg + rowbase * D + h * HD; const bf16_t* Vh = Vg + rowbase * D + h * HD;
#define DMA_T(i) do { int ck_ = c0 - 8 + (i); ck_ = ck_ < 0 ? 0 : ck_; const unsigned so_ = (unsigned)(((i) % NS) * SLOTB + wid * 1024); \
        glds16(Kh + (long)(64 * ck_ + lane) * D + wid * 8, (unsigned)__builtin_amdgcn_readfirstlane(lds0 + L_K + so_)); \
        glds16(Vh + (long)(64 * ck_ + 16 * (wid & 3) + (lane >> 2)) * D + (wid >> 2) * 32 + (lane & 3) * 8, (unsigned)__builtin_amdgcn_readfirstlane(lds0 + L_V + so_)); } while (0)
    DMA_T(0); DMA_T(1); DMA_T(2); DMA_T(3); DMA_T(4);
    bf16x8 qr[4];
#pragma unroll
    for (int d0 = 0; d0 < 4; ++d0) qr[d0] = *(const bf16x8*)(Qw + (long)r32 * D + d0 * 16 + hi * 8);
    State st; st.m = -1e30f; st.l = 0.f;
#pragma unroll
    for (int r = 0; r < 16; ++r) { st.o[0][r] = 0.f; st.o[1][r] = 0.f; }
    const float cfar = tab[63];
    const int ql = 32 * half + r32;
    for (int s = 0; s < 9; ++s) {
        if (s == 0) { WAIT_BAR(0); asm volatile("" : "+v"(qr[0]), "+v"(qr[1]), "+v"(qr[2]), "+v"(qr[3])); }
        else if (s < 8) WAIT_BAR(2); else WAIT_BAR(0);
        if (s + 5 < 12) DMA_T(s + 5);
        const int ck = c0 - 8 + s + pj;
        if (ck >= 0) { const int sl = (s + pj) % NS; const bool near = s >= 6;
            tile(st, qr, lds0 + L_K + sl * SLOTB, lds0 + L_V + sl * SLOTB, near ? 0.f : cfar, near, 64 * (8 - s) + ql + 128, false, tab, wsf, r32, hi, lane); }
    }
#undef DMA_T
    float l = xsum32(st.l);
    if (hi == 0) wsf[32 + r32] = l;
    LDS_WAIT();
    float rli[16];
#pragma unroll
    for (int r = 0; r < 16; ++r) rli[r] = __builtin_amdgcn_rcpf(wsf[32 + crow(r, hi)]);
    bf16_t* Ow = O + (rowbase + 64 * (c0 + pj) + 32 * half) * D + h * HD;
    { LAS bf16_t* stg = (LAS bf16_t*)(lds + L_OST) + wid * 2048;
#pragma unroll
        for (int r = 0; r < 16; ++r) { const int orow = crow(r, hi);
#pragma unroll
            for (int d0 = 0; d0 < 2; ++d0) stg[orow * 64 + d0 * 32 + r32] = (bf16_t)(cvt_pk_bf16(st.o[d0][r] * rli[r], 0.f) & 0xffffu); }
        LDS_WAIT();
#pragma unroll
        for (int i = 0; i < 4; ++i) { const int row = i * 8 + (lane >> 3), ch = lane & 7; const u32x4 v = *(const LAS u32x4*)(stg + row * 64 + ch * 8); *(u32x4*)(Ow + (long)row * D + ch * 8) = v; } }
    asm volatile("s_waitcnt lgkmcnt(0)\n\ts_barrier" ::: "memory");
}

typedef const LAS char* lds_cptr;
typedef short v4i16_t __attribute__((ext_vector_type(4)));
__device__ __forceinline__ void kload8(bf16x8* kf, lds_cptr kp) {
    kf[0] = *(const LAS bf16x8*)(kp);        kf[1] = *(const LAS bf16x8*)(kp + 512);
    kf[2] = *(const LAS bf16x8*)(kp + 2048); kf[3] = *(const LAS bf16x8*)(kp + 2560);
    kf[4] = *(const LAS bf16x8*)(kp + 4096); kf[5] = *(const LAS bf16x8*)(kp + 4608);
    kf[6] = *(const LAS bf16x8*)(kp + 6144); kf[7] = *(const LAS bf16x8*)(kp + 6656);
}
__device__ __forceinline__ void kload2(bf16x8* kf, lds_cptr kp, int j) { kf[2 * j] = *(const LAS bf16x8*)(kp + j * 2048); kf[2 * j + 1] = *(const LAS bf16x8*)(kp + j * 2048 + 512); }
__device__ __forceinline__ s16x4 vtr(lds_cptr p) { return __builtin_bit_cast(s16x4, __builtin_amdgcn_ds_read_tr16_b64_v4i16((LAS v4i16_t*)p)); }
__device__ __forceinline__ float max3f(float a, float b, float c) { float r; asm("v_max3_f32 %0, %1, %2, %3" : "=v"(r) : "v"(a), "v"(b), "v"(c)); return r; }
__device__ __forceinline__ float max2f(float a, float b) { float r; asm("v_max_f32_e32 %0, %1, %2" : "=v"(r) : "v"(a), "v"(b)); return r; }
__device__ __forceinline__ float fadd_s(float a, float b) { float r; asm("v_add_f32_e32 %0, %1, %2" : "=v"(r) : "v"(a), "v"(b)); return r; }
__device__ __forceinline__ float fsub_s(float a, float b) { float r; asm("v_sub_f32_e32 %0, %1, %2" : "=v"(r) : "v"(a), "v"(b)); return r; }
typedef float f32x2_t __attribute__((ext_vector_type(2))); typedef __bf16 bf16x2_t __attribute__((ext_vector_type(2)));
__device__ __forceinline__ unsigned cvtpk_s(float lo, float hi) { f32x2_t v = {lo, hi}; bf16x2_t b = __builtin_convertvector(v, bf16x2_t); return __builtin_bit_cast(unsigned, b); }
#define WAIT_BAR2(N) asm volatile("s_waitcnt vmcnt(" #N ") lgkmcnt(0)\n\ts_barrier" ::: "memory")

template <int THRL>
__device__ __forceinline__ void prompt_unit_fast(int b, int h, int qg, const int nun, const bf16_t* Q, const bf16_t* Kg, const bf16_t* Vg, bf16_t* O, LAS unsigned char* lds, const int tid) {
    const int wid = __builtin_amdgcn_readfirstlane(tid >> 6);
    const int c0 = 4 * qg, pj = wid >> 1, half = wid & 1; const long rowbase = (long)b * SEQ;
    const unsigned lds0 = (unsigned)(uintptr_t)lds;
    const LAS float* tab = (const LAS float*)(lds + L_BIAS); const LAS float* tab2 = (const LAS float*)(lds + L_BIAS2);
    const bf16_t* Qw = Q + (rowbase + 64 * (c0 + pj) + 32 * half) * D + h * HD;
    const bf16_t* Kh = Kg + (rowbase + 64 * (c0 - 8)) * D + h * HD; const bf16_t* Vh = Vg + (rowbase + 64 * (c0 - 8)) * D + h * HD;
#define SLOT(i) ((unsigned)(((i) % NS) * SLOTB))
#define DMA_K(i) glds16(ksrc + uo + (long)(i) * 64 * D, (unsigned)__builtin_amdgcn_readfirstlane(lds0 + L_K + SLOT(i) + wid * 1024))
#define DMA_V(i) glds16(vsrc + uo + (long)(i) * 64 * D, (unsigned)__builtin_amdgcn_readfirstlane(lds0 + L_V + SLOT(i) + wid * 1024))
#define DMA_KN(i) glds16(ksrc + uo + (long)((i) + 4) * 64 * D, (unsigned)__builtin_amdgcn_readfirstlane(lds0 + L_K + SLOT(i) + wid * 1024))
#define DMA_VN(i) glds16(vsrc + uo + (long)((i) + 4) * 64 * D, (unsigned)__builtin_amdgcn_readfirstlane(lds0 + L_V + SLOT(i) + wid * 1024))
    bf16x8 qr[4];
    const float cfar = tab[63];
#pragma unroll 1
  for (int un = 0; un < nun; ++un) {
    const bool more = un + 1 < nun; const long uo = (long)un * 256 * D;
    int tl_ = tid; asm volatile("" : "+v"(tl_));
    const int lane = tl_ & 63, r32 = lane & 31, hi = lane >> 5;
    LAS float* wsf = (LAS float*)(lds + L_WSF) + wid * 64;
    const bf16_t* ksrc = Kh + (long)lane * D + wid * 8;
    const bf16_t* vsrc = Vh + (long)(16 * (wid & 3) + (lane >> 2)) * D + (wid >> 2) * 32 + (lane & 3) * 8;
    const lds_cptr kp0 = (lds_cptr)lds + L_K + hi * 1024 + r32 * 16;
    const lds_cptr vp0 = (lds_cptr)lds + L_V + ((lane >> 4) & 1) * 32 + (lane & 3) * 8 + (4 * hi + ((lane & 15) >> 2)) * 64;
    const int ql = 32 * half + r32;
    if (un == 0) { DMA_K(0); DMA_K(1); DMA_K(2); DMA_K(3); DMA_K(4); DMA_K(5); DMA_V(0); DMA_V(1); DMA_V(2); DMA_V(3);
#pragma unroll
        for (int d0 = 0; d0 < 4; ++d0) qr[d0] = *(const bf16x8*)(Qw + (long)r32 * D + d0 * 16 + hi * 8); }
    float mhat = 0.f, l_reg = 0.f; f32x16 o[2];
#pragma unroll
    for (int r = 0; r < 16; ++r) { o[0][r] = 0.f; o[1][r] = 0.f; }
    f32x16 negm;
#pragma unroll
    for (int r = 0; r < 16; ++r) negm[r] = cfar;
    asm volatile("" : "+v"(negm));
    bf16x8 kf[8];
    if (un == 0) WAIT_BAR2(0); else WAIT_BAR2(3);
    asm volatile("" : "+v"(qr[0]), "+v"(qr[1]), "+v"(qr[2]), "+v"(qr[3]));
    kload8(kf, kp0 + SLOT(pj));
    if (un == 0) WAIT_BAR2(0); else WAIT_BAR2(3);
    bool resc = false;
    f32x16 pA0, pA1, pB0, pB1;
    s16x4 vlo[8], vhi[8]; u32x4 pw0, pw1, pw2, pw3;
#define PKW(P, B) cvtpk_s(P[B], P[B + 1])
#define PAF(k) __builtin_bit_cast(bf16x8, pw##k)
#define VFR(i) (bf16x8){vlo[i][0], vlo[i][1], vlo[i][2], vlo[i][3], vhi[i][0], vhi[i][1], vhi[i][2], vhi[i][3]}
#define PIN(x) asm volatile("" : "+v"(x))
#define MX3(a, b, c) __builtin_fmaxf(__builtin_fmaxf((a), (b)), (c))
#define MF(a, b, c) __builtin_amdgcn_mfma_f32_32x32x16_bf16(a, b, c, 0, 0, 0)
#define GAPA(MFX, A0, A1, A2, A3, W0, W1, PW) do { MFX; sacc += A0; sacc += A1; sacc += A2; sacc += A3; PIN(sacc); W0; W1; PIN(PW); SBAR(); } while (0)
#define EX(v) __builtin_amdgcn_exp2f(v)
#define GAPB(MFX, X, B) do { MFX; X[B] = EX(X[B]); X[B + 1] = EX(X[B + 1]); X[B + 2] = EX(X[B + 2]); X[B + 3] = EX(X[B + 3]); PIN(X); SBAR(); } while (0)
#define VRD(i) do { vlo[i] = vtr(vp_ + (((i) >> 2) * 4096 + ((i) & 3) * 1024)); vhi[i] = vtr(vp_ + (((i) >> 2) * 4096 + ((i) & 3) * 1024 + 512)); } while (0)
#define KRD(GL, j) do { if (GL) { kload2(kf, kn_, j); SBAR(); } } while (0)
#define NEARB(C0, C1, s) do { if ((s) >= 6) { const LAS float* tb_ = tab2 + (319 - (64 * (8 - (s)) + ql + 128)) + 4 * hi; \
        _Pragma("unroll") for (int r = 0; r < 16; ++r) { C0[r] += tb_[(r & 3) + 8 * (r >> 2)]; C1[r] += tb_[32 + (r & 3) + 8 * (r >> 2)]; } } } while (0)
#define DECIDE(C0, C1) do { float a_ = MX3(C0[0], C0[1], C1[0]), b_ = MX3(C0[2], C0[3], C1[1]); a_ = MX3(a_, C1[2], C1[3]); \
        _Pragma("unroll") for (int r = 4; r < 16; r += 4) { a_ = MX3(a_, C0[r], C0[r + 1]); b_ = MX3(b_, C0[r + 2], C0[r + 3]); a_ = MX3(a_, C1[r], C1[r + 1]); b_ = MX3(b_, C1[r + 2], C1[r + 3]); } \
        float rm_ = __builtin_fmaxf(a_, b_); rm_ = xmax32(rm_); \
        resc = false; \
        if (__builtin_expect(__any(rm_ > (float)THRL), 0)) { const float dl_ = __builtin_fmaxf(rm_, 0.f); mhat += dl_; \
            _Pragma("unroll") for (int r = 0; r < 16; ++r) { C0[r] -= dl_; C1[r] -= dl_; } \
            _Pragma("unroll") for (int r = 0; r < 16; ++r) negm[r] = cfar - mhat; asm volatile("" : "+v"(negm)); \
            const float f_ = __builtin_amdgcn_exp2f(-dl_); l_reg *= f_; if (hi == 0) wsf[r32] = f_; resc = true; } } while (0)
#define RESC() do { if (resc) { asm volatile("s_waitcnt lgkmcnt(0)" ::: "memory"); \
        _Pragma("unroll") for (int g_ = 0; g_ < 4; ++g_) { const f32x4 fv_ = *(const LAS f32x4*)(wsf + 8 * g_ + 4 * hi); \
            _Pragma("unroll") for (int e_ = 0; e_ < 4; ++e_) { o[0][4 * g_ + e_] *= fv_[e_]; o[1][4 * g_ + e_] *= fv_[e_]; } } } } while (0)
#define STEP(C0, C1, P0, P1, t, GK, GV, GL) do { SBAR(); \
        const lds_cptr vp_ = vp0 + SLOT((t) - 1 + pj); const lds_cptr kn_ = kp0 + SLOT((t) + 1 + pj); \
        VRD(0); SBAR(); float sacc = (P0[0] + P0[1]); \
        GAPA(C0 = MF(kf[0], qr[0], negm), P0[2], P0[3], P0[4], P0[5],     pw0[0] = PKW(P0, 0), pw0[1] = PKW(P0, 2), pw0); \
        VRD(4); SBAR(); GAPA(C1 = MF(kf[1], qr[0], negm), P0[6], P0[7], P0[8], P0[9],     pw0[2] = PKW(P0, 4), pw0[3] = PKW(P0, 6), pw0); \
        VRD(1); SBAR(); GAPA(C0 = MF(kf[2], qr[1], C0),   P0[10], P0[11], P0[12], P0[13], pw1[0] = PKW(P0, 8), pw1[1] = PKW(P0, 10), pw1); \
        VRD(5); SBAR(); GAPA(C1 = MF(kf[3], qr[1], C1),   P0[14], P0[15], P1[0], P1[1],   pw1[2] = PKW(P0, 12), pw1[3] = PKW(P0, 14), pw1); \
        VRD(2); SBAR(); GAPA(C0 = MF(kf[4], qr[2], C0),   P1[2], P1[3], P1[4], P1[5],     pw2[0] = PKW(P1, 0), pw2[1] = PKW(P1, 2), pw2); \
        VRD(6); SBAR(); GAPA(C1 = MF(kf[5], qr[2], C1),   P1[6], P1[7], P1[8], P1[9],     pw2[2] = PKW(P1, 4), pw2[3] = PKW(P1, 6), pw2); \
        VRD(3); SBAR(); GAPA(C0 = MF(kf[6], qr[3], C0),   P1[10], P1[11], P1[12], P1[13], pw3[0] = PKW(P1, 8), pw3[1] = PKW(P1, 10), pw3); \
        VRD(7); SBAR(); GAPA(C1 = MF(kf[7], qr[3], C1),   P1[14], P1[15], 0.f, 0.f,       pw3[2] = PKW(P1, 12), pw3[3] = PKW(P1, 14), pw3); \
        l_reg += sacc; \
        if (GK) { DMA_K((t) + 6); } if (GV) { DMA_V((t) + 4); } \
        NEARB(C0, C1, t); \
        DECIDE(C0, C1); \
        SBAR(); \
        GAPB(o[0] = MF(PAF(0), VFR(0), o[0]), C0, 0); \
        GAPB(o[1] = MF(PAF(0), VFR(4), o[1]), C0, 4); \
        KRD(GL, 0); GAPB(o[0] = MF(PAF(1), VFR(1), o[0]), C0, 8); \
        KRD(GL, 1); GAPB(o[1] = MF(PAF(1), VFR(5), o[1]), C0, 12); \
        KRD(GL, 2); GAPB(o[0] = MF(PAF(2), VFR(2), o[0]), C1, 0); \
        KRD(GL, 3); GAPB(o[1] = MF(PAF(2), VFR(6), o[1]), C1, 4); \
        GAPB(o[0] = MF(PAF(3), VFR(3), o[0]), C1, 8); \
        GAPB(o[1] = MF(PAF(3), VFR(7), o[1]), C1, 12); \
    } while (0)
    DMA_K(6); DMA_V(4);
    {
#pragma unroll
        for (int d0 = 0; d0 < 4; ++d0) {
            if (d0 == 0) { pA0 = MF(kf[0], qr[0], negm); pA1 = MF(kf[1], qr[0], negm); }
            else { pA0 = MF(kf[2 * d0], qr[d0], pA0); pA1 = MF(kf[2 * d0 + 1], qr[d0], pA1); } }
        float rm = fmaxf(pA0[0], pA1[0]);
#pragma unroll
        for (int r = 1; r < 16; ++r) rm = fmaxf(rm, fmaxf(pA0[r], pA1[r]));
        rm = xmax32(rm);
        mhat = rm;
#pragma unroll
        for (int r = 0; r < 16; ++r) { pA0[r] = __builtin_amdgcn_exp2f(pA0[r] - rm); pA1[r] = __builtin_amdgcn_exp2f(pA1[r] - rm); }
#pragma unroll
        for (int r = 0; r < 16; ++r) negm[r] = cfar - mhat;
        asm volatile("" : "+v"(negm));
    }
    kload8(kf, kp0 + SLOT(1 + pj));
    WAIT_BAR2(2);
    STEP(pB0, pB1, pA0, pA1, 1, true, true, true);   WAIT_BAR2(2); RESC();
    STEP(pA0, pA1, pB0, pB1, 2, true, true, true);   WAIT_BAR2(2); RESC();
    STEP(pB0, pB1, pA0, pA1, 3, true, true, true);   WAIT_BAR2(2); RESC();
    STEP(pA0, pA1, pB0, pB1, 4, true, true, true);   WAIT_BAR2(2); RESC();
    STEP(pB0, pB1, pA0, pA1, 5, true, true, true);   WAIT_BAR2(2); RESC();
    STEP(pA0, pA1, pB0, pB1, 6, false, true, true);  WAIT_BAR2(1); RESC();
    STEP(pB0, pB1, pA0, pA1, 7, false, true, true);  WAIT_BAR2(1); RESC();
    if (more) { DMA_KN(0); DMA_KN(1); DMA_KN(2); DMA_KN(3); DMA_KN(4); DMA_KN(5); DMA_VN(0); }
    STEP(pA0, pA1, pB0, pB1, 8, false, false, false); WAIT_BAR2(0); RESC();
    if (more) {
#pragma unroll
        for (int d0 = 0; d0 < 4; ++d0) qr[d0] = *(const bf16x8*)(Qw + uo + (long)(256 + r32) * D + d0 * 16 + hi * 8); }
    { float sacc = pA0[0] + pA0[1];
#pragma unroll
        for (int r = 2; r < 16; ++r) sacc += pA0[r];
#pragma unroll
        for (int r = 0; r < 16; ++r) sacc += pA1[r];
        l_reg += sacc;
        pw0 = (u32x4){PKW(pA0, 0), PKW(pA0, 2), PKW(pA0, 4), PKW(pA0, 6)}; pw1 = (u32x4){PKW(pA0, 8), PKW(pA0, 10), PKW(pA0, 12), PKW(pA0, 14)};
        pw2 = (u32x4){PKW(pA1, 0), PKW(pA1, 2), PKW(pA1, 4), PKW(pA1, 6)}; pw3 = (u32x4){PKW(pA1, 8), PKW(pA1, 10), PKW(pA1, 12), PKW(pA1, 14)};
        SBAR();
        const int vb = (int)(lds0 + L_V + SLOT(8 + pj)) + ((lane >> 4) & 1) * 32 + (lane & 3) * 8 + (4 * hi + ((lane & 15) >> 2)) * 64;
#pragma unroll
        for (int d0 = 0; d0 < 2; ++d0) { s16x4 lo[4], hh[4];
#pragma unroll
            for (int ks = 0; ks < 4; ++ks) {
                asm volatile("ds_read_b64_tr_b16 %0,%1 offset:%c2" : "=&v"(lo[ks]) : "v"(vb), "i"(d0 * 4096 + ks * 1024) : "memory");
                asm volatile("ds_read_b64_tr_b16 %0,%1 offset:%c2" : "=&v"(hh[ks]) : "v"(vb), "i"(d0 * 4096 + ks * 1024 + 512) : "memory"); }
            asm volatile("s_waitcnt lgkmcnt(0)" ::: "memory"); SBAR();
            o[d0] = MF(PAF(0), ((bf16x8){lo[0][0], lo[0][1], lo[0][2], lo[0][3], hh[0][0], hh[0][1], hh[0][2], hh[0][3]}), o[d0]);
            o[d0] = MF(PAF(1), ((bf16x8){lo[1][0], lo[1][1], lo[1][2], lo[1][3], hh[1][0], hh[1][1], hh[1][2], hh[1][3]}), o[d0]);
            o[d0] = MF(PAF(2), ((bf16x8){lo[2][0], lo[2][1], lo[2][2], lo[2][3], hh[2][0], hh[2][1], hh[2][2], hh[2][3]}), o[d0]);
            o[d0] = MF(PAF(3), ((bf16x8){lo[3][0], lo[3][1], lo[3][2], lo[3][3], hh[3][0], hh[3][1], hh[3][2], hh[3][3]}), o[d0]); } }
    { float l = xsum32(l_reg);
        if (hi == 0) wsf[32 + r32] = l;
        LDS_WAIT();
        float rli[16];
#pragma unroll
        for (int r = 0; r < 16; ++r) rli[r] = __builtin_amdgcn_rcpf(wsf[32 + crow(r, hi)]);
        bf16_t* Ow = O + uo + (rowbase + 64 * (c0 + pj) + 32 * half) * D + h * HD;
        LAS bf16_t* stg = (LAS bf16_t*)(lds + L_OST) + wid * 2048;
#pragma unroll
        for (int r = 0; r < 16; ++r) { const int orow = crow(r, hi);
#pragma unroll
            for (int d0 = 0; d0 < 2; ++d0) stg[orow * 64 + d0 * 32 + r32] = (bf16_t)(cvt_pk_bf16(o[d0][r] * rli[r], 0.f) & 0xffffu); }
        LDS_WAIT();
#pragma unroll
        for (int i = 0; i < 4; ++i) { const int row = i * 8 + (lane >> 3), ch = lane & 7; const u32x4 v = *(const LAS u32x4*)(stg + row * 64 + ch * 8); *(u32x4*)(Ow + (long)row * D + ch * 8) = v; } }
    asm volatile("s_waitcnt lgkmcnt(0)\n\ts_barrier" ::: "memory");
    if (more) { DMA_VN(1); DMA_VN(2); DMA_VN(3); }
  }
#undef SLOT
#undef DMA_K
#undef DMA_V
#undef DMA_KN
#undef DMA_VN
#undef PKW
#undef PAF
#undef VFR
#undef PIN
#undef MX3
#undef MF
#undef GAPA
#undef EX
#undef GAPB
#undef VRD
#undef KRD
#undef NEARB
#undef DECIDE
#undef RESC
#undef STEP
}
#undef WAIT_BAR2

__device__ __forceinline__ void sample_unit(int b, int h, const bf16_t* Q, const bf16_t* Kg, const bf16_t* Vg, const float* CKf, const float* CVf, bf16_t* O, LAS unsigned char* lds, const int tid0) {
    int tid = tid0; asm volatile("" : "+v"(tid));
    const int lane = tid & 63, r32 = lane & 31, hi = lane >> 5; const int wid = __builtin_amdgcn_readfirstlane(tid >> 6);
    const unsigned lds0 = (unsigned)(uintptr_t)lds;
    const LAS float* tab = (const LAS float*)(lds + L_BIAS); LAS float* wsf = (LAS float*)(lds + L_WSF) + wid * 64;
    const long srow = (long)MP + 32 * b;
    const bf16_t* Qw = Q + srow * D + h * HD;
    const unsigned ks = lds0 + wid * 16384, vs = ks + 8192;
    const unsigned ks9 = lds0 + 136192;
    if (wid == 0) {
        const bf16_t* Kn = Kg + srow * D + h * HD; const bf16_t* Vn = Vg + srow * D + h * HD;
#pragma unroll
        for (int p = 0; p < 8; ++p) { const int kr = lane < 32 ? lane : 31; const int vr0 = 16 * (p & 3) + (lane >> 2), vr = vr0 < 32 ? vr0 : 31;
            glds16(Kn + (long)kr * D + p * 8, (unsigned)__builtin_amdgcn_readfirstlane(ks9 + p * 1024));
            glds16(Vn + (long)vr * D + (p >> 2) * 32 + (lane & 3) * 8, (unsigned)__builtin_amdgcn_readfirstlane(ks9 + 8192 + p * 1024)); } }
    { const float* Kc = CKf + ((long)b * CA + 64 * wid) * D + h * HD; const float* Vc = CVf + ((long)b * CA + 64 * wid) * D + h * HD;
        LAS unsigned char* kl = lds + wid * 16384; LAS unsigned char* vl = kl + 8192;
        f32x4 t0[8], t1[8], u0[8], u1[8];
#pragma unroll
        for (int p = 0; p < 8; ++p) { const float* src = Kc + (long)lane * D + p * 8; t0[p] = *(const f32x4*)src; t1[p] = *(const f32x4*)(src + 4); }
#pragma unroll
        for (int p = 0; p < 8; ++p) { const float* src = Vc + (long)(16 * (p & 3) + (lane >> 2)) * D + (p >> 2) * 32 + (lane & 3) * 8; u0[p] = *(const f32x4*)src; u1[p] = *(const f32x4*)(src + 4); }
#pragma unroll
        for (int p = 0; p < 8; ++p) { u32x4 w; w.x = cvt_pk_bf16(t0[p][0], t0[p][1]); w.y = cvt_pk_bf16(t0[p][2], t0[p][3]); w.z = cvt_pk_bf16(t1[p][0], t1[p][1]); w.w = cvt_pk_bf16(t1[p][2], t1[p][3]);
            *(LAS u32x4*)(kl + p * 1024 + lane * 16) = w; }
#pragma unroll
        for (int p = 0; p < 8; ++p) { u32x4 w; w.x = cvt_pk_bf16(u0[p][0], u0[p][1]); w.y = cvt_pk_bf16(u0[p][2], u0[p][3]); w.z = cvt_pk_bf16(u1[p][0], u1[p][1]); w.w = cvt_pk_bf16(u1[p][2], u1[p][3]);
            *(LAS u32x4*)(vl + p * 1024 + lane * 16) = w; } }
    bf16x8 qr[4];
#pragma unroll
    for (int d0 = 0; d0 < 4; ++d0) qr[d0] = *(const bf16x8*)(Qw + (long)r32 * D + d0 * 16 + hi * 8);
    State st; st.m = -1e30f; st.l = 0.f;
#pragma unroll
    for (int r = 0; r < 16; ++r) { st.o[0][r] = 0.f; st.o[1][r] = 0.f; }
    asm volatile("s_waitcnt vmcnt(0) lgkmcnt(0)" ::: "memory"); asm volatile("" : "+v"(qr[0]), "+v"(qr[1]), "+v"(qr[2]), "+v"(qr[3]));
    { const bool near = wid >= 6; tile(st, qr, ks, vs, near ? 0.f : tab[63], near, r32 + 512 - 64 * wid + 128, false, tab, wsf, r32, hi, lane); }
    if (wid == 0) tile(st, qr, ks9, ks9 + 8192, 0.f, true, r32 + 128, true, tab, wsf, r32, hi, lane);
    const float l = xsum32(st.l);
    asm volatile("s_waitcnt lgkmcnt(0)\n\ts_barrier" ::: "memory");
    LAS float* OP = (LAS float*)lds;
    LAS float* MLp = (LAS float*)(lds + 65536);
#pragma unroll
    for (int r = 0; r < 16; ++r) { const int q = crow(r, hi); OP[(wid * 32 + q) * 64 + r32] = st.o[0][r]; OP[(wid * 32 + q) * 64 + 32 + r32] = st.o[1][r]; }
    if (hi == 0) { MLp[wid * 32 + r32] = st.m; MLp[256 + wid * 32 + r32] = l; }
    __syncthreads();
    { const int q = tid >> 4, d4 = (tid & 15) * 4; float mg = -1e30f;
#pragma unroll
        for (int w = 0; w < 8; ++w) mg = fmaxf(mg, MLp[w * 32 + q]);
        f32x4 num = (f32x4){0.f, 0.f, 0.f, 0.f}; float den = 0.f;
#pragma unroll
        for (int w = 0; w < 8; ++w) { const float f = __builtin_amdgcn_exp2f(MLp[w * 32 + q] - mg); den += f * MLp[256 + w * 32 + q]; num += *(const LAS f32x4*)(OP + (w * 32 + q) * 64 + d4) * f; }
        const float rd = 1.0f / den; u32x2 w2; w2.x = cvt_pk_bf16(num[0] * rd, num[1] * rd); w2.y = cvt_pk_bf16(num[2] * rd, num[3] * rd);
        *(u32x2*)(O + (srow + q) * D + h * HD + d4) = w2; }
    __syncthreads();
}
#undef WAIT_BAR
}

namespace gate {
constexpr int L_VS = 0, L_STG = 32768, L_RV = 98304;
__device__ __forceinline__ void unit(bool sample, int nb, int gp, const bf16_t* U, bf16_t* Og, const bf16_t* Vv, const float* ssqv, const float* ssqvs, const float* vgain, const bf16_t* wsb, const float* bsp, float* ogv, LAS unsigned char* lds, const int tid) {
    const int lane = tid & 63, r32 = lane & 31, hi = lane >> 5; const int wid = __builtin_amdgcn_readfirstlane(tid >> 6);
    const long tok0 = sample ? (long)MP + 32 * nb : (long)128 * nb; const int nrows = sample ? 32 : 128;
    const int gi = wid >> 2, pb = wid & 3, g = 2 * gp + gi; const bool act = pb * 32 < nrows; const int nks = sample ? 2 : (pb < 2 ? 4 : 8);
    bf16x8 pa[8]; f32x4 bq[4]; u32x4 uu[4];
    if (act) { const bf16x8* wp = (const bf16x8*)wsb + ((size_t)(g * 128 + 32 * pb + r32) * 8) * 2 + hi;
#pragma unroll
        for (int ks = 0; ks < 8; ++ks) pa[ks] = wp[ks * 2];
#pragma unroll
        for (int gq = 0; gq < 4; ++gq) bq[gq] = *(const f32x4*)(bsp + g * 128 + 32 * pb + 8 * gq + 4 * hi);
#pragma unroll
        for (int i = 0; i < 4; ++i) uu[i] = *(const u32x4*)(U + (size_t)(tok0 + 32 * pb + i * 8 + (lane >> 3)) * D + 64 * g + (lane & 7) * 8); }
    LAS float* rv = (LAS float*)(lds + L_RV);
    if (!sample) { if (tid < 128) { const long t = tok0 + tid; const float s = (ssqv[t] + ssqv[MT + t]) + (ssqv[2 * MT + t] + ssqv[3 * MT + t]); rv[tid] = 1.0f / sqrtf(s * (1.0f / D) + EPS); } }
    else { const int row = tid >> 4, jj = tid & 15; float s = ssqvs[(size_t)jj * MS + nb * 32 + row] + ssqvs[(size_t)(jj + 16) * MS + nb * 32 + row];
        s = sum16(s); if (jj == 0) rv[row] = 1.0f / sqrtf(s * (1.0f / D) + EPS); }
    u32x4 raw[4]; f32x4 g0[4], g1[4];
#pragma unroll
    for (int i = 0; i < 4; ++i) { const int pi = wid + 8 * i, gi2 = pi >> 4, qt = (pi >> 3) & 1, dh = (pi >> 2) & 1, rg = pi & 3;
        const int row = 64 * qt + 16 * rg + (lane >> 2), col = 64 * (2 * gp + gi2) + 32 * dh + 8 * (lane & 3);
        const int rowc = row < nrows ? row : nrows - 1;
        raw[i] = *(const u32x4*)(Vv + (tok0 + rowc) * D + col); g0[i] = *(const f32x4*)(vgain + col); g1[i] = *(const f32x4*)(vgain + col + 4); }
    __syncthreads();
#pragma unroll
    for (int i = 0; i < 4; ++i) { const int pi = wid + 8 * i, gi2 = pi >> 4, qt = (pi >> 3) & 1, dh = (pi >> 2) & 1, rg = pi & 3;
        const int row = 64 * qt + 16 * rg + (lane >> 2), col = 64 * (2 * gp + gi2) + 32 * dh + 8 * (lane & 3);
        if (row < nrows) { const float rs = rv[row]; const u32x4 rw = raw[i];
            float f[8]; f[0] = bf2f(rw.x & 0xffffu) * rs * g0[i][0]; f[1] = bf2f(rw.x >> 16) * rs * g0[i][1]; f[2] = bf2f(rw.y & 0xffffu) * rs * g0[i][2]; f[3] = bf2f(rw.y >> 16) * rs * g0[i][3];
            f[4] = bf2f(rw.z & 0xffffu) * rs * g1[i][0]; f[5] = bf2f(rw.z >> 16) * rs * g1[i][1]; f[6] = bf2f(rw.w & 0xffffu) * rs * g1[i][2]; f[7] = bf2f(rw.w >> 16) * rs * g1[i][3];
            u32x4 w; w.x = cvt_pk_bf16(f[0], f[1]); w.y = cvt_pk_bf16(f[2], f[3]); w.z = cvt_pk_bf16(f[4], f[5]); w.w = cvt_pk_bf16(f[6], f[7]);
            *(LAS u32x4*)(lds + L_VS + (gi2 * 2 + qt) * 8192 + (dh * 4 + rg) * 1024 + lane * 16) = w;
            if (sample) { float* o = ogv + (size_t)(nb * 32 + row) * D + col; *(f32x4*)o = (f32x4){f[0], f[1], f[2], f[3]}; *(f32x4*)(o + 4) = (f32x4){f[4], f[5], f[6], f[7]}; } } }
    __syncthreads();
    if (act) {
        f32x16 o[2];
#pragma unroll
        for (int r = 0; r < 16; ++r) { o[0][r] = 0.f; o[1][r] = 0.f; }
        const unsigned lds0 = (unsigned)(uintptr_t)lds;
#pragma unroll
        for (int ks = 0; ks < 8; ++ks) if (ks < nks) {
            const int vb = (int)(lds0 + L_VS + (gi * 2 + (ks >> 2)) * 8192 + (ks & 3) * 1024) + ((lane >> 4) & 1) * 32 + (lane & 3) * 8 + (4 * hi + ((lane & 15) >> 2)) * 64;
            s16x4 lo[2], hh[2];
#pragma unroll
            for (int d0 = 0; d0 < 2; ++d0) {
                asm volatile("ds_read_b64_tr_b16 %0,%1 offset:%c2" : "=&v"(lo[d0]) : "v"(vb), "i"(d0 * 4096) : "memory");
                asm volatile("ds_read_b64_tr_b16 %0,%1 offset:%c2" : "=&v"(hh[d0]) : "v"(vb), "i"(d0 * 4096 + 512) : "memory"); }
            asm volatile("s_waitcnt lgkmcnt(0)" ::: "memory"); __builtin_amdgcn_sched_barrier(0);
#pragma unroll
            for (int d0 = 0; d0 < 2; ++d0) { const bf16x8 vf = (bf16x8){lo[d0][0], lo[d0][1], lo[d0][2], lo[d0][3], hh[d0][0], hh[d0][1], hh[d0][2], hh[d0][3]};
                o[d0] = __builtin_amdgcn_mfma_f32_32x32x16_bf16(pa[ks], vf, o[d0], 0, 0, 0); }
        }
        LAS float* stg = (LAS float*)(lds + L_STG) + wid * 2048;
#pragma unroll
        for (int r = 0; r < 16; ++r) { const int q = crow(r, hi); const float b_ = bq[r >> 2][r & 3]; stg[q * 64 + r32] = o[0][r] + b_; stg[q * 64 + 32 + r32] = o[1][r] + b_; }
        LDS_WAIT();
#pragma unroll
        for (int i = 0; i < 4; ++i) { const int row = i * 8 + (lane >> 3), ch = lane & 7;
            const f32x4 m0 = *(const LAS f32x4*)(stg + row * 64 + ch * 8), m1 = *(const LAS f32x4*)(stg + row * 64 + ch * 8 + 4);
            const size_t uo = (size_t)(tok0 + 32 * pb + row) * D + 64 * g + ch * 8; const u32x4 u4 = uu[i];
            u32x4 w; w.x = cvt_pk_bf16(bf2f(u4.x & 0xffffu) * m0[0], bf2f(u4.x >> 16) * m0[1]); w.y = cvt_pk_bf16(bf2f(u4.y & 0xffffu) * m0[2], bf2f(u4.y >> 16) * m0[3]);
            w.z = cvt_pk_bf16(bf2f(u4.z & 0xffffu) * m1[0], bf2f(u4.z >> 16) * m1[1]); w.w = cvt_pk_bf16(bf2f(u4.w & 0xffffu) * m1[2], bf2f(u4.w >> 16) * m1[3]);
            *(u32x4*)(Og + uo) = w; }
    }
    __syncthreads();
}
}

template <bool UP, bool GAIN>
__device__ __forceinline__ void transpose_item(const float* W, int K, int N, const float* gain, bf16_t* WT, LAS float* scr, int item, int lane) {
    const int nblk = N / 32, kb = item / nblk, nb = item % nblk, k0 = 64 * kb, n0 = 32 * nb;
    f32x4 v[8]; float gk[8];
#pragma unroll
    for (int i = 0; i < 8; ++i) { const int kk = 8 * i + (lane >> 3), n4 = (lane & 7) * 4; v[i] = *(const f32x4*)(W + (size_t)(k0 + kk) * N + n0 + n4); gk[i] = GAIN ? gain[k0 + kk] : 1.0f; }
#pragma unroll
    for (int i = 0; i < 8; ++i) { const int kk = 8 * i + (lane >> 3), n4 = (lane & 7) * 4; const f32x4 x = GAIN ? v[i] * gk[i] : v[i];
        scr[kk * 33 + n4] = x[0]; scr[kk * 33 + n4 + 1] = x[1]; scr[kk * 33 + n4 + 2] = x[2]; scr[kk * 33 + n4 + 3] = x[3]; }
    LDS_WAIT(); asm volatile("" ::: "memory");
    const int c = lane & 7;
#pragma unroll
    for (int jj = 0; jj < 4; ++jj) { const int n = (lane >> 3) + 8 * jj; const LAS float* s = scr + (8 * c) * 33 + n;
        u32x4 o; o.x = cvt_pk_bf16(s[0 * 33], s[1 * 33]); o.y = cvt_pk_bf16(s[2 * 33], s[3 * 33]); o.z = cvt_pk_bf16(s[4 * 33], s[5 * 33]); o.w = cvt_pk_bf16(s[6 * 33], s[7 * 33]);
        int dn = n0 + n; if (UP) { const int v = dn >= FF ? 1 : 0, gc = dn - v * FF; dn = 256 * (gc >> 7) + 128 * v + (gc & 127); }
        *(u32x4*)(WT + (size_t)dn * K + k0 + 8 * c) = o; }
    LDS_WAIT(); asm volatile("" ::: "memory");
}

#define XB_TMO      128
#define XB_XCNT(j)  (256  + 64 * (j))
#define XB_XSUB(j)  (1280 + 64 * (j))
#define XB_XGEN(j)  (2304 + 64 * (j))
#define XB_TOP      3328
#define XB_TOPGEN   3392
#define XCD_BAR_WORDS 3456
#define XB_SPIN_CAP (1u << 18)
__device__ __forceinline__ unsigned xb_ld(unsigned* p)              { return __hip_atomic_load(p, __ATOMIC_RELAXED, __HIP_MEMORY_SCOPE_AGENT); }
__device__ __forceinline__ unsigned xb_add(unsigned* p, unsigned v) { return __hip_atomic_fetch_add(p, v, __ATOMIC_RELAXED, __HIP_MEMORY_SCOPE_AGENT); }
__device__ __forceinline__ unsigned xb_xcc_id() { return (unsigned)__builtin_amdgcn_s_getreg((3 << 11) | 20) & 0xFu; }
#define XB_SPIN(cond, bar) do { unsigned _sp = 0; while (cond) { __builtin_amdgcn_s_sleep(1); \
    if ((++_sp & 255u) == 0u) { if (xb_ld(&(bar)[XB_TMO])) break; if (_sp > XB_SPIN_CAP) { atomicAdd(&(bar)[XB_TMO], 1u); break; } } } } while (0)
struct XcdBarrier { unsigned* bar; unsigned x; volatile LAS unsigned* st; };
__device__ __forceinline__ void xcd_barrier_complete(unsigned* bar, unsigned x, unsigned& nloc, unsigned& nx) {
    const unsigned G = gridDim.x * gridDim.y * gridDim.z;
    unsigned sum, cnt, mine, sp = 0u;
    for (;;) {
        sum = 0u; cnt = 0u; mine = 0u;
#pragma unroll
        for (unsigned j = 0; j < 16; ++j) { const unsigned c = xb_ld(&bar[XB_XCNT(j)]); sum += c; cnt += (c > 0u) ? 1u : 0u; mine = (j == x) ? c : mine; }
        if (sum == G) break;
        __builtin_amdgcn_s_sleep(1);
        if ((++sp & 255u) == 0u) { if (xb_ld(&bar[XB_TMO])) break; if (sp > XB_SPIN_CAP) { atomicAdd(&bar[XB_TMO], 1u); break; } }
    }
    nloc = mine > 0u ? mine : 1u; nx = cnt > 0u ? cnt : 1u;
}
__device__ __forceinline__ void xcd_barrier(const XcdBarrier& b, const int tid) {
    asm volatile("s_waitcnt vmcnt(0)" ::: "memory");
    __syncthreads();
    if (tid == 0) {
        unsigned* bar = b.bar;
        __builtin_amdgcn_s_waitcnt(0);
        unsigned nloc = b.st[0], nx = b.st[1];
        if (nloc == 0u) { xcd_barrier_complete(bar, b.x, nloc, nx); b.st[0] = nloc; b.st[1] = nx; }
        const unsigned old = xb_add(&bar[XB_XSUB(b.x)], 1u);
        const unsigned gen = old / nloc;
        if (old + 1u == (gen + 1u) * nloc) {
            __builtin_amdgcn_fence(__ATOMIC_RELEASE, "agent");
            asm volatile("s_waitcnt vmcnt(0)" ::: "memory");
            const unsigned og = xb_add(&bar[XB_TOP], 1u);
            const unsigned tg = og / nx;
            if (og + 1u == (tg + 1u) * nx) xb_add(&bar[XB_TOPGEN], 1u);
            else XB_SPIN(xb_ld(&bar[XB_TOPGEN]) == tg, bar);
            __builtin_amdgcn_fence(__ATOMIC_ACQUIRE, "agent");
            xb_add(&bar[XB_XGEN(b.x)], 1u);
            asm volatile("s_waitcnt vmcnt(0)" ::: "memory");
        } else {
            XB_SPIN(xb_ld(&bar[XB_XGEN(b.x)]) == gen, bar);
            __builtin_amdgcn_fence(__ATOMIC_ACQUIRE, "agent");
            asm volatile("s_waitcnt vmcnt(0)" ::: "memory");
        }
    }
    __syncthreads();
}

template <int NQ>
__device__ __forceinline__ void p0_rows(const int m0, const int lane, const float* x_prompt, const float* x_sample, bf16_t* XB, float* SSQ, float* SSQS) {
    f32x4 v[NQ][4];
#pragma unroll
    for (int q = 0; q < NQ; ++q) { const int m = m0 + q; const float* xr = m < MP ? x_prompt + (size_t)m * D : x_sample + (size_t)(m - MP) * D;
#pragma unroll
        for (int jj = 0; jj < 4; ++jj) v[q][jj] = ((const f32x4*)xr)[2 * lane + (jj & 1) + 128 * (jj >> 1)]; }
#pragma unroll
    for (int q = 0; q < NQ; ++q) { const int m = m0 + q; float s = 0.f;
#pragma unroll
        for (int jj = 0; jj < 4; ++jj) s += (v[q][jj][0] * v[q][jj][0] + v[q][jj][1] * v[q][jj][1]) + (v[q][jj][2] * v[q][jj][2] + v[q][jj][3] * v[q][jj][3]);
        s = wave_sum(s);
#pragma unroll
        for (int j2 = 0; j2 < 2; ++j2) { u32x4 w; w.x = cvt_pk_bf16(v[q][2 * j2][0], v[q][2 * j2][1]); w.y = cvt_pk_bf16(v[q][2 * j2][2], v[q][2 * j2][3]);
            w.z = cvt_pk_bf16(v[q][2 * j2 + 1][0], v[q][2 * j2 + 1][1]); w.w = cvt_pk_bf16(v[q][2 * j2 + 1][2], v[q][2 * j2 + 1][3]); ((u32x4*)(XB + (size_t)m * D))[lane + 64 * j2] = w; }
        if (m < MP) { if (lane < 4) SSQ[(size_t)lane * MT + m] = lane == 0 ? s : 0.f; }
        else { if (lane < 32) SSQS[(size_t)lane * MS + (m - MP)] = lane == 0 ? s : 0.f; } }
}

constexpr int WGM_QKV = 4, WGM_RES = 4, WGM_UP = 4, WGM_IN = 4;
#define PH(k)
struct Args { const float* in[20]; float* out; unsigned char* ws; };

__global__ void __launch_bounds__(NTHR, 2) fwd_kernel(Args a) {
    extern __shared__ __attribute__((aligned(16))) unsigned char lds_raw[];
    LAS unsigned char* lds = (LAS unsigned char*)lds_raw;
    const int wave0 = __builtin_amdgcn_readfirstlane((int)threadIdx.x >> 6);
    XcdBarrier bar;
    { volatile LAS unsigned* MISC = (volatile LAS unsigned*)(lds + L_MISC);
        if (threadIdx.x < 4) MISC[threadIdx.x] = 0u;
        __syncthreads();
        bar.bar = (unsigned*)(a.ws + WS_CTL); bar.x = xb_xcc_id(); bar.st = MISC;
        if (threadIdx.x == 0) (void)xb_add(&bar.bar[XB_XCNT(bar.x)], 1u); }
#define GRID_BAR() do { PHASE_VARS xcd_barrier(bar, tid); } while (0)
#define PHASE_VARS int tid; asm volatile("v_mbcnt_lo_u32_b32 %0, -1, 0\n\tv_mbcnt_hi_u32_b32 %0, -1, %0" : "=v"(tid)); tid |= wave0 << 6; const int lane = tid & 63, wave = wave0; (void)lane; (void)wave;
    const int G = gridDim.x, bx = blockIdx.x; const int vcu = (G % 8 == 0) ? (bx % 8) * (G / 8) + bx / 8 : bx;
    unsigned char* ws = a.ws; float* out = a.out;
    const float *x_prompt = a.in[0], *x_sample = a.in[1], *cache_k = a.in[2], *cache_v = a.in[3], *state_conv = a.in[4], *ln_mix = a.in[5], *ln_ffn = a.in[6], *ln_final = a.in[7],
                *w_qkv = a.in[8], *rel_bias = a.in[9], *w_o = a.in[10], *w_in = a.in[11], *v_norm = a.in[12], *w_s = a.in[13], *bias_s = a.in[14], *w_out = a.in[15],
                *w_up = a.in[16], *conv_w = a.in[17], *conv_b = a.in[18], *w_down = a.in[19];
    bf16_t *Wqkv_t = (bf16_t*)(ws + WS_WQKV), *Wo_t = (bf16_t*)(ws + WS_WO), *Win_t = (bf16_t*)(ws + WS_WIN), *Wout_t = (bf16_t*)(ws + WS_WOUT);
    bf16_t *XB = (bf16_t*)(ws + WS_XB), *QB = (bf16_t*)(ws + WS_Q), *KB = (bf16_t*)(ws + WS_K), *VB = (bf16_t*)(ws + WS_V), *GB = (bf16_t*)(ws + WS_G), *OB = (bf16_t*)(ws + WS_OB);
    float *SSQ = (float*)(ws + WS_SSQ), *SSQV = (float*)(ws + WS_SSQV), *SSQS = (float*)(ws + WS_SSQS), *SSQVS = (float*)(ws + WS_SSQVS);

    PH(0) { PHASE_VARS
        LAS float* scr = (LAS float*)(lds + wave * 16384);
        const int gw = vcu * NWAVES + wave, NGW = G * NWAVES;
        constexpr int I_QKV = (D / 64) * (3 * D / 32), I_O = (D / 64) * (D / 32), I_IN = (D / 64) * (2 * D / 32), I_UP = (D / 64) * (FF2 / 32), I_DN = (FF / 64) * (D / 32);
        for (int it = gw; it < I_QKV; it += NGW) transpose_item<false, true>(w_qkv, D, 3 * D, ln_mix, Wqkv_t, scr, it, lane);
        for (int m0 = gw * 4; m0 < MP; m0 += NGW * 4) p0_rows<4>(m0, lane, x_prompt, x_sample, XB, SSQ, SSQS);
        for (int m0 = MP + (NGW - 1 - gw); m0 < MT; m0 += NGW) p0_rows<1>(m0, lane, x_prompt, x_sample, XB, SSQ, SSQS);
        for (int c = (vcu * NWAVES + wave) * 64 + lane; c < 16 * 128 * 16; c += G * NTHR) { const int hi_ = c & 1, ks = (c >> 1) & 7, gp_ = c >> 4;
            const float* src = w_s + (size_t)gp_ * 128 + 16 * ks + 4 * hi_; const f32x4 a0 = *(const f32x4*)src, a1 = *(const f32x4*)(src + 8);
            u32x4 w; w.x = cvt_pk_bf16(a0[0], a0[1]); w.y = cvt_pk_bf16(a0[2], a0[3]); w.z = cvt_pk_bf16(a1[0], a1[1]); w.w = cvt_pk_bf16(a1[2], a1[3]);
            ((u32x4*)(ws + WS_WSB))[c] = w; }
    }
    GRID_BAR();

    PH(1) { PHASE_VARS
        pg8::Gemm g{XB, Wqkv_t, D}; pg8::StaticOrder S; S.init(MP / 256, 3 * D / 256, G, bx, 0, WGM_QKV);
        EpiQKV E{QB, (size_t)(WS_K - WS_Q) / 2, SSQ, out + O_KP, out + O_VP};
        typedef SampleRider<D, 96, SQkv> RQ; const RQ R{XB, Wqkv_t, SQkv{SSQS, QB, KB, VB, out + O_KS, out + O_VS}};
        pg8::gemm_phase<EpiQKV, pg8::StaticOrder, RQ>(lds, g, S, E, tid, R);
    }
    GRID_BAR();

    PH(2) { PHASE_VARS
        LAS float* tab = (LAS float*)(lds + att::L_BIAS);
        const int per = (NB * NH * 32 + G - 1) / G;
        int lasth = -1;
        const int id_end = ((vcu + 1) * per < NB * NH * 32) ? (vcu + 1) * per : NB * NH * 32;
        for (int id = vcu * per; id < id_end; ) { const int bh = id >> 5, qg = id & 31, b = bh / NH, h = bh % NH;
            if (h != lasth) { __syncthreads(); for (int i = tid; i < 320; i += NTHR) { const int j = 319 - i; const float tv = rel_bias[h * NREL + (j > 256 ? 256 : j)] * LOG2E; tab[i] = tv; ((LAS float*)(lds + att::L_BIAS2))[i] = tv - rel_bias[h * NREL + 256] * LOG2E; } __syncthreads(); lasth = h; }
            if (qg >= 2) { int nun = id_end - id; if (nun > 32 - qg) nun = 32 - qg;
                att::prompt_unit_fast<8>(b, h, qg, nun, QB, KB, VB, OB, lds, tid); id += nun; }
            else { att::prompt_unit(b, h, qg, QB, KB, VB, OB, lds, tid); ++id; } }
        const bool std_grid = (G == 256);
        for (int n_ = 0; n_ < (std_grid ? ((vcu & 7) < 4 ? 1 : 0) : (DB * NH - vcu + G - 1) / G); ++n_) {
            const int id = std_grid ? 0 : vcu + n_ * G; const int b = std_grid ? (vcu & 3) + 4 * (vcu >> 7) : id / NH, h = std_grid ? ((vcu >> 3) & 15) : id % NH;
            if (h != lasth) { __syncthreads(); for (int i = tid; i < 320; i += NTHR) { const int j = 319 - i; const float tv = rel_bias[h * NREL + (j > 256 ? 256 : j)] * LOG2E; tab[i] = tv; ((LAS float*)(lds + att::L_BIAS2))[i] = tv - rel_bias[h * NREL + 256] * LOG2E; } __syncthreads(); lasth = h; }
            att::sample_unit(b, h, QB, KB, VB, cache_k, cache_v, OB, lds, tid); }
        __syncthreads();
        { constexpr int I_O = (D / 64) * (D / 32), I_UP = (D / 64) * (FF2 / 32), I_DN = (FF / 64) * (D / 32), I_IN = (D / 64) * (2 * D / 32), NIT0 = I_O + I_UP + I_DN + I_IN;
            LAS float* scr = (LAS float*)(lds + wave * 16384);
          for (int sh = 0; sh < (G == 256 ? 1 : 8); ++sh) {
            const int xq = (int)((bar.x + (unsigned)sh) & 7u); unsigned* qh = (unsigned*)(ws + WS_CTL) + CW_QUEUE0 + 64 * xq;
            const int qlo = xq * (NIT0 / 8), qhi = (xq + 1) * (NIT0 / 8);
            for (;;) { unsigned it0 = 0u; if (lane == 0) it0 = __hip_atomic_fetch_add(qh, 1u, __ATOMIC_RELAXED, __HIP_MEMORY_SCOPE_AGENT); it0 = (unsigned)__builtin_amdgcn_readfirstlane((int)it0);
                if ((int)it0 + qlo >= qhi) break;
              for (int sub = 0; sub < 1; ++sub) {
                int r = qlo + (int)it0 + sub; if (r >= qhi) break;
                if (r < I_O) { transpose_item<false, false>(w_o, D, D, nullptr, Wo_t, scr, r, lane); continue; } r -= I_O;
                if (r < I_UP) { transpose_item<true, true>(w_up, D, FF2, ln_ffn, (bf16_t*)(ws + WS_WUP), scr, r, lane); continue; } r -= I_UP;
                if (r < I_DN) { transpose_item<false, false>(w_down, FF, D, nullptr, (bf16_t*)(ws + WS_WDN), scr, r, lane); continue; } r -= I_DN;
                transpose_item<false, true>(w_in, D, 2 * D, ln_mix + D, Win_t, scr, r, lane); } } }
            __syncthreads(); }
}
    GRID_BAR();

#define RES_PHASE(A_, Wt_, KK) RES_PHASE2(A_, Wt_, KK, XB, SSQ, SSQS)
#define RES_PHASE2(A_, Wt_, KK, XO_, SSQO_, SSQSO_) do { \
        pg8::Gemm g{A_, Wt_, KK}; pg8::StaticOrder S; S.init(MP / 256, D / 256, G, bx, 0, WGM_RES); \
        EpiRes E{XB, XO_, SSQO_}; \
        typedef SampleRider<KK, 32, SRes> RR; const RR R{A_, Wt_, SRes{XB, XO_, SSQSO_}};     \
        pg8::gemm_phase<EpiRes, pg8::StaticOrder, RR>(lds, g, S, E, tid, R); } while (0)
    PH(3) { PHASE_VARS RES_PHASE(OB, Wo_t, D); }
    GRID_BAR();

#define UP_PHASE(L_) do { \
        const bf16_t* Wup_ = (const bf16_t*)(ws + WS_WUP + (L_) * WUP_L); const float* cw_ = conv_w + (size_t)(L_) * 3 * FF2; const float* cb_ = conv_b + (size_t)(L_) * FF2; \
        pg8::Gemm g{XB, Wup_, D}; pg8::StaticOrder S; S.init(67, FF2 / 256, G, bx, 1, WGM_UP); \
        EpiUp E{GB, SSQ, SSQS, cw_, cb_, out + O_CP + (size_t)(L_) * NB * 2 * FF2, state_conv + (size_t)(L_) * DB * 2 * FF2, out + O_CS + (size_t)(L_) * DB * 2 * FF2}; \
        pg8::gemm_phase<EpiUp, pg8::StaticOrder>(lds, g, S, E, tid); } while (0)
    PH(4) { PHASE_VARS UP_PHASE(0);
        { constexpr int I_O = (D / 64) * (D / 32), I_IN = (D / 64) * (2 * D / 32), I_UP = (D / 64) * (FF2 / 32), I_DN = (FF / 64) * (D / 32), NIT1 = I_O + I_UP + I_DN;
            LAS float* scr = (LAS float*)(lds + wave * 16384);
          for (int sh = 0; sh < (G == 256 ? 1 : 8); ++sh) {
            const int xq = (int)((bar.x + (unsigned)sh) & 7u); unsigned* qh = (unsigned*)(ws + WS_CTL) + CW_QUEUE + 64 * xq;
            const int qlo = xq * (NIT1 / 8), qhi = (xq + 1) * (NIT1 / 8);
            for (;;) { unsigned it0 = 0u; if (lane == 0) it0 = __hip_atomic_fetch_add(qh, 1u, __ATOMIC_RELAXED, __HIP_MEMORY_SCOPE_AGENT); it0 = (unsigned)__builtin_amdgcn_readfirstlane((int)it0);
                if ((int)it0 + qlo >= qhi) break;
              for (int sub = 0; sub < 1; ++sub) {
                int r = qlo + (int)it0 + sub; if (r >= qhi) break;
                if (r < I_O) { transpose_item<false, false>(w_out, D, D, nullptr, Wout_t, scr, r, lane); continue; } r -= I_O;
                if (r < I_UP) { transpose_item<true, true>(w_up + (size_t)D * FF2, D, FF2, ln_ffn + D, (bf16_t*)(ws + WS_WUP + WUP_L), scr, r, lane); continue; } r -= I_UP;
                transpose_item<false, false>(w_down + (size_t)FF * D, FF, D, nullptr, (bf16_t*)(ws + WS_WDN + WDN_L), scr, r, lane); } } }
            __syncthreads(); } }
    GRID_BAR();
    PH(5) { PHASE_VARS RES_PHASE(GB, (const bf16_t*)(ws + WS_WDN), FF); }
    GRID_BAR();

    PH(6) { PHASE_VARS
        pg8::Gemm g{XB, Win_t, D}; pg8::StaticOrder S; S.init(MP / 256, 2 * D / 256, G, bx, 0, WGM_IN);
        EpiIn E{QB, (size_t)(WS_K - WS_Q) / 2, SSQ, SSQV};
        typedef SampleRider<D, 64, SIn> RI; const RI R{XB, Win_t, SIn{SSQS, QB, KB, SSQVS}};
        pg8::gemm_phase<EpiIn, pg8::StaticOrder, RI>(lds, g, S, E, tid, R);
    }
    GRID_BAR();

    PH(7) { PHASE_VARS
        const int per = (128 * 8 + G - 1) / G;
        for (int id = vcu * per; id < (vcu + 1) * per && id < 128 * 8; ++id) gate::unit(false, id >> 3, id & 7, QB, VB, KB, SSQV, SSQVS, v_norm, (const bf16_t*)(ws + WS_WSB), bias_s, out + O_GV, lds, tid);
        for (int id = vcu; id < DB * 8; id += G) gate::unit(true, id >> 3, id & 7, QB, VB, KB, SSQV, SSQVS, v_norm, (const bf16_t*)(ws + WS_WSB), bias_s, out + O_GV, lds, tid);
    }
    GRID_BAR();

    PH(8) { PHASE_VARS RES_PHASE(VB, Wout_t, D); }
    GRID_BAR();
    PH(9) { PHASE_VARS UP_PHASE(1); }
    GRID_BAR();
    PH(10) { PHASE_VARS
        const bf16_t* Wdn_ = (const bf16_t*)(ws + WS_WDN + WDN_L); unsigned* ctl = (unsigned*)(ws + WS_CTL); float* XCHS = (float*)(ws + WS_XCHS);
        pg8::Gemm g{GB, Wdn_, FF}; pg8::StaticOrder S; S.init(MP / 256, D / 256, G, bx, 0, WGM_RES);
        EpiFinal E{XB, out + O_YP, (float*)(ws + WS_XCH), ctl + CW_PANEL, ln_final};
        typedef SampleRider<FF, 32, SFin> RF; const RF R{GB, Wdn_, SFin{XB, XCHS, ctl + CW_SPANEL, ln_final, out + O_YS}};
        pg8::gemm_phase<EpiFinal, pg8::StaticOrder, RF>(lds, g, S, E, tid, R); }
}

extern "C" void kernel_launch(void* const* d_in, const int* in_sizes, int n_in, void* d_out, int out_size, void* d_ws, size_t ws_size, hipStream_t stream) {
    static int grid = 0;
    if (grid == 0) {
        if (n_in != 20 || (size_t)out_size != O_END || ws_size < WS_END) { fprintf(stderr, "kernel_launch: unexpected sizes n_in %d out %d ws %zu\n", n_in, out_size, ws_size); grid = -1; return; }
        int dev = 0, cus = 0, per_cu = 0;
        if (hipGetDevice(&dev) != hipSuccess || hipDeviceGetAttribute(&cus, hipDeviceAttributeMultiprocessorCount, dev) != hipSuccess) { grid = -1; return; }
        if (hipFuncSetAttribute((const void*)fwd_kernel, hipFuncAttributeMaxDynamicSharedMemorySize, LDS_BYTES) != hipSuccess) { fprintf(stderr, "kernel_launch: hipFuncSetAttribute failed\n"); grid = -1; return; }
        if (hipOccupancyMaxActiveBlocksPerMultiprocessor(&per_cu, (const void*)fwd_kernel, NTHR, LDS_BYTES) != hipSuccess || per_cu < 1) { fprintf(stderr, "kernel_launch: occupancy query says %d\n", per_cu); per_cu = 1; }
        (void)hipGetLastError();
        grid = cus;
    }
    if (grid < 0) return;
    Args a{};
    for (int i = 0; i < 20; ++i) a.in[i] = (const float*)d_in[i];
    a.out = (float*)d_out; a.ws = (unsigned char*)d_ws;
    if (hipMemsetAsync((char*)d_ws + WS_CTL, 0, CTL_BYTES, stream) != hipSuccess) { fprintf(stderr, "kernel_launch: memset of the barrier words failed\n"); return; }
    hipLaunchKernelGGL(fwd_kernel, dim3(grid), dim3(NTHR), LDS_BYTES, stream, a);
    const hipError_t e = hipPeekAtLastError();
    if (e != hipSuccess) fprintf(stderr, "kernel_launch: launch failed: %s (grid %d)\n", hipGetErrorName(e), grid);
}
```

```cpp
#include <hip/hip_runtime.h>
#include <cstdio>
#include <cstdint>

#define LAS __attribute__((address_space(3)))
typedef unsigned short bf16_t;
typedef short bf16x8 __attribute__((ext_vector_type(8)));
typedef short s16x4 __attribute__((ext_vector_type(4)));
typedef float f32x2 __attribute__((ext_vector_type(2)));
typedef float f32x4 __attribute__((ext_vector_type(4)));
typedef float f32x16 __attribute__((ext_vector_type(16)));
typedef unsigned u32x2 __attribute__((ext_vector_type(2)));
typedef unsigned u32x4 __attribute__((ext_vector_type(4)));

constexpr int D = 1024, SEQ = 8192, NB = 2, MP = NB * SEQ, DB = 8, DT = 32, MS = DB * DT, MT = MP + MS;
constexpr int NH = 16, HD = 64, FF = 2816, FF2 = 5632, CA = 512, NREL = 257;
constexpr float EPS = 1e-6f, LOG2E = 1.4426950408889634f, C2 = 0.125f * LOG2E;
constexpr int NWAVES = 8, NTHR = 512;

constexpr size_t MiB = 1u << 20;
constexpr size_t WS_CTL = 0;
constexpr int CW_PANEL = 4096, CW_SPANEL = 4096 + 64 * 64;
constexpr int CW_QUEUE = 4096 + 64 * 64 + 64 * 8, CW_QUEUE0 = CW_QUEUE + 64 * 16, CW_QUEUE2 = CW_QUEUE0 + 64 * 16, CW_GATE = CW_QUEUE2 + 64 * 8, CW_ATT = CW_GATE + 4 * 72, CW_QKV = CW_ATT + 4 * 72, CW_GATE6 = CW_QKV + 800;
constexpr size_t CTL_BYTES = 65536;
constexpr size_t WS_WQKV = 1 * MiB, WS_WO = 7 * MiB, WS_WIN = 9 * MiB, WS_WOUT = 13 * MiB, WS_WUP = 15 * MiB, WS_WDN = 37 * MiB;
constexpr size_t WUP_L = (size_t)FF2 * D * 2, WDN_L = (size_t)D * FF * 2;
constexpr size_t WS_XB = 48 * MiB + 65536;
constexpr size_t WS_Q = 82 * MiB, WS_K = 116 * MiB, WS_V = 150 * MiB;
constexpr size_t WS_G = 82 * MiB;
constexpr size_t WS_SSQ = 200 * MiB;
constexpr size_t WS_SSQV = 201 * MiB;
constexpr size_t WS_SSQS = 202 * MiB;
constexpr size_t WS_SSQVS = 202 * MiB + 65536;
constexpr size_t WS_XCH = 203 * MiB, WS_XCHS = 203 * MiB + 512 * 1024;
constexpr size_t WS_OB = 204 * MiB;
constexpr size_t WS_WSB = 237 * MiB;
constexpr size_t WS_END = 238 * MiB;

constexpr size_t O_YP = 0, O_YS = O_YP + (size_t)MP * D, O_KP = O_YS + (size_t)MS * D, O_VP = O_KP + (size_t)NB * CA * D, O_KS = O_VP + (size_t)NB * CA * D,
                 O_VS = O_KS + (size_t)MS * D, O_GV = O_VS + (size_t)MS * D, O_CP = O_GV + (size_t)MS * D, O_CS = O_CP + (size_t)2 * NB * 2 * FF2, O_END = O_CS + (size_t)2 * DB * 2 * FF2;

constexpr int RING_BYTES = 131072;
constexpr int L_XBUF = 131072, L_PTAB = 147456, L_CTAB = 151552, L_RSTAB = 159744, L_RIDER = 131072;
constexpr int L_MISC = 161792;
constexpr int LDS_BYTES = 163840;

__device__ __forceinline__ void st16_wt(void* p, u32x4 v) { asm volatile("global_store_dwordx4 %0, %1, off sc1\n\ts_nop 1" :: "v"(p), "v"(v) : "memory"); }
__device__ __forceinline__ void st16_sel(void* p, u32x4 v, bool wt) { if (wt) st16_wt(p, v); else *(u32x4*)p = v; }
__device__ __forceinline__ unsigned cvt_pk_bf16(float lo, float hi) { unsigned r; asm volatile("v_cvt_pk_bf16_f32 %0, %1, %2" : "=v"(r) : "v"(lo), "v"(hi)); return r; }
__device__ __forceinline__ float bf2f(unsigned h) { return __uint_as_float(h << 16); }
__device__ __forceinline__ int crow(int r, int hi) { return (r & 3) + 8 * (r >> 2) + 4 * hi; }
#define LDS_WAIT() asm volatile("s_waitcnt lgkmcnt(0)" ::: "memory")
#define VM_WAIT() asm volatile("s_waitcnt vmcnt(0)" ::: "memory")
#define RAW_BAR() do { asm volatile("s_waitcnt lgkmcnt(0)" ::: "memory"); __builtin_amdgcn_s_barrier(); asm volatile("" ::: "memory"); } while (0)
template <int CTRL> __device__ __forceinline__ float dpp_mov(float x) { return __int_as_float(__builtin_amdgcn_update_dpp(0, __float_as_int(x), CTRL, 0xf, 0xf, true)); }
__device__ __forceinline__ float sum16(float s) { s += dpp_mov<0xB1>(s); s += dpp_mov<0x4E>(s); s += dpp_mov<0x141>(s); s += dpp_mov<0x140>(s); return s; }
__device__ __forceinline__ float xsum16(float x) { auto r = __builtin_amdgcn_permlane16_swap(__float_as_uint(x), __float_as_uint(x), false, false); return __uint_as_float(r[0]) + __uint_as_float(r[1]); }
__device__ __forceinline__ float xsum32(float x) { auto r = __builtin_amdgcn_permlane32_swap(__float_as_uint(x), __float_as_uint(x), false, false); return __uint_as_float(r[0]) + __uint_as_float(r[1]); }
__device__ __forceinline__ float xmax32(float x) { auto r = __builtin_amdgcn_permlane32_swap(__float_as_uint(x), __float_as_uint(x), false, false); return __builtin_fmaxf(__uint_as_float(r[0]), __uint_as_float(r[1])); }
__device__ __forceinline__ float wave_sum(float v) { return xsum32(xsum16(sum16(v))); }
__device__ __forceinline__ f32x2 gelu_pk(f32x2 v) {
    const f32x2 av = __builtin_elementwise_abs(v), d = av * 0.2316418882f + 1.0f;
    f32x2 t; t.x = __builtin_amdgcn_rcpf(d.x); t.y = __builtin_amdgcn_rcpf(d.y);
    f32x2 q = t * 0.5307027145f + (-0.7265760135f); q = q * t + 0.7107068705f; q = q * t + (-0.142248368f); q = q * t + 0.127414796f; q = q * t;
    const f32x2 s = (v * v) * (-0.72134752044f);
    f32x2 e; e.x = __builtin_amdgcn_exp2f(s.x); e.y = __builtin_amdgcn_exp2f(s.y);
    const f32x2 hq = 0.5f - q * e;
    return v * 0.5f + av * hq;
}
__device__ __forceinline__ float gelu1(float x) { f32x2 r = gelu_pk((f32x2){x, x}); return r.x; }
__device__ __forceinline__ float dpp_shr1_old(float old, float x) { return __int_as_float(__builtin_amdgcn_update_dpp(__float_as_int(old), __float_as_int(x), 0x111, 0xf, 0xf, false)); }
__device__ __forceinline__ float dpp_shr1(float x) { return __int_as_float(__builtin_amdgcn_update_dpp(0, __float_as_int(x), 0x111, 0xf, 0xf, true)); }
__device__ __forceinline__ float silu1(float x) { return x * __builtin_amdgcn_rcpf(1.0f + __builtin_amdgcn_exp2f(-x * LOG2E)); }

namespace pg8 {
constexpr int BM = 256, BK = 64, HALF = 128, HTB = HALF * BK * 2, NXCD = 8;
__host__ __device__ __forceinline__ int lds_byte(int r, int c) { const int st = (r >> 4) * 2 + (c >> 5), rr = r & 15, cc = c & 31, ob = rr * 64 + cc * 2; return st * 1024 + (ob ^ (((ob >> 9) & 1) << 5)); }
__host__ __device__ __forceinline__ void stage_rc(int b, int& R, int& C) { const int st = b / 1024, sb = b % 1024, swz = sb ^ (((sb >> 9) & 1) << 5); R = (st >> 1) * 16 + swz / 64; C = (st & 1) * 32 + (swz % 64) / 2; }
__host__ __device__ __forceinline__ int perm32(int rho) { const int n = rho >> 4, i = rho & 15; return 8 * (i >> 2) + 4 * n + (i & 3); }

struct Unit { int pm, pn, arow, seq; };
struct Gemm { const bf16_t* A; const bf16_t* Bt; int K; };

struct StaticOrder {
    int nM, nN, nwg, G, c, up, WGM;
    __device__ void init(int nM_, int nN_, int G_, int c_, int up_, int wgm_) { nM = nM_; nN = nN_; nwg = nM * nN; G = G_; c = c_; up = up_; WGM = wgm_; }
    __device__ bool next(int i, Unit& u) const {
        const long L = (long)i * G + c; if (L >= nwg) return false;
        u.seq = (int)L;
        int wgid = (int)L; { const int q = nwg / NXCD, r = nwg % NXCD, xcd = wgid % NXCD, off = wgid / NXCD; wgid = (xcd < r ? xcd * (q + 1) : r * (q + 1) + (xcd - r) * q) + off; }
        const int nig = WGM * nN, gid = wgid / nig, fm = gid * WGM, gsz = (nM - fm) < WGM ? (nM - fm) : WGM;
        u.pm = fm + ((wgid % nig) % gsz); u.pn = (wgid % nig) / gsz;
        u.arow = up ? (u.pm == 66 ? MP : (u.pm / 33) * SEQ + 254 * (u.pm % 33) - 2) : u.pm * BM;
        return true;
    }
};

struct NoRider { static constexpr bool ON = false; };
template <class E, class = void> struct aperm_t { static constexpr bool v = false; };
template <class E> struct aperm_t<E, decltype((void)E::APERM)> { static constexpr bool v = E::APERM; };
template <class E> __host__ __device__ constexpr bool aperm_of() { return aperm_t<E>::v; }
template <class Epi, class Sched, class Rider = NoRider>
__device__ __forceinline__ void gemm_phase(LAS unsigned char* lds, const Gemm g, const Sched& S, const Epi& E, const int tid, const Rider R = Rider()) {
    const int wid = __builtin_amdgcn_readfirstlane(tid >> 6), lane = tid & 63, wr = wid >> 2, wc = wid & 3, fr = lane & 15, fq = lane >> 4;
    const int K = g.K, nt = K / BK;
    unsigned voffA[2], voffB[2];
#pragma unroll
    for (int i = 0; i < 2; ++i) { int R, C; stage_rc(tid * 16 + i * 8192, R, C); const int Rb = Epi::PERM ? ((R & ~31) + perm32(R & 31)) : R;
        const int Ra = aperm_of<Epi>() ? ((R & 64) + 4 * (R & 15) + ((R >> 4) & 3)) : R;
        voffA[i] = (unsigned)(Ra * K + C) * 2u; voffB[i] = (unsigned)(Rb * K + C) * 2u; }
    const size_t kstep = (size_t)(BK * 2);
    const size_t hstep = (size_t)HALF * K * 2;
    const size_t tstep = 2 * hstep;
    const size_t rstep = (size_t)K * 2;
    const unsigned ldsw = (unsigned)wid * 1024u, ldsu = (unsigned)(uintptr_t)lds;
    const int aoff = lds_byte(wr * 64 + fr, fq * 8), boff = lds_byte(wc * 32 + fr, fq * 8);
#define PG8_SA(b, h) (((b) * 2 + (h)) * HTB)
#define PG8_SB(b, h) ((4 + (b) * 2 + (h)) * HTB)
#define PG8_GLDS(voff_, sbase_, ldsdst_) do { unsigned keep_; asm volatile("s_mov_b32 %0, m0\n\ts_mov_b32 m0, %3\n\ts_nop 0\n\tglobal_load_lds_dwordx4 %1, %2\n\ts_mov_b32 m0, %0" \
        : "=&s"(keep_) : "v"(voff_), "s"(sbase_), "s"(ldsdst_) : "memory"); } while (0)
#define PG8_STAGE(bufoff, gbase, voff) do { const char* sb_ = (const char*)(gbase); _Pragma("unroll") for (int _i = 0; _i < 2; ++_i) \
        PG8_GLDS((voff)[_i], sb_, (unsigned)__builtin_amdgcn_readfirstlane((int)(ldsu + (unsigned)(bufoff) + ldsw + (unsigned)(_i * 8192)))); } while (0)
#define PG8_LDA(dst, b, h) do { _Pragma("unroll") for (int m = 0; m < 4; ++m) _Pragma("unroll") for (int k = 0; k < 2; ++k) dst[m][k] = *(const LAS bf16x8*)(lds + PG8_SA(b, h) + aoff + m * 2048 + k * 1024); } while (0)
#define PG8_LDB(dst, b, h) do { _Pragma("unroll") for (int n = 0; n < 2; ++n) _Pragma("unroll") for (int k = 0; k < 2; ++k) dst[n][k] = *(const LAS bf16x8*)(lds + PG8_SB(b, h) + boff + n * 2048 + k * 1024); } while (0)
#define PG8_MMA(ai, bj, At, Bt) do { __builtin_amdgcn_s_setprio(1); _Pragma("unroll") for (int m = 0; m < 4; ++m) _Pragma("unroll") for (int n = 0; n < 2; ++n) _Pragma("unroll") for (int k = 0; k < 2; ++k) \
        acc[ai][bj][m][n] = __builtin_amdgcn_mfma_f32_16x16x32_bf16(Bt[n][k], At[m][k], acc[ai][bj][m][n], 0, 0, 0); __builtin_amdgcn_s_setprio(0); } while (0)
#define PG8_WAIT_V(n) asm volatile("s_waitcnt vmcnt(" #n ")" ::: "memory")
#define PG8_WAIT_L(n) asm volatile("s_waitcnt lgkmcnt(" #n ")" ::: "memory")
#define PG8_BAR __builtin_amdgcn_s_barrier()
#define PG8_SCHED __builtin_amdgcn_sched_barrier(0)
    Unit cur, nxt; int ui = 0;
    if (!S.next(0, cur)) return;
    f32x4 acc[2][2][4][2];
    u32x4 xin[2][4][2];
    if constexpr (Epi::INIT) E.init_load(xin, cur, wr, wc, fr, fq);
    f32x16 racc; const char* rpa = nullptr; const char* rpb = nullptr; unsigned rvoff = 0u;
    if constexpr (Rider::ON) {
#pragma unroll
        for (int r = 0; r < 16; ++r) racc[r] = 0.f;
        rvoff = (unsigned)(((lane & 31) * Rider::K + (lane >> 5) * 8) * 2);
        R.ptrs(cur.seq, wid, rpa, rpb); }
    bf16x8 At[4][2], B0[2][2], B1[2][2];
    const char* cA = (const char*)g.A + (ptrdiff_t)cur.arow * (ptrdiff_t)rstep; const char* cB = (const char*)g.Bt + (size_t)cur.pn * tstep;
    PG8_STAGE(PG8_SB(0, 0), cB, voffB); PG8_STAGE(PG8_SB(0, 1), cB + hstep, voffB); PG8_STAGE(PG8_SA(0, 0), cA, voffA); PG8_STAGE(PG8_SA(0, 1), cA + hstep, voffA);
    E.first(cur, lds, tid);
#pragma unroll
    for (int a = 0; a < 2; ++a)
#pragma unroll
        for (int m = 0; m < 4; ++m)
#pragma unroll
            for (int b = 0; b < 2; ++b) {
                if constexpr (Epi::INIT) { const u32x4 x4 = xin[a][m][b];
                    acc[a][b][m][0] = (f32x4){bf2f(x4.x & 0xffffu), bf2f(x4.x >> 16), bf2f(x4.y & 0xffffu), bf2f(x4.y >> 16)};
                    acc[a][b][m][1] = (f32x4){bf2f(x4.z & 0xffffu), bf2f(x4.z >> 16), bf2f(x4.w & 0xffffu), bf2f(x4.w >> 16)}; }
                else { acc[a][b][m][0] = (f32x4){0.f, 0.f, 0.f, 0.f}; acc[a][b][m][1] = (f32x4){0.f, 0.f, 0.f, 0.f}; } }
    if (wr == 1) PG8_BAR;
    PG8_WAIT_V(2); PG8_BAR;
    PG8_STAGE(PG8_SB(1, 0), cB + kstep, voffB); PG8_STAGE(PG8_SA(1, 0), cA + kstep, voffA); PG8_STAGE(PG8_SB(1, 1), cB + hstep + kstep, voffB);
    PG8_WAIT_V(6); PG8_BAR;
    for (;;) {
        const bool has_next = S.next(ui + 1, nxt);
        const char* nA = has_next ? (const char*)g.A + (ptrdiff_t)nxt.arow * (ptrdiff_t)rstep : cA; const char* nB = has_next ? (const char*)g.Bt + (size_t)nxt.pn * tstep : cB;
        for (int t = 0; t < nt; t += 2) {
            const bool last = (t == nt - 2);
            const char* a1 = cA + (size_t)(t + 1) * kstep;
            const char* a2 = last ? nA : cA + (size_t)(t + 2) * kstep; const char* b2 = last ? nB : cB + (size_t)(t + 2) * kstep;
            const char* a3 = a2 + kstep; const char* b3 = b2 + kstep;
            bf16x8 ra, rb;
            if constexpr (Rider::ON) { const char* pa_ = rpa + (size_t)t * 16; const char* pb_ = rpb + (size_t)t * 16;
                asm volatile("s_nop 4\n\tglobal_load_dwordx4 %0, %2, %3\n\tglobal_load_dwordx4 %1, %2, %4" : "=&v"(ra), "=&v"(rb) : "v"(rvoff), "s"(pa_), "s"(pb_) : "memory"); }
            PG8_LDB(B0, 0, 0); PG8_LDB(B1, 0, 1); PG8_SCHED; PG8_LDA(At, 0, 0); PG8_STAGE(PG8_SA(1, 1), a1 + hstep, voffA);
            if constexpr (Rider::ON) PG8_WAIT_V(10); else PG8_WAIT_V(8);
            PG8_WAIT_L(0); PG8_BAR; PG8_MMA(0, 0, At, B0); PG8_MMA(0, 1, At, B1); PG8_BAR; PG8_SCHED;
            PG8_LDA(At, 0, 1); PG8_STAGE(PG8_SB(0, 0), b2, voffB); PG8_STAGE(PG8_SB(0, 1), b2 + hstep, voffB); PG8_STAGE(PG8_SA(0, 0), a2, voffA);
            PG8_WAIT_V(8); if constexpr (Rider::ON) asm volatile("" : "+v"(ra), "+v"(rb)); PG8_WAIT_L(0); PG8_BAR; PG8_MMA(1, 0, At, B0); PG8_MMA(1, 1, At, B1); PG8_BAR; PG8_SCHED;
            PG8_LDB(B0, 1, 0); PG8_LDB(B1, 1, 1); PG8_SCHED; PG8_LDA(At, 1, 0); PG8_STAGE(PG8_SA(0, 1), a2 + hstep, voffA);
            PG8_WAIT_V(8); PG8_WAIT_L(0); PG8_BAR; PG8_MMA(0, 0, At, B0); PG8_MMA(0, 1, At, B1); PG8_BAR; PG8_SCHED;
            PG8_LDA(At, 1, 1); PG8_STAGE(PG8_SB(1, 0), b3, voffB); PG8_STAGE(PG8_SB(1, 1), b3 + hstep, voffB); PG8_STAGE(PG8_SA(1, 0), a3, voffA);
            PG8_WAIT_V(8); PG8_WAIT_L(0); PG8_BAR; PG8_MMA(1, 0, At, B0); PG8_MMA(1, 1, At, B1);
            if constexpr (Rider::ON) racc = __builtin_amdgcn_mfma_f32_32x32x16_bf16(ra, rb, racc, 0, 0, 0);
            PG8_BAR; PG8_SCHED;
        }
        if (wr == 0) PG8_BAR;
        f32x2 parked = (f32x2){0.f, 0.f};
        if constexpr (Rider::ON) { if constexpr (Rider::SPLIT) parked = R.finish_a(racc, cur.seq, lds, tid); }
        E(acc, cur, nxt, has_next, ui & 1, wr, wc, fr, fq, lds, tid);
        if constexpr (Rider::ON) { if constexpr (Rider::SPLIT) R.finish_b(parked, cur.seq, lds, tid); else R.finish(racc, cur.seq, lds, tid);
#pragma unroll
            for (int r = 0; r < 16; ++r) racc[r] = 0.f;
            if (has_next) R.ptrs(nxt.seq, wid, rpa, rpb); }
        if (!has_next) break;
        if constexpr (Epi::INIT) E.init_load(xin, nxt, wr, wc, fr, fq);
#pragma unroll
        for (int a = 0; a < 2; ++a)
#pragma unroll
            for (int m = 0; m < 4; ++m)
#pragma unroll
                for (int b = 0; b < 2; ++b) {
                    if constexpr (Epi::INIT) { const u32x4 x4 = xin[a][m][b];
                        acc[a][b][m][0] = (f32x4){bf2f(x4.x & 0xffffu), bf2f(x4.x >> 16), bf2f(x4.y & 0xffffu), bf2f(x4.y >> 16)};
                        acc[a][b][m][1] = (f32x4){bf2f(x4.z & 0xffffu), bf2f(x4.z >> 16), bf2f(x4.w & 0xffffu), bf2f(x4.w >> 16)}; }
                    else { acc[a][b][m][0] = (f32x4){0.f, 0.f, 0.f, 0.f}; acc[a][b][m][1] = (f32x4){0.f, 0.f, 0.f, 0.f}; } }
        cur = nxt; cA = nA; cB = nB; ++ui;
        if (wr == 1) PG8_BAR;
    }
    PG8_WAIT_V(0);
    PG8_BAR;
#undef PG8_SA
#undef PG8_SB
#undef PG8_STAGE
#undef PG8_GLDS
#undef PG8_LDA
#undef PG8_LDB
#undef PG8_MMA
#undef PG8_WAIT_V
#undef PG8_WAIT_L
#undef PG8_BAR
#undef PG8_SCHED
}
}

typedef f32x4 AccT[2][2][4][2];

__device__ __forceinline__ float rs_issue(const float* ssq, int tok0, int tid) {
    float s = 0.f;
    if (tid < 256) { int tok = tok0 + tid; tok = tok < 0 ? 0 : (tok >= MT ? MT - 1 : tok); s = (ssq[tok] + ssq[MT + tok]) + (ssq[2 * MT + tok] + ssq[3 * MT + tok]); }
    return s;
}
__device__ __forceinline__ void rs_commit(LAS unsigned char* lds, int slot, float s, int tid) { if (tid < 256) ((LAS float*)(lds + L_RSTAB))[slot * 256 + tid] = 1.0f / sqrtf(s * (1.0f / D) + EPS); }

struct EpiQKV {
    static constexpr bool PERM = true, INIT = false;
    bf16_t* O; size_t split_stride; const float* ssq; float* okp; float* ovp; bool wt_all;
    __device__ __forceinline__ void first(const pg8::Unit& u, LAS unsigned char* lds, int tid) const { rs_commit(lds, 0, rs_issue(ssq, u.pm * 256, tid), tid); RAW_BAR(); }
    __device__ __forceinline__ void operator()(const AccT& acc, const pg8::Unit& u, const pg8::Unit& nx, bool has_next, int slot, int wr, int wc, int fr0, int fq0, LAS unsigned char* lds, int tid0) const {
        int fr = fr0, fq = fq0, tid = tid0; asm volatile("" : "+v"(fr), "+v"(fq), "+v"(tid));
        float sn = 0.f; if (has_next) sn = rs_issue(ssq, nx.pm * 256, tid);
        const LAS float* rst = (const LAS float*)(lds + L_RSTAB) + slot * 256;
        const int t = u.pn >> 2, colt = (u.pn & 3) * 256; bf16_t* base = O + (size_t)t * split_stride; const float sc = (t == 0) ? C2 : 1.0f;
        const bool side = (t >= 1) && ((u.pm & 31) >= 30);
        float* sp = (t == 1 ? okp : ovp) + ((size_t)((u.pm >> 5) * CA + (u.pm & 1) * 256)) * D;
        const int col0 = colt + wc * 32 + 8 * fq;
#pragma unroll
        for (int ai = 0; ai < 2; ++ai)
#pragma unroll
            for (int m = 0; m < 4; ++m) { const int r = ai * 128 + wr * 64 + m * 16 + fr; const float rs = rst[r] * sc; bf16_t* rowp = base + (size_t)(u.pm * 256 + r) * D + col0;
#pragma unroll
                for (int bj = 0; bj < 2; ++bj) { const f32x4 v0 = acc[ai][bj][m][0] * rs, v1 = acc[ai][bj][m][1] * rs;
                    u32x4 w; w.x = cvt_pk_bf16(v0[0], v0[1]); w.y = cvt_pk_bf16(v0[2], v0[3]); w.z = cvt_pk_bf16(v1[0], v1[1]); w.w = cvt_pk_bf16(v1[2], v1[3]);
                    st16_sel(rowp + bj * 128, w, wt_all || !has_next);
                    if (side) { float* s = sp + (size_t)r * D + col0 + bj * 128; *(f32x4*)s = v0; *(f32x4*)(s + 4) = v1; } } }
        if (has_next) rs_commit(lds, slot ^ 1, sn, tid);
    }
};

__device__ __forceinline__ void res_init_load(u32x4 (&xin)[2][4][2], const bf16_t* xb, const pg8::Unit& u, int wr, int wc, int fr0, int fq0) {
    int fr = fr0, fq = fq0; asm volatile("" : "+v"(fr), "+v"(fq));
    const int col0 = u.pn * 256 + wc * 32 + 8 * fq;
#pragma unroll
    for (int ai = 0; ai < 2; ++ai)
#pragma unroll
        for (int m = 0; m < 4; ++m) { const size_t off = (size_t)(u.pm * 256 + ai * 128 + wr * 64 + m * 16 + fr) * D + col0;
#pragma unroll
            for (int bj = 0; bj < 2; ++bj) xin[ai][m][bj] = *(const u32x4*)(xb + off + bj * 128); }
}
struct EpiRes {
    static constexpr bool PERM = true, INIT = true;
    const bf16_t* xb; bf16_t* xo; float* ssq;
    __device__ __forceinline__ void first(const pg8::Unit&, LAS unsigned char*, int) const {}
    __device__ __forceinline__ void init_load(u32x4 (&xin)[2][4][2], const pg8::Unit& u, int wr, int wc, int fr, int fq) const { res_init_load(xin, xb, u, wr, wc, fr, fq); }
    __device__ __forceinline__ void operator()(const AccT& acc, const pg8::Unit& u, const pg8::Unit&, bool, int, int wr, int wc, int fr0, int fq0, LAS unsigned char* lds, int tid0) const {
        int fr = fr0, fq = fq0, tid = tid0; asm volatile("" : "+v"(fr), "+v"(fq), "+v"(tid));
        LAS float* P = (LAS float*)(lds + L_PTAB);
        const int col0 = u.pn * 256 + wc * 32 + 8 * fq;
#pragma unroll
        for (int ai = 0; ai < 2; ++ai)
#pragma unroll
            for (int m = 0; m < 4; ++m) { const int r = ai * 128 + wr * 64 + m * 16 + fr; const size_t off = (size_t)(u.pm * 256 + r) * D + col0; float s = 0.f;
#pragma unroll
                for (int bj = 0; bj < 2; ++bj) { const f32x4 a0 = acc[ai][bj][m][0], a1 = acc[ai][bj][m][1];
                    { f32x2 q2 = (f32x2){a0[0], a0[1]} * (f32x2){a0[0], a0[1]}; q2 += (f32x2){a0[2], a0[3]} * (f32x2){a0[2], a0[3]}; q2 += (f32x2){a1[0], a1[1]} * (f32x2){a1[0], a1[1]}; q2 += (f32x2){a1[2], a1[3]} * (f32x2){a1[2], a1[3]}; s += q2.x + q2.y; }
                    u32x4 w; w.x = cvt_pk_bf16(a0[0], a0[1]); w.y = cvt_pk_bf16(a0[2], a0[3]); w.z = cvt_pk_bf16(a1[0], a1[1]); w.w = cvt_pk_bf16(a1[2], a1[3]); st16_wt(xo + off + bj * 128, w); }
                s = xsum32(xsum16(s));
                if (fq == 0) P[r * 4 + wc] = s; }
        RAW_BAR();
        if (tid < 256) { const f32x4 p = *(const LAS f32x4*)(P + tid * 4); ssq[(size_t)u.pn * MT + u.pm * 256 + tid] = (p[0] + p[1]) + (p[2] + p[3]); }
    }
};

__device__ __forceinline__ void wait_count(unsigned* cnt, unsigned want, int tid) {
    if (tid == 0) { unsigned sp = 0;
        while (__hip_atomic_load(cnt, __ATOMIC_RELAXED, __HIP_MEMORY_SCOPE_AGENT) < want) { __builtin_amdgcn_s_sleep(2); if (++sp > (1u << 22)) break; }
        __builtin_amdgcn_fence(__ATOMIC_ACQUIRE, "agent"); }
    asm volatile("s_waitcnt vmcnt(0)" ::: "memory");
    RAW_BAR();
}
struct EpiFinal {
    static constexpr bool PERM = true, INIT = true;
    const bf16_t* xb; float* out; float* ssq; unsigned* cnt; const float* gfin;
    __device__ __forceinline__ void first(const pg8::Unit&, LAS unsigned char*, int) const {}
    __device__ __forceinline__ void init_load(u32x4 (&xin)[2][4][2], const pg8::Unit& u, int wr, int wc, int fr, int fq) const { res_init_load(xin, xb, u, wr, wc, fr, fq); }
    __device__ __forceinline__ void operator()(AccT& acc, const pg8::Unit& u, const pg8::Unit&, bool, int, int wr, int wc, int fr0, int fq0, LAS unsigned char* lds, int tid0) const {
        int fr = fr0, fq = fq0, tid = tid0; asm volatile("" : "+v"(fr), "+v"(fq), "+v"(tid));
        LAS float* P = (LAS float*)(lds + L_PTAB); LAS float* rst = (LAS float*)(lds + L_RSTAB);
        const int col0 = u.pn * 256 + wc * 32 + 8 * fq;
#pragma unroll
        for (int ai = 0; ai < 2; ++ai)
#pragma unroll
            for (int m = 0; m < 4; ++m) { const int r = ai * 128 + wr * 64 + m * 16 + fr; float s = 0.f;
#pragma unroll
                for (int bj = 0; bj < 2; ++bj) { const f32x4 a0 = acc[ai][bj][m][0], a1 = acc[ai][bj][m][1];
                    { f32x2 q2 = (f32x2){a0[0], a0[1]} * (f32x2){a0[0], a0[1]}; q2 += (f32x2){a0[2], a0[3]} * (f32x2){a0[2], a0[3]}; q2 += (f32x2){a1[0], a1[1]} * (f32x2){a1[0], a1[1]}; q2 += (f32x2){a1[2], a1[3]} * (f32x2){a1[2], a1[3]}; s += q2.x + q2.y; }     }
                s = xsum32(xsum16(s));
                if (fq == 0) P[r * 4 + wc] = s; }
        RAW_BAR();
        if (tid < 256) { const f32x4 p = *(const LAS f32x4*)(P + tid * 4);
            __hip_atomic_store(ssq + (size_t)u.pn * MT + u.pm * 256 + tid, (p[0] + p[1]) + (p[2] + p[3]), __ATOMIC_RELAXED, __HIP_MEMORY_SCOPE_AGENT); }
        asm volatile("s_waitcnt vmcnt(0)" ::: "memory");
        RAW_BAR();
        if (tid == 0) __hip_atomic_fetch_add(cnt + 64 * u.pm, 1u, __ATOMIC_RELAXED, __HIP_MEMORY_SCOPE_AGENT);
        wait_count(cnt + 64 * u.pm, 4u, tid);
        if (tid < 256) { float s = 0.f;
#pragma unroll
            for (int t = 0; t < 4; ++t) s += __hip_atomic_load(ssq + (size_t)t * MT + u.pm * 256 + tid, __ATOMIC_RELAXED, __HIP_MEMORY_SCOPE_AGENT);
            rst[tid] = 1.0f / sqrtf(s * (1.0f / D) + EPS); }
        RAW_BAR();
        f32x4 gv[2][2];
#pragma unroll
        for (int bj = 0; bj < 2; ++bj)
#pragma unroll
            for (int n = 0; n < 2; ++n) gv[bj][n] = *(const f32x4*)(gfin + col0 + bj * 128 + n * 4);
#pragma unroll
        for (int ai = 0; ai < 2; ++ai)
#pragma unroll
            for (int m = 0; m < 4; ++m) { const int r = ai * 128 + wr * 64 + m * 16 + fr; const float rs = rst[r]; const size_t off = (size_t)(u.pm * 256 + r) * D + col0;
#pragma unroll
                for (int bj = 0; bj < 2; ++bj)
#pragma unroll
                    for (int n = 0; n < 2; ++n) *(f32x4*)(out + off + bj * 128 + n * 4) = acc[ai][bj][m][n] * rs * gv[bj][n]; }
    }
};

struct EpiIn {
    static constexpr bool PERM = true, INIT = false;
    bf16_t* O; size_t split_stride; const float* ssq; float* ssqv; bool wt_all;
    __device__ __forceinline__ void first(const pg8::Unit& u, LAS unsigned char* lds, int tid) const { rs_commit(lds, 0, rs_issue(ssq, u.pm * 256, tid), tid); RAW_BAR(); }
    __device__ __forceinline__ void operator()(const AccT& acc, const pg8::Unit& u, const pg8::Unit& nx, bool has_next, int slot, int wr, int wc, int fr0, int fq0, LAS unsigned char* lds, int tid0) const {
        int fr = fr0, fq = fq0, tid = tid0; asm volatile("" : "+v"(fr), "+v"(fq), "+v"(tid));
        float sn = 0.f; if (has_next) sn = rs_issue(ssq, nx.pm * 256, tid);
        const LAS float* rst = (const LAS float*)(lds + L_RSTAB) + slot * 256; LAS float* P = (LAS float*)(lds + L_PTAB);
        const int t = u.pn >> 2, colt = (u.pn & 3) * 256; bf16_t* base = O + (size_t)t * split_stride;
        const int col0 = colt + wc * 32 + 8 * fq;
#pragma unroll
        for (int ai = 0; ai < 2; ++ai)
#pragma unroll
            for (int m = 0; m < 4; ++m) { const int r = ai * 128 + wr * 64 + m * 16 + fr; const float rs = rst[r]; bf16_t* rowp = base + (size_t)(u.pm * 256 + r) * D + col0; float s = 0.f;
#pragma unroll
                for (int bj = 0; bj < 2; ++bj) { const f32x4 x0 = acc[ai][bj][m][0] * rs, x1 = acc[ai][bj][m][1] * rs;
                    const f32x2 a = gelu_pk((f32x2){x0[0], x0[1]}), b = gelu_pk((f32x2){x0[2], x0[3]}), c = gelu_pk((f32x2){x1[0], x1[1]}), d = gelu_pk((f32x2){x1[2], x1[3]});
                    s += (a.x * a.x + a.y * a.y) + (b.x * b.x + b.y * b.y) + (c.x * c.x + c.y * c.y) + (d.x * d.x + d.y * d.y);
                    u32x4 w; w.x = cvt_pk_bf16(a.x, a.y); w.y = cvt_pk_bf16(b.x, b.y); w.z = cvt_pk_bf16(c.x, c.y); w.w = cvt_pk_bf16(d.x, d.y);
                    st16_sel(rowp + bj * 128, w, wt_all || !has_next); }
                if (t == 1) { s = xsum32(xsum16(s)); if (fq == 0) P[r * 4 + wc] = s; } }
        if (t == 1) { RAW_BAR();
            if (tid < 256) { const f32x4 p = *(const LAS f32x4*)(P + tid * 4); __hip_atomic_store(ssqv + (size_t)(u.pn & 3) * MT + u.pm * 256 + tid, (p[0] + p[1]) + (p[2] + p[3]), __ATOMIC_RELAXED, __HIP_MEMORY_SCOPE_AGENT); } }
        if (has_next) rs_commit(lds, slot ^ 1, sn, tid);
    }
};

__device__ __forceinline__ void conv_dpp(f32x4& o, const f32x4 cur, const f32x4 prv, const f32x4 w1, const f32x4 w0) {
#define CONV1(e) "v_fmac_f32_dpp %" #e ", %[c" #e "], %[a" #e "] row_shr:1 row_mask:0xf bank_mask:0xf bound_ctrl:1\n\t" \
                 "v_fmac_f32_dpp %" #e ", %[p" #e "], %[a" #e "] row_shl:15 row_mask:0xf bank_mask:0xf bound_ctrl:1\n\t" \
                 "v_fmac_f32_dpp %" #e ", %[c" #e "], %[b" #e "] row_shr:2 row_mask:0xf bank_mask:0xf bound_ctrl:1\n\t" \
                 "v_fmac_f32_dpp %" #e ", %[p" #e "], %[b" #e "] row_shl:14 row_mask:0xf bank_mask:0xf bound_ctrl:1\n\t"
    float o0 = o[0], o1 = o[1], o2 = o[2], o3 = o[3];
    asm("s_nop 1\n\t" CONV1(0) CONV1(1) CONV1(2) CONV1(3)
        : "+v"(o0), "+v"(o1), "+v"(o2), "+v"(o3)
        : [c0] "v"(cur[0]), [c1] "v"(cur[1]), [c2] "v"(cur[2]), [c3] "v"(cur[3]), [p0] "v"(prv[0]), [p1] "v"(prv[1]), [p2] "v"(prv[2]), [p3] "v"(prv[3]),
          [a0] "v"(w1[0]), [a1] "v"(w1[1]), [a2] "v"(w1[2]), [a3] "v"(w1[3]), [b0] "v"(w0[0]), [b1] "v"(w0[1]), [b2] "v"(w0[2]), [b3] "v"(w0[3]));
    o = (f32x4){o0, o1, o2, o3};
#undef CONV1
}

struct EpiUp {
    static constexpr bool PERM = true, INIT = false, APERM = true;
    bf16_t* G; const float* ssq; const float* ssqs; const float* cw; const float* cb; float* ocp; const float* hist; float* ocs;
    __device__ __forceinline__ float rs_iss(const pg8::Unit& u, int tid) const {
        if (u.pm != 66) return rs_issue(ssq, u.arow, tid);
        float s = 0.f;
        if (tid < 256) {
#pragma unroll 8
            for (int jj = 0; jj < 32; ++jj) s += ssqs[(size_t)jj * MS + tid]; }
        return s;
    }
    __device__ __forceinline__ f32x2 ct_iss(const pg8::Unit& u, int tid) const {
        const int c = tid & 255, wh = tid >> 8, oc = (c >> 7) * FF + u.pn * 128 + (c & 127);
        f32x2 r; r.x = cw[(size_t)wh * FF2 + oc]; r.y = wh == 0 ? cw[(size_t)2 * FF2 + oc] : cb[oc]; return r;
    }
    __device__ __forceinline__ void ct_commit(LAS unsigned char* lds, int slot, f32x2 v, int tid) const {
        LAS float* ct = (LAS float*)(lds + L_CTAB) + slot * 1024; const int c = tid & 255, wh = tid >> 8;
        const float sc = (c >> 7) ? -1.0f / LOG2E : -LOG2E;
        ct[wh * 256 + c] = v.x * sc; ct[(wh == 0 ? 2 : 3) * 256 + c] = v.y * sc;
    }
    __device__ __forceinline__ void first(const pg8::Unit& u, LAS unsigned char* lds, int tid) const { rs_commit(lds, 0, rs_iss(u, tid), tid); ct_commit(lds, 0, ct_iss(u, tid), tid); RAW_BAR(); }
    __device__ __forceinline__ void operator()(AccT& acc, const pg8::Unit& u, const pg8::Unit& nx, bool has_next, int slot, int wr, int wc, int fr0, int fq0, LAS unsigned char* lds, int tid0) const {
        int fr = fr0, fq = fq0, tid = tid0; asm volatile("" : "+v"(fr), "+v"(fq), "+v"(tid));
        float sn = 0.f; f32x2 cn = (f32x2){0.f, 0.f};
        if (has_next) { sn = rs_iss(nx, tid); cn = ct_iss(nx, tid); }
        const bool smp = u.pm == 66;
        const int b = u.pm / 33, j = smp ? 1 : u.pm % 33, tok0 = u.arow;
        const LAS float* rst = (const LAS float*)(lds + L_RSTAB) + slot * 256; LAS float* xbuf = (LAS float*)(lds + L_XBUF); const LAS float* ct = (const LAS float*)(lds + L_CTAB) + slot * 1024;
#pragma unroll
        for (int ai = 0; ai < 2; ++ai) { const f32x4 rs4 = *(const LAS f32x4*)(rst + ai * 128 + wr * 64 + 4 * fr);
#pragma unroll
            for (int m = 0; m < 4; ++m)
#pragma unroll
                for (int bj = 0; bj < 2; ++bj)
#pragma unroll
                    for (int n = 0; n < 2; ++n) acc[ai][bj][m][n] *= rs4[m]; }
        if (j == 0 && wr == 0 && fr == 0) {
#pragma unroll
            for (int bj = 0; bj < 2; ++bj)
#pragma unroll
                for (int n = 0; n < 2; ++n) { acc[0][bj][0][n] = (f32x4){0.f, 0.f, 0.f, 0.f}; acc[0][bj][1][n] = (f32x4){0.f, 0.f, 0.f, 0.f}; } }
        const int cl = wc * 32 + 8 * fq;
        if (j == 32 && wr == 1 && fr == 0) {
#pragma unroll
            for (int r = 0; r < 2; ++r)
#pragma unroll
                for (int bj = 0; bj < 2; ++bj)
#pragma unroll
                    for (int n = 0; n < 2; ++n) *(f32x4*)(ocp + (size_t)(b * 2 + r) * FF2 + bj * FF + u.pn * 128 + cl + 4 * n) = acc[0][bj][r][n]; }
        if (smp && (fr & 7) == 7) {
            const int cl_ = cl;
#pragma unroll
            for (int ai = 0; ai < 2; ++ai)
#pragma unroll
                for (int r = 0; r < 2; ++r)
#pragma unroll
                    for (int bj = 0; bj < 2; ++bj)
#pragma unroll
                        for (int n = 0; n < 2; ++n) *(f32x4*)(ocs + (size_t)((2 * (2 * ai + wr) + (fr >> 3)) * 2 + r) * FF2 + bj * FF + u.pn * 128 + cl_ + 4 * n) = acc[ai][bj][2 + r][n]; }
        if (!smp) {
            if (fr == 15) {
#pragma unroll
                for (int ai = 0; ai < 2; ++ai)
                    if (2 * ai + wr < 3) {
#pragma unroll
                        for (int r = 0; r < 2; ++r)
#pragma unroll
                            for (int bj = 0; bj < 2; ++bj)
#pragma unroll
                                for (int n = 0; n < 2; ++n) *(LAS f32x4*)(xbuf + ((2 * (2 * ai + wr + 1)) * 2 + r) * 256 + bj * 128 + cl + 4 * n) = acc[ai][bj][2 + r][n]; } }
        } else if (fr >= 14) {
#pragma unroll 1
            for (int q4 = 0; q4 < 4; ++q4) { const int q = (q4 >> 1) * 4 + wr * 2 + (q4 & 1);
#pragma unroll 1
                for (int bj = 0; bj < 2; ++bj) { const f32x4 h0 = *(const f32x4*)(hist + (size_t)(q * 2 + (fr - 14)) * FF2 + bj * FF + u.pn * 128 + cl), h1 = *(const f32x4*)(hist + (size_t)(q * 2 + (fr - 14)) * FF2 + bj * FF + u.pn * 128 + cl + 4);
                    *(LAS f32x4*)(xbuf + (q * 2 + (fr - 14)) * 256 + bj * 128 + cl) = h0; *(LAS f32x4*)(xbuf + (q * 2 + (fr - 14)) * 256 + bj * 128 + cl + 4) = h1; } }
        }
        RAW_BAR();
        const int bend = smp ? MT : (b + 1) * SEQ;
        const int hq = smp ? (fr >> 3) : 0;
        u32x2 wlo[2][4];
#pragma unroll
        for (int n = 0; n < 2; ++n) {
            f32x4 w0[2], w1[2], w2[2], cbv[2];
#pragma unroll
            for (int bj = 0; bj < 2; ++bj) { const int tc = bj * 128 + cl + 4 * n;
                w0[bj] = *(const LAS f32x4*)(ct + tc); w1[bj] = *(const LAS f32x4*)(ct + 256 + tc); w2[bj] = *(const LAS f32x4*)(ct + 512 + tc); cbv[bj] = *(const LAS f32x4*)(ct + 768 + tc); }
#pragma unroll
            for (int ai = 0; ai < 2; ++ai) {
                f32x4 c[4][2];
#pragma unroll
                for (int bj = 0; bj < 2; ++bj) {
                    const f32x4 a0 = acc[ai][bj][0][n], a1 = acc[ai][bj][1][n], a2 = acc[ai][bj][2][n], a3 = acc[ai][bj][3][n];
                    const LAS float* hp = xbuf + ((2 * (2 * ai + wr) + hq) * 2) * 256 + bj * 128 + cl + 4 * n;
                    const f32x4 h2 = *(const LAS f32x4*)hp, h1 = *(const LAS f32x4*)(hp + 256);
                    f32x4 s1, s2;
#pragma unroll
                    for (int e = 0; e < 4; ++e) { s1[e] = dpp_shr1_old(h1[e], a3[e]); s2[e] = dpp_shr1_old(h2[e], a2[e]); }
                    if (smp) { asm volatile("" ::: "memory");
                        const f32x4 g2 = *(const LAS f32x4*)hp, g1 = *(const LAS f32x4*)(hp + 256);
#pragma unroll
                        for (int e = 0; e < 4; ++e) { s1[e] = fr == 8 ? g1[e] : s1[e]; s2[e] = fr == 8 ? g2[e] : s2[e]; } }
                    c[3][bj] = cbv[bj] + w2[bj] * a3 + w1[bj] * a2 + w0[bj] * a1;
                    c[2][bj] = cbv[bj] + w2[bj] * a2 + w1[bj] * a1 + w0[bj] * a0;
                    c[1][bj] = cbv[bj] + w2[bj] * a1 + w1[bj] * a0 + w0[bj] * s1;
                    c[0][bj] = cbv[bj] + w2[bj] * a0 + w1[bj] * s1 + w0[bj] * s2; }
#pragma unroll
                for (int m = 0; m < 4; ++m) {
                    const int tr = ai * 128 + wr * 64 + 4 * fr + m, tok = tok0 + tr;
                    u32x2 w;
                    const f32x4 t_ = c[m][0]; f32x4 e_ = (f32x4){__builtin_amdgcn_exp2f(t_[0]), __builtin_amdgcn_exp2f(t_[1]), __builtin_amdgcn_exp2f(t_[2]), __builtin_amdgcn_exp2f(t_[3])};
                    e_ += 1.0f; const f32x4 r_ = (f32x4){__builtin_amdgcn_rcpf(e_[0]), __builtin_amdgcn_rcpf(e_[1]), __builtin_amdgcn_rcpf(e_[2]), __builtin_amdgcn_rcpf(e_[3])};
                    const f32x4 g_ = (t_ * c[m][1]) * r_;
                    w.x = cvt_pk_bf16(g_[0], g_[1]); w.y = cvt_pk_bf16(g_[2], g_[3]);
                    if (n == 0) wlo[ai][m] = w;
                    else if ((smp || tr >= 2) && tok < bend) { const u32x2 w0_ = wlo[ai][m]; st16_sel(G + (size_t)tok * FF + u.pn * 128 + cl, (u32x4){w0_.x, w0_.y, w.x, w.y}, !has_next); }
                }
            }
        }
        if (has_next) { rs_commit(lds, slot ^ 1, sn, tid); ct_commit(lds, slot ^ 1, cn, tid); }
    }
};

__device__ __forceinline__ float srs_load(const float* ssqs, int mt, int tid) { const int row = tid >> 4, jj = tid & 15; return ssqs[(size_t)jj * MS + mt * 32 + row] + ssqs[(size_t)(jj + 16) * MS + mt * 32 + row]; }
__device__ __forceinline__ float srs_finish(float s) { s = sum16(s); return 1.0f / sqrtf(s * (1.0f / D) + EPS); }

template <int K_, int NTN, class SEpi> struct SampleRider {
    static constexpr bool ON = true, SPLIT = SEpi::SPLIT; static constexpr int K = K_;
    const bf16_t* A; const bf16_t* Bt; SEpi epi;
    __device__ __forceinline__ void ptrs(int seq, int wid, const char*& pa, const char*& pb) const {
        const int mt = seq / NTN, nt = seq % NTN;
        pa = (const char*)(A + ((size_t)(MP + 32 * mt) * K + wid * (K / 8)));
        pb = (const char*)(Bt + ((size_t)(32 * nt) * K + wid * (K / 8)));
    }
    __device__ __forceinline__ void finish(const f32x16& racc, int seq, LAS unsigned char* lds, int tid0) const {
        int tid = tid0; asm volatile("" : "+v"(tid));
        const int lane = tid & 63, r32 = lane & 31, hi = lane >> 5, w = tid >> 6, mt = seq / NTN, nt = seq % NTN;
        const float pre = epi.pre(mt, nt, tid);
#define RSLOT(i) ((LAS float*)(lds + ((i) < 4 ? L_XBUF + (i) * 4096 : L_CTAB + ((i) - 4) * 4096)))
        if (w < 6) { LAS float* part = RSLOT(w);
#pragma unroll
            for (int r = 0; r < 16; ++r) part[crow(r, hi) * 32 + r32] = racc[r]; }
        RAW_BAR();
        if (w >= 6) { LAS float* part = RSLOT(w - 2);
#pragma unroll
            for (int r = 0; r < 16; ++r) part[crow(r, hi) * 32 + r32] += racc[r]; }
        RAW_BAR();
        const int row = tid >> 4, c0 = (tid & 15) * 2; f32x2 v = (f32x2){0.f, 0.f};
#pragma unroll
        for (int sl = 0; sl < 6; ++sl) v += *(const LAS f32x2*)(RSLOT(sl) + row * 32 + c0);
#undef RSLOT
        epi(mt, nt, row, c0, v.x, v.y, pre, tid);
    }
    __device__ __forceinline__ f32x2 finish_a(const f32x16& racc, int seq, LAS unsigned char* lds, int tid0) const {
        int tid = tid0; asm volatile("" : "+v"(tid));
        const int lane = tid & 63, r32 = lane & 31, hi = lane >> 5, w = tid >> 6, mt = seq / NTN, nt = seq % NTN;
        const float pre = epi.pre(mt, nt, tid);
#define RSLOT(i) ((LAS float*)(lds + ((i) < 4 ? L_XBUF + (i) * 4096 : L_CTAB + ((i) - 4) * 4096)))
        if (w < 6) { LAS float* part = RSLOT(w);
#pragma unroll
            for (int r = 0; r < 16; ++r) part[crow(r, hi) * 32 + r32] = racc[r]; }
        RAW_BAR();
        if (w >= 6) { LAS float* part = RSLOT(w - 2);
#pragma unroll
            for (int r = 0; r < 16; ++r) part[crow(r, hi) * 32 + r32] += racc[r]; }
        RAW_BAR();
        const int row = tid >> 4, c0 = (tid & 15) * 2; f32x2 v = (f32x2){0.f, 0.f};
#pragma unroll
        for (int sl = 0; sl < 6; ++sl) v += *(const LAS f32x2*)(RSLOT(sl) + row * 32 + c0);
#undef RSLOT
        return epi.pub(mt, nt, row, c0, v.x, v.y, pre, tid);
    }
    __device__ __forceinline__ void finish_b(const f32x2 parked, int seq, LAS unsigned char* lds, int tid0) const {
        int tid = tid0; asm volatile("" : "+v"(tid));
        const int mt = seq / NTN, nt = seq % NTN, row = tid >> 4, c0 = (tid & 15) * 2;
        epi.fin(mt, nt, row, c0, parked, tid);
    }
};
struct SQkv {   static constexpr bool SPLIT = false;
    const float* ssqs; bf16_t* QB; bf16_t* KB; bf16_t* VB; float* oks; float* ovs;
    __device__ __forceinline__ float pre(int mt, int, int tid) const { return srs_load(ssqs, mt, tid); }
    __device__ __forceinline__ void operator()(int mt, int nt, int row, int c0, float a0, float a1, float pre, int tid) const {
        const float r_ = srs_finish(pre); const int n = 32 * nt + c0, t = n >> 10, nn = n & 1023; const float v0 = a0 * r_, v1 = a1 * r_, sc = t == 0 ? C2 : 1.0f;
        bf16_t* dst = QB + (size_t)t * ((WS_K - WS_Q) / 2) + (size_t)(MP + 32 * mt + row) * D + nn; __hip_atomic_store((unsigned*)dst, cvt_pk_bf16(v0 * sc, v1 * sc), __ATOMIC_RELAXED, __HIP_MEMORY_SCOPE_AGENT);
        if (t >= 1) { float* o = oks + (size_t)(t - 1) * (O_VS - O_KS) + (size_t)(32 * mt + row) * D + nn; *(f32x2*)o = (f32x2){v0, v1}; }
    }
};
struct SRes {   static constexpr bool SPLIT = false;
    const bf16_t* XB; bf16_t* XO; float* ssqs;
    __device__ __forceinline__ float pre(int mt, int nt, int tid) const { return __uint_as_float(*(const unsigned*)(XB + (size_t)(MP + 32 * mt + (tid >> 4)) * D + 32 * nt + (tid & 15) * 2)); }
    __device__ __forceinline__ void operator()(int mt, int nt, int row, int c0, float a0, float a1, float pre, int tid) const {
        const size_t xo_ = (size_t)(MP + 32 * mt + row) * D + 32 * nt + c0; const unsigned bb = __float_as_uint(pre);
        const float v0 = bf2f(bb & 0xffffu) + a0, v1 = bf2f(bb >> 16) + a1; *(unsigned*)(XO + xo_) = cvt_pk_bf16(v0, v1);
        float s_ = v0 * v0 + v1 * v1; s_ = sum16(s_);
        if ((tid & 15) == 0) ssqs[(size_t)nt * MS + 32 * mt + row] = s_;
    }
};
struct SIn {   static constexpr bool SPLIT = false;
    const float* ssqs; bf16_t* UB; bf16_t* VB; float* ssqvs;
    __device__ __forceinline__ float pre(int mt, int, int tid) const { return srs_load(ssqs, mt, tid); }
    __device__ __forceinline__ void operator()(int mt, int nt, int row, int c0, float a0, float a1, float pre, int tid) const {
        const float r_ = srs_finish(pre); const int n = 32 * nt + c0, t = n >> 10, nn = n & 1023;
        const f32x2 z = gelu_pk((f32x2){a0 * r_, a1 * r_});
        __hip_atomic_store((unsigned*)(UB + (size_t)t * ((WS_K - WS_Q) / 2) + (size_t)(MP + 32 * mt + row) * D + nn), cvt_pk_bf16(z.x, z.y), __ATOMIC_RELAXED, __HIP_MEMORY_SCOPE_AGENT);
        if (t == 1) { float s_ = z.x * z.x + z.y * z.y; s_ = sum16(s_);
            if ((tid & 15) == 0) __hip_atomic_store(ssqvs + (size_t)(nt - 32) * MS + 32 * mt + row, s_, __ATOMIC_RELAXED, __HIP_MEMORY_SCOPE_AGENT); }
    }
};

struct SFin {
    static constexpr bool SPLIT = true;
    const bf16_t* XB; float* xchs; unsigned* cnt; const float* gfin; float* ys;
    __device__ __forceinline__ float pre(int mt, int nt, int tid) const { return __uint_as_float(*(const unsigned*)(XB + (size_t)(MP + 32 * mt + (tid >> 4)) * D + 32 * nt + (tid & 15) * 2)); }
    __device__ __forceinline__ void operator()(int, int, int, int, float, float, float, int) const {}
    __device__ __forceinline__ f32x2 pub(int mt, int nt, int row, int c0, float a0, float a1, float pre, int tid) const {
        const unsigned bb = __float_as_uint(pre);
        const float v0 = bf2f(bb & 0xffffu) + a0, v1 = bf2f(bb >> 16) + a1;
        float s_ = v0 * v0 + v1 * v1; s_ = sum16(s_);
        if ((tid & 15) == 0) __hip_atomic_store(xchs + (size_t)nt * MS + 32 * mt + row, s_, __ATOMIC_RELAXED, __HIP_MEMORY_SCOPE_AGENT);
        asm volatile("s_waitcnt vmcnt(0)" ::: "memory");
        RAW_BAR();
        if (tid == 0) __hip_atomic_fetch_add(cnt + 64 * mt, 1u, __ATOMIC_RELAXED, __HIP_MEMORY_SCOPE_AGENT);
        return (f32x2){v0, v1};
    }
    __device__ __forceinline__ void fin(int mt, int nt, int row, int c0, const f32x2 v, int tid) const {
        const int n = 32 * nt + c0;
        wait_count(cnt + 64 * mt, 32u, tid);
        const int jj = tid & 15; float t_ = __hip_atomic_load(xchs + (size_t)jj * MS + 32 * mt + row, __ATOMIC_RELAXED, __HIP_MEMORY_SCOPE_AGENT) + __hip_atomic_load(xchs + (size_t)(jj + 16) * MS + 32 * mt + row, __ATOMIC_RELAXED, __HIP_MEMORY_SCOPE_AGENT);
        t_ = sum16(t_);
        const float rs = 1.0f / sqrtf(t_ * (1.0f / D) + EPS);
        *(f32x2*)(ys + (size_t)(32 * mt + row) * D + n) = (f32x2){v.x * rs * gfin[n], v.y * rs * gfin[n + 1]};
    }
};

namespace att {
constexpr int NS = 6, SLOTB = 8192;
constexpr int L_K = 0, L_V = NS * SLOTB, L_OST = 2 * NS * SLOTB, L_BIAS = 131072, L_WSF = 132352, L_BIAS2 = 134400;
#define SBAR() __builtin_amdgcn_sched_barrier(0)
__device__ __forceinline__ void glds16(const void* gsrc, unsigned lds_dst) { unsigned keep;
    asm volatile("s_mov_b32 %0, m0\n\ts_mov_b32 m0, %2\n\ts_nop 0\n\tglobal_load_lds_dwordx4 %1, off\n\ts_mov_b32 m0, %0" : "=&s"(keep) : "v"(gsrc), "s"(lds_dst) : "memory"); }
#define WAIT_BAR(N) asm volatile("s_waitcnt vmcnt(" #N ") lgkmcnt(0)\n\ts_barrier" ::: "memory")

struct State { float m, l; f32x16 o[2]; };

__device__ __forceinline__ void tile(State& st, const bf16x8 (&qr)[4], unsigned kslot, unsigned vslot, float cinit, bool near, int base, bool mask1, const LAS float* tab, LAS float* wsf, int r32, int hi, int lane) {
    f32x16 p0, p1;
    { const LAS char* kb = (const LAS char*)(uintptr_t)kslot + hi * 1024 + r32 * 16;
        f32x16 ci;
#pragma unroll
        for (int r = 0; r < 16; ++r) ci[r] = cinit;
#pragma unroll
        for (int d0 = 0; d0 < 4; ++d0) { const bf16x8 b0 = *(const LAS bf16x8*)(kb + d0 * 2048), b1 = *(const LAS bf16x8*)(kb + d0 * 2048 + 512);
            if (d0 == 0) { p0 = __builtin_amdgcn_mfma_f32_32x32x16_bf16(b0, qr[0], ci, 0, 0, 0); p1 = __builtin_amdgcn_mfma_f32_32x32x16_bf16(b1, qr[0], ci, 0, 0, 0); }
            else { p0 = __builtin_amdgcn_mfma_f32_32x32x16_bf16(b0, qr[d0], p0, 0, 0, 0); p1 = __builtin_amdgcn_mfma_f32_32x32x16_bf16(b1, qr[d0], p1, 0, 0, 0); } } }
    if (near) {
#pragma unroll
        for (int r = 0; r < 16; ++r) { const LAS float* tb = tab + (319 - base) + 4 * hi; p0[r] += tb[(r & 3) + 8 * (r >> 2)]; p1[r] += tb[32 + (r & 3) + 8 * (r >> 2)]; } }
    if (mask1) {
#pragma unroll
        for (int r = 0; r < 16; ++r) p1[r] = -1e30f; }
    float rm = fmaxf(p0[0], p1[0]);
#pragma unroll
    for (int r = 1; r < 16; ++r) rm = fmaxf(rm, fmaxf(p0[r], p1[r]));
    rm = xmax32(rm);
    const float mn = fmaxf(st.m, rm);
    if (__any(mn > st.m)) {
        const float f = __builtin_amdgcn_exp2f(st.m - mn); st.l *= f; st.m = mn;
        if (hi == 0) wsf[r32] = f;
        LDS_WAIT();
#pragma unroll
        for (int g = 0; g < 4; ++g) { const f32x4 fv = *(const LAS f32x4*)(wsf + 8 * g + 4 * hi);
#pragma unroll
            for (int e = 0; e < 4; ++e) { st.o[0][4 * g + e] *= fv[e]; st.o[1][4 * g + e] *= fv[e]; } }
    }
    float sacc = 0.f;
#pragma unroll
    for (int r = 0; r < 16; ++r) { p0[r] = __builtin_amdgcn_exp2f(p0[r] - st.m); p1[r] = __builtin_amdgcn_exp2f(p1[r] - st.m); sacc += p0[r] + p1[r]; }
    st.l += sacc;
    u32x4 pw[4];
#pragma unroll
    for (int k = 0; k < 2; ++k) { pw[k] = (u32x4){cvt_pk_bf16(p0[8 * k], p0[8 * k + 1]), cvt_pk_bf16(p0[8 * k + 2], p0[8 * k + 3]), cvt_pk_bf16(p0[8 * k + 4], p0[8 * k + 5]), cvt_pk_bf16(p0[8 * k + 6], p0[8 * k + 7])};
        pw[2 + k] = (u32x4){cvt_pk_bf16(p1[8 * k], p1[8 * k + 1]), cvt_pk_bf16(p1[8 * k + 2], p1[8 * k + 3]), cvt_pk_bf16(p1[8 * k + 4], p1[8 * k + 5]), cvt_pk_bf16(p1[8 * k + 6], p1[8 * k + 7])}; }
    const int vb = (int)vslot + ((lane >> 4) & 1) * 32 + (lane & 3) * 8 + (4 * hi + ((lane & 15) >> 2)) * 64;
#pragma unroll
    for (int d0 = 0; d0 < 2; ++d0) { s16x4 lo[4], hh[4];
#pragma unroll
        for (int ks = 0; ks < 4; ++ks) {
            asm volatile("ds_read_b64_tr_b16 %0,%1 offset:%c2" : "=&v"(lo[ks]) : "v"(vb), "i"(d0 * 4096 + ks * 1024) : "memory");
            asm volatile("ds_read_b64_tr_b16 %0,%1 offset:%c2" : "=&v"(hh[ks]) : "v"(vb), "i"(d0 * 4096 + ks * 1024 + 512) : "memory"); }
        asm volatile("s_waitcnt lgkmcnt(0)" ::: "memory"); SBAR();
#pragma unroll
        for (int ks = 0; ks < 4; ++ks) { const bf16x8 vf = (bf16x8){lo[ks][0], lo[ks][1], lo[ks][2], lo[ks][3], hh[ks][0], hh[ks][1], hh[ks][2], hh[ks][3]};
            st.o[d0] = __builtin_amdgcn_mfma_f32_32x32x16_bf16(__builtin_bit_cast(bf16x8, pw[ks]), vf, st.o[d0], 0, 0, 0); }
    }
}

__device__ __forceinline__ void prompt_unit(int b, int h, int qg, const bf16_t* Q, const bf16_t* Kg, const bf16_t* Vg, bf16_t* O, LAS unsigned char* lds, const int tid0) {
    int tid = tid0; asm volatile("" : "+v"(tid));
    const int lane = tid & 63, r32 = lane & 31, hi = lane >> 5; const int wid = __builtin_amdgcn_readfirstlane(tid >> 6);
    const int c0 = 4 * qg, pj = wid >> 1, half = wid & 1; const long rowbase = (long)b * SEQ;
    const unsigned lds0 = (unsigned)(uintptr_t)lds;
    const LAS float* tab = (const LAS float*)(lds + L_BIAS); LAS float* wsf = (LAS float*)(lds + L_WSF) + wid * 64;
    const bf16_t* Qw = Q + (rowbase + 64 * (c0 + pj) + 32 * half) * D + h * HD;
    const bf16_t* Kh = Kg + rowbase * D + h * HD; const bf16_t* Vh = Vg + rowbase * D + h * HD;
#define DMA_T(i) do { int ck_ = c0 - 8 + (i); ck_ = ck_ < 0 ? 0 : ck_; const unsigned so_ = (unsigned)(((i) % NS) * SLOTB + wid * 1024); \
        glds16(Kh + (long)(64 * ck_ + lane) * D + wid * 8, (unsigned)__builtin_amdgcn_readfirstlane(lds0 + L_K + so_)); \
        glds16(Vh + (long)(64 * ck_ + 16 * (wid & 3) + (lane >> 2)) * D + (wid >> 2) * 32 + (lane & 3) * 8, (unsigned)__builtin_amdgcn_readfirstlane(lds0 + L_V + so_)); } while (0)
    DMA_T(0); DMA_T(1); DMA_T(2); DMA_T(3); DMA_T(4);
    bf16x8 qr[4];
#pragma unroll
    for (int d0 = 0; d0 < 4; ++d0) qr[d0] = *(const bf16x8*)(Qw + (long)r32 * D + d0 * 16 + hi * 8);
    State st; st.m = -1e30f; st.l = 0.f;
#pragma unroll
    for (int r = 0; r < 16; ++r) { st.o[0][r] = 0.f; st.o[1][r] = 0.f; }
    const float cfar = tab[63];
    const int ql = 32 * half + r32;
    for (int s = 0; s < 9; ++s) {
        if (s == 0) { WAIT_BAR(0); asm volatile("" : "+v"(qr[0]), "+v"(qr[1]), "+v"(qr[2]), "+v"(qr[3])); }
        else if (s < 8) WAIT_BAR(2); else WAIT_BAR(0);
        if (s + 5 < 12) DMA_T(s + 5);
        const int ck = c0 - 8 + s + pj;
        if (ck >= 0) { const int sl = (s + pj) % NS; const bool near = s >= 6;
            tile(st, qr, lds0 + L_K + sl * SLOTB, lds0 + L_V + sl * SLOTB, near ? 0.f : cfar, near, 64 * (8 - s) + ql + 128, false, tab, wsf, r32, hi, lane); }
    }
#undef DMA_T
    float l = xsum32(st.l);
    if (hi == 0) wsf[32 + r32] = l;
    LDS_WAIT();
    float rli[16];
#pragma unroll
    for (int r = 0; r < 16; ++r) rli[r] = __builtin_amdgcn_rcpf(wsf[32 + crow(r, hi)]);
    bf16_t* Ow = O + (rowbase + 64 * (c0 + pj) + 32 * half) * D + h * HD;
    { LAS bf16_t* stg = (LAS bf16_t*)(lds + L_OST) + wid * 2048;
#pragma unroll
        for (int r = 0; r < 16; ++r) { const int orow = crow(r, hi);
#pragma unroll
            for (int d0 = 0; d0 < 2; ++d0) stg[orow * 64 + d0 * 32 + r32] = (bf16_t)(cvt_pk_bf16(st.o[d0][r] * rli[r], 0.f) & 0xffffu); }
        LDS_WAIT();
#pragma unroll
        for (int i = 0; i < 4; ++i) { const int row = i * 8 + (lane >> 3), ch = lane & 7; const u32x4 v = *(const LAS u32x4*)(stg + row * 64 + ch * 8); st16_wt(Ow + (long)row * D + ch * 8, v); } }
    asm volatile("s_waitcnt lgkmcnt(0)\n\ts_barrier" ::: "memory");
}

typedef const LAS char* lds_cptr;
typedef short v4i16_t __attribute__((ext_vector_type(4)));
__device__ __forceinline__ void kload8(bf16x8* kf, lds_cptr kp) {
    kf[0] = *(const LAS bf16x8*)(kp);        kf[1] = *(const LAS bf16x8*)(kp + 512);
    kf[2] = *(const LAS bf16x8*)(kp + 2048); kf[3] = *(const LAS bf16x8*)(kp + 2560);
    kf[4] = *(const LAS bf16x8*)(kp + 4096); kf[5] = *(const LAS bf16x8*)(kp + 4608);
    kf[6] = *(const LAS bf16x8*)(kp + 6144); kf[7] = *(const LAS bf16x8*)(kp + 6656);
}
__device__ __forceinline__ void kload2(bf16x8* kf, lds_cptr kp, int j) { kf[2 * j] = *(const LAS bf16x8*)(kp + j * 2048); kf[2 * j + 1] = *(const LAS bf16x8*)(kp + j * 2048 + 512); }
__device__ __forceinline__ s16x4 vtr(lds_cptr p) { return __builtin_bit_cast(s16x4, __builtin_amdgcn_ds_read_tr16_b64_v4i16((LAS v4i16_t*)p)); }
__device__ __forceinline__ float max3f(float a, float b, float c) { float r; asm("v_max3_f32 %0, %1, %2, %3" : "=v"(r) : "v"(a), "v"(b), "v"(c)); return r; }
__device__ __forceinline__ float max2f(float a, float b) { float r; asm("v_max_f32_e32 %0, %1, %2" : "=v"(r) : "v"(a), "v"(b)); return r; }
__device__ __forceinline__ float fadd_s(float a, float b) { float r; asm("v_add_f32_e32 %0, %1, %2" : "=v"(r) : "v"(a), "v"(b)); return r; }
__device__ __forceinline__ float fsub_s(float a, float b) { float r; asm("v_sub_f32_e32 %0, %1, %2" : "=v"(r) : "v"(a), "v"(b)); return r; }
typedef float f32x2_t __attribute__((ext_vector_type(2))); typedef __bf16 bf16x2_t __attribute__((ext_vector_type(2)));
__device__ __forceinline__ unsigned cvtpk_s(float lo, float hi) { f32x2_t v = {lo, hi}; bf16x2_t b = __builtin_convertvector(v, bf16x2_t); return __builtin_bit_cast(unsigned, b); }
#define WAIT_BAR2(N) asm volatile("s_waitcnt vmcnt(" #N ") lgkmcnt(0)\n\ts_barrier" ::: "memory")

template <int THRL>
__device__ __forceinline__ void prompt_unit_fast(int b, int h, int qg, const int nun, const bf16_t* Q, const bf16_t* Kg, const bf16_t* Vg, bf16_t* O, LAS unsigned char* lds, const int tid) {
    const int wid = __builtin_amdgcn_readfirstlane(tid >> 6);
    const int c0 = 4 * qg, pj = wid >> 1, half = wid & 1; const long rowbase = (long)b * SEQ;
    const unsigned lds0 = (unsigned)(uintptr_t)lds;
    const LAS float* tab = (const LAS float*)(lds + L_BIAS); const LAS float* tab2 = (const LAS float*)(lds + L_BIAS2);
    const bf16_t* Qw = Q + (rowbase + 64 * (c0 + pj) + 32 * half) * D + h * HD;
    const bf16_t* Kh = Kg + (rowbase + 64 * (c0 - 8)) * D + h * HD; const bf16_t* Vh = Vg + (rowbase + 64 * (c0 - 8)) * D + h * HD;
#define SLOT(i) ((unsigned)(((i) % NS) * SLOTB))
#define DMA_K(i) glds16(ksrc + uo + (long)(i) * 64 * D, (unsigned)__builtin_amdgcn_readfirstlane(lds0 + L_K + SLOT(i) + wid * 1024))
#define DMA_V(i) glds16(vsrc + uo + (long)(i) * 64 * D, (unsigned)__builtin_amdgcn_readfirstlane(lds0 + L_V + SLOT(i) + wid * 1024))
#define DMA_KN(i) glds16(ksrc + uo + (long)((i) + 4) * 64 * D, (unsigned)__builtin_amdgcn_readfirstlane(lds0 + L_K + SLOT(i) + wid * 1024))
#define DMA_VN(i) glds16(vsrc + uo + (long)((i) + 4) * 64 * D, (unsigned)__builtin_amdgcn_readfirstlane(lds0 + L_V + SLOT(i) + wid * 1024))
    bf16x8 qr[4];
    const float cfar = tab[63];
#pragma unroll 1
  for (int un = 0; un < nun; ++un) {
    const bool more = un + 1 < nun; const long uo = (long)un * 256 * D;
    int tl_ = tid; asm volatile("" : "+v"(tl_));
    const int lane = tl_ & 63, r32 = lane & 31, hi = lane >> 5;
    LAS float* wsf = (LAS float*)(lds + L_WSF) + wid * 64;
    const bf16_t* ksrc = Kh + (long)lane * D + wid * 8;
    const bf16_t* vsrc = Vh + (long)(16 * (wid & 3) + (lane >> 2)) * D + (wid >> 2) * 32 + (lane & 3) * 8;
    const lds_cptr kp0 = (lds_cptr)lds + L_K + hi * 1024 + r32 * 16;
    const lds_cptr vp0 = (lds_cptr)lds + L_V + ((lane >> 4) & 1) * 32 + (lane & 3) * 8 + (4 * hi + ((lane & 15) >> 2)) * 64;
    const int ql = 32 * half + r32;
    if (un == 0) { DMA_K(0); DMA_K(1); DMA_K(2); DMA_K(3); DMA_K(4); DMA_K(5); DMA_V(0); DMA_V(1); DMA_V(2); DMA_V(3);
#pragma unroll
        for (int d0 = 0; d0 < 4; ++d0) qr[d0] = *(const bf16x8*)(Qw + (long)r32 * D + d0 * 16 + hi * 8); }
    float mhat = 0.f, l_reg = 0.f; f32x16 o[2];
#pragma unroll
    for (int r = 0; r < 16; ++r) { o[0][r] = 0.f; o[1][r] = 0.f; }
    f32x16 negm;
#pragma unroll
    for (int r = 0; r < 16; ++r) negm[r] = cfar;
    asm volatile("" : "+v"(negm));
    bf16x8 kf[8];
    if (un == 0) WAIT_BAR2(0); else WAIT_BAR2(3);
    asm volatile("" : "+v"(qr[0]), "+v"(qr[1]), "+v"(qr[2]), "+v"(qr[3]));
    kload8(kf, kp0 + SLOT(pj));
    if (un == 0) WAIT_BAR2(0); else WAIT_BAR2(3);
    bool resc = false;
    f32x16 pA0, pA1, pB0, pB1;
    s16x4 vlo[8], vhi[8]; u32x4 pw0, pw1, pw2, pw3;
#define PKW(P, B) cvtpk_s(P[B], P[B + 1])
#define PAF(k) __builtin_bit_cast(bf16x8, pw##k)
#define VFR(i) (bf16x8){vlo[i][0], vlo[i][1], vlo[i][2], vlo[i][3], vhi[i][0], vhi[i][1], vhi[i][2], vhi[i][3]}
#define PIN(x) asm volatile("" : "+v"(x))
#define MX3(a, b, c) __builtin_fmaxf(__builtin_fmaxf((a), (b)), (c))
#define MF(a, b, c) __builtin_amdgcn_mfma_f32_32x32x16_bf16(a, b, c, 0, 0, 0)
#define GAPA(MFX, A0, A1, A2, A3, W0, W1, PW) do { MFX; sacc += A0; sacc += A1; sacc += A2; sacc += A3; PIN(sacc); W0; W1; PIN(PW); SBAR(); } while (0)
#define EX(v) __builtin_amdgcn_exp2f(v)
#define GAPB(MFX, X, B) do { MFX; X[B] = EX(X[B]); X[B + 1] = EX(X[B + 1]); X[B + 2] = EX(X[B + 2]); X[B + 3] = EX(X[B + 3]); PIN(X); SBAR(); } while (0)
#define VRD(i) do { vlo[i] = vtr(vp_ + (((i) >> 2) * 4096 + ((i) & 3) * 1024)); vhi[i] = vtr(vp_ + (((i) >> 2) * 4096 + ((i) & 3) * 1024 + 512)); } while (0)
#define KRD(GL, j) do { if (GL) { kload2(kf, kn_, j); SBAR(); } } while (0)
#define NEARB(C0, C1, s) do { if ((s) >= 6) { const LAS float* tb_ = tab2 + (319 - (64 * (8 - (s)) + ql + 128)) + 4 * hi; \
        _Pragma("unroll") for (int r = 0; r < 16; ++r) { C0[r] += tb_[(r & 3) + 8 * (r >> 2)]; C1[r] += tb_[32 + (r & 3) + 8 * (r >> 2)]; } } } while (0)
#define DECIDE(C0, C1) do { float a_ = MX3(C0[0], C0[1], C1[0]), b_ = MX3(C0[2], C0[3], C1[1]); a_ = MX3(a_, C1[2], C1[3]); \
        _Pragma("unroll") for (int r = 4; r < 16; r += 4) { a_ = MX3(a_, C0[r], C0[r + 1]); b_ = MX3(b_, C0[r + 2], C0[r + 3]); a_ = MX3(a_, C1[r], C1[r + 1]); b_ = MX3(b_, C1[r + 2], C1[r + 3]); } \
        float rm_ = __builtin_fmaxf(a_, b_); rm_ = xmax32(rm_); \
        resc = false; \
        if (__builtin_expect(__any(rm_ > (float)THRL), 0)) { const float dl_ = __builtin_fmaxf(rm_, 0.f); mhat += dl_; \
            _Pragma("unroll") for (int r = 0; r < 16; ++r) { C0[r] -= dl_; C1[r] -= dl_; } \
            _Pragma("unroll") for (int r = 0; r < 16; ++r) negm[r] = cfar - mhat; asm volatile("" : "+v"(negm)); \
            const float f_ = __builtin_amdgcn_exp2f(-dl_); l_reg *= f_; if (hi == 0) wsf[r32] = f_; resc = true; } } while (0)
#define RESC() do { if (resc) { asm volatile("s_waitcnt lgkmcnt(0)" ::: "memory"); \
        _Pragma("unroll") for (int g_ = 0; g_ < 4; ++g_) { const f32x4 fv_ = *(const LAS f32x4*)(wsf + 8 * g_ + 4 * hi); \
            _Pragma("unroll") for (int e_ = 0; e_ < 4; ++e_) { o[0][4 * g_ + e_] *= fv_[e_]; o[1][4 * g_ + e_] *= fv_[e_]; } } } } while (0)
#define STEP(C0, C1, P0, P1, t, GK, GV, GL) do { SBAR(); \
        const lds_cptr vp_ = vp0 + SLOT((t) - 1 + pj); const lds_cptr kn_ = kp0 + SLOT((t) + 1 + pj); \
        VRD(0); SBAR(); float sacc = (P0[0] + P0[1]); \
        GAPA(C0 = MF(kf[0], qr[0], negm), P0[2], P0[3], P0[4], P0[5],     pw0[0] = PKW(P0, 0), pw0[1] = PKW(P0, 2), pw0); \
        VRD(4); SBAR(); GAPA(C1 = MF(kf[1], qr[0], negm), P0[6], P0[7], P0[8], P0[9],     pw0[2] = PKW(P0, 4), pw0[3] = PKW(P0, 6), pw0); \
        VRD(1); SBAR(); GAPA(C0 = MF(kf[2], qr[1], C0),   P0[10], P0[11], P0[12], P0[13], pw1[0] = PKW(P0, 8), pw1[1] = PKW(P0, 10), pw1); \
        VRD(5); SBAR(); GAPA(C1 = MF(kf[3], qr[1], C1),   P0[14], P0[15], P1[0], P1[1],   pw1[2] = PKW(P0, 12), pw1[3] = PKW(P0, 14), pw1); \
        VRD(2); SBAR(); GAPA(C0 = MF(kf[4], qr[2], C0),   P1[2], P1[3], P1[4], P1[5],     pw2[0] = PKW(P1, 0), pw2[1] = PKW(P1, 2), pw2); \
        VRD(6); SBAR(); GAPA(C1 = MF(kf[5], qr[2], C1),   P1[6], P1[7], P1[8], P1[9],     pw2[2] = PKW(P1, 4), pw2[3] = PKW(P1, 6), pw2); \
        VRD(3); SBAR(); GAPA(C0 = MF(kf[6], qr[3], C0),   P1[10], P1[11], P1[12], P1[13], pw3[0] = PKW(P1, 8), pw3[1] = PKW(P1, 10), pw3); \
        VRD(7); SBAR(); GAPA(C1 = MF(kf[7], qr[3], C1),   P1[14], P1[15], 0.f, 0.f,       pw3[2] = PKW(P1, 12), pw3[3] = PKW(P1, 14), pw3); \
        l_reg += sacc; \
        if (GK) { DMA_K((t) + 6); } if (GV) { DMA_V((t) + 4); } \
        NEARB(C0, C1, t); \
        DECIDE(C0, C1); \
        SBAR(); \
        GAPB(o[0] = MF(PAF(0), VFR(0), o[0]), C0, 0); \
        GAPB(o[1] = MF(PAF(0), VFR(4), o[1]), C0, 4); \
        KRD(GL, 0); GAPB(o[0] = MF(PAF(1), VFR(1), o[0]), C0, 8); \
        KRD(GL, 1); GAPB(o[1] = MF(PAF(1), VFR(5), o[1]), C0, 12); \
        KRD(GL, 2); GAPB(o[0] = MF(PAF(2), VFR(2), o[0]), C1, 0); \
        KRD(GL, 3); GAPB(o[1] = MF(PAF(2), VFR(6), o[1]), C1, 4); \
        GAPB(o[0] = MF(PAF(3), VFR(3), o[0]), C1, 8); \
        GAPB(o[1] = MF(PAF(3), VFR(7), o[1]), C1, 12); \
    } while (0)
    DMA_K(6); DMA_V(4);
    {
#pragma unroll
        for (int d0 = 0; d0 < 4; ++d0) {
            if (d0 == 0) { pA0 = MF(kf[0], qr[0], negm); pA1 = MF(kf[1], qr[0], negm); }
            else { pA0 = MF(kf[2 * d0], qr[d0], pA0); pA1 = MF(kf[2 * d0 + 1], qr[d0], pA1); } }
        float rm = fmaxf(pA0[0], pA1[0]);
#pragma unroll
        for (int r = 1; r < 16; ++r) rm = fmaxf(rm, fmaxf(pA0[r], pA1[r]));
        rm = xmax32(rm);
        mhat = rm;
#pragma unroll
        for (int r = 0; r < 16; ++r) { pA0[r] = __builtin_amdgcn_exp2f(pA0[r] - rm); pA1[r] = __builtin_amdgcn_exp2f(pA1[r] - rm); }
#pragma unroll
        for (int r = 0; r < 16; ++r) negm[r] = cfar - mhat;
        asm volatile("" : "+v"(negm));
    }
    kload8(kf, kp0 + SLOT(1 + pj));
    WAIT_BAR2(2);
    STEP(pB0, pB1, pA0, pA1, 1, true, true, true);   WAIT_BAR2(2); RESC();
    STEP(pA0, pA1, pB0, pB1, 2, true, true, true);   WAIT_BAR2(2); RESC();
    STEP(pB0, pB1, pA0, pA1, 3, true, true, true);   WAIT_BAR2(2); RESC();
    STEP(pA0, pA1, pB0, pB1, 4, true, true, true);   WAIT_BAR2(2); RESC();
    STEP(pB0, pB1, pA0, pA1, 5, true, true, true);   WAIT_BAR2(2); RESC();
    STEP(pA0, pA1, pB0, pB1, 6, false, true, true);  WAIT_BAR2(1); RESC();
    STEP(pB0, pB1, pA0, pA1, 7, false, true, true);  WAIT_BAR2(1); RESC();
    if (more) { DMA_KN(0); DMA_KN(1); DMA_KN(2); DMA_KN(3); DMA_KN(4); DMA_KN(5); DMA_VN(0); }
    STEP(pA0, pA1, pB0, pB1, 8, false, false, false); WAIT_BAR2(0); RESC();
    if (more) {
#pragma unroll
        for (int d0 = 0; d0 < 4; ++d0) qr[d0] = *(const bf16x8*)(Qw + uo + (long)(256 + r32) * D + d0 * 16 + hi * 8); }
    { float sacc = pA0[0] + pA0[1];
#pragma unroll
        for (int r = 2; r < 16; ++r) sacc += pA0[r];
#pragma unroll
        for (int r = 0; r < 16; ++r) sacc += pA1[r];
        l_reg += sacc;
        pw0 = (u32x4){PKW(pA0, 0), PKW(pA0, 2), PKW(pA0, 4), PKW(pA0, 6)}; pw1 = (u32x4){PKW(pA0, 8), PKW(pA0, 10), PKW(pA0, 12), PKW(pA0, 14)};
        pw2 = (u32x4){PKW(pA1, 0), PKW(pA1, 2), PKW(pA1, 4), PKW(pA1, 6)}; pw3 = (u32x4){PKW(pA1, 8), PKW(pA1, 10), PKW(pA1, 12), PKW(pA1, 14)};
        SBAR();
        const int vb = (int)(lds0 + L_V + SLOT(8 + pj)) + ((lane >> 4) & 1) * 32 + (lane & 3) * 8 + (4 * hi + ((lane & 15) >> 2)) * 64;
#pragma unroll
        for (int d0 = 0; d0 < 2; ++d0) { s16x4 lo[4], hh[4];
#pragma unroll
            for (int ks = 0; ks < 4; ++ks) {
                asm volatile("ds_read_b64_tr_b16 %0,%1 offset:%c2" : "=&v"(lo[ks]) : "v"(vb), "i"(d0 * 4096 + ks * 1024) : "memory");
                asm volatile("ds_read_b64_tr_b16 %0,%1 offset:%c2" : "=&v"(hh[ks]) : "v"(vb), "i"(d0 * 4096 + ks * 1024 + 512) : "memory"); }
            asm volatile("s_waitcnt lgkmcnt(0)" ::: "memory"); SBAR();
            o[d0] = MF(PAF(0), ((bf16x8){lo[0][0], lo[0][1], lo[0][2], lo[0][3], hh[0][0], hh[0][1], hh[0][2], hh[0][3]}), o[d0]);
            o[d0] = MF(PAF(1), ((bf16x8){lo[1][0], lo[1][1], lo[1][2], lo[1][3], hh[1][0], hh[1][1], hh[1][2], hh[1][3]}), o[d0]);
            o[d0] = MF(PAF(2), ((bf16x8){lo[2][0], lo[2][1], lo[2][2], lo[2][3], hh[2][0], hh[2][1], hh[2][2], hh[2][3]}), o[d0]);
            o[d0] = MF(PAF(3), ((bf16x8){lo[3][0], lo[3][1], lo[3][2], lo[3][3], hh[3][0], hh[3][1], hh[3][2], hh[3][3]}), o[d0]); } }
    { float l = xsum32(l_reg);
        if (hi == 0) wsf[32 + r32] = l;
        LDS_WAIT();
        float rli[16];
#pragma unroll
        for (int r = 0; r < 16; ++r) rli[r] = __builtin_amdgcn_rcpf(wsf[32 + crow(r, hi)]);
        bf16_t* Ow = O + uo + (rowbase + 64 * (c0 + pj) + 32 * half) * D + h * HD;
        LAS bf16_t* stg = (LAS bf16_t*)(lds + L_OST) + wid * 2048;
#pragma unroll
        for (int r = 0; r < 16; ++r) { const int orow = crow(r, hi);
#pragma unroll
            for (int d0 = 0; d0 < 2; ++d0) stg[orow * 64 + d0 * 32 + r32] = (bf16_t)(cvt_pk_bf16(o[d0][r] * rli[r], 0.f) & 0xffffu); }
        LDS_WAIT();
#pragma unroll
        for (int i = 0; i < 4; ++i) { const int row = i * 8 + (lane >> 3), ch = lane & 7; const u32x4 v = *(const LAS u32x4*)(stg + row * 64 + ch * 8); st16_wt(Ow + (long)row * D + ch * 8, v); } }
    asm volatile("s_waitcnt lgkmcnt(0)\n\ts_barrier" ::: "memory");
    if (more) { DMA_VN(1); DMA_VN(2); DMA_VN(3); }
  }
#undef SLOT
#undef DMA_K
#undef DMA_V
#undef DMA_KN
#undef DMA_VN
#undef PKW
#undef PAF
#undef VFR
#undef PIN
#undef MX3
#undef MF
#undef GAPA
#undef EX
#undef GAPB
#undef VRD
#undef KRD
#undef NEARB
#undef DECIDE
#undef RESC
#undef STEP
}
#undef WAIT_BAR2

__device__ __forceinline__ void sample_unit(int b, int h, const bf16_t* Q, const bf16_t* Kg, const bf16_t* Vg, const float* CKf, const float* CVf, bf16_t* O, LAS unsigned char* lds, const int tid0) {
    int tid = tid0; asm volatile("" : "+v"(tid));
    const int lane = tid & 63, r32 = lane & 31, hi = lane >> 5; const int wid = __builtin_amdgcn_readfirstlane(tid >> 6);
    const unsigned lds0 = (unsigned)(uintptr_t)lds;
    const LAS float* tab = (const LAS float*)(lds + L_BIAS); LAS float* wsf = (LAS float*)(lds + L_WSF) + wid * 64;
    const long srow = (long)MP + 32 * b;
    const bf16_t* Qw = Q + srow * D + h * HD;
    const unsigned ks = lds0 + wid * 16384, vs = ks + 8192;
    const unsigned ks9 = lds0 + 136192;
    if (wid == 0) {
        const bf16_t* Kn = Kg + srow * D + h * HD; const bf16_t* Vn = Vg + srow * D + h * HD;
#pragma unroll
        for (int p = 0; p < 8; ++p) { const int kr = lane < 32 ? lane : 31; const int vr0 = 16 * (p & 3) + (lane >> 2), vr = vr0 < 32 ? vr0 : 31;
            glds16(Kn + (long)kr * D + p * 8, (unsigned)__builtin_amdgcn_readfirstlane(ks9 + p * 1024));
            glds16(Vn + (long)vr * D + (p >> 2) * 32 + (lane & 3) * 8, (unsigned)__builtin_amdgcn_readfirstlane(ks9 + 8192 + p * 1024)); } }
    { const float* Kc = CKf + ((long)b * CA + 64 * wid) * D + h * HD; const float* Vc = CVf + ((long)b * CA + 64 * wid) * D + h * HD;
        LAS unsigned char* kl = lds + wid * 16384; LAS unsigned char* vl = kl + 8192;
        f32x4 t[16], u[16];
#pragma unroll
        for (int i = 0; i < 16; ++i) t[i] = *(const f32x4*)(Kc + (long)(4 * i + (lane >> 4)) * D + (lane & 15) * 4);
#pragma unroll
        for (int i = 0; i < 16; ++i) u[i] = *(const f32x4*)(Vc + (long)(4 * i + (lane >> 4)) * D + (lane & 15) * 4);
        { const int c = lane & 15, rq = lane >> 4;
            LAS unsigned char* kd = kl + (c >> 1) * 1024 + (c & 1) * 8;
            LAS unsigned char* vd = vl + (c >> 3) * 4096 + (((c >> 1) & 3) * 16) + (c & 1) * 8;
#pragma unroll
            for (int i = 0; i < 16; ++i) { const int row = 4 * i + rq;
                u32x2 w; w.x = cvt_pk_bf16(t[i][0], t[i][1]); w.y = cvt_pk_bf16(t[i][2], t[i][3]); *(LAS u32x2*)(kd + row * 16) = w; }
#pragma unroll
            for (int i = 0; i < 16; ++i) { const int r16 = 4 * (i & 3) + rq;
                u32x2 w; w.x = cvt_pk_bf16(u[i][0], u[i][1]); w.y = cvt_pk_bf16(u[i][2], u[i][3]); *(LAS u32x2*)(vd + (i >> 2) * 1024 + r16 * 64) = w; } } }
    bf16x8 qr[4];
#pragma unroll
    for (int d0 = 0; d0 < 4; ++d0) qr[d0] = *(const bf16x8*)(Qw + (long)r32 * D + d0 * 16 + hi * 8);
    State st; st.m = -1e30f; st.l = 0.f;
#pragma unroll
    for (int r = 0; r < 16; ++r) { st.o[0][r] = 0.f; st.o[1][r] = 0.f; }
    asm volatile("s_waitcnt vmcnt(0) lgkmcnt(0)" ::: "memory"); asm volatile("" : "+v"(qr[0]), "+v"(qr[1]), "+v"(qr[2]), "+v"(qr[3]));
    { const bool near = wid >= 6; tile(st, qr, ks, vs, near ? 0.f : tab[63], near, r32 + 512 - 64 * wid + 128, false, tab, wsf, r32, hi, lane); }
    if (wid == 0) tile(st, qr, ks9, ks9 + 8192, 0.f, true, r32 + 128, true, tab, wsf, r32, hi, lane);
    const float l = xsum32(st.l);
    asm volatile("s_waitcnt lgkmcnt(0)\n\ts_barrier" ::: "memory");
    LAS float* OP = (LAS float*)lds;
    LAS float* MLp = (LAS float*)(lds + 65536);
#pragma unroll
    for (int r = 0; r < 16; ++r) { const int q = crow(r, hi); OP[(wid * 32 + q) * 64 + r32] = st.o[0][r]; OP[(wid * 32 + q) * 64 + 32 + r32] = st.o[1][r]; }
    if (hi == 0) { MLp[wid * 32 + r32] = st.m; MLp[256 + wid * 32 + r32] = l; }
    __syncthreads();
    { const int q = tid >> 4, d4 = (tid & 15) * 4; float mg = -1e30f;
#pragma unroll
        for (int w = 0; w < 8; ++w) mg = fmaxf(mg, MLp[w * 32 + q]);
        f32x4 num = (f32x4){0.f, 0.f, 0.f, 0.f}; float den = 0.f;
#pragma unroll
        for (int w = 0; w < 8; ++w) { const float f = __builtin_amdgcn_exp2f(MLp[w * 32 + q] - mg); den += f * MLp[256 + w * 32 + q]; num += *(const LAS f32x4*)(OP + (w * 32 + q) * 64 + d4) * f; }
        const float rd = 1.0f / den; u32x2 w2; w2.x = cvt_pk_bf16(num[0] * rd, num[1] * rd); w2.y = cvt_pk_bf16(num[2] * rd, num[3] * rd);
        __hip_atomic_store((unsigned long long*)(O + (srow + q) * D + h * HD + d4), (unsigned long long)w2.x | ((unsigned long long)w2.y << 32), __ATOMIC_RELAXED, __HIP_MEMORY_SCOPE_AGENT); }
    __syncthreads();
}
#undef WAIT_BAR
}

namespace gate {
constexpr int L_VS = 0, L_STG = 32768, L_RV = 98304;
__device__ __forceinline__ void unit(bool wt_last, bool sample, int nb, int gp, const bf16_t* U, bf16_t* Og, const bf16_t* Vv, const float* ssqv, const float* ssqvs, const float* vgain, const bf16_t* wsb, const float* bsp, float* ogv, LAS unsigned char* lds, const int tid) {
    const int lane = tid & 63, r32 = lane & 31, hi = lane >> 5; const int wid = __builtin_amdgcn_readfirstlane(tid >> 6);
    const long tok0 = sample ? (long)MP + 32 * nb : (long)128 * nb; const int nrows = sample ? 32 : 128;
    const int gi = wid >> 2, pb = wid & 3, g = 2 * gp + gi; const bool act = pb * 32 < nrows; const int nks = sample ? 2 : (pb < 2 ? 4 : 8);
    bf16x8 pa[8]; f32x4 bq[4]; u32x4 uu[4];
    if (act) { const bf16x8* wp = (const bf16x8*)wsb + ((size_t)(g * 128 + 32 * pb + r32) * 8) * 2 + hi;
#pragma unroll
        for (int ks = 0; ks < 8; ++ks) pa[ks] = wp[ks * 2];
#pragma unroll
        for (int gq = 0; gq < 4; ++gq) bq[gq] = *(const f32x4*)(bsp + g * 128 + 32 * pb + 8 * gq + 4 * hi);
#pragma unroll
        for (int i = 0; i < 4; ++i) uu[i] = *(const u32x4*)(U + (size_t)(tok0 + 32 * pb + i * 8 + (lane >> 3)) * D + 64 * g + (lane & 7) * 8); }
    LAS float* rv = (LAS float*)(lds + L_RV);
    if (!sample) { if (tid < 128) { const long t = tok0 + tid; const float s = (ssqv[t] + ssqv[MT + t]) + (ssqv[2 * MT + t] + ssqv[3 * MT + t]); rv[tid] = 1.0f / sqrtf(s * (1.0f / D) + EPS); } }
    else { const int row = tid >> 4, jj = tid & 15; float s = ssqvs[(size_t)jj * MS + nb * 32 + row] + ssqvs[(size_t)(jj + 16) * MS + nb * 32 + row];
        s = sum16(s); if (jj == 0) rv[row] = 1.0f / sqrtf(s * (1.0f / D) + EPS); }
    u32x4 raw[4]; f32x4 g0[4], g1[4];
#pragma unroll
    for (int i = 0; i < 4; ++i) { const int pi = wid + 8 * i, gi2 = pi >> 4, qt = (pi >> 3) & 1, dh = (pi >> 2) & 1, rg = pi & 3;
        const int row = 64 * qt + 16 * rg + (lane >> 2), col = 64 * (2 * gp + gi2) + 32 * dh + 8 * (lane & 3);
        const int rowc = row < nrows ? row : nrows - 1;
        raw[i] = *(const u32x4*)(Vv + (tok0 + rowc) * D + col); g0[i] = *(const f32x4*)(vgain + col); g1[i] = *(const f32x4*)(vgain + col + 4); }
    __syncthreads();
#pragma unroll
    for (int i = 0; i < 4; ++i) { const int pi = wid + 8 * i, gi2 = pi >> 4, qt = (pi >> 3) & 1, dh = (pi >> 2) & 1, rg = pi & 3;
        const int row = 64 * qt + 16 * rg + (lane >> 2), col = 64 * (2 * gp + gi2) + 32 * dh + 8 * (lane & 3);
        if (row < nrows) { const float rs = rv[row]; const u32x4 rw = raw[i];
            float f[8]; f[0] = bf2f(rw.x & 0xffffu) * rs * g0[i][0]; f[1] = bf2f(rw.x >> 16) * rs * g0[i][1]; f[2] = bf2f(rw.y & 0xffffu) * rs * g0[i][2]; f[3] = bf2f(rw.y >> 16) * rs * g0[i][3];
            f[4] = bf2f(rw.z & 0xffffu) * rs * g1[i][0]; f[5] = bf2f(rw.z >> 16) * rs * g1[i][1]; f[6] = bf2f(rw.w & 0xffffu) * rs * g1[i][2]; f[7] = bf2f(rw.w >> 16) * rs * g1[i][3];
            u32x4 w; w.x = cvt_pk_bf16(f[0], f[1]); w.y = cvt_pk_bf16(f[2], f[3]); w.z = cvt_pk_bf16(f[4], f[5]); w.w = cvt_pk_bf16(f[6], f[7]);
            *(LAS u32x4*)(lds + L_VS + (gi2 * 2 + qt) * 8192 + (dh * 4 + rg) * 1024 + lane * 16) = w;
            if (sample) { float* o = ogv + (size_t)(nb * 32 + row) * D + col; *(f32x4*)o = (f32x4){f[0], f[1], f[2], f[3]}; *(f32x4*)(o + 4) = (f32x4){f[4], f[5], f[6], f[7]}; } } }
    __syncthreads();
    if (act) {
        f32x16 o[2];
#pragma unroll
        for (int r = 0; r < 16; ++r) { o[0][r] = 0.f; o[1][r] = 0.f; }
        const unsigned lds0 = (unsigned)(uintptr_t)lds;
#pragma unroll
        for (int ks = 0; ks < 8; ++ks) if (ks < nks) {
            const int vb = (int)(lds0 + L_VS + (gi * 2 + (ks >> 2)) * 8192 + (ks & 3) * 1024) + ((lane >> 4) & 1) * 32 + (lane & 3) * 8 + (4 * hi + ((lane & 15) >> 2)) * 64;
            s16x4 lo[2], hh[2];
#pragma unroll
            for (int d0 = 0; d0 < 2; ++d0) {
                asm volatile("ds_read_b64_tr_b16 %0,%1 offset:%c2" : "=&v"(lo[d0]) : "v"(vb), "i"(d0 * 4096) : "memory");
                asm volatile("ds_read_b64_tr_b16 %0,%1 offset:%c2" : "=&v"(hh[d0]) : "v"(vb), "i"(d0 * 4096 + 512) : "memory"); }
            asm volatile("s_waitcnt lgkmcnt(0)" ::: "memory"); __builtin_amdgcn_sched_barrier(0);
#pragma unroll
            for (int d0 = 0; d0 < 2; ++d0) { const bf16x8 vf = (bf16x8){lo[d0][0], lo[d0][1], lo[d0][2], lo[d0][3], hh[d0][0], hh[d0][1], hh[d0][2], hh[d0][3]};
                o[d0] = __builtin_amdgcn_mfma_f32_32x32x16_bf16(pa[ks], vf, o[d0], 0, 0, 0); }
        }
        LAS float* stg = (LAS float*)(lds + L_STG) + wid * 2048;
#pragma unroll
        for (int r = 0; r < 16; ++r) { const int q = crow(r, hi); const float b_ = bq[r >> 2][r & 3]; stg[q * 64 + r32] = o[0][r] + b_; stg[q * 64 + 32 + r32] = o[1][r] + b_; }
        LDS_WAIT();
#pragma unroll
        for (int i = 0; i < 4; ++i) { const int row = i * 8 + (lane >> 3), ch = lane & 7;
            const f32x4 m0 = *(const LAS f32x4*)(stg + row * 64 + ch * 8), m1 = *(const LAS f32x4*)(stg + row * 64 + ch * 8 + 4);
            const size_t uo = (size_t)(tok0 + 32 * pb + row) * D + 64 * g + ch * 8; const u32x4 u4 = uu[i];
            u32x4 w; w.x = cvt_pk_bf16(bf2f(u4.x & 0xffffu) * m0[0], bf2f(u4.x >> 16) * m0[1]); w.y = cvt_pk_bf16(bf2f(u4.y & 0xffffu) * m0[2], bf2f(u4.y >> 16) * m0[3]);
            w.z = cvt_pk_bf16(bf2f(u4.z & 0xffffu) * m1[0], bf2f(u4.z >> 16) * m1[1]); w.w = cvt_pk_bf16(bf2f(u4.w & 0xffffu) * m1[2], bf2f(u4.w >> 16) * m1[3]);
            st16_sel(Og + uo, w, wt_last); }
    }
    __syncthreads();
}
}

template <bool UP, bool GAIN>
__device__ __forceinline__ void transpose_item(const float* W, int K, int N, const float* gain, bf16_t* WT, LAS float* scr, int item, int lane) {
    const int nblk = N / 32, kb = item / nblk, nb = item % nblk, k0 = 64 * kb, n0 = 32 * nb;
    f32x4 v[8]; float gk[8];
#pragma unroll
    for (int i = 0; i < 8; ++i) { const int kk = 8 * i + (lane >> 3), n4 = (lane & 7) * 4; v[i] = *(const f32x4*)(W + (size_t)(k0 + kk) * N + n0 + n4); gk[i] = GAIN ? gain[k0 + kk] : 1.0f; }
#pragma unroll
    for (int i = 0; i < 8; ++i) { const int kk = 8 * i + (lane >> 3), n4 = (lane & 7) * 4; const f32x4 x = GAIN ? v[i] * gk[i] : v[i];
        scr[kk * 33 + n4] = x[0]; scr[kk * 33 + n4 + 1] = x[1]; scr[kk * 33 + n4 + 2] = x[2]; scr[kk * 33 + n4 + 3] = x[3]; }
    LDS_WAIT(); asm volatile("" ::: "memory");
    const int c = lane & 7;
#pragma unroll
    for (int jj = 0; jj < 4; ++jj) { const int n = (lane >> 3) + 8 * jj; const LAS float* s = scr + (8 * c) * 33 + n;
        u32x4 o; o.x = cvt_pk_bf16(s[0 * 33], s[1 * 33]); o.y = cvt_pk_bf16(s[2 * 33], s[3 * 33]); o.z = cvt_pk_bf16(s[4 * 33], s[5 * 33]); o.w = cvt_pk_bf16(s[6 * 33], s[7 * 33]);
        int dn = n0 + n; if (UP) { const int v = dn >= FF ? 1 : 0, gc = dn - v * FF; dn = 256 * (gc >> 7) + 128 * v + (gc & 127); }
        *(u32x4*)(WT + (size_t)dn * K + k0 + 8 * c) = o; }
    LDS_WAIT(); asm volatile("" ::: "memory");
}

#define XB_TMO      128
#define XB_XCNT(j)  (256  + 64 * (j))
#define XB_XSUB(j)  (1280 + 64 * (j))
#define XB_XGEN(j)  (2304 + 64 * (j))
#define XB_TOP      3328
#define XB_TOPGEN   3392
#define XCD_BAR_WORDS 3456
#define XB_SPIN_CAP (1u << 18)
__device__ __forceinline__ unsigned xb_ld(unsigned* p)              { return __hip_atomic_load(p, __ATOMIC_RELAXED, __HIP_MEMORY_SCOPE_AGENT); }
__device__ __forceinline__ unsigned xb_add(unsigned* p, unsigned v) { return __hip_atomic_fetch_add(p, v, __ATOMIC_RELAXED, __HIP_MEMORY_SCOPE_AGENT); }
__device__ __forceinline__ unsigned xb_xcc_id() { return (unsigned)__builtin_amdgcn_s_getreg((3 << 11) | 20) & 0xFu; }
#define XB_SPIN(cond, bar) do { unsigned _sp = 0; while (cond) { __builtin_amdgcn_s_sleep(1); \
    if ((++_sp & 255u) == 0u) { if (xb_ld(&(bar)[XB_TMO])) break; if (_sp > XB_SPIN_CAP) { atomicAdd(&(bar)[XB_TMO], 1u); break; } } } } while (0)
struct XcdBarrier { unsigned* bar; unsigned x; volatile LAS unsigned* st; };
__device__ __forceinline__ void xcd_barrier_complete(unsigned* bar, unsigned x, unsigned& nloc, unsigned& nx) {
    const unsigned G = gridDim.x * gridDim.y * gridDim.z;
    unsigned sum, cnt, mine, sp = 0u;
    for (;;) {
        sum = 0u; cnt = 0u; mine = 0u;
#pragma unroll
        for (unsigned j = 0; j < 16; ++j) { const unsigned c = xb_ld(&bar[XB_XCNT(j)]); sum += c; cnt += (c > 0u) ? 1u : 0u; mine = (j == x) ? c : mine; }
        if (sum == G) break;
        __builtin_amdgcn_s_sleep(1);
        if ((++sp & 255u) == 0u) { if (xb_ld(&bar[XB_TMO])) break; if (sp > XB_SPIN_CAP) { atomicAdd(&bar[XB_TMO], 1u); break; } }
    }
    nloc = mine > 0u ? mine : 1u; nx = cnt > 0u ? cnt : 1u;
}
__device__ __forceinline__ void xcd_barrier(const XcdBarrier& b, const int tid) {
    asm volatile("s_waitcnt vmcnt(0)" ::: "memory");
    __syncthreads();
    if (tid == 0) {
        unsigned* bar = b.bar;
        __builtin_amdgcn_s_waitcnt(0);
        unsigned nloc = b.st[0], nx = b.st[1];
        if (nloc == 0u) { xcd_barrier_complete(bar, b.x, nloc, nx); b.st[0] = nloc; b.st[1] = nx; }
        const unsigned old = xb_add(&bar[XB_XSUB(b.x)], 1u);
        const unsigned gen = old / nloc;
        if (old + 1u == (gen + 1u) * nloc) {
            __builtin_amdgcn_fence(__ATOMIC_RELEASE, "agent");
            asm volatile("s_waitcnt vmcnt(0)" ::: "memory");
            const unsigned og = xb_add(&bar[XB_TOP], 1u);
            const unsigned tg = og / nx;
            if (og + 1u == (tg + 1u) * nx) xb_add(&bar[XB_TOPGEN], 1u);
            else XB_SPIN(xb_ld(&bar[XB_TOPGEN]) == tg, bar);
            __builtin_amdgcn_fence(__ATOMIC_ACQUIRE, "agent");
            xb_add(&bar[XB_XGEN(b.x)], 1u);
            asm volatile("s_waitcnt vmcnt(0)" ::: "memory");
        } else {
            XB_SPIN(xb_ld(&bar[XB_XGEN(b.x)]) == gen, bar);
            __builtin_amdgcn_fence(__ATOMIC_ACQUIRE, "agent");
            asm volatile("s_waitcnt vmcnt(0)" ::: "memory");
        }
    }
    __syncthreads();
}

template <int NQ>
__device__ __forceinline__ void p0_rows(const int m0, const int lane, const float* x_prompt, const float* x_sample, bf16_t* XB, float* SSQ, float* SSQS) {
    f32x4 v[NQ][4];
#pragma unroll
    for (int q = 0; q < NQ; ++q) { const int m = m0 + q; const float* xr = m < MP ? x_prompt + (size_t)m * D : x_sample + (size_t)(m - MP) * D;
#pragma unroll
        for (int jj = 0; jj < 4; ++jj) v[q][jj] = ((const f32x4*)xr)[2 * lane + (jj & 1) + 128 * (jj >> 1)]; }
#pragma unroll
    for (int q = 0; q < NQ; ++q) { const int m = m0 + q; float s = 0.f;
#pragma unroll
        for (int jj = 0; jj < 4; ++jj) s += (v[q][jj][0] * v[q][jj][0] + v[q][jj][1] * v[q][jj][1]) + (v[q][jj][2] * v[q][jj][2] + v[q][jj][3] * v[q][jj][3]);
        s = wave_sum(s);
#pragma unroll
        for (int j2 = 0; j2 < 2; ++j2) { u32x4 w; w.x = cvt_pk_bf16(v[q][2 * j2][0], v[q][2 * j2][1]); w.y = cvt_pk_bf16(v[q][2 * j2][2], v[q][2 * j2][3]);
            w.z = cvt_pk_bf16(v[q][2 * j2 + 1][0], v[q][2 * j2 + 1][1]); w.w = cvt_pk_bf16(v[q][2 * j2 + 1][2], v[q][2 * j2 + 1][3]); st16_wt((u32x4*)(XB + (size_t)m * D) + lane + 64 * j2, w); }
        if (m < MP) { if (lane < 4) SSQ[(size_t)lane * MT + m] = lane == 0 ? s : 0.f; }
        else { if (lane < 32) SSQS[(size_t)lane * MS + (m - MP)] = lane == 0 ? s : 0.f; } }
}

constexpr int WGM_QKV = 4, WGM_RES = 4, WGM_UP = 4, WGM_IN = 4;
#define PH(k)
struct Args { const float* in[20]; float* out; unsigned char* ws; };

__global__ void __launch_bounds__(NTHR, 2) fwd_kernel(Args a) {
    extern __shared__ __attribute__((aligned(16))) unsigned char lds_raw[];
    LAS unsigned char* lds = (LAS unsigned char*)lds_raw;
    const int wave0 = __builtin_amdgcn_readfirstlane((int)threadIdx.x >> 6);
    XcdBarrier bar;
    { volatile LAS unsigned* MISC = (volatile LAS unsigned*)(lds + L_MISC);
        if (threadIdx.x < 4) MISC[threadIdx.x] = 0u;
        __syncthreads();
        bar.bar = (unsigned*)(a.ws + WS_CTL); bar.x = xb_xcc_id(); bar.st = MISC;
        if (threadIdx.x == 0) (void)xb_add(&bar.bar[XB_XCNT(bar.x)], 1u); }
#define GRID_BAR() do { PHASE_VARS xcd_barrier(bar, tid); } while (0)
#define PHASE_VARS int tid; asm volatile("v_mbcnt_lo_u32_b32 %0, -1, 0\n\tv_mbcnt_hi_u32_b32 %0, -1, %0" : "=v"(tid)); tid |= wave0 << 6; const int lane = tid & 63, wave = wave0; (void)lane; (void)wave;
    const int G = gridDim.x, bx = blockIdx.x; const int vcu = (G % 8 == 0) ? (bx % 8) * (G / 8) + bx / 8 : bx;
    unsigned char* ws = a.ws; float* out = a.out;
    const float *x_prompt = a.in[0], *x_sample = a.in[1], *cache_k = a.in[2], *cache_v = a.in[3], *state_conv = a.in[4], *ln_mix = a.in[5], *ln_ffn = a.in[6], *ln_final = a.in[7],
                *w_qkv = a.in[8], *rel_bias = a.in[9], *w_o = a.in[10], *w_in = a.in[11], *v_norm = a.in[12], *w_s = a.in[13], *bias_s = a.in[14], *w_out = a.in[15],
                *w_up = a.in[16], *conv_w = a.in[17], *conv_b = a.in[18], *w_down = a.in[19];
    bf16_t *Wqkv_t = (bf16_t*)(ws + WS_WQKV), *Wo_t = (bf16_t*)(ws + WS_WO), *Win_t = (bf16_t*)(ws + WS_WIN), *Wout_t = (bf16_t*)(ws + WS_WOUT);
    bf16_t *XB = (bf16_t*)(ws + WS_XB), *QB = (bf16_t*)(ws + WS_Q), *KB = (bf16_t*)(ws + WS_K), *VB = (bf16_t*)(ws + WS_V), *GB = (bf16_t*)(ws + WS_G), *OB = (bf16_t*)(ws + WS_OB);
    float *SSQ = (float*)(ws + WS_SSQ), *SSQV = (float*)(ws + WS_SSQV), *SSQS = (float*)(ws + WS_SSQS), *SSQVS = (float*)(ws + WS_SSQVS);

    PH(0) { PHASE_VARS
        LAS float* scr = (LAS float*)(lds + wave * 16384);
        const int gw = vcu * NWAVES + wave, NGW = G * NWAVES;
        constexpr int I_QKV = (D / 64) * (3 * D / 32), I_O = (D / 64) * (D / 32), I_IN = (D / 64) * (2 * D / 32), I_UP = (D / 64) * (FF2 / 32), I_DN = (FF / 64) * (D / 32);
        for (int it = gw; it < I_QKV + I_O; it += NGW) { if (it < I_QKV) transpose_item<false, true>(w_qkv, D, 3 * D, ln_mix, Wqkv_t, scr, it, lane); else transpose_item<false, false>(w_o, D, D, nullptr, Wo_t, scr, it - I_QKV, lane); }
        for (int m0 = gw * 4; m0 < MP; m0 += NGW * 4) p0_rows<4>(m0, lane, x_prompt, x_sample, XB, SSQ, SSQS);
        for (int m0 = MP + (NGW - 1 - gw); m0 < MT; m0 += NGW) p0_rows<1>(m0, lane, x_prompt, x_sample, XB, SSQ, SSQS);
        for (int c = (vcu * NWAVES + wave) * 64 + lane; c < 16 * 128 * 16; c += G * NTHR) { const int hi_ = c & 1, ks = (c >> 1) & 7, gp_ = c >> 4;
            const float* src = w_s + (size_t)gp_ * 128 + 16 * ks + 4 * hi_; const f32x4 a0 = *(const f32x4*)src, a1 = *(const f32x4*)(src + 8);
            u32x4 w; w.x = cvt_pk_bf16(a0[0], a0[1]); w.y = cvt_pk_bf16(a0[2], a0[3]); w.z = cvt_pk_bf16(a1[0], a1[1]); w.w = cvt_pk_bf16(a1[2], a1[3]);
            ((u32x4*)(ws + WS_WSB))[c] = w; }
    }
    GRID_BAR();

    PH(1) { PHASE_VARS
        pg8::Gemm g{XB, Wqkv_t, D}; pg8::StaticOrder S; S.init(MP / 256, 3 * D / 256, G, bx, 0, WGM_QKV);
        EpiQKV E{QB, (size_t)(WS_K - WS_Q) / 2, SSQ, out + O_KP, out + O_VP, G == 256};
        typedef SampleRider<D, 96, SQkv> RQ; const RQ R{XB, Wqkv_t, SQkv{SSQS, QB, KB, VB, out + O_KS, out + O_VS}};
        pg8::gemm_phase<EpiQKV, pg8::StaticOrder, RQ>(lds, g, S, E, tid, R);
        if (G == 256) { static_assert(WGM_QKV == 4, "the P1 -> P2 hand-off assumes StaticOrder's WGM_QKV = 4 mapping");
            asm volatile("s_waitcnt vmcnt(0)" ::: "memory"); __syncthreads();
            if (tid == 0) { unsigned* fq_ = (unsigned*)(ws + WS_CTL) + CW_QKV;
                for (int i = 0; i < 3; ++i) { const int L = i * 256 + bx, wgid = (L & 7) * 96 + (L >> 3), w_ = wgid % 48, pm_ = (wgid / 48) * 4 + (w_ & 3), pn_ = w_ >> 2;
                    __hip_atomic_store(fq_ + pm_ * 12 + pn_, 1u, __ATOMIC_RELAXED, __HIP_MEMORY_SCOPE_AGENT);
                    __hip_atomic_fetch_add(fq_ + 768 + 4 * (L / 96), 1u, __ATOMIC_RELAXED, __HIP_MEMORY_SCOPE_AGENT); } } }
    }
    float pbv = 0.f, pb0 = 0.f;
    { PHASE_VARS const int per_ = (NB * NH * 32 + G - 1) / G, h_ = ((vcu * per_) >> 5) % NH;
        if (tid < 320 && vcu * per_ < NB * NH * 32) { const int j = 319 - tid; pbv = rel_bias[h_ * NREL + (j > 256 ? 256 : j)]; pb0 = rel_bias[h_ * NREL + 256]; } }
    if (G != 256) GRID_BAR();

    PH(2) { PHASE_VARS
        LAS float* tab = (LAS float*)(lds + att::L_BIAS);
        const int per = (NB * NH * 32 + G - 1) / G;
        int lasth = -1;
        if (G == 256) {
            if (tid == 0) { unsigned* fq_ = (unsigned*)(ws + WS_CTL) + CW_QKV; const int bh_ = vcu >> 3, b_ = bh_ / NH, h_ = bh_ % NH, g_ = vcu & 7;
                const int p0_ = 4 * g_ - 2 < 0 ? 0 : 4 * g_ - 2, p1_ = 4 * g_ + 3, sb_ = (vcu & 3) + 4 * (vcu >> 7); const bool smp_ = (vcu & 7) < 4; unsigned sp = 0;
                for (;;) { bool ok = !smp_ || __hip_atomic_load(fq_ + 768 + 4 * sb_, __ATOMIC_RELAXED, __HIP_MEMORY_SCOPE_AGENT) >= 96u;
                    for (int p_ = p0_; p_ <= p1_; ++p_) for (int t_ = 0; t_ < 3; ++t_) ok = ok && __hip_atomic_load(fq_ + (b_ * 32 + p_) * 12 + 4 * t_ + (h_ >> 2), __ATOMIC_RELAXED, __HIP_MEMORY_SCOPE_AGENT) != 0u;
                    if (ok) break; __builtin_amdgcn_s_sleep(2); if (++sp > (1u << 20)) break; }
                __builtin_amdgcn_fence(__ATOMIC_ACQUIRE, "agent"); }
            asm volatile("s_waitcnt vmcnt(0)" ::: "memory"); __syncthreads(); }
        if (vcu * per < NB * NH * 32) { if (tid < 320) { const float tv = pbv * LOG2E; tab[tid] = tv; ((LAS float*)(lds + att::L_BIAS2))[tid] = tv - pb0 * LOG2E; } __syncthreads(); lasth = ((vcu * per) >> 5) % NH; }
        const int id_end = ((vcu + 1) * per < NB * NH * 32) ? (vcu + 1) * per : NB * NH * 32;
        for (int id = vcu * per; id < id_end; ) { const int bh = id >> 5, qg = id & 31, b = bh / NH, h = bh % NH;
            if (h != lasth) { __syncthreads(); for (int i = tid; i < 320; i += NTHR) { const int j = 319 - i; const float tv = rel_bias[h * NREL + (j > 256 ? 256 : j)] * LOG2E; tab[i] = tv; ((LAS float*)(lds + att::L_BIAS2))[i] = tv - rel_bias[h * NREL + 256] * LOG2E; } __syncthreads(); lasth = h; }
            if (qg >= 2) { int nun = id_end - id; if (nun > 32 - qg) nun = 32 - qg;
                att::prompt_unit_fast<8>(b, h, qg, nun, QB, KB, VB, OB, lds, tid); id += nun; }
            else { att::prompt_unit(b, h, qg, QB, KB, VB, OB, lds, tid); ++id; } }
        const bool fuse23 = (G == 256); unsigned* catt = (unsigned*)(ws + WS_CTL) + CW_ATT;
        if (fuse23) { asm volatile("s_waitcnt vmcnt(0)" ::: "memory"); __syncthreads();
            if (tid == 0) for (int id = vcu * per; id < id_end; ++id) __hip_atomic_fetch_add(catt + 4 * (((id >> 5) / NH) * 32 + (id & 31)), 1u, __ATOMIC_RELAXED, __HIP_MEMORY_SCOPE_AGENT); }
        const bool std_grid = (G == 256);
        for (int n_ = 0; n_ < (std_grid ? ((vcu & 7) < 4 ? 1 : 0) : (DB * NH - vcu + G - 1) / G); ++n_) {
            const int id = std_grid ? 0 : vcu + n_ * G; const int b = std_grid ? (vcu & 3) + 4 * (vcu >> 7) : id / NH, h = std_grid ? ((vcu >> 3) & 15) : id % NH;
            if (h != lasth) { __syncthreads(); for (int i = tid; i < 320; i += NTHR) { const int j = 319 - i; const float tv = rel_bias[h * NREL + (j > 256 ? 256 : j)] * LOG2E; tab[i] = tv; ((LAS float*)(lds + att::L_BIAS2))[i] = tv - rel_bias[h * NREL + 256] * LOG2E; } __syncthreads(); lasth = h; }
            att::sample_unit(b, h, QB, KB, VB, cache_k, cache_v, OB, lds, tid);
            if (fuse23) { asm volatile("s_waitcnt vmcnt(0)" ::: "memory"); __syncthreads(); if (tid == 0) __hip_atomic_fetch_add(catt + 4 * (64 + b), 1u, __ATOMIC_RELAXED, __HIP_MEMORY_SCOPE_AGENT); } }
        __syncthreads();
        { constexpr int I_UP = (D / 64) * (FF2 / 32), I_DN = (FF / 64) * (D / 32), I_IN = (D / 64) * (2 * D / 32), NIT0 = I_UP + I_DN + I_IN;
            LAS float* scr = (LAS float*)(lds + wave * 16384);
          for (int sh = 0; sh < (G == 256 ? 1 : 8); ++sh) {
            const int xq = (int)((bar.x + (unsigned)sh) & 7u); unsigned* qh = (unsigned*)(ws + WS_CTL) + CW_QUEUE0 + 64 * xq;
            const int qlo = xq * (NIT0 / 8), qhi = (xq + 1) * (NIT0 / 8);
            for (;;) { unsigned it0 = 0u; if (lane == 0) it0 = __hip_atomic_fetch_add(qh, 1u, __ATOMIC_RELAXED, __HIP_MEMORY_SCOPE_AGENT); it0 = (unsigned)__builtin_amdgcn_readfirstlane((int)it0);
                if ((int)it0 + qlo >= qhi) break;
              for (int sub = 0; sub < 1; ++sub) {
                int r = qlo + (int)it0 + sub; if (r >= qhi) break;
                if (r < I_UP) { transpose_item<true, true>(w_up, D, FF2, ln_ffn, (bf16_t*)(ws + WS_WUP), scr, r, lane); continue; } r -= I_UP;
                if (r < I_DN) { transpose_item<false, false>(w_down, FF, D, nullptr, (bf16_t*)(ws + WS_WDN), scr, r, lane); continue; } r -= I_DN;
                transpose_item<false, true>(w_in, D, 2 * D, ln_mix + D, Win_t, scr, r, lane); } } }
            __syncthreads(); }
}
    if (G != 256) GRID_BAR();

#define RES_PHASE(A_, Wt_, KK) RES_PHASE2(A_, Wt_, KK, XB, SSQ, SSQS)
#define RES_PHASE2(A_, Wt_, KK, XO_, SSQO_, SSQSO_) do { \
        pg8::Gemm g{A_, Wt_, KK}; pg8::StaticOrder S; S.init(MP / 256, D / 256, G, bx, 0, WGM_RES); \
        EpiRes E{XB, XO_, SSQO_}; \
        typedef SampleRider<KK, 32, SRes> RR; const RR R{A_, Wt_, SRes{XB, XO_, SSQSO_}};     \
        pg8::gemm_phase<EpiRes, pg8::StaticOrder, RR>(lds, g, S, E, tid, R); } while (0)
    PH(3) { PHASE_VARS
        if (G == 256) { const int pm0 = 4 * (vcu >> 4) + (vcu & 3), mt0 = bx >> 5;
            if (tid == 0) { unsigned* catt = (unsigned*)(ws + WS_CTL) + CW_ATT; unsigned sp = 0;
                while (__hip_atomic_load(catt + 4 * pm0, __ATOMIC_RELAXED, __HIP_MEMORY_SCOPE_AGENT) < 16u || __hip_atomic_load(catt + 4 * (64 + mt0), __ATOMIC_RELAXED, __HIP_MEMORY_SCOPE_AGENT) < 16u) {
                    __builtin_amdgcn_s_sleep(2); if (++sp > (1u << 22)) break; }
                __builtin_amdgcn_fence(__ATOMIC_ACQUIRE, "agent"); }
            asm volatile("s_waitcnt vmcnt(0)" ::: "memory"); __syncthreads(); }
        RES_PHASE(OB, Wo_t, D); }
    GRID_BAR();

#define UP_PHASE(L_) do { \
        const bf16_t* Wup_ = (const bf16_t*)(ws + WS_WUP + (L_) * WUP_L); const float* cw_ = conv_w + (size_t)(L_) * 3 * FF2; const float* cb_ = conv_b + (size_t)(L_) * FF2; \
        pg8::Gemm g{XB, Wup_, D}; pg8::StaticOrder S; S.init(67, FF2 / 256, G, bx, 1, WGM_UP); \
        EpiUp E{GB, SSQ, SSQS, cw_, cb_, out + O_CP + (size_t)(L_) * NB * 2 * FF2, state_conv + (size_t)(L_) * DB * 2 * FF2, out + O_CS + (size_t)(L_) * DB * 2 * FF2}; \
        pg8::gemm_phase<EpiUp, pg8::StaticOrder>(lds, g, S, E, tid); } while (0)
    PH(4) { PHASE_VARS UP_PHASE(0);
        { constexpr int I_O = (D / 64) * (D / 32), I_UP = (D / 64) * (FF2 / 32), NIT1 = I_O + I_UP;
            LAS float* scr = (LAS float*)(lds + wave * 16384);
          for (int sh = 0; sh < (G == 256 ? 1 : 8); ++sh) {
            const int xq = (int)((bar.x + (unsigned)sh) & 7u); unsigned* qh = (unsigned*)(ws + WS_CTL) + CW_QUEUE + 64 * xq;
            const int qlo = xq * (NIT1 / 8), qhi = (xq + 1) * (NIT1 / 8);
            for (;;) { unsigned it0 = 0u; if (lane == 0) it0 = __hip_atomic_fetch_add(qh, 1u, __ATOMIC_RELAXED, __HIP_MEMORY_SCOPE_AGENT); it0 = (unsigned)__builtin_amdgcn_readfirstlane((int)it0);
                if ((int)it0 + qlo >= qhi) break;
              for (int sub = 0; sub < 1; ++sub) {
                int r = qlo + (int)it0 + sub; if (r >= qhi) break;
                if (r < I_O) { transpose_item<false, false>(w_out, D, D, nullptr, Wout_t, scr, r, lane); continue; } r -= I_O;
                transpose_item<true, true>(w_up + (size_t)D * FF2, D, FF2, ln_ffn + D, (bf16_t*)(ws + WS_WUP + WUP_L), scr, r, lane); } } }
            __syncthreads(); } }
    GRID_BAR();
    PH(5) { PHASE_VARS RES_PHASE(GB, (const bf16_t*)(ws + WS_WDN), FF); }
    GRID_BAR();

    const bool fuse78 = (G == 256);
    PH(6) { PHASE_VARS
        pg8::Gemm g{XB, Win_t, D}; pg8::StaticOrder S; S.init(MP / 256, 2 * D / 256, G, bx, 0, WGM_IN);
        EpiIn E{QB, (size_t)(WS_K - WS_Q) / 2, SSQ, SSQV, fuse78};
        typedef SampleRider<D, 64, SIn> RI; const RI R{XB, Win_t, SIn{SSQS, QB, KB, SSQVS}};
        pg8::gemm_phase<EpiIn, pg8::StaticOrder, RI>(lds, g, S, E, tid, R);
        if (fuse78) { static_assert(WGM_IN == 4, "the P6 -> P7 hand-off assumes StaticOrder's WGM_IN = 4 mapping");
            asm volatile("s_waitcnt vmcnt(0)" ::: "memory"); __syncthreads();
            if (tid == 0) { unsigned* c6 = (unsigned*)(ws + WS_CTL) + CW_GATE6; const int x_ = bx & 7, o_ = bx >> 3;
                for (int i = 0; i < 2; ++i) { __hip_atomic_fetch_add(c6 + 4 * (8 * x_ + 4 * i + (o_ & 3)), 1u, __ATOMIC_RELAXED, __HIP_MEMORY_SCOPE_AGENT);
                    __hip_atomic_fetch_add(c6 + 4 * (64 + 4 * i + (bx >> 6)), 1u, __ATOMIC_RELAXED, __HIP_MEMORY_SCOPE_AGENT); } } }
    }
    if (!fuse78) GRID_BAR();

    PH(7) { PHASE_VARS
        const int per = (128 * 8 + G - 1) / G; unsigned* cntp = (unsigned*)(ws + WS_CTL) + CW_GATE; unsigned* c6 = (unsigned*)(ws + WS_CTL) + CW_GATE6;
        if (fuse78) { if (tid == 0) { unsigned sp = 0;
                while (__hip_atomic_load(c6 + 4 * (vcu >> 2), __ATOMIC_RELAXED, __HIP_MEMORY_SCOPE_AGENT) < 8u || (vcu < DB * 8 && __hip_atomic_load(c6 + 4 * (64 + (vcu >> 3)), __ATOMIC_RELAXED, __HIP_MEMORY_SCOPE_AGENT) < 64u)) {
                    __builtin_amdgcn_s_sleep(2); if (++sp > (1u << 22)) break; }
                __builtin_amdgcn_fence(__ATOMIC_ACQUIRE, "agent"); }
            asm volatile("s_waitcnt vmcnt(0)" ::: "memory"); __syncthreads(); }
        for (int id = vcu * per; id < (vcu + 1) * per && id < 128 * 8; ++id) gate::unit(true, false, id >> 3, id & 7, QB, VB, KB, SSQV, SSQVS, v_norm, (const bf16_t*)(ws + WS_WSB), bias_s, out + O_GV, lds, tid);
        if (fuse78) { asm volatile("s_waitcnt vmcnt(0)" ::: "memory"); __syncthreads();
            if (tid == 0) __hip_atomic_fetch_add(cntp + 4 * (vcu >> 2), 1u, __ATOMIC_RELAXED, __HIP_MEMORY_SCOPE_AGENT); }
        for (int id = vcu; id < DB * 8; id += G) { gate::unit(true, true, id >> 3, id & 7, QB, VB, KB, SSQV, SSQVS, v_norm, (const bf16_t*)(ws + WS_WSB), bias_s, out + O_GV, lds, tid);
            if (fuse78) { asm volatile("s_waitcnt vmcnt(0)" ::: "memory"); __syncthreads();
                if (tid == 0) __hip_atomic_fetch_add(cntp + 4 * (64 + (id >> 3)), 1u, __ATOMIC_RELAXED, __HIP_MEMORY_SCOPE_AGENT); } }
    }
    if (!fuse78) GRID_BAR();

    PH(8) { PHASE_VARS
        if (fuse78) { const int pm0 = 4 * (vcu >> 4) + (vcu & 3), mt0 = bx >> 5;
            static_assert(WGM_RES == 4, "the P7 -> P8 hand-off assumes StaticOrder's WGM_RES = 4 mapping");
            if (tid == 0) { unsigned* cntp = (unsigned*)(ws + WS_CTL) + CW_GATE; unsigned sp = 0;
                while (__hip_atomic_load(cntp + 4 * pm0, __ATOMIC_RELAXED, __HIP_MEMORY_SCOPE_AGENT) < 4u || __hip_atomic_load(cntp + 4 * (64 + mt0), __ATOMIC_RELAXED, __HIP_MEMORY_SCOPE_AGENT) < 8u) {
                    __builtin_amdgcn_s_sleep(2); if (++sp > (1u << 22)) break; }
                __builtin_amdgcn_fence(__ATOMIC_ACQUIRE, "agent"); }
            asm volatile("s_waitcnt vmcnt(0)" ::: "memory"); __syncthreads(); }
        RES_PHASE(VB, Wout_t, D); }
    GRID_BAR();
    PH(9) { PHASE_VARS UP_PHASE(1);
        { constexpr int NIT2 = (FF / 64) * (D / 32);
            LAS float* scr = (LAS float*)(lds + wave * 16384);
          for (int sh = 0; sh < (G == 256 ? 1 : 8); ++sh) {
            const int xq = (int)((bar.x + (unsigned)sh) & 7u); unsigned* qh = (unsigned*)(ws + WS_CTL) + CW_QUEUE2 + 64 * xq;
            const int qlo = xq * (NIT2 / 8), qhi = (xq + 1) * (NIT2 / 8);
            for (;;) { unsigned it0 = 0u; if (lane == 0) it0 = __hip_atomic_fetch_add(qh, 1u, __ATOMIC_RELAXED, __HIP_MEMORY_SCOPE_AGENT); it0 = (unsigned)__builtin_amdgcn_readfirstlane((int)it0);
                if ((int)it0 + qlo >= qhi) break;
                transpose_item<false, false>(w_down + (size_t)FF * D, FF, D, nullptr, (bf16_t*)(ws + WS_WDN + WDN_L), scr, qlo + (int)it0, lane); } }
            __syncthreads(); } }
    GRID_BAR();
    PH(10) { PHASE_VARS
        const bf16_t* Wdn_ = (const bf16_t*)(ws + WS_WDN + WDN_L); unsigned* ctl = (unsigned*)(ws + WS_CTL); float* XCHS = (float*)(ws + WS_XCHS);
        pg8::Gemm g{GB, Wdn_, FF}; pg8::StaticOrder S; S.init(MP / 256, D / 256, G, bx, 0, WGM_RES);
        EpiFinal E{XB, out + O_YP, (float*)(ws + WS_XCH), ctl + CW_PANEL, ln_final};
        typedef SampleRider<FF, 32, SFin> RF; const RF R{GB, Wdn_, SFin{XB, XCHS, ctl + CW_SPANEL, ln_final, out + O_YS}};
        pg8::gemm_phase<EpiFinal, pg8::StaticOrder, RF>(lds, g, S, E, tid, R); }
}

extern "C" void kernel_launch(void* const* d_in, const int* in_sizes, int n_in, void* d_out, int out_size, void* d_ws, size_t ws_size, hipStream_t stream) {
    static int grid = 0;
    if (grid == 0) {
        if (n_in != 20 || (size_t)out_size != O_END || ws_size < WS_END) { fprintf(stderr, "kernel_launch: unexpected sizes n_in %d out %d ws %zu\n", n_in, out_size, ws_size); grid = -1; return; }
        int dev = 0, cus = 0, per_cu = 0;
        if (hipGetDevice(&dev) != hipSuccess || hipDeviceGetAttribute(&cus, hipDeviceAttributeMultiprocessorCount, dev) != hipSuccess) { grid = -1; return; }
        if (hipFuncSetAttribute((const void*)fwd_kernel, hipFuncAttributeMaxDynamicSharedMemorySize, LDS_BYTES) != hipSuccess) { fprintf(stderr, "kernel_launch: hipFuncSetAttribute failed\n"); grid = -1; return; }
        if (hipOccupancyMaxActiveBlocksPerMultiprocessor(&per_cu, (const void*)fwd_kernel, NTHR, LDS_BYTES) != hipSuccess || per_cu < 1) { fprintf(stderr, "kernel_launch: occupancy query says %d\n", per_cu); per_cu = 1; }
        (void)hipGetLastError();
        grid = cus;
    }
    if (grid < 0) return;
    Args a{};
    for (int i = 0; i < 20; ++i) a.in[i] = (const float*)d_in[i];
    a.out = (float*)d_out; a.ws = (unsigned char*)d_ws;
    if (hipMemsetAsync((char*)d_ws + WS_CTL, 0, CTL_BYTES, stream) != hipSuccess) { fprintf(stderr, "kernel_launch: memset of the barrier words failed\n"); return; }
    hipLaunchKernelGGL(fwd_kernel, dim3(grid), dim3(NTHR), LDS_BYTES, stream, a);
    const hipError_t e = hipPeekAtLastError();
    if (e != hipSuccess) fprintf(stderr, "kernel_launch: launch failed: %s (grid %d)\n", hipGetErrorName(e), grid);
}
```
